# Optimizing an MI355X kernel written in HIP

```python
import math
import jax, jax.numpy as jnp
from jax import lax
import numpy as np

D_MODEL = 1024
BATCH = 8
SEQ = 4096
DEPTH = 1

CHUNK = 64
Q_BLOCK = 128
EPS = 1e-6

MIX_WIDTH = D_MODEL
SB_HEAD_DIM = 64
SB_HEADS = (MIX_WIDTH // 2) // SB_HEAD_DIM
SB_WIDTH = SB_HEADS * SB_HEAD_DIM
MLA_V = 64
MLA_HEADS = (MIX_WIDTH - SB_WIDTH) // MLA_V
MLA_WIDTH = MLA_HEADS * MLA_V
MLA_NOPE = 64
MLA_ROPE = 32
MLA_Q_RANK = 384
MLA_KV_RANK = 256
ROPE_THETA = 10000.0

IN_SPLITS = (SB_WIDTH, SB_WIDTH, SB_WIDTH, MLA_Q_RANK, MLA_KV_RANK, MLA_ROPE)
IN_WIDTH = sum(IN_SPLITS)

MEM_TOKENS = 256
MEM_HEADS = 4
MEM_HEAD_DIM = D_MODEL // MEM_HEADS

N_GROUPS = 4
EXPERTS_PER_GROUP = 4
N_EXPERTS = N_GROUPS * EXPERTS_PER_GROUP
EXPERT_TOP_K = 2
EXPERT_FF = 512

kernel_name = "hybrid_stickbreak_mla_mem_hmoe_layer"


def rms_norm(x, g):
    xf = x.astype(jnp.float32)
    y = xf * lax.rsqrt(jnp.mean(xf * xf, axis=-1, keepdims=True) + EPS)
    return (y * g.astype(jnp.float32)).astype(x.dtype)


def rope_tables(positions, rot_dim, dtype):
    half = rot_dim // 2
    inv_freq = ROPE_THETA ** (-(jnp.arange(half, dtype=jnp.float32) * 2.0 / rot_dim))
    ang = positions.astype(jnp.float32)[..., None] * inv_freq
    return jnp.cos(ang).astype(dtype), jnp.sin(ang).astype(dtype)


def apply_rope(x, cos, sin):
    half = x.shape[-1] // 2
    x1, x2 = x[..., :half], x[..., half:]
    return jnp.concatenate([x1 * cos - x2 * sin, x2 * cos + x1 * sin], axis=-1)


def stick_breaking_attention(q, k, v):
    S, dh = q.shape[2], q.shape[3]
    scale = dh ** -0.5
    outs = []
    for qb in range(S // Q_BLOCK):
        q0 = qb * Q_BLOCK
        L = q0 + Q_BLOCK
        z = jnp.einsum('bhqd,bhkd->bhqk', q[:, :, q0:L], k[:, :, :L]).astype(jnp.float32) * scale
        t_idx = q0 + jnp.arange(Q_BLOCK)[:, None]
        s_idx = jnp.arange(L)[None, :]
        past = s_idx < t_idx
        log_fail = jnp.where(past, jax.nn.log_sigmoid(-z), 0.0)
        between = lax.cumsum(log_fail, axis=3, reverse=True) - log_fail
        w = jnp.where(past, jnp.exp(jax.nn.log_sigmoid(z) + between), 0.0)
        outs.append(jnp.einsum('bhqk,bhkd->bhqd', w.astype(v.dtype), v[:, :, :L]))
    return jnp.concatenate(outs, axis=2)


def chunk_causal_attention(q, k, v):
    S, dk = q.shape[2], q.shape[3]
    scale = dk ** -0.5
    outs = []
    for qb in range(S // Q_BLOCK):
        q0 = qb * Q_BLOCK
        L = q0 + Q_BLOCK
        s = jnp.einsum('bhqd,bhkd->bhqk', q[:, :, q0:L], k[:, :, :L]).astype(jnp.float32) * scale
        t_chunk = (q0 + jnp.arange(Q_BLOCK))[:, None] // CHUNK
        s_chunk = jnp.arange(L)[None, :] // CHUNK
        s = jnp.where(s_chunk <= t_chunk, s, -jnp.inf)
        p = jax.nn.softmax(s, axis=-1)
        outs.append(jnp.einsum('bhqk,bhkd->bhqd', p.astype(v.dtype), v[:, :, :L]))
    return jnp.concatenate(outs, axis=2)


def setup_inputs(seed: int = 0) -> dict:
    key = jax.random.key(seed)
    ks = jax.random.split(key, 40)
    f32 = jnp.float32

    def w(i, shape, fan_in):
        return jax.random.normal(ks[i], shape, f32) * (fan_in ** -0.5)

    def gain(i, n):
        return 1.0 + 0.05 * jax.random.normal(ks[i], (n,), f32)

    x = jax.random.normal(ks[0], (BATCH, SEQ, D_MODEL), f32)
    mem = jax.random.normal(ks[1], (BATCH, MEM_TOKENS, D_MODEL), f32)
    offsets = jax.random.randint(ks[2], (BATCH, 1), 0, 4096, dtype=jnp.int32)
    positions = offsets + jnp.arange(SEQ, dtype=jnp.int32)[None, :]
    return {
        "x": x,
        "mem": mem,
        "positions": positions,
        "norm_mix_g": gain(3, D_MODEL),
        "w_in": w(4, (D_MODEL, IN_WIDTH), D_MODEL),
        "mla_q_norm_g": gain(5, MLA_Q_RANK),
        "w_uq": w(6, (MLA_Q_RANK, MLA_HEADS * (MLA_NOPE + MLA_ROPE)), MLA_Q_RANK),
        "mla_kv_norm_g": gain(7, MLA_KV_RANK),
        "w_ukv": w(8, (MLA_KV_RANK, MLA_HEADS * (MLA_NOPE + MLA_V)), MLA_KV_RANK),
        "mla_qn_g": gain(9, MLA_NOPE),
        "mla_qr_g": gain(10, MLA_ROPE),
        "mla_kn_g": gain(11, MLA_NOPE),
        "mla_kr_g": gain(12, MLA_ROPE),
        "sb_out_g": gain(13, SB_WIDTH),
        "mla_out_g": gain(14, MLA_WIDTH),
        "w_o": w(15, (MIX_WIDTH, D_MODEL), MIX_WIDTH),
        "norm_mem_g": gain(16, D_MODEL),
        "mem_src_g": gain(17, D_MODEL),
        "w_mq": w(18, (D_MODEL, D_MODEL), D_MODEL),
        "w_mkv": w(19, (D_MODEL, 2 * D_MODEL), D_MODEL),
        "mem_qhead_g": gain(20, MEM_HEAD_DIM),
        "mem_khead_g": gain(21, MEM_HEAD_DIM),
        "w_mo": w(22, (D_MODEL, D_MODEL), D_MODEL),
        "norm_moe_g": gain(23, D_MODEL),
        "w_group": w(24, (D_MODEL, N_GROUPS), D_MODEL),
        "b_group": 0.01 * jax.random.normal(ks[25], (N_GROUPS,), f32),
        "w_router": w(26, (D_MODEL, N_EXPERTS), D_MODEL),
        "b_router": 0.01 * jax.random.normal(ks[27], (N_EXPERTS,), f32),
        "w_gate": w(28, (N_EXPERTS, D_MODEL, EXPERT_FF), D_MODEL),
        "w_up": w(29, (N_EXPERTS, D_MODEL, EXPERT_FF), D_MODEL),
        "w_down": w(30, (N_EXPERTS, EXPERT_FF, D_MODEL), EXPERT_FF),
    }


def reference(x, mem, positions, norm_mix_g, w_in, mla_q_norm_g, w_uq, mla_kv_norm_g, w_ukv,
              mla_qn_g, mla_qr_g, mla_kn_g, mla_kr_g, sb_out_g, mla_out_g, w_o,
              norm_mem_g, mem_src_g, w_mq, w_mkv, mem_qhead_g, mem_khead_g, w_mo,
              norm_moe_g, w_group, b_group, w_router, b_router, w_gate, w_up, w_down):
    B, S, D = x.shape
    cos, sin = rope_tables(positions, MLA_ROPE, x.dtype)
    h = x
    for _ in range(DEPTH):
        hn = rms_norm(h, norm_mix_g)
        proj = hn @ w_in
        cuts = list(np.cumsum(IN_SPLITS)[:-1])
        sb_q, sb_k, sb_v, c_q, c_kv, k_rope = jnp.split(proj, cuts, axis=-1)

        to_heads = lambda t: t.reshape(B, S, SB_HEADS, SB_HEAD_DIM).transpose(0, 2, 1, 3)
        sb = stick_breaking_attention(to_heads(sb_q), to_heads(sb_k), to_heads(sb_v))
        sb = sb.transpose(0, 2, 1, 3).reshape(B, S, SB_WIDTH)

        q = (rms_norm(c_q, mla_q_norm_g) @ w_uq).reshape(B, S, MLA_HEADS, MLA_NOPE + MLA_ROPE)
        kv = (rms_norm(c_kv, mla_kv_norm_g) @ w_ukv).reshape(B, S, MLA_HEADS, MLA_NOPE + MLA_V)
        q_nope = rms_norm(q[..., :MLA_NOPE], mla_qn_g)
        q_rope = rms_norm(q[..., MLA_NOPE:], mla_qr_g)
        k_nope = rms_norm(kv[..., :MLA_NOPE], mla_kn_g)
        v_mla = kv[..., MLA_NOPE:]
        k_rope = rms_norm(k_rope, mla_kr_g)
        q_rope = apply_rope(q_rope, cos[:, :, None], sin[:, :, None])
        k_rope = apply_rope(k_rope, cos, sin)
        q_full = jnp.concatenate([q_nope, q_rope], axis=-1)
        k_full = jnp.concatenate(
            [k_nope, jnp.broadcast_to(k_rope[:, :, None], (B, S, MLA_HEADS, MLA_ROPE))], axis=-1)
        mla = chunk_causal_attention(q_full.transpose(0, 2, 1, 3), k_full.transpose(0, 2, 1, 3),
                                     v_mla.transpose(0, 2, 1, 3))
        mla = mla.transpose(0, 2, 1, 3).reshape(B, S, MLA_WIDTH)

        mixed = jnp.concatenate([rms_norm(sb, sb_out_g), rms_norm(mla, mla_out_g)], axis=-1)
        h = h + mixed @ w_o

        hq = rms_norm(h, norm_mem_g)
        mn = rms_norm(mem, mem_src_g)
        mq = rms_norm((hq @ w_mq).reshape(B, S, MEM_HEADS, MEM_HEAD_DIM), mem_qhead_g)
        mkv = (mn @ w_mkv).reshape(B, MEM_TOKENS, 2, MEM_HEADS, MEM_HEAD_DIM)
        mk = rms_norm(mkv[:, :, 0], mem_khead_g)
        mv = mkv[:, :, 1]
        sc = jnp.einsum('bshd,bmhd->bhsm', mq, mk).astype(jnp.float32) * (MEM_HEAD_DIM ** -0.5)
        p = jax.nn.softmax(sc, axis=-1).astype(mv.dtype)
        mo = jnp.einsum('bhsm,bmhd->bshd', p, mv).reshape(B, S, D)
        h = h + mo @ w_mo

        t = rms_norm(h, norm_moe_g).reshape(B * S, D)
        g_prob = jax.nn.softmax((t @ w_group).astype(jnp.float32) + b_group.astype(jnp.float32), axis=-1)
        g_idx = jnp.argmax(g_prob, axis=-1)
        g_w = jnp.take_along_axis(g_prob, g_idx[:, None], axis=-1)
        e_logits = ((t @ w_router).astype(jnp.float32) + b_router.astype(jnp.float32)
                    ).reshape(-1, N_GROUPS, EXPERTS_PER_GROUP)
        e_logits = jnp.take_along_axis(e_logits, g_idx[:, None, None], axis=1)[:, 0]
        e_prob = jax.nn.softmax(e_logits, axis=-1)
        top_p, top_i = lax.top_k(e_prob, EXPERT_TOP_K)
        weights = g_w * top_p / jnp.sum(top_p, axis=-1, keepdims=True)
        expert_id = g_idx[:, None] * EXPERTS_PER_GROUP + top_i
        gates = jnp.sum(jax.nn.one_hot(expert_id, N_EXPERTS, dtype=jnp.float32) * weights[..., None],
                        axis=1).astype(t.dtype)
        moe = jnp.zeros_like(t)
        for e in range(N_EXPERTS):
            he = jax.nn.silu(t @ w_gate[e]) * (t @ w_up[e])
            moe = moe + gates[:, e:e + 1] * (he @ w_down[e])
        h = h + moe.reshape(B, S, D)
    return h
```

```cpp
#include <hip/hip_runtime.h>
#include <cstdio>
#include <cstdint>

#define LAS __attribute__((address_space(3)))
#define GAS __attribute__((address_space(1)))
typedef _Float16 f16;
typedef _Float16 f16x8 __attribute__((ext_vector_type(8)));
typedef _Float16 f16x4 __attribute__((ext_vector_type(4)));
typedef _Float16 f16x2 __attribute__((ext_vector_type(2)));
typedef float f32x2 __attribute__((ext_vector_type(2)));
typedef float f32x4 __attribute__((ext_vector_type(4)));
typedef float f32x16 __attribute__((ext_vector_type(16)));
typedef unsigned u32x4 __attribute__((ext_vector_type(4)));
typedef unsigned u32x2 __attribute__((ext_vector_type(2)));

__device__ __forceinline__ unsigned pk2(float lo, float hi) { f16x2 v = {(f16)lo, (f16)hi}; return __builtin_bit_cast(unsigned, v); }
__device__ __forceinline__ u32x4 pk8(f32x4 a, f32x4 b) { u32x4 w; w.x = pk2(a[0], a[1]); w.y = pk2(a[2], a[3]); w.z = pk2(b[0], b[1]); w.w = pk2(b[2], b[3]); return w; }
__device__ __forceinline__ u32x2 pk4(f32x4 a) { u32x2 w; w.x = pk2(a[0], a[1]); w.y = pk2(a[2], a[3]); return w; }
__device__ __forceinline__ float dot4(f32x4 a) { return (a[0] * a[0] + a[1] * a[1]) + (a[2] * a[2] + a[3] * a[3]); }
__device__ __forceinline__ float wave_sum(float v) {
#pragma unroll
    for (int o = 1; o < 64; o <<= 1) v += __shfl_xor(v, o);
    return v;
}
__device__ __forceinline__ int L32(int q) { return 8 * ((q >> 2) & 3) + 4 * (q >> 4) + (q & 3); }

__device__ __forceinline__ int fresh_tid() { int t = (int)threadIdx.x; asm volatile("" : "+v"(t)); return t; }
constexpr int T = 32768, D = 1024, SEQ = 4096, NB = 8;
constexpr float EPS = 1e-6f;
constexpr int NPOS = 152 * 256;

namespace pg8 {
constexpr int BM = 256, BK = 64, HALF = 128, HTB = HALF * BK * 2, STAGE_BYTES = 8 * HTB;
__host__ __device__ __forceinline__ int lds_byte(int r, int c) { const int st = (r >> 4) * 2 + (c >> 5), rr = r & 15, cc = c & 31, ob = rr * 64 + cc * 2; return st * 1024 + (ob ^ (((ob >> 9) & 1) << 5)); }
__host__ __device__ __forceinline__ void stage_rc(int b, int& R, int& C) { const int st = b / 1024, sb = b % 1024, swz = sb ^ (((sb >> 9) & 1) << 5); R = (st >> 1) * 16 + swz / 64; C = (st & 1) * 32 + (swz % 64) / 2; }
struct Unit { const char* A; const char* B; int pm, pn, aux; };

template <class Epi, class Sched, bool ALIGN_EPI>
__device__ __forceinline__ void gemm_phase(LAS unsigned char* lds, const int K, const int lda, const int ldb, const Sched& S, const Epi& E) {
    const int tid = fresh_tid(), wid = __builtin_amdgcn_readfirstlane(tid >> 6), lane = tid & 63, wr = wid >> 2, wc = wid & 3, fr = lane & 15, fq = lane >> 4;
    const int nt = K / BK;
    unsigned voffA[2], voffB[2];
#pragma unroll
    for (int i = 0; i < 2; ++i) { int R, C; stage_rc(tid * 16 + i * 8192, R, C); voffA[i] = (unsigned)(R * lda + C) * 2u; voffB[i] = (unsigned)(R * ldb + C) * 2u; }
    const size_t kstep = (size_t)(BK * 2);
    const size_t hstepA = (size_t)HALF * lda * 2, hstepB = (size_t)HALF * ldb * 2;
    const unsigned ldsw = (unsigned)wid * 1024u;
    const int aoff = lds_byte(wr * 64 + fr, fq * 8), boff = lds_byte(wc * 32 + fr, fq * 8);
#define PG8_SA(b, h) (((b) * 2 + (h)) * HTB)
#define PG8_SB(b, h) ((4 + (b) * 2 + (h)) * HTB)
#define PG8_STAGE(bufoff, gbase, voff) do { _Pragma("unroll") for (int _i = 0; _i < 2; ++_i) \
        __builtin_amdgcn_global_load_lds((const unsigned*)((const char*)(gbase) + (voff)[_i]), (LAS unsigned*)(lds + (bufoff) + ldsw + _i * 8192), 16, 0, 0); } while (0)
#define PG8_LDA(dst, b, h) do { _Pragma("unroll") for (int m = 0; m < 4; ++m) _Pragma("unroll") for (int k = 0; k < 2; ++k) dst[m][k] = *(const LAS f16x8*)(lds + PG8_SA(b, h) + aoff + m * 2048 + k * 1024); } while (0)
#define PG8_LDB(dst, b, h) do { _Pragma("unroll") for (int n = 0; n < 2; ++n) _Pragma("unroll") for (int k = 0; k < 2; ++k) dst[n][k] = *(const LAS f16x8*)(lds + PG8_SB(b, h) + boff + n * 2048 + k * 1024); } while (0)
#define PG8_MMA(ai, bj, At, Bt) do { __builtin_amdgcn_s_setprio(1); _Pragma("unroll") for (int m = 0; m < 4; ++m) _Pragma("unroll") for (int n = 0; n < 2; ++n) _Pragma("unroll") for (int k = 0; k < 2; ++k) \
        acc[ai][bj][m][n] = __builtin_amdgcn_mfma_f32_16x16x32_f16(Bt[n][k], At[m][k], acc[ai][bj][m][n], 0, 0, 0); __builtin_amdgcn_s_setprio(0); } while (0)
#define PG8_WAIT_V(n) asm volatile("s_waitcnt vmcnt(" #n ")" ::: "memory")
#define PG8_WAIT_L(n) asm volatile("s_waitcnt lgkmcnt(" #n ")" ::: "memory")
#define PG8_BAR __builtin_amdgcn_s_barrier()
#define PG8_SCHED __builtin_amdgcn_sched_barrier(0)
    Unit cur, nxt; int ui = 0;
    if (!S.next(0, cur)) return;
    f32x4 acc[2][2][4][2];
#pragma unroll
    for (int a = 0; a < 2; ++a)
#pragma unroll
        for (int b = 0; b < 2; ++b)
#pragma unroll
            for (int m = 0; m < 4; ++m)
#pragma unroll
                for (int n = 0; n < 2; ++n) acc[a][b][m][n] = (f32x4){0.f, 0.f, 0.f, 0.f};
    f16x8 At[4][2], B0[2][2], B1[2][2];
    const char* cA = cur.A; const char* cB = cur.B;
    PG8_STAGE(PG8_SB(0, 0), cB, voffB); PG8_STAGE(PG8_SB(0, 1), cB + hstepB, voffB); PG8_STAGE(PG8_SA(0, 0), cA, voffA); PG8_STAGE(PG8_SA(0, 1), cA + hstepA, voffA);
    if (wr == 1) PG8_BAR;
    PG8_WAIT_V(2); PG8_BAR;
    PG8_STAGE(PG8_SB(1, 0), cB + kstep, voffB); PG8_STAGE(PG8_SA(1, 0), cA + kstep, voffA); PG8_STAGE(PG8_SB(1, 1), cB + hstepB + kstep, voffB);
    PG8_WAIT_V(6); PG8_BAR;
    for (;;) {
        const bool has_next = S.next(ui + 1, nxt);
        const char* nA = has_next ? nxt.A : cA; const char* nB = has_next ? nxt.B : cB;
        for (int t = 0; t < nt; t += 2) {
            const bool last = (t == nt - 2);
            const char* a1 = cA + (size_t)(t + 1) * kstep;
            const char* a2 = last ? nA : cA + (size_t)(t + 2) * kstep; const char* b2 = last ? nB : cB + (size_t)(t + 2) * kstep;
            const char* a3 = a2 + kstep; const char* b3 = b2 + kstep;
            PG8_LDB(B0, 0, 0); PG8_LDB(B1, 0, 1); PG8_SCHED; PG8_LDA(At, 0, 0); PG8_STAGE(PG8_SA(1, 1), a1 + hstepA, voffA);
            PG8_WAIT_V(8); PG8_WAIT_L(0); PG8_BAR; PG8_MMA(0, 0, At, B0); PG8_MMA(0, 1, At, B1); PG8_BAR; PG8_SCHED;
            PG8_LDA(At, 0, 1); PG8_STAGE(PG8_SB(0, 0), b2, voffB); PG8_STAGE(PG8_SB(0, 1), b2 + hstepB, voffB); PG8_STAGE(PG8_SA(0, 0), a2, voffA);
            PG8_WAIT_V(8); PG8_WAIT_L(0); PG8_BAR; PG8_MMA(1, 0, At, B0); PG8_MMA(1, 1, At, B1); PG8_BAR; PG8_SCHED;
            PG8_LDB(B0, 1, 0); PG8_LDB(B1, 1, 1); PG8_SCHED; PG8_LDA(At, 1, 0); PG8_STAGE(PG8_SA(0, 1), a2 + hstepA, voffA);
            PG8_WAIT_V(8); PG8_WAIT_L(0); PG8_BAR; PG8_MMA(0, 0, At, B0); PG8_MMA(0, 1, At, B1); PG8_BAR; PG8_SCHED;
            PG8_LDA(At, 1, 1); PG8_STAGE(PG8_SB(1, 0), b3, voffB); PG8_STAGE(PG8_SB(1, 1), b3 + hstepB, voffB); PG8_STAGE(PG8_SA(1, 0), a3, voffA);
            PG8_WAIT_V(8); PG8_WAIT_L(0); PG8_BAR; PG8_MMA(1, 0, At, B0); PG8_MMA(1, 1, At, B1); PG8_BAR; PG8_SCHED;
        }
        if constexpr (ALIGN_EPI) { if (wr == 0) PG8_BAR; }
        E(acc, cur, wr, wc, fr, fq);
        if (!has_next) break;
#pragma unroll
        for (int a = 0; a < 2; ++a)
#pragma unroll
            for (int b = 0; b < 2; ++b)
#pragma unroll
                for (int m = 0; m < 4; ++m)
#pragma unroll
                    for (int n = 0; n < 2; ++n) acc[a][b][m][n] = (f32x4){0.f, 0.f, 0.f, 0.f};
        cur = nxt; cA = nA; cB = nB; ++ui;
        if constexpr (ALIGN_EPI) { if (wr == 1) PG8_BAR; }
    }
    PG8_WAIT_V(0);
    if constexpr (!ALIGN_EPI) { if (wr == 0) PG8_BAR; }
    PG8_BAR;
#undef PG8_SA
#undef PG8_SB
#undef PG8_STAGE
#undef PG8_LDA
#undef PG8_LDB
#undef PG8_MMA
#undef PG8_WAIT_V
#undef PG8_WAIT_L
#undef PG8_BAR
#undef PG8_SCHED
}
__device__ __forceinline__ void tile_map(int L, int nM, int nN, int& pm, int& pn) {
    const int nwg = nM * nN; int wgid = L;
    { const int q = nwg / 8, r = nwg % 8, xcd = wgid % 8, off = wgid / 8; wgid = (xcd < r ? xcd * (q + 1) : r * (q + 1) + (xcd - r) * q) + off; }
    const int nig = 8 * nN, gid = wgid / nig, fm = gid * 8, gsz = (nM - fm) < 8 ? (nM - fm) : 8;
    pm = fm + ((wgid % nig) % gsz); pn = (wgid % nig) / gsz;
}
}
using pg8::Unit;

#define XB_TMO      128
#define XB_XCNT(j)  (256  + 64 * (j))
#define XB_XSUB(j)  (1280 + 64 * (j))
#define XB_XGEN(j)  (2304 + 64 * (j))
#define XB_TOP      3328
#define XB_TOPGEN   3392
#define XCD_BAR_WORDS 3456
#define XB_SPIN_CAP (1u << 18)
__device__ __forceinline__ unsigned xb_ld(unsigned* p)              { return __hip_atomic_load(p, __ATOMIC_RELAXED, __HIP_MEMORY_SCOPE_AGENT); }
__device__ __forceinline__ unsigned xb_add(unsigned* p, unsigned v) { return __hip_atomic_fetch_add(p, v, __ATOMIC_RELAXED, __HIP_MEMORY_SCOPE_AGENT); }
__device__ __forceinline__ unsigned xb_xcc_id() { return (unsigned)__builtin_amdgcn_s_getreg((3 << 11) | 20) & 0xFu; }
#define XB_SPIN(cond, bar) do { unsigned _sp = 0; while (cond) { __builtin_amdgcn_s_sleep(1); \
    if ((++_sp & 255u) == 0u) { if (xb_ld(&(bar)[XB_TMO])) break; if (_sp > XB_SPIN_CAP) { atomicAdd(&(bar)[XB_TMO], 1u); break; } } } } while (0)
struct XcdBarrier { unsigned* bar; unsigned x; volatile LAS unsigned* st; };
__device__ __forceinline__ XcdBarrier xcd_barrier_post(unsigned* bar, volatile LAS unsigned* st) {
    XcdBarrier b; b.bar = bar; b.x = xb_xcc_id(); b.st = st;
    if (threadIdx.x == 0) (void)xb_add(&bar[XB_XCNT(b.x)], 1u);
    return b;
}
__device__ __forceinline__ void xcd_barrier_complete(unsigned* bar, unsigned x, unsigned& nloc, unsigned& nx) {
    const unsigned G = gridDim.x * gridDim.y * gridDim.z;
    unsigned sum, cnt, mine, sp = 0u;
    for (;;) {
        sum = 0u; cnt = 0u; mine = 0u;
#pragma unroll
        for (unsigned j = 0; j < 16; ++j) { const unsigned c = xb_ld(&bar[XB_XCNT(j)]); sum += c; cnt += (c > 0u) ? 1u : 0u; mine = (j == x) ? c : mine; }
        if (sum == G) break;
        __builtin_amdgcn_s_sleep(1);
        if ((++sp & 255u) == 0u) { if (xb_ld(&bar[XB_TMO])) break; if (sp > XB_SPIN_CAP) { atomicAdd(&bar[XB_TMO], 1u); break; } }
    }
    nloc = mine > 0u ? mine : 1u; nx = cnt > 0u ? cnt : 1u;
}
__device__ __forceinline__ void xcd_barrier(const XcdBarrier& b) {
    asm volatile("s_waitcnt vmcnt(0)" ::: "memory");
    __syncthreads();
    if (threadIdx.x == 0) {
        unsigned* bar = b.bar;
        __builtin_amdgcn_s_waitcnt(0);
        unsigned nloc = b.st[0], nx = b.st[1];
        if (nloc == 0u) { xcd_barrier_complete(bar, b.x, nloc, nx); b.st[0] = nloc; b.st[1] = nx; }
        const unsigned old = xb_add(&bar[XB_XSUB(b.x)], 1u);
        const unsigned gen = old / nloc;
        if (old + 1u == (gen + 1u) * nloc) {
            __builtin_amdgcn_fence(__ATOMIC_RELEASE, "agent");
            asm volatile("s_waitcnt vmcnt(0)" ::: "memory");
            const unsigned og = xb_add(&bar[XB_TOP], 1u);
            const unsigned tg = og / nx;
            if (og + 1u == (tg + 1u) * nx) xb_add(&bar[XB_TOPGEN], 1u);
            else XB_SPIN(xb_ld(&bar[XB_TOPGEN]) == tg, bar);
            __builtin_amdgcn_fence(__ATOMIC_ACQUIRE, "agent");
            xb_add(&bar[XB_XGEN(b.x)], 1u);
            asm volatile("s_waitcnt vmcnt(0)" ::: "memory");
        } else {
            XB_SPIN(xb_ld(&bar[XB_XGEN(b.x)]) == gen, bar);
            __builtin_amdgcn_fence(__ATOMIC_ACQUIRE, "agent");
            asm volatile("s_waitcnt vmcnt(0)" ::: "memory");
        }
    }
    __syncthreads();
}

constexpr size_t MiB = 1u << 20;
constexpr size_t WS_CTL = 0, CTL_ZERO_BYTES = 65536;
constexpr int CW_BAR = 1024;
constexpr int CW_CNT = 8192;
constexpr int CW_CUR = 8192 + 64;
constexpr size_t WS_SSQ_CQ  = 1 * MiB;
constexpr size_t WS_SSQ_CKV = 2 * MiB;
constexpr size_t WS_SSQ_MK  = 2 * MiB + 512 * 1024;
constexpr size_t WS_SSQ_ATT = 3 * MiB;
constexpr size_t WS_SSQ_H1  = 5 * MiB;
constexpr size_t WS_SSQ_MQ  = 7 * MiB;
constexpr size_t WS_COS     = 9 * MiB;
constexpr size_t WS_SIN     = 11 * MiB;
constexpr size_t WS_BKT     = 13 * MiB;
constexpr size_t WS_RR      = 13 * MiB + 128 * 1024;
constexpr size_t WS_W0      = 13 * MiB + 256 * 1024;
constexpr size_t WS_W1      = 13 * MiB + 384 * 1024;
constexpr size_t WS_TOK     = 13 * MiB + 512 * 1024;
constexpr size_t WS_PR      = 13 * MiB + 704 * 1024;
constexpr size_t WS_PW0     = 14 * MiB;
constexpr size_t WS_PW1     = 14 * MiB + 192 * 1024;
constexpr size_t WS_KRF     = 14 * MiB + 512 * 1024;
constexpr size_t WS_WIN  = 17 * MiB;
constexpr size_t WS_WSV  = WS_WIN  + 3584 * 1024;
constexpr size_t WS_WMK  = WS_WSV  + 1 * MiB;
constexpr size_t WS_WMV  = WS_WMK  + 2 * MiB;
constexpr size_t WS_WUQ  = WS_WMV  + 2 * MiB;
constexpr size_t WS_WUKN = WS_WUQ  + 1 * MiB;
constexpr size_t WS_WUKV = WS_WUKN + 256 * 1024;
constexpr size_t WS_WO   = WS_WUKV + 256 * 1024;
constexpr size_t WS_WMQ  = WS_WO   + 2 * MiB;
constexpr size_t WS_WMO  = WS_WMQ  + 2 * MiB;
constexpr size_t WS_WGU  = WS_WMO  + 2 * MiB;
constexpr size_t WS_WD2  = WS_WGU  + 32 * MiB;
constexpr size_t WS_WEND = WS_WD2  + 48 * MiB;
constexpr size_t WS_MN   = 114 * MiB;
constexpr size_t WS_MKR  = 118 * MiB;
constexpr size_t WS_MVT  = 122 * MiB;
constexpr size_t WS_KP   = 126 * MiB;
constexpr size_t WS_R1   = 130 * MiB;
constexpr size_t WS_R2   = 194 * MiB;
constexpr size_t WS_R3   = 290 * MiB;
constexpr size_t WS_R4   = 330 * MiB;
constexpr size_t WS_END  = 458 * MiB;
static_assert(WS_WEND <= WS_MN, "ws map");
constexpr size_t WS_HN = WS_R1, WS_ATT = WS_R1, WS_MQ = WS_R1, WS_H2H = WS_R1;
constexpr size_t WS_SBQ = WS_R2, WS_SBK = WS_R2 + 32 * MiB, WS_SBVT = WS_R2 + 64 * MiB, WS_H1H = WS_R2, WS_MO = WS_R2, WS_TS = WS_R2;
constexpr size_t WS_CQ = WS_R3, WS_CKV = WS_R3 + 24 * MiB;
constexpr size_t WS_MLAQ = WS_R4, WS_MLAK = WS_R4 + 48 * MiB, WS_MLAVT = WS_R4 + 96 * MiB, WS_HE = WS_R4;

constexpr int LDS_BYTES = 147456;
constexpr int LDS_MISC = 143360;
constexpr int NWAVES = 8, NTHR = 512;

struct Params { const float* in[31]; float* out; unsigned char* ws; int ph_lo, ph_hi; };

struct Frame {
    LAS unsigned char* lds; volatile LAS unsigned* MISC;
    int vcu, G, bx;
    unsigned char* ws; float* out; unsigned* ctl;
};
#define PHASE_IDS() const int tid = fresh_tid(), lane = tid & 63, wave = __builtin_amdgcn_readfirstlane(tid >> 6); (void)lane; (void)wave

__device__ __forceinline__ void conv_item(const float* src, int ld, int srccol0, int mode, int ksrc0, const float* kscale, f16* dst, int K, int row0, int k0, LAS float* scr, int lane) {
    if (mode != 2) {
#pragma unroll 8
        for (int i = 0; i < 32; ++i) { const int kk = 2 * i + (lane >> 5); float v = src[(size_t)(ksrc0 + kk) * ld + srccol0 + (lane & 31)]; if (kscale) v *= kscale[ksrc0 + kk]; scr[kk * 33 + (lane & 31)] = v; }
    }
    asm volatile("s_waitcnt lgkmcnt(0)" ::: "memory");
    const int c = lane & 7;
#pragma unroll
    for (int j = 0; j < 4; ++j) { const int q = (lane >> 3) + 8 * j; const int lc = (mode == 1) ? L32(q) : q; const LAS float* s = scr + (8 * c) * 33 + lc;
        u32x4 o;
        if (mode == 2) { o = (u32x4){0u, 0u, 0u, 0u}; }
        else { o.x = pk2(s[0 * 33], s[1 * 33]); o.y = pk2(s[2 * 33], s[3 * 33]); o.z = pk2(s[4 * 33], s[5 * 33]); o.w = pk2(s[6 * 33], s[7 * 33]); }
        *(u32x4*)(dst + (size_t)(row0 + q) * K + k0 + 8 * c) = o; }
    asm volatile("s_waitcnt lgkmcnt(0)" ::: "memory");
}
__device__ __forceinline__ void rms_row_to_f16(const float* xrow, const float* g, f16* orow, int lane) {
    const f32x4* xr = (const f32x4*)xrow + lane; const f32x4* gr = (const f32x4*)g + lane;
    f32x4 v[4]; float s = 0.f;
#pragma unroll
    for (int j = 0; j < 4; ++j) { v[j] = xr[64 * j]; s += dot4(v[j]); }
    const float r = __builtin_amdgcn_rsqf(wave_sum(s) * (1.f / 1024.f) + EPS);
    u32x2* o8 = (u32x2*)orow + lane;
#pragma unroll
    for (int j = 0; j < 4; ++j) { const f32x4 gg = gr[64 * j]; o8[64 * j] = pk4(v[j] * r * gg); }
}
__device__ __forceinline__ void moe_pair(int pi, int& lo, int& hi) { lo = pi < 3 ? 0 : (pi < 5 ? 1 : 2); hi = pi < 3 ? pi + 1 : (pi < 5 ? pi - 1 : 3); }

__device__ __forceinline__ void p0_prologue(Frame& F, const Params& P) {
    PHASE_IDS();
    LAS float* scr = (LAS float*)(F.lds + wave * 16384);
    const int gw = F.vcu * NWAVES + wave, NGW = F.G * NWAVES;
    unsigned char* ws = F.ws;
    const float* w_in = P.in[4]; const float* w_uq = P.in[6]; const float* w_ukv = P.in[8]; const float* w_o = P.in[15];
    const float* w_mq = P.in[18]; const float* w_mkv = P.in[19]; const float* w_mo = P.in[22];
    const float* w_gate = P.in[28]; const float* w_up = P.in[29]; const float* w_down = P.in[30];
    for (int it = gw; it < 56 * 16; it += NGW) { const int rb = it >> 4, kb = it & 15, tile = rb >> 3, g = rb & 7, bj = g >> 2, wc = g & 3; int col, mode = 1;
        if (tile < 2) col = (4 * tile + wc) * 64 + 32 * bj;
        else if (tile < 4) col = 512 + (4 * (tile - 2) + wc) * 64 + 32 * bj;
        else if (tile == 4) col = 1536 + 64 * wc + 32 * bj;
        else if (tile == 5) { if (bj == 0) col = 1536 + 256 + 32 * wc; else if (wc == 0) { col = 2176; mode = 0; } else { col = 0; mode = 2; } }
        else col = 1920 + 64 * wc + 32 * bj;
        conv_item(w_in, 2208, col, mode, kb * 64, nullptr, (f16*)(ws + WS_WIN), 1024, rb * 32, kb * 64, scr, lane); }
    for (int it = gw; it < 16 * 16; it += NGW) { const int rb = it >> 4, kb = it & 15; conv_item(w_in, 2208, 1024 + 32 * rb, 0, kb * 64, nullptr, (f16*)(ws + WS_WSV), 1024, rb * 32, kb * 64, scr, lane); }
    for (int it = gw; it < 32 * 16; it += NGW) { const int rb = it >> 4, kb = it & 15, tile = rb >> 3, g = rb & 7, bj = g >> 2, wc = g & 3;
        conv_item(w_mkv, 2048, 256 * tile + 64 * wc + 32 * bj, 1, kb * 64, nullptr, (f16*)(ws + WS_WMK), 1024, rb * 32, kb * 64, scr, lane); }
    for (int it = gw; it < 32 * 16; it += NGW) { const int rb = it >> 4, kb = it & 15; conv_item(w_mkv, 2048, 1024 + 32 * rb, 0, kb * 64, nullptr, (f16*)(ws + WS_WMV), 1024, rb * 32, kb * 64, scr, lane); }
    for (int it = gw; it < 24 * 6; it += NGW) { const int rb = it / 6, kb = it % 6, tile = rb >> 3, g = rb & 7, bj = g >> 2, wc = g & 3; int col, mode = 1;
        if (tile < 2) col = (4 * tile + wc) * 96 + 32 * bj; else { col = (4 * bj + wc) * 96 + 64; mode = 0; }
        conv_item(w_uq, 768, col, mode, kb * 64, P.in[5], (f16*)(ws + WS_WUQ), 384, rb * 32, kb * 64, scr, lane); }
    for (int it = gw; it < 16 * 4; it += NGW) { const int rb = it >> 2, kb = it & 3, tile = rb >> 3, g = rb & 7, bj = g >> 2, wc = g & 3;
        conv_item(w_ukv, 1024, (4 * tile + wc) * 128 + 32 * bj, 1, kb * 64, P.in[7], (f16*)(ws + WS_WUKN), 256, rb * 32, kb * 64, scr, lane); }
    for (int it = gw; it < 16 * 4; it += NGW) { const int rb = it >> 2, kb = it & 3;
        conv_item(w_ukv, 1024, (rb >> 1) * 128 + 64 + 32 * (rb & 1), 0, kb * 64, P.in[7], (f16*)(ws + WS_WUKV), 256, rb * 32, kb * 64, scr, lane); }
    for (int it = gw; it < 32 * 16; it += NGW) { const int rb = it >> 4, kb = it & 15; conv_item(w_o, 1024, 32 * rb, 1, kb * 64, nullptr, (f16*)(ws + WS_WO), 1024, rb * 32, kb * 64, scr, lane); }
    for (int it = gw; it < 32 * 16; it += NGW) { const int rb = it >> 4, kb = it & 15; conv_item(w_mq, 1024, 32 * rb, 1, kb * 64, P.in[16], (f16*)(ws + WS_WMQ), 1024, rb * 32, kb * 64, scr, lane); }
    for (int it = gw; it < 32 * 16; it += NGW) { const int rb = it >> 4, kb = it & 15; conv_item(w_mo, 1024, 32 * rb, 1, kb * 64, nullptr, (f16*)(ws + WS_WMO), 1024, rb * 32, kb * 64, scr, lane); }
    for (int it = gw; it < 64 * 8 * 16; it += NGW) { const int kb = it & 15, rb = (it >> 4) & 7, tile = it >> 7, e = tile >> 2, ffb = tile & 3, bj = rb >> 2, wc = rb & 3;
        conv_item((bj ? w_up : w_gate) + (size_t)e * 1024 * 512, 512, ffb * 128 + 32 * wc, 1, kb * 64, P.in[23], (f16*)(ws + WS_WGU) + (size_t)tile * 256 * 1024, 1024, rb * 32, kb * 64, scr, lane); }
    for (int it = gw; it < 24 * 32 * 16; it += NGW) { const int kb = it & 15, rb = (it >> 4) & 31, bk = it >> 9; int lo, hi; moe_pair(bk % 6, lo, hi);
        const int e = 4 * (bk / 6) + (kb < 8 ? lo : hi);
        conv_item(w_down + (size_t)e * 512 * 1024, 1024, 32 * rb, 1, (kb & 7) * 64, nullptr, (f16*)(ws + WS_WD2) + (size_t)bk * 1024 * 1024, 1024, rb * 32, kb * 64, scr, lane); }
    for (int m = gw; m < T; m += NGW) rms_row_to_f16(P.in[0] + (size_t)m * D, P.in[3], (f16*)(ws + WS_HN) + (size_t)m * D, lane);
    for (int m = gw; m < 2048; m += NGW) rms_row_to_f16(P.in[1] + (size_t)m * D, P.in[17], (f16*)(ws + WS_MN) + (size_t)m * D, lane);
    {
        const int gt = F.vcu * NTHR + tid, NGT = F.G * NTHR; const int* pos = (const int*)P.in[2];
        float* COS = (float*)(ws + WS_COS); float* SIN = (float*)(ws + WS_SIN);
        for (int e = gt; e < T * 16; e += NGT) { const int tok = e >> 4, i = e & 15;
            const float invf = i == 0 ? 1.000000000e+00f : i == 1 ? 5.623413324e-01f : i == 2 ? 3.162277639e-01f : i == 3 ? 1.778279394e-01f : i == 4 ? 1.000000015e-01f : i == 5 ? 5.623413250e-02f : i == 6 ? 3.162277490e-02f : i == 7 ? 1.778279431e-02f :
                               i == 8 ? 9.999999776e-03f : i == 9 ? 5.623413250e-03f : i == 10 ? 3.162277630e-03f : i == 11 ? 1.778279431e-03f : i == 12 ? 1.000000047e-03f : i == 13 ? 5.623413017e-04f : i == 14 ? 3.162277571e-04f : 1.778279402e-04f;
            const float ang = (float)pos[tok] * invf;
            const double x = (double)ang; const double n = __builtin_rint(x * 0.15915494309189535); const float rev = (float)(x * 0.15915494309189535 - n);
            COS[e] = __builtin_amdgcn_cosf(rev); SIN[e] = __builtin_amdgcn_sinf(rev); }
        int* TOK = (int*)(ws + WS_TOK);
        for (int e = gt; e < NPOS; e += NGT) TOK[e] = -1;
    }
}

typedef f32x4 Acc[2][2][4][2];
template <bool SSQ>
__device__ __forceinline__ void store_w64(const Acc& acc, int rowb, f16* dst, int ld, int colb, float scale, float* ssq, int ldq, int slot, int fq) {
#pragma unroll
    for (int ai = 0; ai < 2; ++ai)
#pragma unroll
        for (int m = 0; m < 4; ++m) { const int row = rowb + ai * 128 + m * 16; float s = 0.f;
#pragma unroll
            for (int bj = 0; bj < 2; ++bj) { const f32x4 v0 = acc[ai][bj][m][0] * scale, v1 = acc[ai][bj][m][1] * scale;
                if (SSQ) s += dot4(v0) + dot4(v1);
                *(u32x4*)(dst + (size_t)row * ld + colb + bj * 32 + 8 * fq) = pk8(v0, v1); }
            if (SSQ) { s += __shfl_xor(s, 16); s += __shfl_xor(s, 32); if (fq == 0) ssq[(size_t)row * ldq + slot] = s; } }
}

struct EpiP1N {
    unsigned char* ws; const float* krg;
    __device__ __forceinline__ void operator()(const Acc& acc, const Unit& u, int wr, int wc, int fr_, int fq_) const {
        int fr = fr_, fq = fq_; asm volatile("" : "+v"(fr), "+v"(fq));
        const int rowb = u.pm * 256 + wr * 64 + fr;
        if (u.aux == 0) { store_w64<false>(acc, rowb, (f16*)(ws + WS_SBQ), 512, (4 * u.pn + wc) * 64, 0.125f, nullptr, 0, 0, fq); }
        else if (u.aux == 1) { store_w64<false>(acc, rowb, (f16*)(ws + WS_SBK), 512, (4 * u.pn + wc) * 64, 1.f, nullptr, 0, 0, fq); }
        else if (u.aux == 2) { store_w64<true>(acc, rowb, (f16*)(ws + WS_CQ), 384, 64 * wc, 1.f, (float*)(ws + WS_SSQ_CQ), 8, wc, fq); }
        else if (u.aux == 4) { store_w64<true>(acc, rowb, (f16*)(ws + WS_CKV), 256, 64 * wc, 1.f, (float*)(ws + WS_SSQ_CKV), 4, wc, fq); }
        else if (u.aux == 5) { store_w64<true>(acc, rowb, (f16*)(ws + WS_MKR), 1024, 256 * u.pn + 64 * wc, 1.f, (float*)(ws + WS_SSQ_MK), 16, 4 * u.pn + wc, fq); }
        else {
            f16* CQ = (f16*)(ws + WS_CQ); float* SS = (float*)(ws + WS_SSQ_CQ);
#pragma unroll
            for (int ai = 0; ai < 2; ++ai)
#pragma unroll
                for (int m = 0; m < 4; ++m) { const int row = rowb + ai * 128 + m * 16;
                    const f32x4 v0 = acc[ai][0][m][0], v1 = acc[ai][0][m][1]; float s = dot4(v0) + dot4(v1);
                    *(u32x4*)(CQ + (size_t)row * 384 + 256 + 32 * wc + 8 * fq) = pk8(v0, v1);
                    s += __shfl_xor(s, 16); s += __shfl_xor(s, 32); if (fq == 0) SS[(size_t)row * 8 + 4 + wc] = s; }
            if (wc == 0) {
                const float* COS = (const float*)(ws + WS_COS); const float* SIN = (const float*)(ws + WS_SIN); f16* KRF = (f16*)(ws + WS_KRF);
                const f32x4 g1 = *(const f32x4*)(krg + 4 * fq), g2 = *(const f32x4*)(krg + 16 + 4 * fq);
#pragma unroll
                for (int ai = 0; ai < 2; ++ai)
#pragma unroll
                    for (int m = 0; m < 4; ++m) { const int row = rowb + ai * 128 + m * 16;
                        f32x4 x1 = acc[ai][1][m][0], x2 = acc[ai][1][m][1]; float s = dot4(x1) + dot4(x2);
                        s += __shfl_xor(s, 16); s += __shfl_xor(s, 32);
                        const float rn = __builtin_amdgcn_rsqf(s * (1.f / 32.f) + EPS);
                        x1 = x1 * rn * g1; x2 = x2 * rn * g2;
                        const f32x4 c = *(const f32x4*)(COS + (size_t)row * 16 + 4 * fq), sn = *(const f32x4*)(SIN + (size_t)row * 16 + 4 * fq);
                        const f32x4 o1 = x1 * c - x2 * sn, o2 = x2 * c + x1 * sn;
                        *(u32x2*)(KRF + (size_t)row * 32 + 4 * fq) = pk4(o1); *(u32x2*)(KRF + (size_t)row * 32 + 16 + 4 * fq) = pk4(o2); }
            }
        }
    }
};
struct SchedP1N {
    unsigned char* ws; int G, c;
    __device__ __forceinline__ bool next(int i, Unit& u) const {
        int L = i * G + c;
        if (L < 896) { int pm, pn; pg8::tile_map(L, 128, 7, pm, pn);
            u.A = (const char*)(ws + WS_HN) + (size_t)pm * 256 * 1024 * 2; u.B = (const char*)(ws + WS_WIN) + (size_t)pn * 256 * 1024 * 2; u.pm = pm;
            u.aux = pn < 2 ? 0 : (pn < 4 ? 1 : pn - 2); u.pn = pn < 2 ? pn : (pn < 4 ? pn - 2 : 0); return true; }
        L -= 896; if (L >= 32) return false;
        int pm, pn; pg8::tile_map(L, 8, 4, pm, pn);
        u.A = (const char*)(ws + WS_MN) + (size_t)pm * 256 * 1024 * 2; u.B = (const char*)(ws + WS_WMK) + (size_t)pn * 256 * 1024 * 2; u.pm = pm; u.pn = pn; u.aux = 5; return true;
    }
};
struct EpiP1S {
    unsigned char* ws;
    __device__ __forceinline__ void operator()(const Acc& acc, const Unit& u, int wr, int wc, int fr_, int fq_) const {
        int fr = fr_, fq = fq_; asm volatile("" : "+v"(fr), "+v"(fq));
        const int rowb = u.pm * 256 + wr * 64 + fr;
        if (u.aux == 0) { f16* dst = (f16*)(ws + WS_SBVT);
#pragma unroll
            for (int ai = 0; ai < 2; ++ai)
#pragma unroll
                for (int m = 0; m < 4; ++m) { const size_t ro = (size_t)(rowb + ai * 128 + m * 16) * T + u.pn * 256 + 32 * wc + 8 * (fq & 1) + 4 * (fq >> 1);
#pragma unroll
                    for (int bj = 0; bj < 2; ++bj)
#pragma unroll
                        for (int n = 0; n < 2; ++n) *(u32x2*)(dst + ro + 128 * bj + 16 * n) = pk4(acc[ai][bj][m][n]); }
        } else { f16* dst = (f16*)(ws + WS_MVT);
#pragma unroll
            for (int ai = 0; ai < 2; ++ai)
#pragma unroll
                for (int m = 0; m < 4; ++m) { const size_t ro = (size_t)(rowb + ai * 128 + m * 16) * 2048 + u.pn * 256 + 32 * wc + 8 * fq;
#pragma unroll
                    for (int bj = 0; bj < 2; ++bj)
#pragma unroll
                        for (int n = 0; n < 2; ++n) *(u32x2*)(dst + ro + 128 * bj + 4 * n) = pk4(acc[ai][bj][m][n]); }
        }
    }
};
struct SchedP1S {
    unsigned char* ws; int G, c;
    __device__ __forceinline__ bool next(int i, Unit& u) const {
        int L = i * G + c;
        if (L < 256) { int pm, pn; pg8::tile_map(L, 2, 128, pm, pn);
            u.A = (const char*)(ws + WS_WSV) + (size_t)pm * 256 * 1024 * 2; u.B = (const char*)(ws + WS_HN) + (size_t)pn * 256 * 1024 * 2; u.pm = pm; u.pn = pn; u.aux = 0; return true; }
        L -= 256; if (L >= 32) return false;
        int pm, pn; pg8::tile_map(L, 4, 8, pm, pn);
        u.A = (const char*)(ws + WS_WMV) + (size_t)pm * 256 * 1024 * 2; u.B = (const char*)(ws + WS_MN) + (size_t)pn * 256 * 1024 * 2; u.pm = pm; u.pn = pn; u.aux = 1; return true;
    }
};

constexpr float MLA_QSCALE = 0.10206207261596575f * 1.4426950408889634f;
__device__ __forceinline__ float rq_of(const float* SS8, int row) { const f32x4 a = *(const f32x4*)(SS8 + (size_t)row * 8), b = *(const f32x4*)(SS8 + (size_t)row * 8 + 4);
    return __builtin_amdgcn_rsqf((((a[0] + a[1]) + (a[2] + a[3])) + ((b[0] + b[1]) + (b[2] + b[3]))) * (1.f / 384.f) + EPS); }
__device__ __forceinline__ float rkv_of(const float* SS4, int row) { const f32x4 a = *(const f32x4*)(SS4 + (size_t)row * 4);
    return __builtin_amdgcn_rsqf(((a[0] + a[1]) + (a[2] + a[3])) * (1.f / 256.f) + EPS); }
struct EpiP2Q {
    unsigned char* ws; const float* qng; const float* qrg;
    __device__ __forceinline__ void operator()(const Acc& acc, const Unit& u, int wr, int wc, int fr_, int fq_) const {
        int fr = fr_, fq = fq_; asm volatile("" : "+v"(fr), "+v"(fq));
        const int rowb = u.pm * 256 + wr * 64 + fr; const float* SS = (const float*)(ws + WS_SSQ_CQ); f16* Q = (f16*)(ws + WS_MLAQ);
        if (u.pn < 2) { const int h = 4 * u.pn + wc;
            f32x4 g[2][2];
#pragma unroll
            for (int bj = 0; bj < 2; ++bj)
#pragma unroll
                for (int n = 0; n < 2; ++n) g[bj][n] = *(const f32x4*)(qng + 32 * bj + 8 * fq + 4 * n) * MLA_QSCALE;
#pragma unroll
            for (int ai = 0; ai < 2; ++ai)
#pragma unroll
                for (int m = 0; m < 4; ++m) { const int row = rowb + ai * 128 + m * 16; const float rq = rq_of(SS, row);
                    f32x4 v[2][2]; float s = 0.f;
#pragma unroll
                    for (int bj = 0; bj < 2; ++bj)
#pragma unroll
                        for (int n = 0; n < 2; ++n) { v[bj][n] = acc[ai][bj][m][n] * rq; s += dot4(v[bj][n]); }
                    s += __shfl_xor(s, 16); s += __shfl_xor(s, 32);
                    const float rn = __builtin_amdgcn_rsqf(s * (1.f / 64.f) + EPS);
#pragma unroll
                    for (int bj = 0; bj < 2; ++bj) *(u32x4*)(Q + (size_t)row * 768 + h * 96 + 32 * bj + 8 * fq) = pk8(v[bj][0] * rn * g[bj][0], v[bj][1] * rn * g[bj][1]); }
        } else {
            const float* COS = (const float*)(ws + WS_COS); const float* SIN = (const float*)(ws + WS_SIN);
            const f32x4 g1 = *(const f32x4*)(qrg + 4 * fq) * MLA_QSCALE, g2 = *(const f32x4*)(qrg + 16 + 4 * fq) * MLA_QSCALE;
#pragma unroll
            for (int ai = 0; ai < 2; ++ai)
#pragma unroll
                for (int m = 0; m < 4; ++m) { const int row = rowb + ai * 128 + m * 16; const float rq = rq_of(SS, row);
                    const f32x4 c = *(const f32x4*)(COS + (size_t)row * 16 + 4 * fq), sn = *(const f32x4*)(SIN + (size_t)row * 16 + 4 * fq);
#pragma unroll
                    for (int bj = 0; bj < 2; ++bj) { const int h = 4 * bj + wc;
                        f32x4 x1 = acc[ai][bj][m][0] * rq, x2 = acc[ai][bj][m][1] * rq; float s = dot4(x1) + dot4(x2);
                        s += __shfl_xor(s, 16); s += __shfl_xor(s, 32);
                        const float rn = __builtin_amdgcn_rsqf(s * (1.f / 32.f) + EPS);
                        x1 = x1 * rn * g1; x2 = x2 * rn * g2;
                        const f32x4 o1 = x1 * c - x2 * sn, o2 = x2 * c + x1 * sn;
                        *(u32x2*)(Q + (size_t)row * 768 + h * 96 + 64 + 4 * fq) = pk4(o1); *(u32x2*)(Q + (size_t)row * 768 + h * 96 + 80 + 4 * fq) = pk4(o2); } }
        }
    }
};
struct EpiP2K {
    unsigned char* ws; const float* kng;
    __device__ __forceinline__ void operator()(const Acc& acc, const Unit& u, int wr, int wc, int fr_, int fq_) const {
        int fr = fr_, fq = fq_; asm volatile("" : "+v"(fr), "+v"(fq));
        const int rowb = u.pm * 256 + wr * 64 + fr; const float* SS = (const float*)(ws + WS_SSQ_CKV); f16* Kd = (f16*)(ws + WS_MLAK); const f16* KRF = (const f16*)(ws + WS_KRF);
        const int h = 4 * u.pn + wc;
        f32x4 g[2][2];
#pragma unroll
        for (int bj = 0; bj < 2; ++bj)
#pragma unroll
            for (int n = 0; n < 2; ++n) g[bj][n] = *(const f32x4*)(kng + 32 * bj + 8 * fq + 4 * n);
#pragma unroll
        for (int ai = 0; ai < 2; ++ai)
#pragma unroll
            for (int m = 0; m < 4; ++m) { const int row = rowb + ai * 128 + m * 16; const float rk = rkv_of(SS, row);
                f32x4 v[2][2]; float s = 0.f;
#pragma unroll
                for (int bj = 0; bj < 2; ++bj)
#pragma unroll
                    for (int n = 0; n < 2; ++n) { v[bj][n] = acc[ai][bj][m][n] * rk; s += dot4(v[bj][n]); }
                s += __shfl_xor(s, 16); s += __shfl_xor(s, 32);
                const float rn = __builtin_amdgcn_rsqf(s * (1.f / 64.f) + EPS);
#pragma unroll
                for (int bj = 0; bj < 2; ++bj) *(u32x4*)(Kd + (size_t)row * 768 + h * 96 + 32 * bj + 8 * fq) = pk8(v[bj][0] * rn * g[bj][0], v[bj][1] * rn * g[bj][1]);
                *(u32x4*)(Kd + (size_t)row * 768 + h * 96 + 64 + 8 * fq) = *(const u32x4*)(KRF + (size_t)row * 32 + 8 * fq); }
    }
};
struct EpiP2V {
    unsigned char* ws;
    __device__ __forceinline__ void operator()(const Acc& acc, const Unit& u, int wr, int wc, int fr_, int fq_) const {
        int fr = fr_, fq = fq_; asm volatile("" : "+v"(fr), "+v"(fq));
        const int rowb = u.pm * 256 + wr * 64 + fr; const float* SS = (const float*)(ws + WS_SSQ_CKV); f16* dst = (f16*)(ws + WS_MLAVT);
        f32x4 rk[2][2];
#pragma unroll
        for (int bj = 0; bj < 2; ++bj)
#pragma unroll
            for (int n = 0; n < 2; ++n) { const int tok = u.pn * 256 + 128 * bj + 32 * wc + 16 * n + 4 * fq;
#pragma unroll
                for (int j = 0; j < 4; ++j) rk[bj][n][j] = rkv_of(SS, tok + j); }
#pragma unroll
        for (int ai = 0; ai < 2; ++ai)
#pragma unroll
            for (int m = 0; m < 4; ++m) { const size_t ro = (size_t)(rowb + ai * 128 + m * 16) * T + u.pn * 256 + 32 * wc + 8 * (fq & 1) + 4 * (fq >> 1);
#pragma unroll
                for (int bj = 0; bj < 2; ++bj)
#pragma unroll
                    for (int n = 0; n < 2; ++n) *(u32x2*)(dst + ro + 128 * bj + 16 * n) = pk4(acc[ai][bj][m][n] * rk[bj][n]); }
    }
};
struct SchedGrid {
    const char* A; const char* B; size_t sA, sB; int nM, nN, G, c;
    __device__ __forceinline__ bool next(int i, Unit& u) const {
        const int L = i * G + c; if (L >= nM * nN) return false;
        int pm, pn; pg8::tile_map(L, nM, nN, pm, pn);
        u.A = A + (size_t)pm * sA; u.B = B + (size_t)pn * sB; u.pm = pm; u.pn = pn; u.aux = 0; return true;
    }
};
__device__ __forceinline__ void p2_kprime(Frame& F, const Params& P) {
    PHASE_IDS();
    const int gw = F.vcu * NWAVES + wave, NGW = F.G * NWAVES;
    const f16* MKR = (const f16*)(F.ws + WS_MKR); const float* SS = (const float*)(F.ws + WS_SSQ_MK); f16* KP = (f16*)(F.ws + WS_KP);
    const f32x4 gg = *(const f32x4*)(P.in[21] + 4 * lane) * *(const f32x4*)(P.in[20] + 4 * lane);
    for (int it = gw; it < 2048 * 4; it += NGW) { const int row = it >> 2, h = it & 3, b = row >> 8, key = row & 255;
        const f32x4 a = *(const f32x4*)(SS + (size_t)row * 16 + 4 * h); const float r = __builtin_amdgcn_rsqf(((a[0] + a[1]) + (a[2] + a[3])) * (1.f / 256.f) + EPS);
        const f16x4 x = *(const f16x4*)(MKR + (size_t)row * 1024 + 256 * h + 4 * lane);
        const f32x4 v = (f32x4){(float)x[0], (float)x[1], (float)x[2], (float)x[3]} * r * gg;
        *(u32x2*)(KP + ((size_t)((b * 4 + h) * 256 + key)) * 256 + 4 * lane) = pk4(v); }
}

#define MFMA32(a, b, c) __builtin_amdgcn_mfma_f32_32x32x16_f16((a), (b), (c), 0, 0, 0)
#define MFMA16(a, b, c) __builtin_amdgcn_mfma_f32_16x16x32_f16((a), (b), (c), 0, 0, 0)
__device__ __forceinline__ f16x8 pack8(const f32x16& s, int base) {
    u32x4 w; w.x = pk2(s[base + 0], s[base + 1]); w.y = pk2(s[base + 2], s[base + 3]); w.z = pk2(s[base + 4], s[base + 5]); w.w = pk2(s[base + 6], s[base + 7]);
    return __builtin_bit_cast(f16x8, w);
}
__device__ __forceinline__ float store_ot(const f32x16& o0, const f32x16& o1, float inv, f16* dst, int hf) {
    float ss = 0.f;
#pragma unroll
    for (int g4 = 0; g4 < 4; ++g4) {
        const f32x4 a = (f32x4){o0[4 * g4], o0[4 * g4 + 1], o0[4 * g4 + 2], o0[4 * g4 + 3]} * inv, b = (f32x4){o1[4 * g4], o1[4 * g4 + 1], o1[4 * g4 + 2], o1[4 * g4 + 3]} * inv;
        ss += dot4(a) + dot4(b);
        *(u32x2*)(dst + 8 * g4 + 4 * hf) = pk4(a); *(u32x2*)(dst + 32 + 8 * g4 + 4 * hf) = pk4(b); }
    return ss;
}
constexpr float SB_EXIT = -104.0f;
__device__ __forceinline__ void sb_item(const f16* __restrict__ Qg, const f16* __restrict__ Kg, const f16* __restrict__ Vt, f16* Og, float* SSQ, int b, int h, int qblk, int lane) {
    const int r32 = lane & 31, hf = lane >> 5;
    const int t0 = qblk * 32, t = t0 + r32; const size_t row = (size_t)b * SEQ + t;
    f16x8 qf[4];
#pragma unroll
    for (int ks = 0; ks < 4; ++ks) qf[ks] = *(const f16x8*)(Qg + row * 512 + h * 64 + 16 * ks + 8 * hf);
    f32x16 o0 = {}, o1 = {};
    float carry = 0.f;
    const int kt0 = t0 >> 6;
    for (int kt = kt0; kt >= 0; --kt) {
        const int key0 = kt * 64;
        const f16* kp = Kg + ((size_t)b * SEQ + key0 + r32) * 512 + h * 64 + 8 * hf;
        const f16* vp = Vt + ((size_t)(h * 64 + r32)) * T + (size_t)b * SEQ + key0 + 8 * hf;
        f16x8 kf[2][4], vf[2][4];
#pragma unroll
        for (int kb = 0; kb < 2; ++kb)
#pragma unroll
            for (int ks = 0; ks < 4; ++ks) kf[kb][ks] = *(const f16x8*)(kp + (size_t)kb * 32 * 512 + 16 * ks);
#pragma unroll
        for (int dvb = 0; dvb < 2; ++dvb)
#pragma unroll
            for (int kk = 0; kk < 4; ++kk) vf[dvb][kk] = *(const f16x8*)(vp + (size_t)dvb * 32 * T + 16 * kk);
        f32x16 s[2]; s[0] = (f32x16){}; s[1] = (f32x16){};
#pragma unroll
        for (int ks = 0; ks < 4; ++ks) { s[0] = MFMA32(kf[0][ks], qf[ks], s[0]); s[1] = MFMA32(kf[1][ks], qf[ks], s[1]); }
        const bool diag = (kt == kt0);
        float lfv[2][16], G[2][4], PG[2][4];
#pragma unroll
        for (int kb = 0; kb < 2; ++kb)
#pragma unroll
            for (int q4 = 0; q4 < 4; ++q4) { float gs = 0.f;
#pragma unroll
                for (int j = 0; j < 4; ++j) { const int r = 4 * q4 + j; const float z = s[kb][r];
                    const float e = __expf(-__builtin_fabsf(z)); const float sp = __builtin_fmaxf(z, 0.f) + __logf(1.f + e);
                    const int key = key0 + 32 * kb + 8 * q4 + 4 * hf + j;
                    const bool vis = (!diag) || (key < t);
                    const float lf = vis ? -sp : 0.f;
                    lfv[kb][r] = lf; s[kb][r] = vis ? (z - sp) : -INFINITY; gs += lf; }
                G[kb][q4] = gs; PG[kb][q4] = __shfl_xor(gs, 32); }
        float running = carry;
#pragma unroll
        for (int kb = 1; kb >= 0; --kb)
#pragma unroll
            for (int q4 = 3; q4 >= 0; --q4) {
                float a = running + (hf == 0 ? PG[kb][q4] : 0.f);
#pragma unroll
                for (int j = 3; j >= 0; --j) { const int r = 4 * q4 + j; const float w = __expf(s[kb][r] + a); a += lfv[kb][r]; s[kb][r] = w; }
                running += G[kb][q4] + PG[kb][q4]; }
        carry = running;
#pragma unroll
        for (int kk = 0; kk < 4; ++kk) { const f16x8 pa = pack8(s[kk >> 1], 8 * (kk & 1)); o0 = MFMA32(vf[0][kk], pa, o0); o1 = MFMA32(vf[1][kk], pa, o1); }
        if (__all(carry < SB_EXIT)) break;
    }
    const float ss = store_ot(o0, o1, 1.f, Og + row * 1024 + h * 64, hf);
    const float tot = ss + __shfl_xor(ss, 32);
    if (hf == 0) SSQ[row * 16 + h] = tot;
}

constexpr int MLA_KROW = 208, MLA_VROW = 144, MLA_KBYTES = 64 * MLA_KROW, MLA_VBYTES = 64 * MLA_VROW, MLA_BUF = MLA_KBYTES + MLA_VBYTES;
__device__ __forceinline__ void mla_unit(LAS unsigned char* lds, const f16* __restrict__ Qg, const f16* __restrict__ Kg, const f16* __restrict__ Vt, f16* Og, float* SSQ, int b, int h, int qb, int tid) {
    const int lane = tid & 63, wid = __builtin_amdgcn_readfirstlane(tid >> 6), r32 = lane & 31, hf = lane >> 5;
    const size_t row = (size_t)b * SEQ + qb * 256 + wid * 32 + r32;
    f16x8 qf[6];
#pragma unroll
    for (int ks = 0; ks < 6; ++ks) qf[ks] = *(const f16x8*)(Qg + row * 768 + h * 96 + 16 * ks + 8 * hf);
    const int NT = 4 * qb + 4, my_last = 4 * qb + (wid >> 1);
    const int k0key = tid / 12, k0c = tid % 12, k1key = (tid + 512) / 12, k1c = (tid + 512) % 12, vdv = tid >> 3, vc = tid & 7;
    const f16* ksrc0 = Kg + ((size_t)b * SEQ + k0key) * 768 + h * 96 + 8 * k0c;
    const f16* ksrc1 = Kg + ((size_t)b * SEQ + k1key) * 768 + h * 96 + 8 * k1c;
    const f16* vsrc = Vt + (size_t)(h * 64 + vdv) * T + (size_t)b * SEQ + 8 * vc;
    const int kd0 = k0key * MLA_KROW + k0c * 16, kd1 = k1key * MLA_KROW + k1c * 16, vd = MLA_KBYTES + vdv * MLA_VROW + vc * 16;
    const bool has1 = tid < 256;
    u32x4 rk0, rk1 = {}, rv;
    rk0 = *(const u32x4*)ksrc0; if (has1) rk1 = *(const u32x4*)ksrc1; rv = *(const u32x4*)vsrc;
    __syncthreads();
    *(LAS u32x4*)(lds + kd0) = rk0; if (has1) *(LAS u32x4*)(lds + kd1) = rk1; *(LAS u32x4*)(lds + vd) = rv;
    __syncthreads();
    f32x16 o0 = {}, o1 = {};
    float mrun = -INFINITY, lrun = 0.f;
    for (int t = 0; t < NT; ++t) {
        const bool pre = (t + 1 < NT);
        if (pre) { const size_t ko = (size_t)(t + 1) * 64 * 768; rk0 = *(const u32x4*)(ksrc0 + ko); if (has1) rk1 = *(const u32x4*)(ksrc1 + ko); rv = *(const u32x4*)(vsrc + (t + 1) * 64); }
        if (t <= my_last) {
            const LAS unsigned char* kb_ = lds + (t & 1) * MLA_BUF; const LAS unsigned char* vb_ = kb_ + MLA_KBYTES;
            f32x16 s0 = {}, s1 = {};
#pragma unroll
            for (int ks = 0; ks < 6; ++ks) {
                const f16x8 k0 = *(const LAS f16x8*)(kb_ + r32 * MLA_KROW + (16 * ks + 8 * hf) * 2);
                const f16x8 k1 = *(const LAS f16x8*)(kb_ + (32 + r32) * MLA_KROW + (16 * ks + 8 * hf) * 2);
                s0 = MFMA32(k0, qf[ks], s0); s1 = MFMA32(k1, qf[ks], s1); }
            float tm = s0[0];
#pragma unroll
            for (int r = 1; r < 16; ++r) tm = __builtin_fmaxf(tm, s0[r]);
#pragma unroll
            for (int r = 0; r < 16; ++r) tm = __builtin_fmaxf(tm, s1[r]);
            tm = __builtin_fmaxf(tm, __shfl_xor(tm, 32));
            const float mnew = __builtin_fmaxf(mrun, tm), alpha = __builtin_amdgcn_exp2f(mrun - mnew);
            mrun = mnew;
            float ps = 0.f;
#pragma unroll
            for (int r = 0; r < 16; ++r) { s0[r] = __builtin_amdgcn_exp2f(s0[r] - mnew); s1[r] = __builtin_amdgcn_exp2f(s1[r] - mnew); ps += s0[r] + s1[r]; }
            lrun = lrun * alpha + ps;
            o0 = o0 * alpha; o1 = o1 * alpha;
#pragma unroll
            for (int kk = 0; kk < 4; ++kk) { const f16x8 pa = (kk < 2) ? pack8(s0, 8 * (kk & 1)) : pack8(s1, 8 * (kk & 1));
                const f16x8 v0 = *(const LAS f16x8*)(vb_ + r32 * MLA_VROW + (16 * kk + 8 * hf) * 2);
                const f16x8 v1 = *(const LAS f16x8*)(vb_ + (32 + r32) * MLA_VROW + (16 * kk + 8 * hf) * 2);
                o0 = MFMA32(v0, pa, o0); o1 = MFMA32(v1, pa, o1); }
        }
        if (pre) { LAS unsigned char* nb = lds + ((t + 1) & 1) * MLA_BUF; *(LAS u32x4*)(nb + kd0) = rk0; if (has1) *(LAS u32x4*)(nb + kd1) = rk1; *(LAS u32x4*)(nb + vd) = rv; }
        __syncthreads();
    }
    const float ltot = lrun + __shfl_xor(lrun, 32);
    const float ss = store_ot(o0, o1, 1.f / ltot, Og + row * 1024 + 512 + h * 64, hf);
    const float tot = ss + __shfl_xor(ss, 32);
    if (hf == 0) SSQ[row * 16 + 8 + h] = tot;
}
__device__ __forceinline__ void p3_attention(Frame& F) {
    PHASE_IDS();
    unsigned char* ws = F.ws;
    f16* ATT = (f16*)(ws + WS_ATT); float* SSQ = (float*)(ws + WS_SSQ_ATT);
    {
        const f16* Q = (const f16*)(ws + WS_SBQ); const f16* K = (const f16*)(ws + WS_SBK); const f16* Vt = (const f16*)(ws + WS_SBVT);
        const int gw = F.vcu * NWAVES + wave, NGW = F.G * NWAVES;
        for (int it = gw; it < NB * 8 * 128; it += NGW) { const int qblk = it & 127, h = (it >> 7) & 7, b = it >> 10; sb_item(Q, K, Vt, ATT, SSQ, b, h, qblk, lane); }
    }
    {
        const f16* Q = (const f16*)(ws + WS_MLAQ); const f16* K = (const f16*)(ws + WS_MLAK); const f16* Vt = (const f16*)(ws + WS_MLAVT);
        for (int pr = F.vcu; pr < 64 * 8; pr += F.G) { const int bh = pr >> 3, qa = pr & 7, b = bh >> 3, h = bh & 7;
            mla_unit(F.lds, Q, K, Vt, ATT, SSQ, b, h, 15 - qa, tid);
            mla_unit(F.lds, Q, K, Vt, ATT, SSQ, b, h, qa, tid); }
    }
}
__device__ __forceinline__ void p3b_norm(Frame& F, const Params& P) {
    PHASE_IDS();
    const int gw = F.vcu * NWAVES + wave, NGW = F.G * NWAVES;
    f16* ATT = (f16*)(F.ws + WS_ATT); const float* SSQ = (const float*)(F.ws + WS_SSQ_ATT);
    const f32x4 ga0 = *(const f32x4*)(P.in[13] + 8 * lane), ga1 = *(const f32x4*)(P.in[13] + 8 * lane + 4), gb0 = *(const f32x4*)(P.in[14] + 8 * lane), gb1 = *(const f32x4*)(P.in[14] + 8 * lane + 4);
    for (int row = gw; row < T; row += NGW) {
        const f32x4 a0 = *(const f32x4*)(SSQ + (size_t)row * 16), a1 = *(const f32x4*)(SSQ + (size_t)row * 16 + 4), b0 = *(const f32x4*)(SSQ + (size_t)row * 16 + 8), b1 = *(const f32x4*)(SSQ + (size_t)row * 16 + 12);
        const float ra = __builtin_amdgcn_rsqf((((a0[0] + a0[1]) + (a0[2] + a0[3])) + ((a1[0] + a1[1]) + (a1[2] + a1[3]))) * (1.f / 512.f) + EPS);
        const float rb = __builtin_amdgcn_rsqf((((b0[0] + b0[1]) + (b0[2] + b0[3])) + ((b1[0] + b1[1]) + (b1[2] + b1[3]))) * (1.f / 512.f) + EPS);
        f16* pa = ATT + (size_t)row * 1024 + 8 * lane; f16* pb = pa + 512;
        const f16x8 xa = *(const f16x8*)pa, xb = *(const f16x8*)pb;
        f32x4 va0, va1, vb0, vb1;
#pragma unroll
        for (int j = 0; j < 4; ++j) { va0[j] = (float)xa[j]; va1[j] = (float)xa[4 + j]; vb0[j] = (float)xb[j]; vb1[j] = (float)xb[4 + j]; }
        *(u32x4*)pa = pk8(va0 * ra * ga0, va1 * ra * ga1); *(u32x4*)pb = pk8(vb0 * rb * gb0, vb1 * rb * gb1);
    }
}

struct EpiWo {
    unsigned char* ws; const float* x; float* out;
    __device__ __forceinline__ void operator()(const Acc& acc, const Unit& u, int wr, int wc, int fr_, int fq_) const {
        int fr = fr_, fq = fq_; asm volatile("" : "+v"(fr), "+v"(fq));
        const int rowb = u.pm * 256 + wr * 64 + fr, colb = u.pn * 256 + 32 * wc + 8 * fq; f16* H = (f16*)(ws + WS_H1H); float* SS = (float*)(ws + WS_SSQ_H1);
#pragma unroll
        for (int ai = 0; ai < 2; ++ai)
#pragma unroll
            for (int m = 0; m < 4; ++m) { const size_t ro = (size_t)(rowb + ai * 128 + m * 16) * 1024 + colb; float s = 0.f;
#pragma unroll
                for (int bj = 0; bj < 2; ++bj) { const size_t o = ro + 128 * bj;
                    const f32x4 v0 = acc[ai][bj][m][0] + *(const f32x4*)(x + o), v1 = acc[ai][bj][m][1] + *(const f32x4*)(x + o + 4);
                    *(f32x4*)(out + o) = v0; *(f32x4*)(out + o + 4) = v1; *(u32x4*)(H + o) = pk8(v0, v1); s += dot4(v0) + dot4(v1); }
                s += __shfl_xor(s, 16); s += __shfl_xor(s, 32); if (fq == 0) SS[(size_t)(rowb + ai * 128 + m * 16) * 16 + 4 * u.pn + wc] = s; }
    }
};
struct EpiMq {
    unsigned char* ws;
    __device__ __forceinline__ void operator()(const Acc& acc, const Unit& u, int wr, int wc, int fr_, int fq_) const {
        int fr = fr_, fq = fq_; asm volatile("" : "+v"(fr), "+v"(fq));
        const int rowb = u.pm * 256 + wr * 64 + fr, colb = u.pn * 256 + 32 * wc + 8 * fq; f16* Q = (f16*)(ws + WS_MQ); float* SS = (float*)(ws + WS_SSQ_MQ);
#pragma unroll
        for (int ai = 0; ai < 2; ++ai)
#pragma unroll
            for (int m = 0; m < 4; ++m) { const size_t ro = (size_t)(rowb + ai * 128 + m * 16) * 1024 + colb; float s = 0.f;
#pragma unroll
                for (int bj = 0; bj < 2; ++bj) { const f32x4 v0 = acc[ai][bj][m][0], v1 = acc[ai][bj][m][1]; *(u32x4*)(Q + ro + 128 * bj) = pk8(v0, v1); s += dot4(v0) + dot4(v1); }
                s += __shfl_xor(s, 16); s += __shfl_xor(s, 32); if (fq == 0) SS[(size_t)(rowb + ai * 128 + m * 16) * 16 + 4 * u.pn + wc] = s; }
    }
};
struct EpiMo {
    unsigned char* ws; float* out;
    __device__ __forceinline__ void operator()(const Acc& acc, const Unit& u, int wr, int wc, int fr_, int fq_) const {
        int fr = fr_, fq = fq_; asm volatile("" : "+v"(fr), "+v"(fq));
        const int rowb = u.pm * 256 + wr * 64 + fr, colb = u.pn * 256 + 32 * wc + 8 * fq; f16* H = (f16*)(ws + WS_H2H);
#pragma unroll
        for (int ai = 0; ai < 2; ++ai)
#pragma unroll
            for (int m = 0; m < 4; ++m) { const size_t ro = (size_t)(rowb + ai * 128 + m * 16) * 1024 + colb;
#pragma unroll
                for (int bj = 0; bj < 2; ++bj) { const size_t o = ro + 128 * bj;
                    const f32x4 v0 = acc[ai][bj][m][0] + *(const f32x4*)(out + o), v1 = acc[ai][bj][m][1] + *(const f32x4*)(out + o + 4);
                    *(f32x4*)(out + o) = v0; *(f32x4*)(out + o + 4) = v1; *(u32x4*)(H + o) = pk8(v0, v1); } }
    }
};

constexpr int MEM_ROWB = 528;
template <int RS>
__device__ __forceinline__ void mem_stage(LAS unsigned char* lds, const f16* src, int tid) {
    const unsigned voff = (unsigned)((tid >> 5) * RS + 8 * (tid & 31)) * 2u;
    const unsigned loff = (unsigned)((tid >> 5) * MEM_ROWB + (tid & 31) * 16);
#pragma unroll
    for (int bt = 0; bt < 4; ++bt) { u32x4 r[4];
#pragma unroll
        for (int i = 0; i < 4; ++i) r[i] = *(const u32x4*)((const char*)src + (size_t)(4 * bt + i) * 16 * RS * 2 + voff);
#pragma unroll
        for (int i = 0; i < 4; ++i) *(LAS u32x4*)(lds + loff + (4 * bt + i) * 16 * MEM_ROWB) = r[i]; }
}
__device__ __forceinline__ void p6_memattn(Frame& F) {
    PHASE_IDS(); unsigned char* ws = F.ws; LAS unsigned char* lds = F.lds; const int wid = wave, l16 = lane & 15, g = lane >> 4;
    const f16* MQ = (const f16*)(ws + WS_MQ); const f16* KP = (const f16*)(ws + WS_KP); const f16* MVT = (const f16*)(ws + WS_MVT); f16* MO = (f16*)(ws + WS_MO);
    const float* SSH = (const float*)(ws + WS_SSQ_H1); const float* SSM = (const float*)(ws + WS_SSQ_MQ);
    for (int un = F.vcu; un < 256; un += F.G) { const int bh = un >> 3, qc = un & 7, b = bh >> 2, h = bh & 3;
        for (int pass = 0; pass < 4; ++pass) {
            const size_t row = (size_t)b * SEQ + qc * 512 + pass * 128 + wid * 16 + l16;
            f16x8 qf[8];
#pragma unroll
            for (int ks = 0; ks < 8; ++ks) qf[ks] = *(const f16x8*)(MQ + row * 1024 + h * 256 + 32 * ks + 8 * g);
            float fac;
            { const f32x4 a0 = *(const f32x4*)(SSH + row * 16), a1 = *(const f32x4*)(SSH + row * 16 + 4), a2 = *(const f32x4*)(SSH + row * 16 + 8), a3 = *(const f32x4*)(SSH + row * 16 + 12);
              const float sh = (((a0[0] + a0[1]) + (a0[2] + a0[3])) + ((a1[0] + a1[1]) + (a1[2] + a1[3]))) + (((a2[0] + a2[1]) + (a2[2] + a2[3])) + ((a3[0] + a3[1]) + (a3[2] + a3[3])));
              const float r1 = __builtin_amdgcn_rsqf(sh * (1.f / 1024.f) + EPS);
              const f32x4 q4 = *(const f32x4*)(SSM + row * 16 + 4 * h); const float mv = ((q4[0] + q4[1]) + (q4[2] + q4[3])) * (1.f / 256.f);
              fac = r1 * __builtin_amdgcn_rsqf(r1 * r1 * mv + EPS) * (0.0625f * 1.4426950408889634f); }
            __syncthreads();
            mem_stage<256>(lds, KP + (size_t)(b * 4 + h) * 256 * 256, tid);
            __syncthreads();
            f32x4 s[16];
#pragma unroll
            for (int kb = 0; kb < 16; ++kb) { s[kb] = (f32x4){0.f, 0.f, 0.f, 0.f};
#pragma unroll
                for (int ks = 0; ks < 8; ++ks) { const f16x8 a = *(const LAS f16x8*)(lds + (16 * kb + l16) * MEM_ROWB + (32 * ks + 8 * g) * 2); s[kb] = MFMA16(a, qf[ks], s[kb]); } }
            float mx = -INFINITY;
#pragma unroll
            for (int kb = 0; kb < 16; ++kb) { s[kb] = s[kb] * fac; mx = __builtin_fmaxf(mx, __builtin_fmaxf(__builtin_fmaxf(s[kb][0], s[kb][1]), __builtin_fmaxf(s[kb][2], s[kb][3]))); }
            mx = __builtin_fmaxf(mx, __shfl_xor(mx, 16)); mx = __builtin_fmaxf(mx, __shfl_xor(mx, 32));
            float sum = 0.f; u32x4 pf[8];
#pragma unroll
            for (int s8 = 0; s8 < 8; ++s8) { f32x4 p0, p1;
#pragma unroll
                for (int j = 0; j < 4; ++j) { p0[j] = __builtin_amdgcn_exp2f(s[2 * s8][j] - mx); p1[j] = __builtin_amdgcn_exp2f(s[2 * s8 + 1][j] - mx); }
                sum += ((p0[0] + p0[1]) + (p0[2] + p0[3])) + ((p1[0] + p1[1]) + (p1[2] + p1[3]));
                pf[s8] = pk8(p0, p1); }
            sum += __shfl_xor(sum, 16); sum += __shfl_xor(sum, 32);
            const float inv = 1.f / sum;
            __syncthreads();
            mem_stage<2048>(lds, MVT + (size_t)(h * 256) * 2048 + b * 256, tid);
            __syncthreads();
#pragma unroll 4
            for (int dvb = 0; dvb < 16; ++dvb) { f32x4 o = (f32x4){0.f, 0.f, 0.f, 0.f};
#pragma unroll
                for (int s8 = 0; s8 < 8; ++s8) { const f16x8 a = *(const LAS f16x8*)(lds + (16 * dvb + l16) * MEM_ROWB + (32 * s8 + 8 * g) * 2); o = MFMA16(a, __builtin_bit_cast(f16x8, pf[s8]), o); }
                *(u32x2*)(MO + row * 1024 + h * 256 + 16 * dvb + 4 * g) = pk4(o * inv); }
        }
    }
}

__device__ __forceinline__ void p8_route(Frame& F, const Params& P) {
    PHASE_IDS(); unsigned char* ws = F.ws;
    LAS float* WR = (LAS float*)F.lds;
    LAS unsigned* hist = (LAS unsigned*)(F.lds + LDS_MISC) + 8;
    const float* w_group = P.in[24]; const float* w_router = P.in[26];
    for (int e = tid; e < 1024 * 20; e += NTHR) { const int d = e / 20, c = e % 20; WR[e] = c < 4 ? w_group[d * 4 + c] : w_router[d * 16 + (c - 4)]; }
    if (tid < 24) hist[tid] = 0u;
    __syncthreads();
    const float* H2 = F.out; const float* gm = P.in[23];
    f32x4 g[4];
#pragma unroll
    for (int k = 0; k < 4; ++k) g[k] = *(const f32x4*)(gm + 256 * k + 4 * lane);
    float bias[20];
#pragma unroll
    for (int c = 0; c < 20; ++c) bias[c] = c < 4 ? P.in[25][c] : P.in[27][c - 4];
    int* BKT = (int*)(ws + WS_BKT); float* RR = (float*)(ws + WS_RR); float* W0 = (float*)(ws + WS_W0); float* W1 = (float*)(ws + WS_W1);
    const int gw = F.vcu * NWAVES + wave, NGW = F.G * NWAVES;
    for (int tok = gw; tok < T; tok += NGW) {
        f32x4 v[4]; float ss = 0.f;
#pragma unroll
        for (int k = 0; k < 4; ++k) { v[k] = *(const f32x4*)(H2 + (size_t)tok * 1024 + 256 * k + 4 * lane); ss += dot4(v[k]); }
        const float r = __builtin_amdgcn_rsqf(wave_sum(ss) * (1.f / 1024.f) + EPS);
        float lg[20];
#pragma unroll
        for (int c = 0; c < 20; ++c) lg[c] = 0.f;
#pragma unroll
        for (int k = 0; k < 4; ++k) { const f32x4 tv = v[k] * r * g[k];
#pragma unroll
            for (int j = 0; j < 4; ++j) { const LAS f32x4* wp = (const LAS f32x4*)(WR + (256 * k + 4 * lane + j) * 20);
#pragma unroll
                for (int c4 = 0; c4 < 5; ++c4) { const f32x4 w = wp[c4];
#pragma unroll
                    for (int i = 0; i < 4; ++i) lg[4 * c4 + i] += tv[j] * w[i]; } } }
#pragma unroll
        for (int c = 0; c < 20; ++c) lg[c] = wave_sum(lg[c]) + bias[c];
        int gi = 0; float gmx = lg[0];
#pragma unroll
        for (int c = 1; c < 4; ++c) if (lg[c] > gmx) { gmx = lg[c]; gi = c; }
        float gden = 0.f;
#pragma unroll
        for (int c = 0; c < 4; ++c) gden += __expf(lg[c] - gmx);
        const float gw_ = 1.f / gden;
        float el[4];
#pragma unroll
        for (int c = 0; c < 4; ++c) el[c] = gi == 0 ? lg[4 + c] : (gi == 1 ? lg[8 + c] : (gi == 2 ? lg[12 + c] : lg[16 + c]));
        int i1 = 0; float m1 = el[0];
#pragma unroll
        for (int c = 1; c < 4; ++c) if (el[c] > m1) { m1 = el[c]; i1 = c; }
        int i2 = -1; float m2 = -INFINITY;
#pragma unroll
        for (int c = 0; c < 4; ++c) if (c != i1 && el[c] > m2) { m2 = el[c]; i2 = c; }
        const float e2 = __expf(m2 - m1), wa = gw_ / (1.f + e2), wb = gw_ * e2 / (1.f + e2);
        const int lo = i1 < i2 ? i1 : i2, hi = i1 < i2 ? i2 : i1;
        const int pi = lo == 0 ? hi - 1 : (lo == 1 ? hi + 1 : 5);
        const int bk = gi * 6 + pi;
        if (lane == 0) { BKT[tok] = bk; RR[tok] = r; W0[tok] = (i1 < i2) ? wa : wb; W1[tok] = (i1 < i2) ? wb : wa; atomicAdd((unsigned*)&hist[bk], 1u); }
    }
    __syncthreads();
    if (tid < 24) { const unsigned hv = hist[tid]; if (hv) atomicAdd(F.ctl + CW_CNT + tid, hv); }
}
__device__ __forceinline__ void moe_tiles(Frame& F) {
    LAS int* tstart = (LAS int*)(F.lds + LDS_MISC) + 32;
    const int tid0 = fresh_tid();
    __syncthreads();
    if (tid0 == 0) { int acc = 0;
        for (int b = 0; b < 24; ++b) { tstart[b] = acc; acc += (int)((__hip_atomic_load(F.ctl + CW_CNT + b, __ATOMIC_RELAXED, __HIP_MEMORY_SCOPE_AGENT) + 255u) >> 8); }
        tstart[24] = acc; }
    __syncthreads();
}
__device__ __forceinline__ void p9_gather(Frame& F) {
    PHASE_IDS(); unsigned char* ws = F.ws; const int wid = wave;
    moe_tiles(F);
    LAS int* tstart = (LAS int*)(F.lds + LDS_MISC) + 32; LAS int* posarr = (LAS int*)(F.lds + LDS_MISC) + 64;
    const int* BKT = (const int*)(ws + WS_BKT); const float* RR = (const float*)(ws + WS_RR); const float* W0 = (const float*)(ws + WS_W0); const float* W1 = (const float*)(ws + WS_W1);
    int* TOK = (int*)(ws + WS_TOK); float* PR = (float*)(ws + WS_PR); float* PW0 = (float*)(ws + WS_PW0); float* PW1 = (float*)(ws + WS_PW1);
    const f16* H2H = (const f16*)(ws + WS_H2H); f16* TS = (f16*)(ws + WS_TS);
    for (int blk = F.vcu; blk < T / 128; blk += F.G) {
        if (wid < 2) { const int tok = blk * 128 + wid * 64 + lane; const int bk = BKT[tok];
            unsigned mycount = 0u, rank = 0u;
            for (int bb = 0; bb < 24; ++bb) { const unsigned long long mask = __ballot(bk == bb); const unsigned c = (unsigned)__popcll(mask);
                if (lane == bb) mycount = c;
                if (bk == bb) rank = (unsigned)__popcll(mask & ((1ull << lane) - 1ull)); }
            unsigned basev = 0u;
            if (lane < 24 && mycount) basev = atomicAdd(F.ctl + CW_CUR + lane, mycount);
            const unsigned mybase = (unsigned)__shfl((int)basev, bk);
            posarr[wid * 64 + lane] = tstart[bk] * 256 + (int)(mybase + rank); }
        __syncthreads();
#pragma unroll 4
        for (int j = 0; j < 16; ++j) { const int tl = wid * 16 + j, tok = blk * 128 + tl, pos = posarr[tl];
            const u32x4 a = *(const u32x4*)(H2H + (size_t)tok * 1024 + 8 * lane), b = *(const u32x4*)(H2H + (size_t)tok * 1024 + 512 + 8 * lane);
            *(u32x4*)(TS + (size_t)pos * 1024 + 8 * lane) = a; *(u32x4*)(TS + (size_t)pos * 1024 + 512 + 8 * lane) = b;
            if (lane == 0) { TOK[pos] = tok; PR[pos] = RR[tok]; PW0[pos] = W0[tok]; PW1[pos] = W1[tok]; } }
        __syncthreads();
    }
}

struct SchedMoe {
    const char* A; const char* B; LAS const int* tstart; int G, c, nct_log2, down;
    __device__ __forceinline__ bool next(int i, Unit& u) const {
        const int L = i * G + c, rt = L >> nct_log2, ct = L & ((1 << nct_log2) - 1);
        if (rt >= tstart[24]) return false;
        int bk = 0;
        for (int b = 1; b < 24; ++b) bk = (rt >= tstart[b]) ? b : bk;
        u.A = A + (size_t)rt * 256 * 1024 * 2; u.pm = rt; u.pn = ct; u.aux = bk;
        if (down) { u.B = B + ((size_t)bk * 1024 + ct * 256) * 1024 * 2; }
        else { int lo, hi; moe_pair(bk % 6, lo, hi); const int e = 4 * (bk / 6) + ((ct >> 2) ? hi : lo); u.B = B + (size_t)(e * 4 + (ct & 3)) * 256 * 1024 * 2; }
        return true;
    }
};
struct EpiGU {
    unsigned char* ws;
    __device__ __forceinline__ void operator()(const Acc& acc, const Unit& u, int wr, int wc, int fr_, int fq_) const {
        int fr = fr_, fq = fq_; asm volatile("" : "+v"(fr), "+v"(fq));
        const int rowb = u.pm * 256 + wr * 64 + fr, slot = u.pn >> 2, ffb = u.pn & 3; f16* HE = (f16*)(ws + WS_HE);
        const float* PR = (const float*)(ws + WS_PR); const float* PW = (const float*)(ws + (slot ? WS_PW1 : WS_PW0));
#pragma unroll
        for (int ai = 0; ai < 2; ++ai)
#pragma unroll
            for (int m = 0; m < 4; ++m) { const int row = rowb + ai * 128 + m * 16; const float r = PR[row], w = PW[row];
                f32x4 o[2];
#pragma unroll
                for (int n = 0; n < 2; ++n) { const f32x4 gt = acc[ai][0][m][n] * r, up = acc[ai][1][m][n] * r;
#pragma unroll
                    for (int j = 0; j < 4; ++j) { const float sg = gt[j] * __builtin_amdgcn_rcpf(1.f + __expf(-gt[j])); o[n][j] = sg * up[j] * w; } }
                *(u32x4*)(HE + (size_t)row * 1024 + slot * 512 + ffb * 128 + 32 * wc + 8 * fq) = pk8(o[0], o[1]); }
    }
};
struct EpiDown {
    unsigned char* ws; float* out;
    __device__ __forceinline__ void operator()(const Acc& acc, const Unit& u, int wr, int wc, int fr_, int fq_) const {
        int fr = fr_, fq = fq_; asm volatile("" : "+v"(fr), "+v"(fq));
        const int rowb = u.pm * 256 + wr * 64 + fr, colb = u.pn * 256 + 32 * wc + 8 * fq; const int* TOK = (const int*)(ws + WS_TOK);
#pragma unroll
        for (int ai = 0; ai < 2; ++ai)
#pragma unroll
            for (int m = 0; m < 4; ++m) { const int tok = TOK[rowb + ai * 128 + m * 16];
                if (tok >= 0) { const size_t ro = (size_t)tok * 1024 + colb;
#pragma unroll
                    for (int bj = 0; bj < 2; ++bj) { const size_t o = ro + 128 * bj;
                        *(f32x4*)(out + o) = acc[ai][bj][m][0] + *(const f32x4*)(out + o); *(f32x4*)(out + o + 4) = acc[ai][bj][m][1] + *(const f32x4*)(out + o + 4); } } }
    }
};

#ifndef MK_N_LAUNCHES
#define MK_N_LAUNCHES 1
#endif
constexpr int N_PHASES = 13;
__global__ void __launch_bounds__(NTHR, 2) fwd_kernel(Params P) {
    extern __shared__ __attribute__((aligned(16))) unsigned char lds_raw[];
    Frame F;
    F.lds = (LAS unsigned char*)lds_raw; F.MISC = (volatile LAS unsigned*)(F.lds + LDS_MISC);
    F.G = gridDim.x; F.bx = blockIdx.x; F.vcu = (F.G % 8 == 0) ? (F.bx % 8) * (F.G / 8) + F.bx / 8 : F.bx;
    F.ws = P.ws; F.out = P.out; F.ctl = (unsigned*)(P.ws + WS_CTL);
    for (int u = fresh_tid(); u < (LDS_BYTES - LDS_MISC) / 4; u += NTHR) ((LAS unsigned*)(F.lds + LDS_MISC))[u] = 0u;
    __syncthreads();
    const int lo = P.ph_lo, hi = P.ph_hi;
    const bool multi = (hi - lo) > 1;
    XcdBarrier bar; bar.bar = F.ctl + CW_BAR; bar.x = 0; bar.st = F.MISC;
    if (multi) bar = xcd_barrier_post(F.ctl + CW_BAR, F.MISC);
#define IN(k) (lo <= (k) && (k) < hi)
#define SEAM(k) do { if (IN(k) && IN((k) + 1)) xcd_barrier(bar); } while (0)
    unsigned char* ws = F.ws;
    if (IN(0)) { p0_prologue(F, P); } SEAM(0);
    if (IN(1)) {
        { SchedP1N S{ws, F.G, F.bx}; EpiP1N E{ws, P.in[12]}; pg8::gemm_phase<EpiP1N, SchedP1N, true>(F.lds, 1024, 1024, 1024, S, E); }
        { SchedP1S S{ws, F.G, (F.bx + F.G - 160) % F.G}; EpiP1S E{ws}; pg8::gemm_phase<EpiP1S, SchedP1S, true>(F.lds, 1024, 1024, 1024, S, E); }
    } SEAM(1);
    if (IN(2)) {
        p2_kprime(F, P);
        { SchedGrid S{(const char*)(ws + WS_CQ), (const char*)(ws + WS_WUQ), (size_t)256 * 384 * 2, (size_t)256 * 384 * 2, 128, 3, F.G, F.bx}; EpiP2Q E{ws, P.in[9], P.in[10]};
          pg8::gemm_phase<EpiP2Q, SchedGrid, true>(F.lds, 384, 384, 384, S, E); }
        { SchedGrid S{(const char*)(ws + WS_CKV), (const char*)(ws + WS_WUKN), (size_t)256 * 256 * 2, (size_t)256 * 256 * 2, 128, 2, F.G, (F.bx + F.G - 128) % F.G}; EpiP2K E{ws, P.in[11]};
          pg8::gemm_phase<EpiP2K, SchedGrid, true>(F.lds, 256, 256, 256, S, E); }
        { SchedGrid S{(const char*)(ws + WS_WUKV), (const char*)(ws + WS_CKV), (size_t)256 * 256 * 2, (size_t)256 * 256 * 2, 2, 128, F.G, (F.bx + F.G - 128) % F.G}; EpiP2V E{ws};
          pg8::gemm_phase<EpiP2V, SchedGrid, true>(F.lds, 256, 256, 256, S, E); }
    } SEAM(2);
    if (IN(3)) { p3_attention(F); } SEAM(3);
    if (IN(4)) { p3b_norm(F, P); } SEAM(4);
    if (IN(5)) { SchedGrid S{(const char*)(ws + WS_ATT), (const char*)(ws + WS_WO), (size_t)256 * 1024 * 2, (size_t)256 * 1024 * 2, 128, 4, F.G, F.bx}; EpiWo E{ws, P.in[0], P.out};
        pg8::gemm_phase<EpiWo, SchedGrid, true>(F.lds, 1024, 1024, 1024, S, E); } SEAM(5);
    if (IN(6)) { SchedGrid S{(const char*)(ws + WS_H1H), (const char*)(ws + WS_WMQ), (size_t)256 * 1024 * 2, (size_t)256 * 1024 * 2, 128, 4, F.G, F.bx}; EpiMq E{ws};
        pg8::gemm_phase<EpiMq, SchedGrid, true>(F.lds, 1024, 1024, 1024, S, E); } SEAM(6);
    if (IN(7)) { p6_memattn(F); } SEAM(7);
    if (IN(8)) { SchedGrid S{(const char*)(ws + WS_MO), (const char*)(ws + WS_WMO), (size_t)256 * 1024 * 2, (size_t)256 * 1024 * 2, 128, 4, F.G, F.bx}; EpiMo E{ws, P.out};
        pg8::gemm_phase<EpiMo, SchedGrid, true>(F.lds, 1024, 1024, 1024, S, E); } SEAM(8);
    if (IN(9)) { p8_route(F, P); } SEAM(9);
    if (IN(10)) { p9_gather(F); } SEAM(10);
    if (IN(11)) { moe_tiles(F); SchedMoe S{(const char*)(ws + WS_TS), (const char*)(ws + WS_WGU), (LAS const int*)(F.lds + LDS_MISC) + 32, F.G, F.vcu, 3, 0}; EpiGU E{ws};
        pg8::gemm_phase<EpiGU, SchedMoe, true>(F.lds, 1024, 1024, 1024, S, E); } SEAM(11);
    if (IN(12)) { moe_tiles(F); SchedMoe S{(const char*)(ws + WS_HE), (const char*)(ws + WS_WD2), (LAS const int*)(F.lds + LDS_MISC) + 32, F.G, F.vcu, 2, 1}; EpiDown E{ws, P.out};
        pg8::gemm_phase<EpiDown, SchedMoe, true>(F.lds, 1024, 1024, 1024, S, E); }
#undef IN
#undef SEAM
}

extern "C" void kernel_launch(void* const* d_in, const int* in_sizes, int n_in, void* d_out, int out_size, void* d_ws, size_t ws_size, hipStream_t stream) {
    static int grid = 0;
    if (grid == 0) {
        if (n_in != 31 || out_size != T * D || ws_size < WS_END) { fprintf(stderr, "kernel_launch: unexpected shapes (n_in %d, out %d, ws %zu < %zu)\n", n_in, out_size, ws_size, (size_t)WS_END); grid = -1; return; }
        int dev = 0, cus = 0, per_cu = 0;
        if (hipGetDevice(&dev) != hipSuccess || hipDeviceGetAttribute(&cus, hipDeviceAttributeMultiprocessorCount, dev) != hipSuccess) { grid = -1; return; }
        if (hipFuncSetAttribute((const void*)fwd_kernel, hipFuncAttributeMaxDynamicSharedMemorySize, LDS_BYTES) != hipSuccess) { fprintf(stderr, "kernel_launch: hipFuncSetAttribute failed\n"); grid = -1; return; }
        if (hipOccupancyMaxActiveBlocksPerMultiprocessor(&per_cu, (const void*)fwd_kernel, NTHR, LDS_BYTES) != hipSuccess || per_cu < 1) { fprintf(stderr, "kernel_launch: occupancy query says %d\n", per_cu); }
        (void)hipGetLastError();
        grid = cus;
    }
    if (grid < 0) return;
    (void)hipMemsetAsync((char*)d_ws + WS_CTL, 0, CTL_ZERO_BYTES, stream);
    Params p{};
    for (int i = 0; i < 31; ++i) p.in[i] = (const float*)d_in[i];
    p.out = (float*)d_out; p.ws = (unsigned char*)d_ws;
    if (MK_N_LAUNCHES == 1) { p.ph_lo = 0; p.ph_hi = N_PHASES; hipLaunchKernelGGL(fwd_kernel, dim3(grid), dim3(NTHR), LDS_BYTES, stream, p); }
    else { for (int k = 0; k < N_PHASES; ++k) { p.ph_lo = k; p.ph_hi = k + 1; hipLaunchKernelGGL(fwd_kernel, dim3(grid), dim3(NTHR), LDS_BYTES, stream, p); } }
}
```

```cpp
#include <hip/hip_runtime.h>
#include <cstdio>
#include <cstdint>

#define LAS __attribute__((address_space(3)))
#define GAS __attribute__((address_space(1)))
typedef _Float16 f16;
typedef _Float16 f16x8 __attribute__((ext_vector_type(8)));
typedef _Float16 f16x4 __attribute__((ext_vector_type(4)));
typedef _Float16 f16x2 __attribute__((ext_vector_type(2)));
typedef float f32x2 __attribute__((ext_vector_type(2)));
typedef float f32x4 __attribute__((ext_vector_type(4)));
typedef float f32x16 __attribute__((ext_vector_type(16)));
typedef unsigned u32x4 __attribute__((ext_vector_type(4)));
typedef unsigned u32x2 __attribute__((ext_vector_type(2)));

__device__ __forceinline__ unsigned pk2(float lo, float hi) { f16x2 v = {(f16)lo, (f16)hi}; return __builtin_bit_cast(unsigned, v); }
__device__ __forceinline__ u32x4 pk8(f32x4 a, f32x4 b) { u32x4 w; w.x = pk2(a[0], a[1]); w.y = pk2(a[2], a[3]); w.z = pk2(b[0], b[1]); w.w = pk2(b[2], b[3]); return w; }
__device__ __forceinline__ u32x2 pk4(f32x4 a) { u32x2 w; w.x = pk2(a[0], a[1]); w.y = pk2(a[2], a[3]); return w; }
__device__ __forceinline__ float dot4(f32x4 a) { return (a[0] * a[0] + a[1] * a[1]) + (a[2] * a[2] + a[3] * a[3]); }
__device__ __forceinline__ float wave_sum(float v) {
#pragma unroll
    for (int o = 1; o < 64; o <<= 1) v += __shfl_xor(v, o);
    return v;
}
__device__ __forceinline__ int L32(int q) { return 8 * ((q >> 2) & 3) + 4 * (q >> 4) + (q & 3); }

__device__ __forceinline__ int fresh_tid() { int t = (int)threadIdx.x; asm volatile("" : "+v"(t)); return t; }
constexpr int T = 32768, D = 1024, SEQ = 4096, NB = 8;
constexpr float EPS = 1e-6f;
constexpr int NPOS = 152 * 256;

namespace pg8 {
constexpr int BM = 256, BK = 64, HALF = 128, HTB = HALF * BK * 2, STAGE_BYTES = 8 * HTB;
__host__ __device__ __forceinline__ int lds_byte(int r, int c) { const int st = (r >> 4) * 2 + (c >> 5), rr = r & 15, cc = c & 31, ob = rr * 64 + cc * 2; return st * 1024 + (ob ^ (((ob >> 9) & 1) << 5)); }
__host__ __device__ __forceinline__ void stage_rc(int b, int& R, int& C) { const int st = b / 1024, sb = b % 1024, swz = sb ^ (((sb >> 9) & 1) << 5); R = (st >> 1) * 16 + swz / 64; C = (st & 1) * 32 + (swz % 64) / 2; }
struct Unit { const char* A; const char* B; int pm, pn, aux; };

template <class Epi, class Sched, bool ALIGN_EPI>
__device__ __forceinline__ void gemm_phase(LAS unsigned char* lds, const int K, const int lda, const int ldb, const Sched& S, const Epi& E) {
    const int tid = fresh_tid(), wid = __builtin_amdgcn_readfirstlane(tid >> 6), lane = tid & 63, wr = wid >> 2, wc = wid & 3, fr = lane & 15, fq = lane >> 4;
    const int nt = K / BK;
    unsigned voffA[2], voffB[2];
#pragma unroll
    for (int i = 0; i < 2; ++i) { int R, C; stage_rc(tid * 16 + i * 8192, R, C); voffA[i] = (unsigned)(R * lda + C) * 2u; voffB[i] = (unsigned)(R * ldb + C) * 2u; }
    const size_t kstep = (size_t)(BK * 2);
    const size_t hstepA = (size_t)HALF * lda * 2, hstepB = (size_t)HALF * ldb * 2;
    const unsigned ldsw = (unsigned)wid * 1024u;
    const int aoff = lds_byte(wr * 64 + fr, fq * 8), boff = lds_byte(wc * 32 + fr, fq * 8);
#define PG8_SA(b, h) (((b) * 2 + (h)) * HTB)
#define PG8_SB(b, h) ((4 + (b) * 2 + (h)) * HTB)
#define PG8_STAGE(bufoff, gbase, voff) do { _Pragma("unroll") for (int _i = 0; _i < 2; ++_i) \
        __builtin_amdgcn_global_load_lds((const unsigned*)((const char*)(gbase) + (voff)[_i]), (LAS unsigned*)(lds + (bufoff) + ldsw + _i * 8192), 16, 0, 0); } while (0)
#define PG8_LDA(dst, b, h) do { _Pragma("unroll") for (int m = 0; m < 4; ++m) _Pragma("unroll") for (int k = 0; k < 2; ++k) dst[m][k] = *(const LAS f16x8*)(lds + PG8_SA(b, h) + aoff + m * 2048 + k * 1024); } while (0)
#define PG8_LDB(dst, b, h) do { _Pragma("unroll") for (int n = 0; n < 2; ++n) _Pragma("unroll") for (int k = 0; k < 2; ++k) dst[n][k] = *(const LAS f16x8*)(lds + PG8_SB(b, h) + boff + n * 2048 + k * 1024); } while (0)
#define PG8_MMA(ai, bj, At, Bt) do { __builtin_amdgcn_s_setprio(1); _Pragma("unroll") for (int m = 0; m < 4; ++m) _Pragma("unroll") for (int n = 0; n < 2; ++n) _Pragma("unroll") for (int k = 0; k < 2; ++k) \
        acc[ai][bj][m][n] = __builtin_amdgcn_mfma_f32_16x16x32_f16(Bt[n][k], At[m][k], acc[ai][bj][m][n], 0, 0, 0); __builtin_amdgcn_s_setprio(0); } while (0)
#define PG8_WAIT_V(n) asm volatile("s_waitcnt vmcnt(" #n ")" ::: "memory")
#define PG8_WAIT_L(n) asm volatile("s_waitcnt lgkmcnt(" #n ")" ::: "memory")
#define PG8_BAR __builtin_amdgcn_s_barrier()
#define PG8_SCHED __builtin_amdgcn_sched_barrier(0)
    Unit cur, nxt; int ui = 0;
    if (!S.next(0, cur)) return;
    f32x4 acc[2][2][4][2];
#pragma unroll
    for (int a = 0; a < 2; ++a)
#pragma unroll
        for (int b = 0; b < 2; ++b)
#pragma unroll
            for (int m = 0; m < 4; ++m)
#pragma unroll
                for (int n = 0; n < 2; ++n) acc[a][b][m][n] = (f32x4){0.f, 0.f, 0.f, 0.f};
    f16x8 At[4][2], B0[2][2], B1[2][2];
    const char* cA = cur.A; const char* cB = cur.B;
    PG8_STAGE(PG8_SB(0, 0), cB, voffB); PG8_STAGE(PG8_SB(0, 1), cB + hstepB, voffB); PG8_STAGE(PG8_SA(0, 0), cA, voffA); PG8_STAGE(PG8_SA(0, 1), cA + hstepA, voffA);
    if (wr == 1) PG8_BAR;
    PG8_WAIT_V(2); PG8_BAR;
    PG8_STAGE(PG8_SB(1, 0), cB + kstep, voffB); PG8_STAGE(PG8_SA(1, 0), cA + kstep, voffA); PG8_STAGE(PG8_SB(1, 1), cB + hstepB + kstep, voffB);
    PG8_WAIT_V(6); PG8_BAR;
    for (;;) {
        const bool has_next = S.next(ui + 1, nxt);
        const char* nA = has_next ? nxt.A : cA; const char* nB = has_next ? nxt.B : cB;
        for (int t = 0; t < nt; t += 2) {
            const bool last = (t == nt - 2);
            const char* a1 = cA + (size_t)(t + 1) * kstep;
            const char* a2 = last ? nA : cA + (size_t)(t + 2) * kstep; const char* b2 = last ? nB : cB + (size_t)(t + 2) * kstep;
            const char* a3 = a2 + kstep; const char* b3 = b2 + kstep;
            PG8_LDB(B0, 0, 0); PG8_LDB(B1, 0, 1); PG8_SCHED; PG8_LDA(At, 0, 0); PG8_STAGE(PG8_SA(1, 1), a1 + hstepA, voffA);
            PG8_WAIT_V(8); PG8_WAIT_L(0); PG8_BAR; PG8_MMA(0, 0, At, B0); PG8_MMA(0, 1, At, B1); PG8_BAR; PG8_SCHED;
            PG8_LDA(At, 0, 1); PG8_STAGE(PG8_SB(0, 0), b2, voffB); PG8_STAGE(PG8_SB(0, 1), b2 + hstepB, voffB); PG8_STAGE(PG8_SA(0, 0), a2, voffA);
            PG8_WAIT_V(8); PG8_WAIT_L(0); PG8_BAR; PG8_MMA(1, 0, At, B0); PG8_MMA(1, 1, At, B1); PG8_BAR; PG8_SCHED;
            PG8_LDB(B0, 1, 0); PG8_LDB(B1, 1, 1); PG8_SCHED; PG8_LDA(At, 1, 0); PG8_STAGE(PG8_SA(0, 1), a2 + hstepA, voffA);
            PG8_WAIT_V(8); PG8_WAIT_L(0); PG8_BAR; PG8_MMA(0, 0, At, B0); PG8_MMA(0, 1, At, B1); PG8_BAR; PG8_SCHED;
            PG8_LDA(At, 1, 1); PG8_STAGE(PG8_SB(1, 0), b3, voffB); PG8_STAGE(PG8_SB(1, 1), b3 + hstepB, voffB); PG8_STAGE(PG8_SA(1, 0), a3, voffA);
            PG8_WAIT_V(8); PG8_WAIT_L(0); PG8_BAR; PG8_MMA(1, 0, At, B0); PG8_MMA(1, 1, At, B1); PG8_BAR; PG8_SCHED;
        }
        if constexpr (ALIGN_EPI) { if (wr == 0) PG8_BAR; }
        E(acc, cur, wr, wc, fr, fq);
        if (!has_next) break;
#pragma unroll
        for (int a = 0; a < 2; ++a)
#pragma unroll
            for (int b = 0; b < 2; ++b)
#pragma unroll
                for (int m = 0; m < 4; ++m)
#pragma unroll
                    for (int n = 0; n < 2; ++n) acc[a][b][m][n] = (f32x4){0.f, 0.f, 0.f, 0.f};
        cur = nxt; cA = nA; cB = nB; ++ui;
        if constexpr (ALIGN_EPI) { if (wr == 1) PG8_BAR; }
    }
    PG8_WAIT_V(0);
    if constexpr (!ALIGN_EPI) { if (wr == 0) PG8_BAR; }
    PG8_BAR;
#undef PG8_SA
#undef PG8_SB
#undef PG8_STAGE
#undef PG8_LDA
#undef PG8_LDB
#undef PG8_MMA
#undef PG8_WAIT_V
#undef PG8_WAIT_L
#undef PG8_BAR
#undef PG8_SCHED
}
__device__ __forceinline__ void tile_map(int L, int nM, int nN, int& pm, int& pn) {
    const int nwg = nM * nN; int wgid = L;
    { const int q = nwg / 8, r = nwg % 8, xcd = wgid % 8, off = wgid / 8; wgid = (xcd < r ? xcd * (q + 1) : r * (q + 1) + (xcd - r) * q) + off; }
    const int nig = 8 * nN, gid = wgid / nig, fm = gid * 8, gsz = (nM - fm) < 8 ? (nM - fm) : 8;
    pm = fm + ((wgid % nig) % gsz); pn = (wgid % nig) / gsz;
}
}
using pg8::Unit;

#define XB_TMO      128
#define XB_XCNT(j)  (256  + 64 * (j))
#define XB_XSUB(j)  (1280 + 64 * (j))
#define XB_XGEN(j)  (2304 + 64 * (j))
#define XB_TOP      3328
#define XB_TOPGEN   3392
#define XCD_BAR_WORDS 3456
#define XB_SPIN_CAP (1u << 18)
__device__ __forceinline__ unsigned xb_ld(unsigned* p)              { return __hip_atomic_load(p, __ATOMIC_RELAXED, __HIP_MEMORY_SCOPE_AGENT); }
__device__ __forceinline__ unsigned xb_add(unsigned* p, unsigned v) { return __hip_atomic_fetch_add(p, v, __ATOMIC_RELAXED, __HIP_MEMORY_SCOPE_AGENT); }
__device__ __forceinline__ unsigned xb_xcc_id() { return (unsigned)__builtin_amdgcn_s_getreg((3 << 11) | 20) & 0xFu; }
#define XB_SPIN(cond, bar) do { unsigned _sp = 0; while (cond) { __builtin_amdgcn_s_sleep(1); \
    if ((++_sp & 255u) == 0u) { if (xb_ld(&(bar)[XB_TMO])) break; if (_sp > XB_SPIN_CAP) { atomicAdd(&(bar)[XB_TMO], 1u); break; } } } } while (0)
struct XcdBarrier { unsigned* bar; unsigned x; volatile LAS unsigned* st; };
__device__ __forceinline__ XcdBarrier xcd_barrier_post(unsigned* bar, volatile LAS unsigned* st) {
    XcdBarrier b; b.bar = bar; b.x = xb_xcc_id(); b.st = st;
    if (threadIdx.x == 0) (void)xb_add(&bar[XB_XCNT(b.x)], 1u);
    return b;
}
__device__ __forceinline__ void xcd_barrier_complete(unsigned* bar, unsigned x, unsigned& nloc, unsigned& nx) {
    const unsigned G = gridDim.x * gridDim.y * gridDim.z;
    unsigned sum, cnt, mine, sp = 0u;
    for (;;) {
        sum = 0u; cnt = 0u; mine = 0u;
#pragma unroll
        for (unsigned j = 0; j < 16; ++j) { const unsigned c = xb_ld(&bar[XB_XCNT(j)]); sum += c; cnt += (c > 0u) ? 1u : 0u; mine = (j == x) ? c : mine; }
        if (sum == G) break;
        __builtin_amdgcn_s_sleep(1);
        if ((++sp & 255u) == 0u) { if (xb_ld(&bar[XB_TMO])) break; if (sp > XB_SPIN_CAP) { atomicAdd(&bar[XB_TMO], 1u); break; } }
    }
    nloc = mine > 0u ? mine : 1u; nx = cnt > 0u ? cnt : 1u;
}
__device__ __forceinline__ void xcd_barrier(const XcdBarrier& b) {
    asm volatile("s_waitcnt vmcnt(0)" ::: "memory");
    __syncthreads();
    if (threadIdx.x == 0) {
        unsigned* bar = b.bar;
        __builtin_amdgcn_s_waitcnt(0);
        unsigned nloc = b.st[0], nx = b.st[1];
        if (nloc == 0u) { xcd_barrier_complete(bar, b.x, nloc, nx); b.st[0] = nloc; b.st[1] = nx; }
        const unsigned old = xb_add(&bar[XB_XSUB(b.x)], 1u);
        const unsigned gen = old / nloc;
        if (old + 1u == (gen + 1u) * nloc) {
            __builtin_amdgcn_fence(__ATOMIC_RELEASE, "agent");
            asm volatile("s_waitcnt vmcnt(0)" ::: "memory");
            const unsigned og = xb_add(&bar[XB_TOP], 1u);
            const unsigned tg = og / nx;
            if (og + 1u == (tg + 1u) * nx) xb_add(&bar[XB_TOPGEN], 1u);
            else XB_SPIN(xb_ld(&bar[XB_TOPGEN]) == tg, bar);
            __builtin_amdgcn_fence(__ATOMIC_ACQUIRE, "agent");
            xb_add(&bar[XB_XGEN(b.x)], 1u);
            asm volatile("s_waitcnt vmcnt(0)" ::: "memory");
        } else {
            XB_SPIN(xb_ld(&bar[XB_XGEN(b.x)]) == gen, bar);
            __builtin_amdgcn_fence(__ATOMIC_ACQUIRE, "agent");
            asm volatile("s_waitcnt vmcnt(0)" ::: "memory");
        }
    }
    __syncthreads();
}

constexpr size_t MiB = 1u << 20;
constexpr size_t WS_CTL = 0, CTL_ZERO_BYTES = 65536;
constexpr int CW_BAR = 1024;
constexpr int CW_CNT = 8192;
constexpr int CW_CUR = 8192 + 64;
constexpr size_t WS_SSQ_CQ  = 1 * MiB;
constexpr size_t WS_SSQ_CKV = 2 * MiB;
constexpr size_t WS_SSQ_MK  = 2 * MiB + 512 * 1024;
constexpr size_t WS_SSQ_ATT = 3 * MiB;
constexpr size_t WS_SSQ_H1  = 5 * MiB;
constexpr size_t WS_SSQ_MQ  = 7 * MiB;
constexpr size_t WS_COS     = 9 * MiB;
constexpr size_t WS_SIN     = 11 * MiB;
constexpr size_t WS_BKT     = 13 * MiB;
constexpr size_t WS_RR      = 13 * MiB + 128 * 1024;
constexpr size_t WS_W0      = 13 * MiB + 256 * 1024;
constexpr size_t WS_W1      = 13 * MiB + 384 * 1024;
constexpr size_t WS_TOK     = 13 * MiB + 512 * 1024;
constexpr size_t WS_PR      = 13 * MiB + 704 * 1024;
constexpr size_t WS_PW0     = 14 * MiB;
constexpr size_t WS_PW1     = 14 * MiB + 192 * 1024;
constexpr size_t WS_KRF     = 14 * MiB + 512 * 1024;
constexpr size_t WS_WIN  = 17 * MiB;
constexpr size_t WS_WSV  = WS_WIN  + 3584 * 1024;
constexpr size_t WS_WMK  = WS_WSV  + 1 * MiB;
constexpr size_t WS_WMV  = WS_WMK  + 2 * MiB;
constexpr size_t WS_WUQ  = WS_WMV  + 2 * MiB;
constexpr size_t WS_WUKN = WS_WUQ  + 1 * MiB;
constexpr size_t WS_WUKV = WS_WUKN + 256 * 1024;
constexpr size_t WS_WO   = WS_WUKV + 256 * 1024;
constexpr size_t WS_WMQ  = WS_WO   + 2 * MiB;
constexpr size_t WS_WMO  = WS_WMQ  + 2 * MiB;
constexpr size_t WS_WGU  = WS_WMO  + 2 * MiB;
constexpr size_t WS_WD2  = WS_WGU  + 32 * MiB;
constexpr size_t WS_WEND = WS_WD2  + 48 * MiB;
constexpr size_t WS_MN   = 114 * MiB;
constexpr size_t WS_MKR  = 118 * MiB;
constexpr size_t WS_MVT  = 122 * MiB;
constexpr size_t WS_KP   = 126 * MiB;
constexpr size_t WS_R1   = 130 * MiB;
constexpr size_t WS_R2   = 194 * MiB;
constexpr size_t WS_R3   = 290 * MiB;
constexpr size_t WS_R4   = 330 * MiB;
constexpr size_t WS_END  = 458 * MiB;
static_assert(WS_WEND <= WS_MN, "ws map");
constexpr size_t WS_HN = WS_R1, WS_ATT = WS_R1, WS_MQ = WS_R1, WS_H2H = WS_R1;
constexpr size_t WS_SBQ = WS_R2, WS_SBK = WS_R2 + 32 * MiB, WS_SBVT = WS_R2 + 64 * MiB, WS_H1H = WS_R2, WS_TS = WS_R2;
constexpr size_t WS_CQ = WS_R3, WS_CKV = WS_R3 + 24 * MiB;
constexpr size_t WS_MLAQ = WS_R4, WS_MLAK = WS_R4 + 48 * MiB, WS_MLAVT = WS_R4 + 96 * MiB, WS_HE = WS_R4, WS_MO = WS_R4;

constexpr int LDS_BYTES = 147456;
constexpr int LDS_MISC = 143360;
constexpr int NWAVES = 8, NTHR = 512;

struct Params { const float* in[31]; float* out; unsigned char* ws; int ph_lo, ph_hi; };

struct Frame {
    LAS unsigned char* lds; volatile LAS unsigned* MISC;
    int vcu, G, bx;
    unsigned char* ws; float* out; unsigned* ctl;
};
#define PHASE_IDS() const int tid = fresh_tid(), lane = tid & 63, wave = __builtin_amdgcn_readfirstlane(tid >> 6); (void)lane; (void)wave

__device__ __forceinline__ void conv_item(const float* src, int ld, int srccol0, int mode, int ksrc0, const float* kscale, f16* dst, int K, int row0, int k0, LAS float* scr, int lane) {
    if (mode != 2) {
#pragma unroll 8
        for (int i = 0; i < 32; ++i) { const int kk = 2 * i + (lane >> 5); float v = src[(size_t)(ksrc0 + kk) * ld + srccol0 + (lane & 31)]; if (kscale) v *= kscale[ksrc0 + kk]; scr[kk * 33 + (lane & 31)] = v; }
    }
    asm volatile("s_waitcnt lgkmcnt(0)" ::: "memory");
    const int c = lane & 7;
#pragma unroll
    for (int j = 0; j < 4; ++j) { const int q = (lane >> 3) + 8 * j; const int lc = (mode == 1) ? L32(q) : q; const LAS float* s = scr + (8 * c) * 33 + lc;
        u32x4 o;
        if (mode == 2) { o = (u32x4){0u, 0u, 0u, 0u}; }
        else { o.x = pk2(s[0 * 33], s[1 * 33]); o.y = pk2(s[2 * 33], s[3 * 33]); o.z = pk2(s[4 * 33], s[5 * 33]); o.w = pk2(s[6 * 33], s[7 * 33]); }
        *(u32x4*)(dst + (size_t)(row0 + q) * K + k0 + 8 * c) = o; }
    asm volatile("s_waitcnt lgkmcnt(0)" ::: "memory");
}
__device__ __forceinline__ void rms_row_to_f16(const float* xrow, const float* g, f16* orow, int lane) {
    const f32x4* xr = (const f32x4*)xrow + lane; const f32x4* gr = (const f32x4*)g + lane;
    f32x4 v[4]; float s = 0.f;
#pragma unroll
    for (int j = 0; j < 4; ++j) { v[j] = xr[64 * j]; s += dot4(v[j]); }
    const float r = __builtin_amdgcn_rsqf(wave_sum(s) * (1.f / 1024.f) + EPS);
    u32x2* o8 = (u32x2*)orow + lane;
#pragma unroll
    for (int j = 0; j < 4; ++j) { const f32x4 gg = gr[64 * j]; o8[64 * j] = pk4(v[j] * r * gg); }
}
__device__ __forceinline__ void moe_pair(int pi, int& lo, int& hi) { lo = pi < 3 ? 0 : (pi < 5 ? 1 : 2); hi = pi < 3 ? pi + 1 : (pi < 5 ? pi - 1 : 3); }

__device__ __forceinline__ void p0_prologue(Frame& F, const Params& P) {
    PHASE_IDS();
    LAS float* scr = (LAS float*)(F.lds + wave * 16384);
    const int gw = F.vcu * NWAVES + wave, NGW = F.G * NWAVES;
    unsigned char* ws = F.ws;
    const float* w_in = P.in[4]; const float* w_uq = P.in[6]; const float* w_ukv = P.in[8]; const float* w_o = P.in[15];
    const float* w_mq = P.in[18]; const float* w_mkv = P.in[19]; const float* w_mo = P.in[22];
    const float* w_gate = P.in[28]; const float* w_up = P.in[29]; const float* w_down = P.in[30];
    for (int it = gw; it < 56 * 16; it += NGW) { const int rb = it >> 4, kb = it & 15, tile = rb >> 3, g = rb & 7, bj = g >> 2, wc = g & 3; int col, mode = 1;
        if (tile < 2) col = (4 * tile + wc) * 64 + 32 * bj;
        else if (tile < 4) col = 512 + (4 * (tile - 2) + wc) * 64 + 32 * bj;
        else if (tile == 4) col = 1536 + 64 * wc + 32 * bj;
        else if (tile == 5) { if (bj == 0) col = 1536 + 256 + 32 * wc; else if (wc == 0) { col = 2176; mode = 0; } else { col = 0; mode = 2; } }
        else col = 1920 + 64 * wc + 32 * bj;
        conv_item(w_in, 2208, col, mode, kb * 64, nullptr, (f16*)(ws + WS_WIN), 1024, rb * 32, kb * 64, scr, lane); }
    for (int it = gw; it < 16 * 16; it += NGW) { const int rb = it >> 4, kb = it & 15; conv_item(w_in, 2208, 1024 + 32 * rb, 0, kb * 64, nullptr, (f16*)(ws + WS_WSV), 1024, rb * 32, kb * 64, scr, lane); }
    for (int it = gw; it < 32 * 16; it += NGW) { const int rb = it >> 4, kb = it & 15, tile = rb >> 3, g = rb & 7, bj = g >> 2, wc = g & 3;
        conv_item(w_mkv, 2048, 256 * tile + 64 * wc + 32 * bj, 1, kb * 64, nullptr, (f16*)(ws + WS_WMK), 1024, rb * 32, kb * 64, scr, lane); }
    for (int it = gw; it < 32 * 16; it += NGW) { const int rb = it >> 4, kb = it & 15; conv_item(w_mkv, 2048, 1024 + 32 * rb, 0, kb * 64, nullptr, (f16*)(ws + WS_WMV), 1024, rb * 32, kb * 64, scr, lane); }
    for (int it = gw; it < 24 * 6; it += NGW) { const int rb = it / 6, kb = it % 6, tile = rb >> 3, g = rb & 7, bj = g >> 2, wc = g & 3; int col, mode = 1;
        if (tile < 2) col = (4 * tile + wc) * 96 + 32 * bj; else { col = (4 * bj + wc) * 96 + 64; mode = 0; }
        conv_item(w_uq, 768, col, mode, kb * 64, P.in[5], (f16*)(ws + WS_WUQ), 384, rb * 32, kb * 64, scr, lane); }
    for (int it = gw; it < 16 * 4; it += NGW) { const int rb = it >> 2, kb = it & 3, tile = rb >> 3, g = rb & 7, bj = g >> 2, wc = g & 3;
        conv_item(w_ukv, 1024, (4 * tile + wc) * 128 + 32 * bj, 1, kb * 64, P.in[7], (f16*)(ws + WS_WUKN), 256, rb * 32, kb * 64, scr, lane); }
    for (int it = gw; it < 16 * 4; it += NGW) { const int rb = it >> 2, kb = it & 3;
        conv_item(w_ukv, 1024, (rb >> 1) * 128 + 64 + 32 * (rb & 1), 0, kb * 64, P.in[7], (f16*)(ws + WS_WUKV), 256, rb * 32, kb * 64, scr, lane); }
    for (int it = gw; it < 32 * 16; it += NGW) { const int rb = it >> 4, kb = it & 15; conv_item(w_o, 1024, 32 * rb, 1, kb * 64, nullptr, (f16*)(ws + WS_WO), 1024, rb * 32, kb * 64, scr, lane); }
    for (int it = gw; it < 32 * 16; it += NGW) { const int rb = it >> 4, kb = it & 15; conv_item(w_mq, 1024, 32 * rb, 1, kb * 64, P.in[16], (f16*)(ws + WS_WMQ), 1024, rb * 32, kb * 64, scr, lane); }
    for (int it = gw; it < 32 * 16; it += NGW) { const int rb = it >> 4, kb = it & 15; conv_item(w_mo, 1024, 32 * rb, 1, kb * 64, nullptr, (f16*)(ws + WS_WMO), 1024, rb * 32, kb * 64, scr, lane); }
    for (int it = gw; it < 64 * 8 * 16; it += NGW) { const int kb = it & 15, rb = (it >> 4) & 7, tile = it >> 7, e = tile >> 2, ffb = tile & 3, bj = rb >> 2, wc = rb & 3;
        conv_item((bj ? w_up : w_gate) + (size_t)e * 1024 * 512, 512, ffb * 128 + 32 * wc, 1, kb * 64, P.in[23], (f16*)(ws + WS_WGU) + (size_t)tile * 256 * 1024, 1024, rb * 32, kb * 64, scr, lane); }
    for (int it = gw; it < 24 * 32 * 16; it += NGW) { const int kb = it & 15, rb = (it >> 4) & 31, bk = it >> 9; int lo, hi; moe_pair(bk % 6, lo, hi);
        const int e = 4 * (bk / 6) + (kb < 8 ? lo : hi);
        conv_item(w_down + (size_t)e * 512 * 1024, 1024, 32 * rb, 1, (kb & 7) * 64, nullptr, (f16*)(ws + WS_WD2) + (size_t)bk * 1024 * 1024, 1024, rb * 32, kb * 64, scr, lane); }
    for (int m = gw; m < T; m += NGW) rms_row_to_f16(P.in[0] + (size_t)m * D, P.in[3], (f16*)(ws + WS_HN) + (size_t)m * D, lane);
    for (int m = gw; m < 2048; m += NGW) rms_row_to_f16(P.in[1] + (size_t)m * D, P.in[17], (f16*)(ws + WS_MN) + (size_t)m * D, lane);
    {
        const int gt = F.vcu * NTHR + tid, NGT = F.G * NTHR; const int* pos = (const int*)P.in[2];
        float* COS = (float*)(ws + WS_COS); float* SIN = (float*)(ws + WS_SIN);
        for (int e = gt; e < T * 16; e += NGT) { const int tok = e >> 4, i = e & 15;
            const float invf = i == 0 ? 1.000000000e+00f : i == 1 ? 5.623413324e-01f : i == 2 ? 3.162277639e-01f : i == 3 ? 1.778279394e-01f : i == 4 ? 1.000000015e-01f : i == 5 ? 5.623413250e-02f : i == 6 ? 3.162277490e-02f : i == 7 ? 1.778279431e-02f :
                               i == 8 ? 9.999999776e-03f : i == 9 ? 5.623413250e-03f : i == 10 ? 3.162277630e-03f : i == 11 ? 1.778279431e-03f : i == 12 ? 1.000000047e-03f : i == 13 ? 5.623413017e-04f : i == 14 ? 3.162277571e-04f : 1.778279402e-04f;
            const float ang = (float)pos[tok] * invf;
            const double x = (double)ang; const double n = __builtin_rint(x * 0.15915494309189535); const float rev = (float)(x * 0.15915494309189535 - n);
            COS[e] = __builtin_amdgcn_cosf(rev); SIN[e] = __builtin_amdgcn_sinf(rev); }
        int* TOK = (int*)(ws + WS_TOK);
        for (int e = gt; e < NPOS; e += NGT) TOK[e] = -1;
    }
}

typedef f32x4 Acc[2][2][4][2];
template <bool SSQ>
__device__ __forceinline__ void store_w64(const Acc& acc, int rowb, f16* dst, int ld, int colb, float scale, float* ssq, int ldq, int slot, int fq) {
#pragma unroll
    for (int ai = 0; ai < 2; ++ai)
#pragma unroll
        for (int m = 0; m < 4; ++m) { const int row = rowb + ai * 128 + m * 16; float s = 0.f;
#pragma unroll
            for (int bj = 0; bj < 2; ++bj) { const f32x4 v0 = acc[ai][bj][m][0] * scale, v1 = acc[ai][bj][m][1] * scale;
                if (SSQ) s += dot4(v0) + dot4(v1);
                *(u32x4*)(dst + (size_t)row * ld + colb + bj * 32 + 8 * fq) = pk8(v0, v1); }
            if (SSQ) { s += __shfl_xor(s, 16); s += __shfl_xor(s, 32); if (fq == 0) ssq[(size_t)row * ldq + slot] = s; } }
}

struct EpiP1N {
    unsigned char* ws; const float* krg;
    __device__ __forceinline__ void operator()(const Acc& acc, const Unit& u, int wr, int wc, int fr_, int fq_) const {
        int fr = fr_, fq = fq_; asm volatile("" : "+v"(fr), "+v"(fq));
        const int rowb = u.pm * 256 + wr * 64 + fr;
        if (u.aux == 0) { store_w64<false>(acc, rowb, (f16*)(ws + WS_SBQ), 512, (4 * u.pn + wc) * 64, 0.125f, nullptr, 0, 0, fq); }
        else if (u.aux == 1) { store_w64<false>(acc, rowb, (f16*)(ws + WS_SBK), 512, (4 * u.pn + wc) * 64, 1.f, nullptr, 0, 0, fq); }
        else if (u.aux == 2) { store_w64<true>(acc, rowb, (f16*)(ws + WS_CQ), 384, 64 * wc, 1.f, (float*)(ws + WS_SSQ_CQ), 8, wc, fq); }
        else if (u.aux == 4) { store_w64<true>(acc, rowb, (f16*)(ws + WS_CKV), 256, 64 * wc, 1.f, (float*)(ws + WS_SSQ_CKV), 4, wc, fq); }
        else if (u.aux == 5) { store_w64<true>(acc, rowb, (f16*)(ws + WS_MKR), 1024, 256 * u.pn + 64 * wc, 1.f, (float*)(ws + WS_SSQ_MK), 16, 4 * u.pn + wc, fq); }
        else {
            f16* CQ = (f16*)(ws + WS_CQ); float* SS = (float*)(ws + WS_SSQ_CQ);
#pragma unroll
            for (int ai = 0; ai < 2; ++ai)
#pragma unroll
                for (int m = 0; m < 4; ++m) { const int row = rowb + ai * 128 + m * 16;
                    const f32x4 v0 = acc[ai][0][m][0], v1 = acc[ai][0][m][1]; float s = dot4(v0) + dot4(v1);
                    *(u32x4*)(CQ + (size_t)row * 384 + 256 + 32 * wc + 8 * fq) = pk8(v0, v1);
                    s += __shfl_xor(s, 16); s += __shfl_xor(s, 32); if (fq == 0) SS[(size_t)row * 8 + 4 + wc] = s; }
            if (wc == 0) {
                const float* COS = (const float*)(ws + WS_COS); const float* SIN = (const float*)(ws + WS_SIN); f16* KRF = (f16*)(ws + WS_KRF);
                const f32x4 g1 = *(const f32x4*)(krg + 4 * fq), g2 = *(const f32x4*)(krg + 16 + 4 * fq);
#pragma unroll
                for (int ai = 0; ai < 2; ++ai)
#pragma unroll
                    for (int m = 0; m < 4; ++m) { const int row = rowb + ai * 128 + m * 16;
                        f32x4 x1 = acc[ai][1][m][0], x2 = acc[ai][1][m][1]; float s = dot4(x1) + dot4(x2);
                        s += __shfl_xor(s, 16); s += __shfl_xor(s, 32);
                        const float rn = __builtin_amdgcn_rsqf(s * (1.f / 32.f) + EPS);
                        x1 = x1 * rn * g1; x2 = x2 * rn * g2;
                        const f32x4 c = *(const f32x4*)(COS + (size_t)row * 16 + 4 * fq), sn = *(const f32x4*)(SIN + (size_t)row * 16 + 4 * fq);
                        const f32x4 o1 = x1 * c - x2 * sn, o2 = x2 * c + x1 * sn;
                        *(u32x2*)(KRF + (size_t)row * 32 + 4 * fq) = pk4(o1); *(u32x2*)(KRF + (size_t)row * 32 + 16 + 4 * fq) = pk4(o2); }
            }
        }
    }
};
struct SchedP1N {
    unsigned char* ws; int G, c;
    __device__ __forceinline__ bool next(int i, Unit& u) const {
        int L = i * G + c;
        if (L < 896) { int pm, pn; pg8::tile_map(L, 128, 7, pm, pn);
            u.A = (const char*)(ws + WS_HN) + (size_t)pm * 256 * 1024 * 2; u.B = (const char*)(ws + WS_WIN) + (size_t)pn * 256 * 1024 * 2; u.pm = pm;
            u.aux = pn < 2 ? 0 : (pn < 4 ? 1 : pn - 2); u.pn = pn < 2 ? pn : (pn < 4 ? pn - 2 : 0); return true; }
        L -= 896; if (L >= 32) return false;
        int pm, pn; pg8::tile_map(L, 8, 4, pm, pn);
        u.A = (const char*)(ws + WS_MN) + (size_t)pm * 256 * 1024 * 2; u.B = (const char*)(ws + WS_WMK) + (size_t)pn * 256 * 1024 * 2; u.pm = pm; u.pn = pn; u.aux = 5; return true;
    }
};
struct EpiP1S {
    unsigned char* ws;
    __device__ __forceinline__ void operator()(const Acc& acc, const Unit& u, int wr, int wc, int fr_, int fq_) const {
        int fr = fr_, fq = fq_; asm volatile("" : "+v"(fr), "+v"(fq));
        const int rowb = u.pm * 256 + wr * 64 + fr;
        if (u.aux == 0) { f16* dst = (f16*)(ws + WS_SBVT);
#pragma unroll
            for (int ai = 0; ai < 2; ++ai)
#pragma unroll
                for (int m = 0; m < 4; ++m) { const size_t ro = (size_t)(rowb + ai * 128 + m * 16) * T + u.pn * 256 + 32 * wc + 8 * (fq & 1) + 4 * (fq >> 1);
#pragma unroll
                    for (int bj = 0; bj < 2; ++bj)
#pragma unroll
                        for (int n = 0; n < 2; ++n) *(u32x2*)(dst + ro + 128 * bj + 16 * n) = pk4(acc[ai][bj][m][n]); }
        } else { f16* dst = (f16*)(ws + WS_MVT);
#pragma unroll
            for (int ai = 0; ai < 2; ++ai)
#pragma unroll
                for (int m = 0; m < 4; ++m) { const size_t ro = (size_t)(rowb + ai * 128 + m * 16) * 2048 + u.pn * 256 + 32 * wc + 8 * fq;
#pragma unroll
                    for (int bj = 0; bj < 2; ++bj)
#pragma unroll
                        for (int n = 0; n < 2; ++n) *(u32x2*)(dst + ro + 128 * bj + 4 * n) = pk4(acc[ai][bj][m][n]); }
        }
    }
};
struct SchedP1S {
    unsigned char* ws; int G, c;
    __device__ __forceinline__ bool next(int i, Unit& u) const {
        int L = i * G + c;
        if (L < 256) { int pm, pn; pg8::tile_map(L, 2, 128, pm, pn);
            u.A = (const char*)(ws + WS_WSV) + (size_t)pm * 256 * 1024 * 2; u.B = (const char*)(ws + WS_HN) + (size_t)pn * 256 * 1024 * 2; u.pm = pm; u.pn = pn; u.aux = 0; return true; }
        L -= 256; if (L >= 32) return false;
        int pm, pn; pg8::tile_map(L, 4, 8, pm, pn);
        u.A = (const char*)(ws + WS_WMV) + (size_t)pm * 256 * 1024 * 2; u.B = (const char*)(ws + WS_MN) + (size_t)pn * 256 * 1024 * 2; u.pm = pm; u.pn = pn; u.aux = 1; return true;
    }
};

constexpr float MLA_QSCALE = 0.10206207261596575f * 1.4426950408889634f;
__device__ __forceinline__ float rq_of(const float* SS8, int row) { const f32x4 a = *(const f32x4*)(SS8 + (size_t)row * 8), b = *(const f32x4*)(SS8 + (size_t)row * 8 + 4);
    return __builtin_amdgcn_rsqf((((a[0] + a[1]) + (a[2] + a[3])) + ((b[0] + b[1]) + (b[2] + b[3]))) * (1.f / 384.f) + EPS); }
__device__ __forceinline__ float rkv_of(const float* SS4, int row) { const f32x4 a = *(const f32x4*)(SS4 + (size_t)row * 4);
    return __builtin_amdgcn_rsqf(((a[0] + a[1]) + (a[2] + a[3])) * (1.f / 256.f) + EPS); }
struct EpiP2Q {
    unsigned char* ws; const float* qng; const float* qrg;
    __device__ __forceinline__ void operator()(const Acc& acc, const Unit& u, int wr, int wc, int fr_, int fq_) const {
        int fr = fr_, fq = fq_; asm volatile("" : "+v"(fr), "+v"(fq));
        const int rowb = u.pm * 256 + wr * 64 + fr; const float* SS = (const float*)(ws + WS_SSQ_CQ); f16* Q = (f16*)(ws + WS_MLAQ);
        if (u.pn < 2) { const int h = 4 * u.pn + wc;
            f32x4 g[2][2];
#pragma unroll
            for (int bj = 0; bj < 2; ++bj)
#pragma unroll
                for (int n = 0; n < 2; ++n) g[bj][n] = *(const f32x4*)(qng + 32 * bj + 8 * fq + 4 * n) * MLA_QSCALE;
#pragma unroll
            for (int ai = 0; ai < 2; ++ai)
#pragma unroll
                for (int m = 0; m < 4; ++m) { const int row = rowb + ai * 128 + m * 16; const float rq = rq_of(SS, row);
                    f32x4 v[2][2]; float s = 0.f;
#pragma unroll
                    for (int bj = 0; bj < 2; ++bj)
#pragma unroll
                        for (int n = 0; n < 2; ++n) { v[bj][n] = acc[ai][bj][m][n] * rq; s += dot4(v[bj][n]); }
                    s += __shfl_xor(s, 16); s += __shfl_xor(s, 32);
                    const float rn = __builtin_amdgcn_rsqf(s * (1.f / 64.f) + EPS);
#pragma unroll
                    for (int bj = 0; bj < 2; ++bj) *(u32x4*)(Q + (size_t)row * 768 + h * 96 + 32 * bj + 8 * fq) = pk8(v[bj][0] * rn * g[bj][0], v[bj][1] * rn * g[bj][1]); }
        } else {
            const float* COS = (const float*)(ws + WS_COS); const float* SIN = (const float*)(ws + WS_SIN);
            const f32x4 g1 = *(const f32x4*)(qrg + 4 * fq) * MLA_QSCALE, g2 = *(const f32x4*)(qrg + 16 + 4 * fq) * MLA_QSCALE;
#pragma unroll
            for (int ai = 0; ai < 2; ++ai)
#pragma unroll
                for (int m = 0; m < 4; ++m) { const int row = rowb + ai * 128 + m * 16; const float rq = rq_of(SS, row);
                    const f32x4 c = *(const f32x4*)(COS + (size_t)row * 16 + 4 * fq), sn = *(const f32x4*)(SIN + (size_t)row * 16 + 4 * fq);
#pragma unroll
                    for (int bj = 0; bj < 2; ++bj) { const int h = 4 * bj + wc;
                        f32x4 x1 = acc[ai][bj][m][0] * rq, x2 = acc[ai][bj][m][1] * rq; float s = dot4(x1) + dot4(x2);
                        s += __shfl_xor(s, 16); s += __shfl_xor(s, 32);
                        const float rn = __builtin_amdgcn_rsqf(s * (1.f / 32.f) + EPS);
                        x1 = x1 * rn * g1; x2 = x2 * rn * g2;
                        const f32x4 o1 = x1 * c - x2 * sn, o2 = x2 * c + x1 * sn;
                        *(u32x2*)(Q + (size_t)row * 768 + h * 96 + 64 + 4 * fq) = pk4(o1); *(u32x2*)(Q + (size_t)row * 768 + h * 96 + 80 + 4 * fq) = pk4(o2); } }
        }
    }
};
struct EpiP2K {
    unsigned char* ws; const float* kng;
    __device__ __forceinline__ void operator()(const Acc& acc, const Unit& u, int wr, int wc, int fr_, int fq_) const {
        int fr = fr_, fq = fq_; asm volatile("" : "+v"(fr), "+v"(fq));
        const int rowb = u.pm * 256 + wr * 64 + fr; const float* SS = (const float*)(ws + WS_SSQ_CKV); f16* Kd = (f16*)(ws + WS_MLAK); const f16* KRF = (const f16*)(ws + WS_KRF);
        const int h = 4 * u.pn + wc;
        f32x4 g[2][2];
#pragma unroll
        for (int bj = 0; bj < 2; ++bj)
#pragma unroll
            for (int n = 0; n < 2; ++n) g[bj][n] = *(const f32x4*)(kng + 32 * bj + 8 * fq + 4 * n);
#pragma unroll
        for (int ai = 0; ai < 2; ++ai)
#pragma unroll
            for (int m = 0; m < 4; ++m) { const int row = rowb + ai * 128 + m * 16; const float rk = rkv_of(SS, row);
                f32x4 v[2][2]; float s = 0.f;
#pragma unroll
                for (int bj = 0; bj < 2; ++bj)
#pragma unroll
                    for (int n = 0; n < 2; ++n) { v[bj][n] = acc[ai][bj][m][n] * rk; s += dot4(v[bj][n]); }
                s += __shfl_xor(s, 16); s += __shfl_xor(s, 32);
                const float rn = __builtin_amdgcn_rsqf(s * (1.f / 64.f) + EPS);
#pragma unroll
                for (int bj = 0; bj < 2; ++bj) *(u32x4*)(Kd + (size_t)row * 768 + h * 96 + 32 * bj + 8 * fq) = pk8(v[bj][0] * rn * g[bj][0], v[bj][1] * rn * g[bj][1]);
                *(u32x4*)(Kd + (size_t)row * 768 + h * 96 + 64 + 8 * fq) = *(const u32x4*)(KRF + (size_t)row * 32 + 8 * fq); }
    }
};
struct EpiP2V {
    unsigned char* ws;
    __device__ __forceinline__ void operator()(const Acc& acc, const Unit& u, int wr, int wc, int fr_, int fq_) const {
        int fr = fr_, fq = fq_; asm volatile("" : "+v"(fr), "+v"(fq));
        const int rowb = u.pm * 256 + wr * 64 + fr; const float* SS = (const float*)(ws + WS_SSQ_CKV); f16* dst = (f16*)(ws + WS_MLAVT);
        f32x4 rk[2][2];
#pragma unroll
        for (int bj = 0; bj < 2; ++bj)
#pragma unroll
            for (int n = 0; n < 2; ++n) { const int tok = u.pn * 256 + 128 * bj + 32 * wc + 16 * n + 4 * fq;
#pragma unroll
                for (int j = 0; j < 4; ++j) rk[bj][n][j] = rkv_of(SS, tok + j); }
#pragma unroll
        for (int ai = 0; ai < 2; ++ai)
#pragma unroll
            for (int m = 0; m < 4; ++m) { const size_t ro = (size_t)(rowb + ai * 128 + m * 16) * T + u.pn * 256 + 32 * wc + 8 * (fq & 1) + 4 * (fq >> 1);
#pragma unroll
                for (int bj = 0; bj < 2; ++bj)
#pragma unroll
                    for (int n = 0; n < 2; ++n) *(u32x2*)(dst + ro + 128 * bj + 16 * n) = pk4(acc[ai][bj][m][n] * rk[bj][n]); }
    }
};
struct SchedGrid {
    const char* A; const char* B; size_t sA, sB; int nM, nN, G, c;
    __device__ __forceinline__ bool next(int i, Unit& u) const {
        const int L = i * G + c; if (L >= nM * nN) return false;
        int pm, pn; pg8::tile_map(L, nM, nN, pm, pn);
        u.A = A + (size_t)pm * sA; u.B = B + (size_t)pn * sB; u.pm = pm; u.pn = pn; u.aux = 0; return true;
    }
};
__device__ __forceinline__ void p2_kprime(Frame& F, const Params& P) {
    PHASE_IDS();
    const int gw = F.vcu * NWAVES + wave, NGW = F.G * NWAVES;
    const f16* MKR = (const f16*)(F.ws + WS_MKR); const float* SS = (const float*)(F.ws + WS_SSQ_MK); f16* KP = (f16*)(F.ws + WS_KP);
    const f32x4 gg = *(const f32x4*)(P.in[21] + 4 * lane) * *(const f32x4*)(P.in[20] + 4 * lane);
    for (int it = gw; it < 2048 * 4; it += NGW) { const int row = it >> 2, h = it & 3, b = row >> 8, key = row & 255;
        const f32x4 a = *(const f32x4*)(SS + (size_t)row * 16 + 4 * h); const float r = __builtin_amdgcn_rsqf(((a[0] + a[1]) + (a[2] + a[3])) * (1.f / 256.f) + EPS);
        const f16x4 x = *(const f16x4*)(MKR + (size_t)row * 1024 + 256 * h + 4 * lane);
        const f32x4 v = (f32x4){(float)x[0], (float)x[1], (float)x[2], (float)x[3]} * r * gg;
        *(u32x2*)(KP + ((size_t)((b * 4 + h) * 256 + key)) * 256 + 4 * lane) = pk4(v); }
}

#define MFMA32(a, b, c) __builtin_amdgcn_mfma_f32_32x32x16_f16((a), (b), (c), 0, 0, 0)
#define MFMA16(a, b, c) __builtin_amdgcn_mfma_f32_16x16x32_f16((a), (b), (c), 0, 0, 0)
__device__ __forceinline__ f16x8 pack8(const f32x16& s, int base) {
    u32x4 w; w.x = pk2(s[base + 0], s[base + 1]); w.y = pk2(s[base + 2], s[base + 3]); w.z = pk2(s[base + 4], s[base + 5]); w.w = pk2(s[base + 6], s[base + 7]);
    return __builtin_bit_cast(f16x8, w);
}
__device__ __forceinline__ float store_ot(const f32x16& o0, const f32x16& o1, float inv, f16* dst, int hf) {
    float ss = 0.f;
#pragma unroll
    for (int g4 = 0; g4 < 4; ++g4) {
        const f32x4 a = (f32x4){o0[4 * g4], o0[4 * g4 + 1], o0[4 * g4 + 2], o0[4 * g4 + 3]} * inv, b = (f32x4){o1[4 * g4], o1[4 * g4 + 1], o1[4 * g4 + 2], o1[4 * g4 + 3]} * inv;
        ss += dot4(a) + dot4(b);
        *(u32x2*)(dst + 8 * g4 + 4 * hf) = pk4(a); *(u32x2*)(dst + 32 + 8 * g4 + 4 * hf) = pk4(b); }
    return ss;
}
constexpr float SB_EXIT = -104.0f;
__device__ __forceinline__ void sb_item(const f16* __restrict__ Qg, const f16* __restrict__ Kg, const f16* __restrict__ Vt, f16* Og, float* SSQ, int b, int h, int qblk, int lane) {
    const int r32 = lane & 31, hf = lane >> 5;
    const int t0 = qblk * 32, t = t0 + r32; const size_t row = (size_t)b * SEQ + t;
    f16x8 qf[4];
#pragma unroll
    for (int ks = 0; ks < 4; ++ks) qf[ks] = *(const f16x8*)(Qg + row * 512 + h * 64 + 16 * ks + 8 * hf);
    f32x16 o0 = {}, o1 = {};
    float carry = 0.f;
    const int kt0 = t0 >> 6;
    for (int kt = kt0; kt >= 0; --kt) {
        const int key0 = kt * 64;
        const f16* kp = Kg + ((size_t)b * SEQ + key0 + r32) * 512 + h * 64 + 8 * hf;
        const f16* vp = Vt + ((size_t)(h * 64 + r32)) * T + (size_t)b * SEQ + key0 + 8 * hf;
        f16x8 kf[2][4], vf[2][4];
#pragma unroll
        for (int kb = 0; kb < 2; ++kb)
#pragma unroll
            for (int ks = 0; ks < 4; ++ks) kf[kb][ks] = *(const f16x8*)(kp + (size_t)kb * 32 * 512 + 16 * ks);
#pragma unroll
        for (int dvb = 0; dvb < 2; ++dvb)
#pragma unroll
            for (int kk = 0; kk < 4; ++kk) vf[dvb][kk] = *(const f16x8*)(vp + (size_t)dvb * 32 * T + 16 * kk);
        f32x16 s[2]; s[0] = (f32x16){}; s[1] = (f32x16){};
#pragma unroll
        for (int ks = 0; ks < 4; ++ks) { s[0] = MFMA32(kf[0][ks], qf[ks], s[0]); s[1] = MFMA32(kf[1][ks], qf[ks], s[1]); }
        const bool diag = (kt == kt0);
        float lfv[2][16], G[2][4], PG[2][4];
#pragma unroll
        for (int kb = 0; kb < 2; ++kb)
#pragma unroll
            for (int q4 = 0; q4 < 4; ++q4) { float gs = 0.f;
#pragma unroll
                for (int j = 0; j < 4; ++j) { const int r = 4 * q4 + j; const float z = s[kb][r];
                    const float e = __expf(-__builtin_fabsf(z)); const float sp = __builtin_fmaxf(z, 0.f) + __logf(1.f + e);
                    const int key = key0 + 32 * kb + 8 * q4 + 4 * hf + j;
                    const bool vis = (!diag) || (key < t);
                    const float lf = vis ? -sp : 0.f;
                    lfv[kb][r] = lf; s[kb][r] = vis ? (z - sp) : -INFINITY; gs += lf; }
                G[kb][q4] = gs; PG[kb][q4] = __shfl_xor(gs, 32); }
        float running = carry;
#pragma unroll
        for (int kb = 1; kb >= 0; --kb)
#pragma unroll
            for (int q4 = 3; q4 >= 0; --q4) {
                float a = running + (hf == 0 ? PG[kb][q4] : 0.f);
#pragma unroll
                for (int j = 3; j >= 0; --j) { const int r = 4 * q4 + j; const float w = __expf(s[kb][r] + a); a += lfv[kb][r]; s[kb][r] = w; }
                running += G[kb][q4] + PG[kb][q4]; }
        carry = running;
#pragma unroll
        for (int kk = 0; kk < 4; ++kk) { const f16x8 pa = pack8(s[kk >> 1], 8 * (kk & 1)); o0 = MFMA32(vf[0][kk], pa, o0); o1 = MFMA32(vf[1][kk], pa, o1); }
        if (__all(carry < SB_EXIT)) break;
    }
    const float ss = store_ot(o0, o1, 1.f, Og + row * 1024 + h * 64, hf);
    const float tot = ss + __shfl_xor(ss, 32);
    if (hf == 0) SSQ[row * 16 + h] = tot;
}

constexpr int MLA_KROW = 208, MLA_VROW = 144, MLA_KBYTES = 64 * MLA_KROW, MLA_VBYTES = 64 * MLA_VROW, MLA_BUF = MLA_KBYTES + MLA_VBYTES;
__device__ __forceinline__ void mla_unit(LAS unsigned char* lds, const f16* __restrict__ Qg, const f16* __restrict__ Kg, const f16* __restrict__ Vt, f16* Og, float* SSQ, int b, int h, int qb, int tid) {
    const int lane = tid & 63, wid = __builtin_amdgcn_readfirstlane(tid >> 6), r32 = lane & 31, hf = lane >> 5;
    const size_t row = (size_t)b * SEQ + qb * 256 + wid * 32 + r32;
    f16x8 qf[6];
#pragma unroll
    for (int ks = 0; ks < 6; ++ks) qf[ks] = *(const f16x8*)(Qg + row * 768 + h * 96 + 16 * ks + 8 * hf);
    const int NT = 4 * qb + 4, my_last = 4 * qb + (wid >> 1);
    const int k0key = tid / 12, k0c = tid % 12, k1key = (tid + 512) / 12, k1c = (tid + 512) % 12, vdv = tid >> 3, vc = tid & 7;
    const f16* ksrc0 = Kg + ((size_t)b * SEQ + k0key) * 768 + h * 96 + 8 * k0c;
    const f16* ksrc1 = Kg + ((size_t)b * SEQ + k1key) * 768 + h * 96 + 8 * k1c;
    const f16* vsrc = Vt + (size_t)(h * 64 + vdv) * T + (size_t)b * SEQ + 8 * vc;
    const int kd0 = k0key * MLA_KROW + k0c * 16, kd1 = k1key * MLA_KROW + k1c * 16, vd = MLA_KBYTES + vdv * MLA_VROW + vc * 16;
    const bool has1 = tid < 256;
    u32x4 rk0, rk1 = {}, rv;
    rk0 = *(const u32x4*)ksrc0; if (has1) rk1 = *(const u32x4*)ksrc1; rv = *(const u32x4*)vsrc;
    __syncthreads();
    *(LAS u32x4*)(lds + kd0) = rk0; if (has1) *(LAS u32x4*)(lds + kd1) = rk1; *(LAS u32x4*)(lds + vd) = rv;
    __syncthreads();
    f32x16 o0 = {}, o1 = {};
    float mrun = -INFINITY, lrun = 0.f;
    for (int t = 0; t < NT; ++t) {
        const bool pre = (t + 1 < NT);
        if (pre) { const size_t ko = (size_t)(t + 1) * 64 * 768; rk0 = *(const u32x4*)(ksrc0 + ko); if (has1) rk1 = *(const u32x4*)(ksrc1 + ko); rv = *(const u32x4*)(vsrc + (t + 1) * 64); }
        if (t <= my_last) {
            const LAS unsigned char* kb_ = lds + (t & 1) * MLA_BUF; const LAS unsigned char* vb_ = kb_ + MLA_KBYTES;
            f32x16 s0 = {}, s1 = {};
#pragma unroll
            for (int ks = 0; ks < 6; ++ks) {
                const f16x8 k0 = *(const LAS f16x8*)(kb_ + r32 * MLA_KROW + (16 * ks + 8 * hf) * 2);
                const f16x8 k1 = *(const LAS f16x8*)(kb_ + (32 + r32) * MLA_KROW + (16 * ks + 8 * hf) * 2);
                s0 = MFMA32(k0, qf[ks], s0); s1 = MFMA32(k1, qf[ks], s1); }
            float tm = s0[0];
#pragma unroll
            for (int r = 1; r < 16; ++r) tm = __builtin_fmaxf(tm, s0[r]);
#pragma unroll
            for (int r = 0; r < 16; ++r) tm = __builtin_fmaxf(tm, s1[r]);
            tm = __builtin_fmaxf(tm, __shfl_xor(tm, 32));
            const float mnew = __builtin_fmaxf(mrun, tm), alpha = __builtin_amdgcn_exp2f(mrun - mnew);
            mrun = mnew;
            float ps = 0.f;
#pragma unroll
            for (int r = 0; r < 16; ++r) { s0[r] = __builtin_amdgcn_exp2f(s0[r] - mnew); s1[r] = __builtin_amdgcn_exp2f(s1[r] - mnew); ps += s0[r] + s1[r]; }
            lrun = lrun * alpha + ps;
            o0 = o0 * alpha; o1 = o1 * alpha;
#pragma unroll
            for (int kk = 0; kk < 4; ++kk) { const f16x8 pa = (kk < 2) ? pack8(s0, 8 * (kk & 1)) : pack8(s1, 8 * (kk & 1));
                const f16x8 v0 = *(const LAS f16x8*)(vb_ + r32 * MLA_VROW + (16 * kk + 8 * hf) * 2);
                const f16x8 v1 = *(const LAS f16x8*)(vb_ + (32 + r32) * MLA_VROW + (16 * kk + 8 * hf) * 2);
                o0 = MFMA32(v0, pa, o0); o1 = MFMA32(v1, pa, o1); }
        }
        if (pre) { LAS unsigned char* nb = lds + ((t + 1) & 1) * MLA_BUF; *(LAS u32x4*)(nb + kd0) = rk0; if (has1) *(LAS u32x4*)(nb + kd1) = rk1; *(LAS u32x4*)(nb + vd) = rv; }
        __syncthreads();
    }
    const float ltot = lrun + __shfl_xor(lrun, 32);
    const float ss = store_ot(o0, o1, 1.f / ltot, Og + row * 1024 + 512 + h * 64, hf);
    const float tot = ss + __shfl_xor(ss, 32);
    if (hf == 0) SSQ[row * 16 + 8 + h] = tot;
}
__device__ __forceinline__ void p3_attention(Frame& F) {
    PHASE_IDS();
    unsigned char* ws = F.ws;
    f16* ATT = (f16*)(ws + WS_ATT); float* SSQ = (float*)(ws + WS_SSQ_ATT);
    {
        const f16* Q = (const f16*)(ws + WS_SBQ); const f16* K = (const f16*)(ws + WS_SBK); const f16* Vt = (const f16*)(ws + WS_SBVT);
        const int gw = F.vcu * NWAVES + wave, NGW = F.G * NWAVES;
        for (int it = gw; it < NB * 8 * 128; it += NGW) { const int qblk = it & 127, h = (it >> 7) & 7, b = it >> 10; sb_item(Q, K, Vt, ATT, SSQ, b, h, qblk, lane); }
    }
    {
        const f16* Q = (const f16*)(ws + WS_MLAQ); const f16* K = (const f16*)(ws + WS_MLAK); const f16* Vt = (const f16*)(ws + WS_MLAVT);
        for (int pr = F.vcu; pr < 64 * 8; pr += F.G) { const int bh = pr >> 3, qa = pr & 7, b = bh >> 3, h = bh & 7;
            mla_unit(F.lds, Q, K, Vt, ATT, SSQ, b, h, 15 - qa, tid);
            mla_unit(F.lds, Q, K, Vt, ATT, SSQ, b, h, qa, tid); }
    }
}
__device__ __forceinline__ void p3b_norm(Frame& F, const Params& P) {
    PHASE_IDS();
    const int gw = F.vcu * NWAVES + wave, NGW = F.G * NWAVES;
    f16* ATT = (f16*)(F.ws + WS_ATT); const float* SSQ = (const float*)(F.ws + WS_SSQ_ATT);
    const f32x4 ga0 = *(const f32x4*)(P.in[13] + 8 * lane), ga1 = *(const f32x4*)(P.in[13] + 8 * lane + 4), gb0 = *(const f32x4*)(P.in[14] + 8 * lane), gb1 = *(const f32x4*)(P.in[14] + 8 * lane + 4);
    for (int row = gw; row < T; row += NGW) {
        const f32x4 a0 = *(const f32x4*)(SSQ + (size_t)row * 16), a1 = *(const f32x4*)(SSQ + (size_t)row * 16 + 4), b0 = *(const f32x4*)(SSQ + (size_t)row * 16 + 8), b1 = *(const f32x4*)(SSQ + (size_t)row * 16 + 12);
        const float ra = __builtin_amdgcn_rsqf((((a0[0] + a0[1]) + (a0[2] + a0[3])) + ((a1[0] + a1[1]) + (a1[2] + a1[3]))) * (1.f / 512.f) + EPS);
        const float rb = __builtin_amdgcn_rsqf((((b0[0] + b0[1]) + (b0[2] + b0[3])) + ((b1[0] + b1[1]) + (b1[2] + b1[3]))) * (1.f / 512.f) + EPS);
        f16* pa = ATT + (size_t)row * 1024 + 8 * lane; f16* pb = pa + 512;
        const f16x8 xa = *(const f16x8*)pa, xb = *(const f16x8*)pb;
        f32x4 va0, va1, vb0, vb1;
#pragma unroll
        for (int j = 0; j < 4; ++j) { va0[j] = (float)xa[j]; va1[j] = (float)xa[4 + j]; vb0[j] = (float)xb[j]; vb1[j] = (float)xb[4 + j]; }
        *(u32x4*)pa = pk8(va0 * ra * ga0, va1 * ra * ga1); *(u32x4*)pb = pk8(vb0 * rb * gb0, vb1 * rb * gb1);
    }
}

struct EpiWo {
    unsigned char* ws; const float* x;
    __device__ __forceinline__ void operator()(const Acc& acc, const Unit& u, int wr, int wc, int fr_, int fq_) const {
        int fr = fr_, fq = fq_; asm volatile("" : "+v"(fr), "+v"(fq));
        const int rowb = u.pm * 256 + wr * 64 + fr, colb = u.pn * 256 + 32 * wc + 8 * fq; f16* H = (f16*)(ws + WS_H1H); float* SS = (float*)(ws + WS_SSQ_H1);
#pragma unroll
        for (int ai = 0; ai < 2; ++ai)
#pragma unroll
            for (int m = 0; m < 4; ++m) { const size_t ro = (size_t)(rowb + ai * 128 + m * 16) * 1024 + colb; float s = 0.f;
#pragma unroll
                for (int bj = 0; bj < 2; ++bj) { const size_t o = ro + 128 * bj;
                    const f32x4 v0 = acc[ai][bj][m][0] + *(const f32x4*)(x + o), v1 = acc[ai][bj][m][1] + *(const f32x4*)(x + o + 4);
                    *(u32x4*)(H + o) = pk8(v0, v1); s += dot4(v0) + dot4(v1); }
                s += __shfl_xor(s, 16); s += __shfl_xor(s, 32); if (fq == 0) SS[(size_t)(rowb + ai * 128 + m * 16) * 16 + 4 * u.pn + wc] = s; }
    }
};
struct EpiMq {
    unsigned char* ws;
    __device__ __forceinline__ void operator()(const Acc& acc, const Unit& u, int wr, int wc, int fr_, int fq_) const {
        int fr = fr_, fq = fq_; asm volatile("" : "+v"(fr), "+v"(fq));
        const int rowb = u.pm * 256 + wr * 64 + fr, colb = u.pn * 256 + 32 * wc + 8 * fq; f16* Q = (f16*)(ws + WS_MQ); float* SS = (float*)(ws + WS_SSQ_MQ);
#pragma unroll
        for (int ai = 0; ai < 2; ++ai)
#pragma unroll
            for (int m = 0; m < 4; ++m) { const size_t ro = (size_t)(rowb + ai * 128 + m * 16) * 1024 + colb; float s = 0.f;
#pragma unroll
                for (int bj = 0; bj < 2; ++bj) { const f32x4 v0 = acc[ai][bj][m][0], v1 = acc[ai][bj][m][1]; *(u32x4*)(Q + ro + 128 * bj) = pk8(v0, v1); s += dot4(v0) + dot4(v1); }
                s += __shfl_xor(s, 16); s += __shfl_xor(s, 32); if (fq == 0) SS[(size_t)(rowb + ai * 128 + m * 16) * 16 + 4 * u.pn + wc] = s; }
    }
};
struct EpiMo {
    unsigned char* ws;
    __device__ __forceinline__ void operator()(const Acc& acc, const Unit& u, int wr, int wc, int fr_, int fq_) const {
        int fr = fr_, fq = fq_; asm volatile("" : "+v"(fr), "+v"(fq));
        const int rowb = u.pm * 256 + wr * 64 + fr, colb = u.pn * 256 + 32 * wc + 8 * fq; f16* H = (f16*)(ws + WS_H2H); const f16* H1 = (const f16*)(ws + WS_H1H);
#pragma unroll
        for (int ai = 0; ai < 2; ++ai)
#pragma unroll
            for (int m = 0; m < 4; ++m) { const size_t ro = (size_t)(rowb + ai * 128 + m * 16) * 1024 + colb;
#pragma unroll
                for (int bj = 0; bj < 2; ++bj) { const size_t o = ro + 128 * bj; const f16x8 hv = *(const f16x8*)(H1 + o);
                    f32x4 v0 = acc[ai][bj][m][0], v1 = acc[ai][bj][m][1];
#pragma unroll
                    for (int j = 0; j < 4; ++j) { v0[j] += (float)hv[j]; v1[j] += (float)hv[4 + j]; }
                    *(u32x4*)(H + o) = pk8(v0, v1); } }
    }
};

constexpr int MEM_ROWB = 528;
template <int RS>
__device__ __forceinline__ void mem_stage(LAS unsigned char* lds, const f16* src, int tid) {
    const unsigned voff = (unsigned)((tid >> 5) * RS + 8 * (tid & 31)) * 2u;
    const unsigned loff = (unsigned)((tid >> 5) * MEM_ROWB + (tid & 31) * 16);
#pragma unroll
    for (int bt = 0; bt < 4; ++bt) { u32x4 r[4];
#pragma unroll
        for (int i = 0; i < 4; ++i) r[i] = *(const u32x4*)((const char*)src + (size_t)(4 * bt + i) * 16 * RS * 2 + voff);
#pragma unroll
        for (int i = 0; i < 4; ++i) *(LAS u32x4*)(lds + loff + (4 * bt + i) * 16 * MEM_ROWB) = r[i]; }
}
__device__ __forceinline__ void p6_memattn(Frame& F) {
    PHASE_IDS(); unsigned char* ws = F.ws; LAS unsigned char* lds = F.lds; const int wid = wave, l16 = lane & 15, g = lane >> 4;
    const f16* MQ = (const f16*)(ws + WS_MQ); const f16* KP = (const f16*)(ws + WS_KP); const f16* MVT = (const f16*)(ws + WS_MVT); f16* MO = (f16*)(ws + WS_MO);
    const float* SSH = (const float*)(ws + WS_SSQ_H1); const float* SSM = (const float*)(ws + WS_SSQ_MQ);
    for (int un = F.vcu; un < 256; un += F.G) { const int bh = un >> 3, qc = un & 7, b = bh >> 2, h = bh & 3;
        for (int pass = 0; pass < 4; ++pass) {
            const size_t row = (size_t)b * SEQ + qc * 512 + pass * 128 + wid * 16 + l16;
            f16x8 qf[8];
#pragma unroll
            for (int ks = 0; ks < 8; ++ks) qf[ks] = *(const f16x8*)(MQ + row * 1024 + h * 256 + 32 * ks + 8 * g);
            float fac;
            { const f32x4 a0 = *(const f32x4*)(SSH + row * 16), a1 = *(const f32x4*)(SSH + row * 16 + 4), a2 = *(const f32x4*)(SSH + row * 16 + 8), a3 = *(const f32x4*)(SSH + row * 16 + 12);
              const float sh = (((a0[0] + a0[1]) + (a0[2] + a0[3])) + ((a1[0] + a1[1]) + (a1[2] + a1[3]))) + (((a2[0] + a2[1]) + (a2[2] + a2[3])) + ((a3[0] + a3[1]) + (a3[2] + a3[3])));
              const float r1 = __builtin_amdgcn_rsqf(sh * (1.f / 1024.f) + EPS);
              const f32x4 q4 = *(const f32x4*)(SSM + row * 16 + 4 * h); const float mv = ((q4[0] + q4[1]) + (q4[2] + q4[3])) * (1.f / 256.f);
              fac = r1 * __builtin_amdgcn_rsqf(r1 * r1 * mv + EPS) * (0.0625f * 1.4426950408889634f); }
            __syncthreads();
            mem_stage<256>(lds, KP + (size_t)(b * 4 + h) * 256 * 256, tid);
            __syncthreads();
            f32x4 s[16];
#pragma unroll
            for (int kb = 0; kb < 16; ++kb) { s[kb] = (f32x4){0.f, 0.f, 0.f, 0.f};
#pragma unroll
                for (int ks = 0; ks < 8; ++ks) { const f16x8 a = *(const LAS f16x8*)(lds + (16 * kb + l16) * MEM_ROWB + (32 * ks + 8 * g) * 2); s[kb] = MFMA16(a, qf[ks], s[kb]); } }
            float mx = -INFINITY;
#pragma unroll
            for (int kb = 0; kb < 16; ++kb) { s[kb] = s[kb] * fac; mx = __builtin_fmaxf(mx, __builtin_fmaxf(__builtin_fmaxf(s[kb][0], s[kb][1]), __builtin_fmaxf(s[kb][2], s[kb][3]))); }
            mx = __builtin_fmaxf(mx, __shfl_xor(mx, 16)); mx = __builtin_fmaxf(mx, __shfl_xor(mx, 32));
            float sum = 0.f; u32x4 pf[8];
#pragma unroll
            for (int s8 = 0; s8 < 8; ++s8) { f32x4 p0, p1;
#pragma unroll
                for (int j = 0; j < 4; ++j) { p0[j] = __builtin_amdgcn_exp2f(s[2 * s8][j] - mx); p1[j] = __builtin_amdgcn_exp2f(s[2 * s8 + 1][j] - mx); }
                sum += ((p0[0] + p0[1]) + (p0[2] + p0[3])) + ((p1[0] + p1[1]) + (p1[2] + p1[3]));
                pf[s8] = pk8(p0, p1); }
            sum += __shfl_xor(sum, 16); sum += __shfl_xor(sum, 32);
            const float inv = 1.f / sum;
            __syncthreads();
            mem_stage<2048>(lds, MVT + (size_t)(h * 256) * 2048 + b * 256, tid);
            __syncthreads();
#pragma unroll 4
            for (int dvb = 0; dvb < 16; ++dvb) { f32x4 o = (f32x4){0.f, 0.f, 0.f, 0.f};
#pragma unroll
                for (int s8 = 0; s8 < 8; ++s8) { const f16x8 a = *(const LAS f16x8*)(lds + (16 * dvb + l16) * MEM_ROWB + (32 * s8 + 8 * g) * 2); o = MFMA16(a, __builtin_bit_cast(f16x8, pf[s8]), o); }
                *(u32x2*)(MO + row * 1024 + h * 256 + 16 * dvb + 4 * g) = pk4(o * inv); }
        }
    }
}

__device__ __forceinline__ void p8_route(Frame& F, const Params& P) {
    PHASE_IDS(); unsigned char* ws = F.ws;
    LAS float* WR = (LAS float*)F.lds;
    LAS unsigned* hist = (LAS unsigned*)(F.lds + LDS_MISC) + 8;
    const float* w_group = P.in[24]; const float* w_router = P.in[26];
    for (int e = tid; e < 1024 * 20; e += NTHR) { const int d = e / 20, c = e % 20; WR[c * 1024 + d] = c < 4 ? w_group[d * 4 + c] : w_router[d * 16 + (c - 4)]; }
    if (tid < 24) hist[tid] = 0u;
    __syncthreads();
    const f16* H2 = (const f16*)(ws + WS_H2H); const float* gm = P.in[23];
    f32x4 g[4];
#pragma unroll
    for (int k = 0; k < 4; ++k) g[k] = *(const f32x4*)(gm + 256 * k + 4 * lane);
    float bias[20];
#pragma unroll
    for (int c = 0; c < 20; ++c) bias[c] = c < 4 ? P.in[25][c] : P.in[27][c - 4];
    int* BKT = (int*)(ws + WS_BKT); float* RR = (float*)(ws + WS_RR); float* W0 = (float*)(ws + WS_W0); float* W1 = (float*)(ws + WS_W1);
    const int gw = F.vcu * NWAVES + wave, NGW = F.G * NWAVES;
    for (int tok = gw; tok < T; tok += NGW) {
        f32x4 v[4]; float ss = 0.f;
#pragma unroll
        for (int k = 0; k < 4; ++k) { const f16x4 hx = *(const f16x4*)(H2 + (size_t)tok * 1024 + 256 * k + 4 * lane); v[k] = (f32x4){(float)hx[0], (float)hx[1], (float)hx[2], (float)hx[3]}; ss += dot4(v[k]); }
        const float r = __builtin_amdgcn_rsqf(wave_sum(ss) * (1.f / 1024.f) + EPS);
        float lg[20];
#pragma unroll
        for (int c = 0; c < 20; ++c) lg[c] = 0.f;
#pragma unroll
        for (int k = 0; k < 4; ++k) { const f32x4 tv = v[k] * r * g[k];
#pragma unroll
            for (int c = 0; c < 20; ++c) { const f32x4 w = *(const LAS f32x4*)(WR + c * 1024 + 256 * k + 4 * lane); lg[c] += (tv[0] * w[0] + tv[1] * w[1]) + (tv[2] * w[2] + tv[3] * w[3]); }
            __builtin_amdgcn_sched_barrier(0); }
#pragma unroll
        for (int c = 0; c < 20; ++c) lg[c] = wave_sum(lg[c]) + bias[c];
        int gi = 0; float gmx = lg[0];
#pragma unroll
        for (int c = 1; c < 4; ++c) if (lg[c] > gmx) { gmx = lg[c]; gi = c; }
        float gden = 0.f;
#pragma unroll
        for (int c = 0; c < 4; ++c) gden += __expf(lg[c] - gmx);
        const float gw_ = 1.f / gden;
        float el[4];
#pragma unroll
        for (int c = 0; c < 4; ++c) el[c] = gi == 0 ? lg[4 + c] : (gi == 1 ? lg[8 + c] : (gi == 2 ? lg[12 + c] : lg[16 + c]));
        int i1 = 0; float m1 = el[0];
#pragma unroll
        for (int c = 1; c < 4; ++c) if (el[c] > m1) { m1 = el[c]; i1 = c; }
        int i2 = -1; float m2 = -INFINITY;
#pragma unroll
        for (int c = 0; c < 4; ++c) if (c != i1 && el[c] > m2) { m2 = el[c]; i2 = c; }
        const float e2 = __expf(m2 - m1), wa = gw_ / (1.f + e2), wb = gw_ * e2 / (1.f + e2);
        const int lo = i1 < i2 ? i1 : i2, hi = i1 < i2 ? i2 : i1;
        const int pi = lo == 0 ? hi - 1 : (lo == 1 ? hi + 1 : 5);
        const int bk = gi * 6 + pi;
        if (lane == 0) { BKT[tok] = bk; RR[tok] = r; W0[tok] = (i1 < i2) ? wa : wb; W1[tok] = (i1 < i2) ? wb : wa; atomicAdd((unsigned*)&hist[bk], 1u); }
    }
    __syncthreads();
    if (tid < 24) { const unsigned hv = hist[tid]; if (hv) atomicAdd(F.ctl + CW_CNT + tid, hv); }
}
__device__ __forceinline__ void moe_tiles(Frame& F) {
    LAS int* tstart = (LAS int*)(F.lds + LDS_MISC) + 32;
    const int tid0 = fresh_tid();
    __syncthreads();
    if (tid0 == 0) { int acc = 0;
        for (int b = 0; b < 24; ++b) { tstart[b] = acc; acc += (int)((__hip_atomic_load(F.ctl + CW_CNT + b, __ATOMIC_RELAXED, __HIP_MEMORY_SCOPE_AGENT) + 255u) >> 8); }
        tstart[24] = acc; }
    __syncthreads();
}
__device__ __forceinline__ void p9_gather(Frame& F) {
    PHASE_IDS(); unsigned char* ws = F.ws; const int wid = wave;
    moe_tiles(F);
    LAS int* tstart = (LAS int*)(F.lds + LDS_MISC) + 32; LAS int* posarr = (LAS int*)(F.lds + LDS_MISC) + 64;
    const int* BKT = (const int*)(ws + WS_BKT); const float* RR = (const float*)(ws + WS_RR); const float* W0 = (const float*)(ws + WS_W0); const float* W1 = (const float*)(ws + WS_W1);
    int* TOK = (int*)(ws + WS_TOK); float* PR = (float*)(ws + WS_PR); float* PW0 = (float*)(ws + WS_PW0); float* PW1 = (float*)(ws + WS_PW1);
    const f16* H2H = (const f16*)(ws + WS_H2H); f16* TS = (f16*)(ws + WS_TS);
    for (int blk = F.vcu; blk < T / 128; blk += F.G) {
        if (wid < 2) { const int tok = blk * 128 + wid * 64 + lane; const int bk = BKT[tok];
            unsigned mycount = 0u, rank = 0u;
            for (int bb = 0; bb < 24; ++bb) { const unsigned long long mask = __ballot(bk == bb); const unsigned c = (unsigned)__popcll(mask);
                if (lane == bb) mycount = c;
                if (bk == bb) rank = (unsigned)__popcll(mask & ((1ull << lane) - 1ull)); }
            unsigned basev = 0u;
            if (lane < 24 && mycount) basev = atomicAdd(F.ctl + CW_CUR + lane, mycount);
            const unsigned mybase = (unsigned)__shfl((int)basev, bk);
            posarr[wid * 64 + lane] = tstart[bk] * 256 + (int)(mybase + rank); }
        __syncthreads();
#pragma unroll 4
        for (int j = 0; j < 16; ++j) { const int tl = wid * 16 + j, tok = blk * 128 + tl, pos = posarr[tl];
            const u32x4 a = *(const u32x4*)(H2H + (size_t)tok * 1024 + 8 * lane), b = *(const u32x4*)(H2H + (size_t)tok * 1024 + 512 + 8 * lane);
            *(u32x4*)(TS + (size_t)pos * 1024 + 8 * lane) = a; *(u32x4*)(TS + (size_t)pos * 1024 + 512 + 8 * lane) = b;
            if (lane == 0) { TOK[pos] = tok; PR[pos] = RR[tok]; PW0[pos] = W0[tok]; PW1[pos] = W1[tok]; } }
        __syncthreads();
    }
}

struct SchedMoe {
    const char* A; const char* B; LAS const int* tstart; int G, c, nct_log2, down;
    __device__ __forceinline__ bool next(int i, Unit& u) const {
        const int L = i * G + c, rt = L >> nct_log2, ct = L & ((1 << nct_log2) - 1);
        if (rt >= tstart[24]) return false;
        int bk = 0;
        for (int b = 1; b < 24; ++b) bk = (rt >= tstart[b]) ? b : bk;
        u.A = A + (size_t)rt * 256 * 1024 * 2; u.pm = rt; u.pn = ct; u.aux = bk;
        if (down) { u.B = B + ((size_t)bk * 1024 + ct * 256) * 1024 * 2; }
        else { int lo, hi; moe_pair(bk % 6, lo, hi); const int e = 4 * (bk / 6) + ((ct >> 2) ? hi : lo); u.B = B + (size_t)(e * 4 + (ct & 3)) * 256 * 1024 * 2; }
        return true;
    }
};
struct EpiGU {
    unsigned char* ws;
    __device__ __forceinline__ void operator()(const Acc& acc, const Unit& u, int wr, int wc, int fr_, int fq_) const {
        int fr = fr_, fq = fq_; asm volatile("" : "+v"(fr), "+v"(fq));
        const int rowb = u.pm * 256 + wr * 64 + fr, slot = u.pn >> 2, ffb = u.pn & 3; f16* HE = (f16*)(ws + WS_HE);
        const float* PR = (const float*)(ws + WS_PR); const float* PW = (const float*)(ws + (slot ? WS_PW1 : WS_PW0));
#pragma unroll
        for (int ai = 0; ai < 2; ++ai)
#pragma unroll
            for (int m = 0; m < 4; ++m) { const int row = rowb + ai * 128 + m * 16; const float r = PR[row], w = PW[row];
                f32x4 o[2];
#pragma unroll
                for (int n = 0; n < 2; ++n) { const f32x4 gt = acc[ai][0][m][n] * r, up = acc[ai][1][m][n] * r;
#pragma unroll
                    for (int j = 0; j < 4; ++j) { const float sg = gt[j] * __builtin_amdgcn_rcpf(1.f + __expf(-gt[j])); o[n][j] = sg * up[j] * w; } }
                *(u32x4*)(HE + (size_t)row * 1024 + slot * 512 + ffb * 128 + 32 * wc + 8 * fq) = pk8(o[0], o[1]); }
    }
};
struct EpiDown {
    unsigned char* ws; float* out;
    __device__ __forceinline__ void operator()(const Acc& acc, const Unit& u, int wr, int wc, int fr_, int fq_) const {
        int fr = fr_, fq = fq_; asm volatile("" : "+v"(fr), "+v"(fq));
        const int rowb = u.pm * 256 + wr * 64 + fr, colb = u.pn * 256 + 32 * wc + 8 * fq; const int* TOK = (const int*)(ws + WS_TOK); const f16* H2 = (const f16*)(ws + WS_H2H);
#pragma unroll
        for (int ai = 0; ai < 2; ++ai)
#pragma unroll
            for (int m = 0; m < 4; ++m) { const int tok = TOK[rowb + ai * 128 + m * 16];
                if (tok >= 0) { const size_t ro = (size_t)tok * 1024 + colb;
#pragma unroll
                    for (int bj = 0; bj < 2; ++bj) { const size_t o = ro + 128 * bj; const f16x8 hv = *(const f16x8*)(H2 + o);
                        f32x4 v0 = acc[ai][bj][m][0], v1 = acc[ai][bj][m][1];
#pragma unroll
                        for (int j = 0; j < 4; ++j) { v0[j] += (float)hv[j]; v1[j] += (float)hv[4 + j]; }
                        *(f32x4*)(out + o) = v0; *(f32x4*)(out + o + 4) = v1; } } }
    }
};

#ifndef MK_N_LAUNCHES
#define MK_N_LAUNCHES 1
#endif
constexpr int N_PHASES = 13;
__global__ void __launch_bounds__(NTHR, 2) fwd_kernel(Params P) {
    extern __shared__ __attribute__((aligned(16))) unsigned char lds_raw[];
    Frame F;
    F.lds = (LAS unsigned char*)lds_raw; F.MISC = (volatile LAS unsigned*)(F.lds + LDS_MISC);
    F.G = gridDim.x; F.bx = blockIdx.x; F.vcu = (F.G % 8 == 0) ? (F.bx % 8) * (F.G / 8) + F.bx / 8 : F.bx;
    F.ws = P.ws; F.out = P.out; F.ctl = (unsigned*)(P.ws + WS_CTL);
    for (int u = fresh_tid(); u < (LDS_BYTES - LDS_MISC) / 4; u += NTHR) ((LAS unsigned*)(F.lds + LDS_MISC))[u] = 0u;
    __syncthreads();
    const int lo = P.ph_lo, hi = P.ph_hi;
    const bool multi = (hi - lo) > 1;
    XcdBarrier bar; bar.bar = F.ctl + CW_BAR; bar.x = 0; bar.st = F.MISC;
    if (multi) bar = xcd_barrier_post(F.ctl + CW_BAR, F.MISC);
#define IN(k) (lo <= (k) && (k) < hi)
#define SEAM(k) do { if (IN(k) && IN((k) + 1)) xcd_barrier(bar); } while (0)
    unsigned char* ws = F.ws;
#ifndef PROBE_DUP
#define PROBE_DUP -1
#endif
#define RUN(k, ...) do { if (IN(k)) { __VA_ARGS__ if (PROBE_DUP == (k)) { xcd_barrier(bar); __VA_ARGS__ } } SEAM(k); } while (0)
    RUN(0, { p0_prologue(F, P); });
    RUN(1, {
        { SchedP1N S{ws, F.G, F.bx}; EpiP1N E{ws, P.in[12]}; pg8::gemm_phase<EpiP1N, SchedP1N, true>(F.lds, 1024, 1024, 1024, S, E); }
        { SchedP1S S{ws, F.G, (F.bx + F.G - 160) % F.G}; EpiP1S E{ws}; pg8::gemm_phase<EpiP1S, SchedP1S, true>(F.lds, 1024, 1024, 1024, S, E); }
    });
    RUN(2, {
        p2_kprime(F, P);
        { SchedGrid S{(const char*)(ws + WS_CQ), (const char*)(ws + WS_WUQ), (size_t)256 * 384 * 2, (size_t)256 * 384 * 2, 128, 3, F.G, F.bx}; EpiP2Q E{ws, P.in[9], P.in[10]};
          pg8::gemm_phase<EpiP2Q, SchedGrid, true>(F.lds, 384, 384, 384, S, E); }
        { SchedGrid S{(const char*)(ws + WS_CKV), (const char*)(ws + WS_WUKN), (size_t)256 * 256 * 2, (size_t)256 * 256 * 2, 128, 2, F.G, (F.bx + F.G - 128) % F.G}; EpiP2K E{ws, P.in[11]};
          pg8::gemm_phase<EpiP2K, SchedGrid, true>(F.lds, 256, 256, 256, S, E); }
        { SchedGrid S{(const char*)(ws + WS_WUKV), (const char*)(ws + WS_CKV), (size_t)256 * 256 * 2, (size_t)256 * 256 * 2, 2, 128, F.G, (F.bx + F.G - 128) % F.G}; EpiP2V E{ws};
          pg8::gemm_phase<EpiP2V, SchedGrid, true>(F.lds, 256, 256, 256, S, E); }
    });
    RUN(3, { p3_attention(F); });
    RUN(4, { p3b_norm(F, P); });
    RUN(5, { SchedGrid S{(const char*)(ws + WS_ATT), (const char*)(ws + WS_WO), (size_t)256 * 1024 * 2, (size_t)256 * 1024 * 2, 128, 4, F.G, F.bx}; EpiWo E{ws, P.in[0]};
        pg8::gemm_phase<EpiWo, SchedGrid, true>(F.lds, 1024, 1024, 1024, S, E); });
    RUN(6, { SchedGrid S{(const char*)(ws + WS_H1H), (const char*)(ws + WS_WMQ), (size_t)256 * 1024 * 2, (size_t)256 * 1024 * 2, 128, 4, F.G, F.bx}; EpiMq E{ws};
        pg8::gemm_phase<EpiMq, SchedGrid, true>(F.lds, 1024, 1024, 1024, S, E); });
    RUN(7, { p6_memattn(F); });
    RUN(8, { SchedGrid S{(const char*)(ws + WS_MO), (const char*)(ws + WS_WMO), (size_t)256 * 1024 * 2, (size_t)256 * 1024 * 2, 128, 4, F.G, F.bx}; EpiMo E{ws};
        pg8::gemm_phase<EpiMo, SchedGrid, true>(F.lds, 1024, 1024, 1024, S, E); });
    RUN(9, { p8_route(F, P); });
    RUN(10, { p9_gather(F); });
    RUN(11, { moe_tiles(F); SchedMoe S{(const char*)(ws + WS_TS), (const char*)(ws + WS_WGU), (LAS const int*)(F.lds + LDS_MISC) + 32, F.G, F.vcu, 3, 0}; EpiGU E{ws};
        pg8::gemm_phase<EpiGU, SchedMoe, true>(F.lds, 1024, 1024, 1024, S, E); });
    RUN(12, { moe_tiles(F); SchedMoe S{(const char*)(ws + WS_HE), (const char*)(ws + WS_WD2), (LAS const int*)(F.lds + LDS_MISC) + 32, F.G, F.vcu, 2, 1}; EpiDown E{ws, P.out};
        pg8::gemm_phase<EpiDown, SchedMoe, true>(F.lds, 1024, 1024, 1024, S, E); });
#undef RUN
#undef IN
#undef SEAM
}

extern "C" void kernel_launch(void* const* d_in, const int* in_sizes, int n_in, void* d_out, int out_size, void* d_ws, size_t ws_size, hipStream_t stream) {
    static int grid = 0;
    if (grid == 0) {
        if (n_in != 31 || out_size != T * D || ws_size < WS_END) { fprintf(stderr, "kernel_launch: unexpected shapes (n_in %d, out %d, ws %zu < %zu)\n", n_in, out_size, ws_size, (size_t)WS_END); grid = -1; return; }
        int dev = 0, cus = 0, per_cu = 0;
        if (hipGetDevice(&dev) != hipSuccess || hipDeviceGetAttribute(&cus, hipDeviceAttributeMultiprocessorCount, dev) != hipSuccess) { grid = -1; return; }
        if (hipFuncSetAttribute((const void*)fwd_kernel, hipFuncAttributeMaxDynamicSharedMemorySize, LDS_BYTES) != hipSuccess) { fprintf(stderr, "kernel_launch: hipFuncSetAttribute failed\n"); grid = -1; return; }
        if (hipOccupancyMaxActiveBlocksPerMultiprocessor(&per_cu, (const void*)fwd_kernel, NTHR, LDS_BYTES) != hipSuccess || per_cu < 1) { fprintf(stderr, "kernel_launch: occupancy query says %d\n", per_cu); }
        (void)hipGetLastError();
        grid = cus;
    }
    if (grid < 0) return;
    (void)hipMemsetAsync((char*)d_ws + WS_CTL, 0, CTL_ZERO_BYTES, stream);
    Params p{};
    for (int i = 0; i < 31; ++i) p.in[i] = (const float*)d_in[i];
    p.out = (float*)d_out; p.ws = (unsigned char*)d_ws;
    if (MK_N_LAUNCHES == 1) { p.ph_lo = 0; p.ph_hi = N_PHASES; hipLaunchKernelGGL(fwd_kernel, dim3(grid), dim3(NTHR), LDS_BYTES, stream, p); }
    else { for (int k = 0; k < N_PHASES; ++k) { p.ph_lo = k; p.ph_hi = k + 1; hipLaunchKernelGGL(fwd_kernel, dim3(grid), dim3(NTHR), LDS_BYTES, stream, p); } }
}
```

```cpp
#include <hip/hip_runtime.h>
#include <cstdio>
#include <cstdint>

#define LAS __attribute__((address_space(3)))
#define GAS __attribute__((address_space(1)))
typedef _Float16 f16;
typedef _Float16 f16x8 __attribute__((ext_vector_type(8)));
typedef _Float16 f16x4 __attribute__((ext_vector_type(4)));
typedef _Float16 f16x2 __attribute__((ext_vector_type(2)));
typedef float f32x2 __attribute__((ext_vector_type(2)));
typedef float f32x4 __attribute__((ext_vector_type(4)));
typedef float f32x16 __attribute__((ext_vector_type(16)));
typedef unsigned u32x4 __attribute__((ext_vector_type(4)));
typedef unsigned u32x2 __attribute__((ext_vector_type(2)));

__device__ __forceinline__ unsigned pk2(float lo, float hi) { f16x2 v = {(f16)lo, (f16)hi}; return __builtin_bit_cast(unsigned, v); }
__device__ __forceinline__ u32x4 pk8(f32x4 a, f32x4 b) { u32x4 w; w.x = pk2(a[0], a[1]); w.y = pk2(a[2], a[3]); w.z = pk2(b[0], b[1]); w.w = pk2(b[2], b[3]); return w; }
__device__ __forceinline__ u32x2 pk4(f32x4 a) { u32x2 w; w.x = pk2(a[0], a[1]); w.y = pk2(a[2], a[3]); return w; }
__device__ __forceinline__ float dot4(f32x4 a) { return (a[0] * a[0] + a[1] * a[1]) + (a[2] * a[2] + a[3] * a[3]); }
__device__ __forceinline__ float wave_sum(float v) {
#pragma unroll
    for (int o = 1; o < 64; o <<= 1) v += __shfl_xor(v, o);
    return v;
}
__device__ __forceinline__ int L32(int q) { return 8 * ((q >> 2) & 3) + 4 * (q >> 4) + (q & 3); }

__device__ __forceinline__ int fresh_tid() { int t = (int)threadIdx.x; asm volatile("" : "+v"(t)); return t; }
constexpr int T = 32768, D = 1024, SEQ = 4096, NB = 8;
constexpr float EPS = 1e-6f;
constexpr int NPOS = 152 * 256;

namespace pg8 {
constexpr int BM = 256, BK = 64, HALF = 128, HTB = HALF * BK * 2, STAGE_BYTES = 8 * HTB;
__host__ __device__ __forceinline__ int lds_byte(int r, int c) { const int st = (r >> 4) * 2 + (c >> 5), rr = r & 15, cc = c & 31, ob = rr * 64 + cc * 2; return st * 1024 + (ob ^ (((ob >> 9) & 1) << 5)); }
__host__ __device__ __forceinline__ void stage_rc(int b, int& R, int& C) { const int st = b / 1024, sb = b % 1024, swz = sb ^ (((sb >> 9) & 1) << 5); R = (st >> 1) * 16 + swz / 64; C = (st & 1) * 32 + (swz % 64) / 2; }
struct Unit { const char* A; const char* B; const char* B2; int pm, pn, aux; };

template <class Epi, class Sched, bool ALIGN_EPI, bool SPLITB = false>
__device__ __forceinline__ void gemm_phase(LAS unsigned char* lds, const int K, const int lda, const int ldb, const Sched& S, const Epi& E) {
    const int tid = fresh_tid(), wid = __builtin_amdgcn_readfirstlane(tid >> 6), lane = tid & 63, wr = wid >> 2, wc = wid & 3, fr = lane & 15, fq = lane >> 4;
    const int nt = K / BK;
    unsigned voffA[2], voffB[2];
#pragma unroll
    for (int i = 0; i < 2; ++i) { int R, C; stage_rc(tid * 16 + i * 8192, R, C); voffA[i] = (unsigned)(R * lda + C) * 2u; voffB[i] = (unsigned)(R * ldb + C) * 2u; }
    const size_t kstep = (size_t)(BK * 2);
    const size_t hstepA = (size_t)HALF * lda * 2, hstepB = (size_t)HALF * ldb * 2;
    const unsigned ldsw = (unsigned)wid * 1024u;
    const int aoff = lds_byte(wr * 64 + fr, fq * 8), boff = lds_byte(wc * 32 + fr, fq * 8);
#define PG8_SA(b, h) (((b) * 2 + (h)) * HTB)
#define PG8_SB(b, h) ((4 + (b) * 2 + (h)) * HTB)
#define PG8_STAGE(bufoff, gbase, voff) do { _Pragma("unroll") for (int _i = 0; _i < 2; ++_i) \
        __builtin_amdgcn_global_load_lds((const unsigned*)((const char*)(gbase) + (voff)[_i]), (LAS unsigned*)(lds + (bufoff) + ldsw + _i * 8192), 16, 0, 0); } while (0)
#define PG8_LDA(dst, b, h) do { _Pragma("unroll") for (int m = 0; m < 4; ++m) _Pragma("unroll") for (int k = 0; k < 2; ++k) dst[m][k] = *(const LAS f16x8*)(lds + PG8_SA(b, h) + aoff + m * 2048 + k * 1024); } while (0)
#define PG8_LDB(dst, b, h) do { _Pragma("unroll") for (int n = 0; n < 2; ++n) _Pragma("unroll") for (int k = 0; k < 2; ++k) dst[n][k] = *(const LAS f16x8*)(lds + PG8_SB(b, h) + boff + n * 2048 + k * 1024); } while (0)
#define PG8_MMA(ai, bj, At, Bt) do { __builtin_amdgcn_s_setprio(1); _Pragma("unroll") for (int m = 0; m < 4; ++m) _Pragma("unroll") for (int n = 0; n < 2; ++n) _Pragma("unroll") for (int k = 0; k < 2; ++k) \
        acc[ai][bj][m][n] = __builtin_amdgcn_mfma_f32_16x16x32_f16(Bt[n][k], At[m][k], acc[ai][bj][m][n], 0, 0, 0); __builtin_amdgcn_s_setprio(0); } while (0)
#define PG8_WAIT_V(n) asm volatile("s_waitcnt vmcnt(" #n ")" ::: "memory")
#define PG8_WAIT_L(n) asm volatile("s_waitcnt lgkmcnt(" #n ")" ::: "memory")
#define PG8_BAR __builtin_amdgcn_s_barrier()
#define PG8_SCHED __builtin_amdgcn_sched_barrier(0)
    Unit cur, nxt; int ui = 0;
    if (!S.next(0, cur)) return;
    f32x4 acc[2][2][4][2];
#pragma unroll
    for (int a = 0; a < 2; ++a)
#pragma unroll
        for (int b = 0; b < 2; ++b)
#pragma unroll
            for (int m = 0; m < 4; ++m)
#pragma unroll
                for (int n = 0; n < 2; ++n) acc[a][b][m][n] = (f32x4){0.f, 0.f, 0.f, 0.f};
    f16x8 At[4][2], B0[2][2], B1[2][2];
    const char* cA = cur.A; const char* cB = cur.B; const char* cB2 = SPLITB ? cur.B2 : nullptr; const int th = nt >> 1;
    PG8_STAGE(PG8_SB(0, 0), cB, voffB); PG8_STAGE(PG8_SB(0, 1), cB + hstepB, voffB); PG8_STAGE(PG8_SA(0, 0), cA, voffA); PG8_STAGE(PG8_SA(0, 1), cA + hstepA, voffA);
    if (wr == 1) PG8_BAR;
    PG8_WAIT_V(2); PG8_BAR;
    PG8_STAGE(PG8_SB(1, 0), cB + kstep, voffB); PG8_STAGE(PG8_SA(1, 0), cA + kstep, voffA); PG8_STAGE(PG8_SB(1, 1), cB + hstepB + kstep, voffB);
    PG8_WAIT_V(6); PG8_BAR;
    for (;;) {
        const bool has_next = S.next(ui + 1, nxt);
        const char* nA = has_next ? nxt.A : cA; const char* nB = has_next ? nxt.B : cB; const char* nB2 = SPLITB ? (has_next ? nxt.B2 : cB2) : nullptr;
        for (int t = 0; t < nt; t += 2) {
            const bool last = (t == nt - 2);
            const char* a1 = cA + (size_t)(t + 1) * kstep;
            const char* a2 = last ? nA : cA + (size_t)(t + 2) * kstep;
            const char* b2 = last ? nB : ((SPLITB && t + 2 >= th) ? cB2 + (size_t)(t + 2 - th) * kstep : cB + (size_t)(t + 2) * kstep);
            const char* a3 = a2 + kstep; const char* b3 = b2 + kstep;
            PG8_LDB(B0, 0, 0); PG8_LDB(B1, 0, 1); PG8_SCHED; PG8_LDA(At, 0, 0); PG8_STAGE(PG8_SA(1, 1), a1 + hstepA, voffA);
            PG8_WAIT_V(8); PG8_WAIT_L(0); PG8_BAR; PG8_MMA(0, 0, At, B0); PG8_MMA(0, 1, At, B1); PG8_BAR; PG8_SCHED;
            PG8_LDA(At, 0, 1); PG8_STAGE(PG8_SB(0, 0), b2, voffB); PG8_STAGE(PG8_SB(0, 1), b2 + hstepB, voffB); PG8_STAGE(PG8_SA(0, 0), a2, voffA);
            PG8_WAIT_V(8); PG8_WAIT_L(0); PG8_BAR; PG8_MMA(1, 0, At, B0); PG8_MMA(1, 1, At, B1); PG8_BAR; PG8_SCHED;
            PG8_LDB(B0, 1, 0); PG8_LDB(B1, 1, 1); PG8_SCHED; PG8_LDA(At, 1, 0); PG8_STAGE(PG8_SA(0, 1), a2 + hstepA, voffA);
            PG8_WAIT_V(8); PG8_WAIT_L(0); PG8_BAR; PG8_MMA(0, 0, At, B0); PG8_MMA(0, 1, At, B1); PG8_BAR; PG8_SCHED;
            PG8_LDA(At, 1, 1); PG8_STAGE(PG8_SB(1, 0), b3, voffB); PG8_STAGE(PG8_SB(1, 1), b3 + hstepB, voffB); PG8_STAGE(PG8_SA(1, 0), a3, voffA);
            PG8_WAIT_V(8); PG8_WAIT_L(0); PG8_BAR; PG8_MMA(1, 0, At, B0); PG8_MMA(1, 1, At, B1); PG8_BAR; PG8_SCHED;
        }
        if constexpr (ALIGN_EPI) { if (wr == 0) PG8_BAR; }
        E(acc, cur, wr, wc, fr, fq);
        if (!has_next) break;
#pragma unroll
        for (int a = 0; a < 2; ++a)
#pragma unroll
            for (int b = 0; b < 2; ++b)
#pragma unroll
                for (int m = 0; m < 4; ++m)
#pragma unroll
                    for (int n = 0; n < 2; ++n) acc[a][b][m][n] = (f32x4){0.f, 0.f, 0.f, 0.f};
        cur = nxt; cA = nA; cB = nB; cB2 = nB2; ++ui;
        if constexpr (ALIGN_EPI) { if (wr == 1) PG8_BAR; }
    }
    PG8_WAIT_V(0);
    if constexpr (!ALIGN_EPI) { if (wr == 0) PG8_BAR; }
    PG8_BAR;
#undef PG8_SA
#undef PG8_SB
#undef PG8_STAGE
#undef PG8_LDA
#undef PG8_LDB
#undef PG8_MMA
#undef PG8_WAIT_V
#undef PG8_WAIT_L
#undef PG8_BAR
#undef PG8_SCHED
}
__device__ __forceinline__ void tile_map(int L, int nM, int nN, int& pm, int& pn) {
    const int nwg = nM * nN; int wgid = L;
    { const int q = nwg / 8, r = nwg % 8, xcd = wgid % 8, off = wgid / 8; wgid = (xcd < r ? xcd * (q + 1) : r * (q + 1) + (xcd - r) * q) + off; }
    const int nig = 8 * nN, gid = wgid / nig, fm = gid * 8, gsz = (nM - fm) < 8 ? (nM - fm) : 8;
    pm = fm + ((wgid % nig) % gsz); pn = (wgid % nig) / gsz;
}
}
using pg8::Unit;

#define XB_TMO      128
#define XB_XCNT(j)  (256  + 64 * (j))
#define XB_XSUB(j)  (1280 + 64 * (j))
#define XB_XGEN(j)  (2304 + 64 * (j))
#define XB_TOP      3328
#define XB_TOPGEN   3392
#define XCD_BAR_WORDS 3456
#define XB_SPIN_CAP (1u << 18)
__device__ __forceinline__ unsigned xb_ld(unsigned* p)              { return __hip_atomic_load(p, __ATOMIC_RELAXED, __HIP_MEMORY_SCOPE_AGENT); }
__device__ __forceinline__ unsigned xb_add(unsigned* p, unsigned v) { return __hip_atomic_fetch_add(p, v, __ATOMIC_RELAXED, __HIP_MEMORY_SCOPE_AGENT); }
__device__ __forceinline__ unsigned xb_xcc_id() { return (unsigned)__builtin_amdgcn_s_getreg((3 << 11) | 20) & 0xFu; }
#define XB_SPIN(cond, bar) do { unsigned _sp = 0; while (cond) { __builtin_amdgcn_s_sleep(1); \
    if ((++_sp & 255u) == 0u) { if (xb_ld(&(bar)[XB_TMO])) break; if (_sp > XB_SPIN_CAP) { atomicAdd(&(bar)[XB_TMO], 1u); break; } } } } while (0)
struct XcdBarrier { unsigned* bar; unsigned x; volatile LAS unsigned* st; };
__device__ __forceinline__ XcdBarrier xcd_barrier_post(unsigned* bar, volatile LAS unsigned* st) {
    XcdBarrier b; b.bar = bar; b.x = xb_xcc_id(); b.st = st;
    if (threadIdx.x == 0) (void)xb_add(&bar[XB_XCNT(b.x)], 1u);
    return b;
}
__device__ __forceinline__ void xcd_barrier_complete(unsigned* bar, unsigned x, unsigned& nloc, unsigned& nx) {
    const unsigned G = gridDim.x * gridDim.y * gridDim.z;
    unsigned sum, cnt, mine, sp = 0u;
    for (;;) {
        sum = 0u; cnt = 0u; mine = 0u;
#pragma unroll
        for (unsigned j = 0; j < 16; ++j) { const unsigned c = xb_ld(&bar[XB_XCNT(j)]); sum += c; cnt += (c > 0u) ? 1u : 0u; mine = (j == x) ? c : mine; }
        if (sum == G) break;
        __builtin_amdgcn_s_sleep(1);
        if ((++sp & 255u) == 0u) { if (xb_ld(&bar[XB_TMO])) break; if (sp > XB_SPIN_CAP) { atomicAdd(&bar[XB_TMO], 1u); break; } }
    }
    nloc = mine > 0u ? mine : 1u; nx = cnt > 0u ? cnt : 1u;
}
__device__ __forceinline__ void xcd_barrier(const XcdBarrier& b) {
    asm volatile("s_waitcnt vmcnt(0)" ::: "memory");
    __syncthreads();
    if (threadIdx.x == 0) {
        unsigned* bar = b.bar;
        __builtin_amdgcn_s_waitcnt(0);
        unsigned nloc = b.st[0], nx = b.st[1];
        if (nloc == 0u) { xcd_barrier_complete(bar, b.x, nloc, nx); b.st[0] = nloc; b.st[1] = nx; }
        const unsigned old = xb_add(&bar[XB_XSUB(b.x)], 1u);
        const unsigned gen = old / nloc;
        if (old + 1u == (gen + 1u) * nloc) {
            __builtin_amdgcn_fence(__ATOMIC_RELEASE, "agent");
            asm volatile("s_waitcnt vmcnt(0)" ::: "memory");
            const unsigned og = xb_add(&bar[XB_TOP], 1u);
            const unsigned tg = og / nx;
            if (og + 1u == (tg + 1u) * nx) xb_add(&bar[XB_TOPGEN], 1u);
            else XB_SPIN(xb_ld(&bar[XB_TOPGEN]) == tg, bar);
            __builtin_amdgcn_fence(__ATOMIC_ACQUIRE, "agent");
            xb_add(&bar[XB_XGEN(b.x)], 1u);
            asm volatile("s_waitcnt vmcnt(0)" ::: "memory");
        } else {
            XB_SPIN(xb_ld(&bar[XB_XGEN(b.x)]) == gen, bar);
            __builtin_amdgcn_fence(__ATOMIC_ACQUIRE, "agent");
            asm volatile("s_waitcnt vmcnt(0)" ::: "memory");
        }
    }
    __syncthreads();
}

constexpr size_t MiB = 1u << 20;
constexpr size_t WS_CTL = 0, CTL_ZERO_BYTES = 65536;
constexpr int CW_BAR = 1024;
constexpr int CW_CNT = 8192;
constexpr int CW_CUR = 8192 + 64;
constexpr size_t WS_SSQ_CQ  = 1 * MiB;
constexpr size_t WS_SSQ_CKV = 2 * MiB;
constexpr size_t WS_SSQ_MK  = 2 * MiB + 512 * 1024;
constexpr size_t WS_SSQ_ATT = 3 * MiB;
constexpr size_t WS_SSQ_H1  = 5 * MiB;
constexpr size_t WS_SSQ_MQ  = 7 * MiB;
constexpr size_t WS_COS     = 9 * MiB;
constexpr size_t WS_SIN     = 11 * MiB;
constexpr size_t WS_BKT     = 13 * MiB;
constexpr size_t WS_RR      = 13 * MiB + 128 * 1024;
constexpr size_t WS_W0      = 13 * MiB + 256 * 1024;
constexpr size_t WS_W1      = 13 * MiB + 384 * 1024;
constexpr size_t WS_TOK     = 13 * MiB + 512 * 1024;
constexpr size_t WS_PR      = 13 * MiB + 704 * 1024;
constexpr size_t WS_PW0     = 14 * MiB;
constexpr size_t WS_PW1     = 14 * MiB + 192 * 1024;
constexpr size_t WS_KRF     = 14 * MiB + 512 * 1024;
constexpr size_t WS_WIN  = 17 * MiB;
constexpr size_t WS_WSV  = WS_WIN  + 3584 * 1024;
constexpr size_t WS_WMK  = WS_WSV  + 1 * MiB;
constexpr size_t WS_WMV  = WS_WMK  + 2 * MiB;
constexpr size_t WS_WUQ  = WS_WMV  + 2 * MiB;
constexpr size_t WS_WUKN = WS_WUQ  + 1 * MiB;
constexpr size_t WS_WUKV = WS_WUKN + 256 * 1024;
constexpr size_t WS_WO   = WS_WUKV + 256 * 1024;
constexpr size_t WS_WMQ  = WS_WO   + 2 * MiB;
constexpr size_t WS_WMO  = WS_WMQ  + 2 * MiB;
constexpr size_t WS_WGU  = WS_WMO  + 2 * MiB;
constexpr size_t WS_WD2  = WS_WGU  + 32 * MiB;
constexpr size_t WS_WEND = WS_WD2  + 48 * MiB;
constexpr size_t WS_MN   = 114 * MiB;
constexpr size_t WS_MKR  = 118 * MiB;
constexpr size_t WS_MVT  = 122 * MiB;
constexpr size_t WS_KP   = 126 * MiB;
constexpr size_t WS_R1   = 130 * MiB;
constexpr size_t WS_R2   = 194 * MiB;
constexpr size_t WS_R3   = 290 * MiB;
constexpr size_t WS_R4   = 330 * MiB;
constexpr size_t WS_END  = 458 * MiB;
static_assert(WS_WEND <= WS_MN, "ws map");
constexpr size_t WS_HN = WS_R1, WS_ATT = WS_R1, WS_MQ = WS_R1, WS_H2H = WS_R1;
constexpr size_t WS_SBQ = WS_R2, WS_SBK = WS_R2 + 32 * MiB, WS_SBVT = WS_R2 + 64 * MiB, WS_H1H = WS_R2, WS_TS = WS_R2;
constexpr size_t WS_CQ = WS_R3, WS_CKV = WS_R3 + 24 * MiB;
constexpr size_t WS_MLAQ = WS_R4, WS_MLAK = WS_R4 + 48 * MiB, WS_MLAVT = WS_R4 + 96 * MiB, WS_HE = WS_R4, WS_MO = WS_R4;

constexpr int LDS_BYTES = 147456;
constexpr int LDS_MISC = 143360;
constexpr int NWAVES = 8, NTHR = 512;

struct Params { const float* in[31]; float* out; unsigned char* ws; int ph_lo, ph_hi; };

struct Frame {
    LAS unsigned char* lds; volatile LAS unsigned* MISC;
    int vcu, G, bx;
    unsigned char* ws; float* out; unsigned* ctl;
};
#define PHASE_IDS() const int tid = fresh_tid(), lane = tid & 63, wave = __builtin_amdgcn_readfirstlane(tid >> 6); (void)lane; (void)wave

__device__ __forceinline__ void conv_item(const float* src, int ld, int srccol0, int mode, int ksrc0, const float* kscale, f16* dst, int K, int row0, int k0, LAS float* scr, int lane) {
    if (mode != 2) {
        const float* base = src + (size_t)ksrc0 * ld + srccol0;
        const unsigned voff = (unsigned)((lane >> 5) * ld + (lane & 31)) * 4u;
        float v[32];
#pragma unroll
        for (int i = 0; i < 32; ++i) v[i] = *(const float*)((const char*)(base + (size_t)2 * i * ld) + voff);
#pragma unroll
        for (int i = 0; i < 32; ++i) scr[(2 * i + (lane >> 5)) * 33 + (lane & 31)] = v[i];
    }
    asm volatile("s_waitcnt lgkmcnt(0)" ::: "memory");
    const int c = lane & 7;
    f32x4 ks0 = (f32x4){1.f, 1.f, 1.f, 1.f}, ks1 = ks0;
    if (kscale) { ks0 = *(const f32x4*)(kscale + ksrc0 + 8 * c); ks1 = *(const f32x4*)(kscale + ksrc0 + 8 * c + 4); }
#pragma unroll
    for (int j = 0; j < 4; ++j) { const int q = (lane >> 3) + 8 * j; const int lc = (mode == 1) ? L32(q) : q; const LAS float* s = scr + (8 * c) * 33 + lc;
        u32x4 o;
        if (mode == 2) { o = (u32x4){0u, 0u, 0u, 0u}; }
        else { o.x = pk2(s[0 * 33] * ks0[0], s[1 * 33] * ks0[1]); o.y = pk2(s[2 * 33] * ks0[2], s[3 * 33] * ks0[3]); o.z = pk2(s[4 * 33] * ks1[0], s[5 * 33] * ks1[1]); o.w = pk2(s[6 * 33] * ks1[2], s[7 * 33] * ks1[3]); }
        *(u32x4*)(dst + (size_t)(row0 + q) * K + k0 + 8 * c) = o; }
    asm volatile("s_waitcnt lgkmcnt(0)" ::: "memory");
}
__device__ __forceinline__ void rms_rows2_to_f16(const float* x, const float* g, f16* o, int m0, int m1, bool has1, int lane) {
    const f32x4* x0 = (const f32x4*)(x + (size_t)m0 * D) + lane; const f32x4* x1 = (const f32x4*)(x + (size_t)m1 * D) + lane; const f32x4* gr = (const f32x4*)g + lane;
    f32x4 v[4], w[4]; float s0 = 0.f, s1 = 0.f;
#pragma unroll
    for (int j = 0; j < 4; ++j) v[j] = x0[64 * j];
    if (has1) {
#pragma unroll
        for (int j = 0; j < 4; ++j) w[j] = x1[64 * j];
    } else {
#pragma unroll
        for (int j = 0; j < 4; ++j) w[j] = (f32x4){0.f, 0.f, 0.f, 0.f};
    }
#pragma unroll
    for (int j = 0; j < 4; ++j) { s0 += dot4(v[j]); s1 += dot4(w[j]); }
#pragma unroll
    for (int o_ = 1; o_ < 64; o_ <<= 1) { s0 += __shfl_xor(s0, o_); s1 += __shfl_xor(s1, o_); }
    const float r0 = __builtin_amdgcn_rsqf(s0 * (1.f / 1024.f) + EPS), r1 = __builtin_amdgcn_rsqf(s1 * (1.f / 1024.f) + EPS);
    u32x2* o0 = (u32x2*)(o + (size_t)m0 * D) + lane; u32x2* o1 = (u32x2*)(o + (size_t)m1 * D) + lane;
#pragma unroll
    for (int j = 0; j < 4; ++j) { const f32x4 gg = gr[64 * j]; o0[64 * j] = pk4(v[j] * r0 * gg); if (has1) o1[64 * j] = pk4(w[j] * r1 * gg); }
}
__device__ __forceinline__ void moe_pair(int pi, int& lo, int& hi) { lo = pi < 3 ? 0 : (pi < 5 ? 1 : 2); hi = pi < 3 ? pi + 1 : (pi < 5 ? pi - 1 : 3); }

__device__ __forceinline__ void p0_prologue(Frame& F, const Params& P) {
    PHASE_IDS();
    LAS float* scr = (LAS float*)(F.lds + wave * 16384);
    const int gw = F.vcu * NWAVES + wave, NGW = F.G * NWAVES;
    unsigned char* ws = F.ws;
    const float* w_in = P.in[4]; const float* w_uq = P.in[6]; const float* w_ukv = P.in[8]; const float* w_o = P.in[15];
    const float* w_mq = P.in[18]; const float* w_mkv = P.in[19]; const float* w_mo = P.in[22];
    const float* w_gate = P.in[28]; const float* w_up = P.in[29]; const float* w_down = P.in[30];
    for (int it = gw; it < 56 * 16; it += NGW) { const int rb = it >> 4, kb = it & 15, tile = rb >> 3, g = rb & 7, bj = g >> 2, wc = g & 3; int col, mode = 1;
        if (tile < 2) col = (4 * tile + wc) * 64 + 32 * bj;
        else if (tile < 4) col = 512 + (4 * (tile - 2) + wc) * 64 + 32 * bj;
        else if (tile == 4) col = 1536 + 64 * wc + 32 * bj;
        else if (tile == 5) { if (bj == 0) col = 1536 + 256 + 32 * wc; else if (wc == 0) { col = 2176; mode = 0; } else { col = 0; mode = 2; } }
        else col = 1920 + 64 * wc + 32 * bj;
        conv_item(w_in, 2208, col, mode, kb * 64, nullptr, (f16*)(ws + WS_WIN), 1024, rb * 32, kb * 64, scr, lane); }
    for (int it = gw; it < 16 * 16; it += NGW) { const int rb = it >> 4, kb = it & 15; conv_item(w_in, 2208, 1024 + 32 * rb, 0, kb * 64, nullptr, (f16*)(ws + WS_WSV), 1024, rb * 32, kb * 64, scr, lane); }
    for (int it = gw; it < 32 * 16; it += NGW) { const int rb = it >> 4, kb = it & 15, tile = rb >> 3, g = rb & 7, bj = g >> 2, wc = g & 3;
        conv_item(w_mkv, 2048, 256 * tile + 64 * wc + 32 * bj, 1, kb * 64, nullptr, (f16*)(ws + WS_WMK), 1024, rb * 32, kb * 64, scr, lane); }
    for (int it = gw; it < 32 * 16; it += NGW) { const int rb = it >> 4, kb = it & 15; conv_item(w_mkv, 2048, 1024 + 32 * rb, 0, kb * 64, nullptr, (f16*)(ws + WS_WMV), 1024, rb * 32, kb * 64, scr, lane); }
    for (int it = gw; it < 24 * 6; it += NGW) { const int rb = it / 6, kb = it % 6, tile = rb >> 3, g = rb & 7, bj = g >> 2, wc = g & 3; int col, mode = 1;
        if (tile < 2) col = (4 * tile + wc) * 96 + 32 * bj; else { col = (4 * bj + wc) * 96 + 64; mode = 0; }
        conv_item(w_uq, 768, col, mode, kb * 64, P.in[5], (f16*)(ws + WS_WUQ), 384, rb * 32, kb * 64, scr, lane); }
    for (int it = gw; it < 16 * 4; it += NGW) { const int rb = it >> 2, kb = it & 3, tile = rb >> 3, g = rb & 7, bj = g >> 2, wc = g & 3;
        conv_item(w_ukv, 1024, (4 * tile + wc) * 128 + 32 * bj, 1, kb * 64, P.in[7], (f16*)(ws + WS_WUKN), 256, rb * 32, kb * 64, scr, lane); }
    for (int it = gw; it < 16 * 4; it += NGW) { const int rb = it >> 2, kb = it & 3;
        conv_item(w_ukv, 1024, (rb >> 1) * 128 + 64 + 32 * (rb & 1), 0, kb * 64, P.in[7], (f16*)(ws + WS_WUKV), 256, rb * 32, kb * 64, scr, lane); }
    for (int it = gw; it < 32 * 16; it += NGW) { const int rb = it >> 4, kb = it & 15; conv_item(w_o, 1024, 32 * rb, 1, kb * 64, nullptr, (f16*)(ws + WS_WO), 1024, rb * 32, kb * 64, scr, lane); }
    for (int it = gw; it < 32 * 16; it += NGW) { const int rb = it >> 4, kb = it & 15; conv_item(w_mq, 1024, 32 * rb, 1, kb * 64, P.in[16], (f16*)(ws + WS_WMQ), 1024, rb * 32, kb * 64, scr, lane); }
    for (int it = gw; it < 32 * 16; it += NGW) { const int rb = it >> 4, kb = it & 15; conv_item(w_mo, 1024, 32 * rb, 1, kb * 64, nullptr, (f16*)(ws + WS_WMO), 1024, rb * 32, kb * 64, scr, lane); }
    for (int it = gw; it < 64 * 8 * 16; it += NGW) { const int kb = it & 15, rb = (it >> 4) & 7, tile = it >> 7, e = tile >> 2, ffb = tile & 3, bj = rb >> 2, wc = rb & 3;
        conv_item((bj ? w_up : w_gate) + (size_t)e * 1024 * 512, 512, ffb * 128 + 32 * wc, 1, kb * 64, P.in[23], (f16*)(ws + WS_WGU) + (size_t)tile * 256 * 1024, 1024, rb * 32, kb * 64, scr, lane); }
    for (int it = gw; it < 16 * 32 * 8; it += NGW) { const int kb = it & 7, rb = (it >> 3) & 31, e = it >> 8;
        conv_item(w_down + (size_t)e * 512 * 1024, 1024, 32 * rb, 1, kb * 64, nullptr, (f16*)(ws + WS_WD2) + (size_t)e * 1024 * 512, 512, rb * 32, kb * 64, scr, lane); }
    for (int m = gw; m < T; m += 2 * NGW) rms_rows2_to_f16(P.in[0], P.in[3], (f16*)(ws + WS_HN), m, m + NGW, m + NGW < T, lane);
    for (int m = gw; m < 2048; m += 2 * NGW) rms_rows2_to_f16(P.in[1], P.in[17], (f16*)(ws + WS_MN), m, m + NGW, m + NGW < 2048, lane);
    {
        const int gt = F.vcu * NTHR + tid, NGT = F.G * NTHR; const int* pos = (const int*)P.in[2];
        float* COS = (float*)(ws + WS_COS); float* SIN = (float*)(ws + WS_SIN);
        for (int e = gt; e < T * 16; e += NGT) { const int tok = e >> 4, i = e & 15;
            const float invf = i == 0 ? 1.000000000e+00f : i == 1 ? 5.623413324e-01f : i == 2 ? 3.162277639e-01f : i == 3 ? 1.778279394e-01f : i == 4 ? 1.000000015e-01f : i == 5 ? 5.623413250e-02f : i == 6 ? 3.162277490e-02f : i == 7 ? 1.778279431e-02f :
                               i == 8 ? 9.999999776e-03f : i == 9 ? 5.623413250e-03f : i == 10 ? 3.162277630e-03f : i == 11 ? 1.778279431e-03f : i == 12 ? 1.000000047e-03f : i == 13 ? 5.623413017e-04f : i == 14 ? 3.162277571e-04f : 1.778279402e-04f;
            const float ang = (float)pos[tok] * invf;
            const double x = (double)ang; const double n = __builtin_rint(x * 0.15915494309189535); const float rev = (float)(x * 0.15915494309189535 - n);
            COS[e] = __builtin_amdgcn_cosf(rev); SIN[e] = __builtin_amdgcn_sinf(rev); }
        int* TOK = (int*)(ws + WS_TOK);
        for (int e = gt; e < NPOS; e += NGT) TOK[e] = -1;
    }
}

typedef f32x4 Acc[2][2][4][2];
template <bool SSQ>
__device__ __forceinline__ void store_w64(const Acc& acc, int rowb, f16* dst, int ld, int colb, float scale, float* ssq, int ldq, int slot, int fq) {
#pragma unroll
    for (int ai = 0; ai < 2; ++ai)
#pragma unroll
        for (int m = 0; m < 4; ++m) { const int row = rowb + ai * 128 + m * 16; float s = 0.f;
#pragma unroll
            for (int bj = 0; bj < 2; ++bj) { const f32x4 v0 = acc[ai][bj][m][0] * scale, v1 = acc[ai][bj][m][1] * scale;
                if (SSQ) s += dot4(v0) + dot4(v1);
                *(u32x4*)(dst + (size_t)row * ld + colb + bj * 32 + 8 * fq) = pk8(v0, v1); }
            if (SSQ) { s += __shfl_xor(s, 16); s += __shfl_xor(s, 32); if (fq == 0) ssq[(size_t)row * ldq + slot] = s; } }
}

struct EpiP1N {
    unsigned char* ws; const float* krg;
    __device__ __forceinline__ void operator()(const Acc& acc, const Unit& u, int wr, int wc, int fr_, int fq_) const {
        int fr = fr_, fq = fq_; asm volatile("" : "+v"(fr), "+v"(fq));
        const int rowb = u.pm * 256 + wr * 64 + fr;
        if (u.aux == 0) { store_w64<false>(acc, rowb, (f16*)(ws + WS_SBQ), 512, (4 * u.pn + wc) * 64, 0.125f, nullptr, 0, 0, fq); }
        else if (u.aux == 1) { store_w64<false>(acc, rowb, (f16*)(ws + WS_SBK), 512, (4 * u.pn + wc) * 64, 1.f, nullptr, 0, 0, fq); }
        else if (u.aux == 2) { store_w64<true>(acc, rowb, (f16*)(ws + WS_CQ), 384, 64 * wc, 1.f, (float*)(ws + WS_SSQ_CQ), 8, wc, fq); }
        else if (u.aux == 4) { store_w64<true>(acc, rowb, (f16*)(ws + WS_CKV), 256, 64 * wc, 1.f, (float*)(ws + WS_SSQ_CKV), 4, wc, fq); }
        else if (u.aux == 5) { store_w64<true>(acc, rowb, (f16*)(ws + WS_MKR), 1024, 256 * u.pn + 64 * wc, 1.f, (float*)(ws + WS_SSQ_MK), 16, 4 * u.pn + wc, fq); }
        else {
            f16* CQ = (f16*)(ws + WS_CQ); float* SS = (float*)(ws + WS_SSQ_CQ);
#pragma unroll
            for (int ai = 0; ai < 2; ++ai)
#pragma unroll
                for (int m = 0; m < 4; ++m) { const int row = rowb + ai * 128 + m * 16;
                    const f32x4 v0 = acc[ai][0][m][0], v1 = acc[ai][0][m][1]; float s = dot4(v0) + dot4(v1);
                    *(u32x4*)(CQ + (size_t)row * 384 + 256 + 32 * wc + 8 * fq) = pk8(v0, v1);
                    s += __shfl_xor(s, 16); s += __shfl_xor(s, 32); if (fq == 0) SS[(size_t)row * 8 + 4 + wc] = s; }
            if (wc == 0) {
                const float* COS = (const float*)(ws + WS_COS); const float* SIN = (const float*)(ws + WS_SIN); f16* KRF = (f16*)(ws + WS_KRF);
                const f32x4 g1 = *(const f32x4*)(krg + 4 * fq), g2 = *(const f32x4*)(krg + 16 + 4 * fq);
#pragma unroll
                for (int ai = 0; ai < 2; ++ai)
#pragma unroll
                    for (int m = 0; m < 4; ++m) { const int row = rowb + ai * 128 + m * 16;
                        f32x4 x1 = acc[ai][1][m][0], x2 = acc[ai][1][m][1]; float s = dot4(x1) + dot4(x2);
                        s += __shfl_xor(s, 16); s += __shfl_xor(s, 32);
                        const float rn = __builtin_amdgcn_rsqf(s * (1.f / 32.f) + EPS);
                        x1 = x1 * rn * g1; x2 = x2 * rn * g2;
                        const f32x4 c = *(const f32x4*)(COS + (size_t)row * 16 + 4 * fq), sn = *(const f32x4*)(SIN + (size_t)row * 16 + 4 * fq);
                        const f32x4 o1 = x1 * c - x2 * sn, o2 = x2 * c + x1 * sn;
                        *(u32x2*)(KRF + (size_t)row * 32 + 4 * fq) = pk4(o1); *(u32x2*)(KRF + (size_t)row * 32 + 16 + 4 * fq) = pk4(o2); }
            }
        }
    }
};
struct SchedP1N {
    unsigned char* ws; int G, c;
    __device__ __forceinline__ bool next(int i, Unit& u) const {
        int L = i * G + c;
        if (L < 896) { int pm, pn; pg8::tile_map(L, 128, 7, pm, pn);
            u.A = (const char*)(ws + WS_HN) + (size_t)pm * 256 * 1024 * 2; u.B = (const char*)(ws + WS_WIN) + (size_t)pn * 256 * 1024 * 2; u.pm = pm;
            u.aux = pn < 2 ? 0 : (pn < 4 ? 1 : pn - 2); u.pn = pn < 2 ? pn : (pn < 4 ? pn - 2 : 0); return true; }
        L -= 896; if (L >= 32) return false;
        int pm, pn; pg8::tile_map(L, 8, 4, pm, pn);
        u.A = (const char*)(ws + WS_MN) + (size_t)pm * 256 * 1024 * 2; u.B = (const char*)(ws + WS_WMK) + (size_t)pn * 256 * 1024 * 2; u.pm = pm; u.pn = pn; u.aux = 5; return true;
    }
};
struct EpiP1S {
    unsigned char* ws;
    __device__ __forceinline__ void operator()(const Acc& acc, const Unit& u, int wr, int wc, int fr_, int fq_) const {
        int fr = fr_, fq = fq_; asm volatile("" : "+v"(fr), "+v"(fq));
        const int rowb = u.pm * 256 + wr * 64 + fr;
        if (u.aux == 0) { f16* dst = (f16*)(ws + WS_SBVT);
#pragma unroll
            for (int ai = 0; ai < 2; ++ai)
#pragma unroll
                for (int m = 0; m < 4; ++m) { const size_t ro = (size_t)(rowb + ai * 128 + m * 16) * T + u.pn * 256 + 32 * wc + 8 * (fq & 1) + 4 * (fq >> 1);
#pragma unroll
                    for (int bj = 0; bj < 2; ++bj)
#pragma unroll
                        for (int n = 0; n < 2; ++n) *(u32x2*)(dst + ro + 128 * bj + 16 * n) = pk4(acc[ai][bj][m][n]); }
        } else { f16* dst = (f16*)(ws + WS_MVT);
#pragma unroll
            for (int ai = 0; ai < 2; ++ai)
#pragma unroll
                for (int m = 0; m < 4; ++m) { const size_t ro = (size_t)(rowb + ai * 128 + m * 16) * 2048 + u.pn * 256 + 32 * wc + 8 * fq;
#pragma unroll
                    for (int bj = 0; bj < 2; ++bj)
#pragma unroll
                        for (int n = 0; n < 2; ++n) *(u32x2*)(dst + ro + 128 * bj + 4 * n) = pk4(acc[ai][bj][m][n]); }
        }
    }
};
struct SchedP1S {
    unsigned char* ws; int G, c;
    __device__ __forceinline__ bool next(int i, Unit& u) const {
        int L = i * G + c;
        if (L < 256) { int pm, pn; pg8::tile_map(L, 2, 128, pm, pn);
            u.A = (const char*)(ws + WS_WSV) + (size_t)pm * 256 * 1024 * 2; u.B = (const char*)(ws + WS_HN) + (size_t)pn * 256 * 1024 * 2; u.pm = pm; u.pn = pn; u.aux = 0; return true; }
        L -= 256; if (L >= 32) return false;
        int pm, pn; pg8::tile_map(L, 4, 8, pm, pn);
        u.A = (const char*)(ws + WS_WMV) + (size_t)pm * 256 * 1024 * 2; u.B = (const char*)(ws + WS_MN) + (size_t)pn * 256 * 1024 * 2; u.pm = pm; u.pn = pn; u.aux = 1; return true;
    }
};

constexpr float MLA_QSCALE = 0.10206207261596575f * 1.4426950408889634f;
__device__ __forceinline__ float rq_of(const float* SS8, int row) { const f32x4 a = *(const f32x4*)(SS8 + (size_t)row * 8), b = *(const f32x4*)(SS8 + (size_t)row * 8 + 4);
    return __builtin_amdgcn_rsqf((((a[0] + a[1]) + (a[2] + a[3])) + ((b[0] + b[1]) + (b[2] + b[3]))) * (1.f / 384.f) + EPS); }
__device__ __forceinline__ float rkv_of(const float* SS4, int row) { const f32x4 a = *(const f32x4*)(SS4 + (size_t)row * 4);
    return __builtin_amdgcn_rsqf(((a[0] + a[1]) + (a[2] + a[3])) * (1.f / 256.f) + EPS); }
struct EpiP2Q {
    unsigned char* ws; const float* qng; const float* qrg;
    __device__ __forceinline__ void operator()(const Acc& acc, const Unit& u, int wr, int wc, int fr_, int fq_) const {
        int fr = fr_, fq = fq_; asm volatile("" : "+v"(fr), "+v"(fq));
        const int rowb = u.pm * 256 + wr * 64 + fr; const float* SS = (const float*)(ws + WS_SSQ_CQ); f16* Q = (f16*)(ws + WS_MLAQ);
        if (u.pn < 2) { const int h = 4 * u.pn + wc;
            f32x4 g[2][2];
#pragma unroll
            for (int bj = 0; bj < 2; ++bj)
#pragma unroll
                for (int n = 0; n < 2; ++n) g[bj][n] = *(const f32x4*)(qng + 32 * bj + 8 * fq + 4 * n) * MLA_QSCALE;
#pragma unroll
            for (int ai = 0; ai < 2; ++ai)
#pragma unroll
                for (int m = 0; m < 4; ++m) { const int row = rowb + ai * 128 + m * 16; const float rq = rq_of(SS, row);
                    f32x4 v[2][2]; float s = 0.f;
#pragma unroll
                    for (int bj = 0; bj < 2; ++bj)
#pragma unroll
                        for (int n = 0; n < 2; ++n) { v[bj][n] = acc[ai][bj][m][n] * rq; s += dot4(v[bj][n]); }
                    s += __shfl_xor(s, 16); s += __shfl_xor(s, 32);
                    const float rn = __builtin_amdgcn_rsqf(s * (1.f / 64.f) + EPS);
#pragma unroll
                    for (int bj = 0; bj < 2; ++bj) *(u32x4*)(Q + (size_t)row * 768 + h * 96 + 32 * bj + 8 * fq) = pk8(v[bj][0] * rn * g[bj][0], v[bj][1] * rn * g[bj][1]); }
        } else {
            const float* COS = (const float*)(ws + WS_COS); const float* SIN = (const float*)(ws + WS_SIN);
            const f32x4 g1 = *(const f32x4*)(qrg + 4 * fq) * MLA_QSCALE, g2 = *(const f32x4*)(qrg + 16 + 4 * fq) * MLA_QSCALE;
#pragma unroll
            for (int ai = 0; ai < 2; ++ai)
#pragma unroll
                for (int m = 0; m < 4; ++m) { const int row = rowb + ai * 128 + m * 16; const float rq = rq_of(SS, row);
                    const f32x4 c = *(const f32x4*)(COS + (size_t)row * 16 + 4 * fq), sn = *(const f32x4*)(SIN + (size_t)row * 16 + 4 * fq);
#pragma unroll
                    for (int bj = 0; bj < 2; ++bj) { const int h = 4 * bj + wc;
                        f32x4 x1 = acc[ai][bj][m][0] * rq, x2 = acc[ai][bj][m][1] * rq; float s = dot4(x1) + dot4(x2);
                        s += __shfl_xor(s, 16); s += __shfl_xor(s, 32);
                        const float rn = __builtin_amdgcn_rsqf(s * (1.f / 32.f) + EPS);
                        x1 = x1 * rn * g1; x2 = x2 * rn * g2;
                        const f32x4 o1 = x1 * c - x2 * sn, o2 = x2 * c + x1 * sn;
                        *(u32x2*)(Q + (size_t)row * 768 + h * 96 + 64 + 4 * fq) = pk4(o1); *(u32x2*)(Q + (size_t)row * 768 + h * 96 + 80 + 4 * fq) = pk4(o2); } }
        }
    }
};
struct EpiP2K {
    unsigned char* ws; const float* kng;
    __device__ __forceinline__ void operator()(const Acc& acc, const Unit& u, int wr, int wc, int fr_, int fq_) const {
        int fr = fr_, fq = fq_; asm volatile("" : "+v"(fr), "+v"(fq));
        const int rowb = u.pm * 256 + wr * 64 + fr; const float* SS = (const float*)(ws + WS_SSQ_CKV); f16* Kd = (f16*)(ws + WS_MLAK); const f16* KRF = (const f16*)(ws + WS_KRF);
        const int h = 4 * u.pn + wc;
        f32x4 g[2][2];
#pragma unroll
        for (int bj = 0; bj < 2; ++bj)
#pragma unroll
            for (int n = 0; n < 2; ++n) g[bj][n] = *(const f32x4*)(kng + 32 * bj + 8 * fq + 4 * n);
#pragma unroll
        for (int ai = 0; ai < 2; ++ai)
#pragma unroll
            for (int m = 0; m < 4; ++m) { const int row = rowb + ai * 128 + m * 16; const float rk = rkv_of(SS, row);
                f32x4 v[2][2]; float s = 0.f;
#pragma unroll
                for (int bj = 0; bj < 2; ++bj)
#pragma unroll
                    for (int n = 0; n < 2; ++n) { v[bj][n] = acc[ai][bj][m][n] * rk; s += dot4(v[bj][n]); }
                s += __shfl_xor(s, 16); s += __shfl_xor(s, 32);
                const float rn = __builtin_amdgcn_rsqf(s * (1.f / 64.f) + EPS);
#pragma unroll
                for (int bj = 0; bj < 2; ++bj) *(u32x4*)(Kd + (size_t)row * 768 + h * 96 + 32 * bj + 8 * fq) = pk8(v[bj][0] * rn * g[bj][0], v[bj][1] * rn * g[bj][1]);
                *(u32x4*)(Kd + (size_t)row * 768 + h * 96 + 64 + 8 * fq) = *(const u32x4*)(KRF + (size_t)row * 32 + 8 * fq); }
    }
};
struct EpiP2V {
    unsigned char* ws;
    __device__ __forceinline__ void operator()(const Acc& acc, const Unit& u, int wr, int wc, int fr_, int fq_) const {
        int fr = fr_, fq = fq_; asm volatile("" : "+v"(fr), "+v"(fq));
        const int rowb = u.pm * 256 + wr * 64 + fr; const float* SS = (const float*)(ws + WS_SSQ_CKV); f16* dst = (f16*)(ws + WS_MLAVT);
        f32x4 rk[2][2];
#pragma unroll
        for (int bj = 0; bj < 2; ++bj)
#pragma unroll
            for (int n = 0; n < 2; ++n) { const int tok = u.pn * 256 + 128 * bj + 32 * wc + 16 * n + 4 * fq;
#pragma unroll
                for (int j = 0; j < 4; ++j) rk[bj][n][j] = rkv_of(SS, tok + j); }
#pragma unroll
        for (int ai = 0; ai < 2; ++ai)
#pragma unroll
            for (int m = 0; m < 4; ++m) { const size_t ro = (size_t)(rowb + ai * 128 + m * 16) * T + u.pn * 256 + 32 * wc + 8 * (fq & 1) + 4 * (fq >> 1);
#pragma unroll
                for (int bj = 0; bj < 2; ++bj)
#pragma unroll
                    for (int n = 0; n < 2; ++n) *(u32x2*)(dst + ro + 128 * bj + 16 * n) = pk4(acc[ai][bj][m][n] * rk[bj][n]); }
    }
};
struct SchedGrid {
    const char* A; const char* B; size_t sA, sB; int nM, nN, G, c;
    __device__ __forceinline__ bool next(int i, Unit& u) const {
        const int L = i * G + c; if (L >= nM * nN) return false;
        int pm, pn; pg8::tile_map(L, nM, nN, pm, pn);
        u.A = A + (size_t)pm * sA; u.B = B + (size_t)pn * sB; u.pm = pm; u.pn = pn; u.aux = 0; return true;
    }
};
__device__ __forceinline__ void p2_kprime(Frame& F, const Params& P) {
    PHASE_IDS();
    const int gw = F.vcu * NWAVES + wave, NGW = F.G * NWAVES;
    const f16* MKR = (const f16*)(F.ws + WS_MKR); const float* SS = (const float*)(F.ws + WS_SSQ_MK); f16* KP = (f16*)(F.ws + WS_KP);
    const f32x4 gg = *(const f32x4*)(P.in[21] + 4 * lane) * *(const f32x4*)(P.in[20] + 4 * lane);
    for (int it = gw; it < 2048 * 4; it += NGW) { const int row = it >> 2, h = it & 3, b = row >> 8, key = row & 255;
        const f32x4 a = *(const f32x4*)(SS + (size_t)row * 16 + 4 * h); const float r = __builtin_amdgcn_rsqf(((a[0] + a[1]) + (a[2] + a[3])) * (1.f / 256.f) + EPS);
        const f16x4 x = *(const f16x4*)(MKR + (size_t)row * 1024 + 256 * h + 4 * lane);
        const f32x4 v = (f32x4){(float)x[0], (float)x[1], (float)x[2], (float)x[3]} * r * gg;
        *(u32x2*)(KP + ((size_t)((b * 4 + h) * 256 + key)) * 256 + 4 * lane) = pk4(v); }
}

#define MFMA32(a, b, c) __builtin_amdgcn_mfma_f32_32x32x16_f16((a), (b), (c), 0, 0, 0)
#define MFMA16(a, b, c) __builtin_amdgcn_mfma_f32_16x16x32_f16((a), (b), (c), 0, 0, 0)
__device__ __forceinline__ f16x8 pack8(const f32x16& s, int base) {
    u32x4 w; w.x = pk2(s[base + 0], s[base + 1]); w.y = pk2(s[base + 2], s[base + 3]); w.z = pk2(s[base + 4], s[base + 5]); w.w = pk2(s[base + 6], s[base + 7]);
    return __builtin_bit_cast(f16x8, w);
}
__device__ __forceinline__ float store_ot(const f32x16& o0, const f32x16& o1, float inv, f16* dst, int hf) {
    float ss = 0.f;
#pragma unroll
    for (int g4 = 0; g4 < 4; ++g4) {
        const f32x4 a = (f32x4){o0[4 * g4], o0[4 * g4 + 1], o0[4 * g4 + 2], o0[4 * g4 + 3]} * inv, b = (f32x4){o1[4 * g4], o1[4 * g4 + 1], o1[4 * g4 + 2], o1[4 * g4 + 3]} * inv;
        ss += dot4(a) + dot4(b);
        *(u32x2*)(dst + 8 * g4 + 4 * hf) = pk4(a); *(u32x2*)(dst + 32 + 8 * g4 + 4 * hf) = pk4(b); }
    return ss;
}
constexpr float SB_EXIT = -104.0f;
__device__ __forceinline__ void sb_item(const f16* __restrict__ Qg, const f16* __restrict__ Kg, const f16* __restrict__ Vt, f16* Og, float* SSQ, int b, int h, int qblk, int lane) {
    const int r32 = lane & 31, hf = lane >> 5;
    const int t0 = qblk * 32, t = t0 + r32; const size_t row = (size_t)b * SEQ + t;
    f16x8 qf[4];
#pragma unroll
    for (int ks = 0; ks < 4; ++ks) qf[ks] = *(const f16x8*)(Qg + row * 512 + h * 64 + 16 * ks + 8 * hf);
    f32x16 o0 = {}, o1 = {};
    float carry = 0.f;
    const int kt0 = t0 >> 6;
    for (int kt = kt0; kt >= 0; --kt) {
        const int key0 = kt * 64;
        const f16* kp = Kg + ((size_t)b * SEQ + key0 + r32) * 512 + h * 64 + 8 * hf;
        const f16* vp = Vt + ((size_t)(h * 64 + r32)) * T + (size_t)b * SEQ + key0 + 8 * hf;
        f16x8 kf[2][4], vf[2][4];
#pragma unroll
        for (int kb = 0; kb < 2; ++kb)
#pragma unroll
            for (int ks = 0; ks < 4; ++ks) kf[kb][ks] = *(const f16x8*)(kp + (size_t)kb * 32 * 512 + 16 * ks);
#pragma unroll
        for (int dvb = 0; dvb < 2; ++dvb)
#pragma unroll
            for (int kk = 0; kk < 4; ++kk) vf[dvb][kk] = *(const f16x8*)(vp + (size_t)dvb * 32 * T + 16 * kk);
        f32x16 s[2]; s[0] = (f32x16){}; s[1] = (f32x16){};
#pragma unroll
        for (int ks = 0; ks < 4; ++ks) { s[0] = MFMA32(kf[0][ks], qf[ks], s[0]); s[1] = MFMA32(kf[1][ks], qf[ks], s[1]); }
        const bool diag = (kt == kt0);
        float lfv[2][16], G[2][4], PG[2][4];
#pragma unroll
        for (int kb = 0; kb < 2; ++kb)
#pragma unroll
            for (int q4 = 0; q4 < 4; ++q4) { float gs = 0.f;
#pragma unroll
                for (int j = 0; j < 4; ++j) { const int r = 4 * q4 + j; const float z = s[kb][r];
                    const float e = __expf(-__builtin_fabsf(z)); const float sp = __builtin_fmaxf(z, 0.f) + __logf(1.f + e);
                    const int key = key0 + 32 * kb + 8 * q4 + 4 * hf + j;
                    const bool vis = (!diag) || (key < t);
                    const float lf = vis ? -sp : 0.f;
                    lfv[kb][r] = lf; s[kb][r] = vis ? (z - sp) : -INFINITY; gs += lf; }
                G[kb][q4] = gs; PG[kb][q4] = __shfl_xor(gs, 32); }
        float running = carry;
#pragma unroll
        for (int kb = 1; kb >= 0; --kb)
#pragma unroll
            for (int q4 = 3; q4 >= 0; --q4) {
                float a = running + (hf == 0 ? PG[kb][q4] : 0.f);
#pragma unroll
                for (int j = 3; j >= 0; --j) { const int r = 4 * q4 + j; const float w = __expf(s[kb][r] + a); a += lfv[kb][r]; s[kb][r] = w; }
                running += G[kb][q4] + PG[kb][q4]; }
        carry = running;
#pragma unroll
        for (int kk = 0; kk < 4; ++kk) { const f16x8 pa = pack8(s[kk >> 1], 8 * (kk & 1)); o0 = MFMA32(vf[0][kk], pa, o0); o1 = MFMA32(vf[1][kk], pa, o1); }
        if (__all(carry < SB_EXIT)) break;
    }
    const float ss = store_ot(o0, o1, 1.f, Og + row * 1024 + h * 64, hf);
    const float tot = ss + __shfl_xor(ss, 32);
    if (hf == 0) SSQ[row * 16 + h] = tot;
}

constexpr int MLA_KROW = 208, MLA_VROW = 144, MLA_KBYTES = 64 * MLA_KROW, MLA_VBYTES = 64 * MLA_VROW, MLA_BUF = MLA_KBYTES + MLA_VBYTES;
__device__ __forceinline__ void mla_unit(LAS unsigned char* lds, const f16* __restrict__ Qg, const f16* __restrict__ Kg, const f16* __restrict__ Vt, f16* Og, float* SSQ, int b, int h, int qb, int tid) {
    const int lane = tid & 63, wid = __builtin_amdgcn_readfirstlane(tid >> 6), r32 = lane & 31, hf = lane >> 5;
    const size_t row = (size_t)b * SEQ + qb * 256 + wid * 32 + r32;
    f16x8 qf[6];
#pragma unroll
    for (int ks = 0; ks < 6; ++ks) qf[ks] = *(const f16x8*)(Qg + row * 768 + h * 96 + 16 * ks + 8 * hf);
    const int NT = 4 * qb + 4, my_last = 4 * qb + (wid >> 1);
    const int k0key = tid / 12, k0c = tid % 12, k1key = (tid + 512) / 12, k1c = (tid + 512) % 12, vdv = tid >> 3, vc = tid & 7;
    const f16* ksrc0 = Kg + ((size_t)b * SEQ + k0key) * 768 + h * 96 + 8 * k0c;
    const f16* ksrc1 = Kg + ((size_t)b * SEQ + k1key) * 768 + h * 96 + 8 * k1c;
    const f16* vsrc = Vt + (size_t)(h * 64 + vdv) * T + (size_t)b * SEQ + 8 * vc;
    const int kd0 = k0key * MLA_KROW + k0c * 16, kd1 = k1key * MLA_KROW + k1c * 16, vd = MLA_KBYTES + vdv * MLA_VROW + vc * 16;
    const bool has1 = tid < 256;
    u32x4 rk0, rk1 = {}, rv;
    rk0 = *(const u32x4*)ksrc0; if (has1) rk1 = *(const u32x4*)ksrc1; rv = *(const u32x4*)vsrc;
    __syncthreads();
    *(LAS u32x4*)(lds + kd0) = rk0; if (has1) *(LAS u32x4*)(lds + kd1) = rk1; *(LAS u32x4*)(lds + vd) = rv;
    __syncthreads();
    f32x16 o0 = {}, o1 = {};
    float mrun = -INFINITY, lrun = 0.f;
    for (int t = 0; t < NT; ++t) {
        const bool pre = (t + 1 < NT);
        if (pre) { const size_t ko = (size_t)(t + 1) * 64 * 768; rk0 = *(const u32x4*)(ksrc0 + ko); if (has1) rk1 = *(const u32x4*)(ksrc1 + ko); rv = *(const u32x4*)(vsrc + (t + 1) * 64); }
        if (t <= my_last) {
            const LAS unsigned char* kb_ = lds + (t & 1) * MLA_BUF; const LAS unsigned char* vb_ = kb_ + MLA_KBYTES;
            f32x16 s0 = {}, s1 = {};
#pragma unroll
            for (int ks = 0; ks < 6; ++ks) {
                const f16x8 k0 = *(const LAS f16x8*)(kb_ + r32 * MLA_KROW + (16 * ks + 8 * hf) * 2);
                const f16x8 k1 = *(const LAS f16x8*)(kb_ + (32 + r32) * MLA_KROW + (16 * ks + 8 * hf) * 2);
                s0 = MFMA32(k0, qf[ks], s0); s1 = MFMA32(k1, qf[ks], s1); }
            float tm = s0[0];
#pragma unroll
            for (int r = 1; r < 16; ++r) tm = __builtin_fmaxf(tm, s0[r]);
#pragma unroll
            for (int r = 0; r < 16; ++r) tm = __builtin_fmaxf(tm, s1[r]);
            tm = __builtin_fmaxf(tm, __shfl_xor(tm, 32));
            const float mnew = __builtin_fmaxf(mrun, tm), alpha = __builtin_amdgcn_exp2f(mrun - mnew);
            mrun = mnew;
            float ps = 0.f;
#pragma unroll
            for (int r = 0; r < 16; ++r) { s0[r] = __builtin_amdgcn_exp2f(s0[r] - mnew); s1[r] = __builtin_amdgcn_exp2f(s1[r] - mnew); ps += s0[r] + s1[r]; }
            lrun = lrun * alpha + ps;
            o0 = o0 * alpha; o1 = o1 * alpha;
#pragma unroll
            for (int kk = 0; kk < 4; ++kk) { const f16x8 pa = (kk < 2) ? pack8(s0, 8 * (kk & 1)) : pack8(s1, 8 * (kk & 1));
                const f16x8 v0 = *(const LAS f16x8*)(vb_ + r32 * MLA_VROW + (16 * kk + 8 * hf) * 2);
                const f16x8 v1 = *(const LAS f16x8*)(vb_ + (32 + r32) * MLA_VROW + (16 * kk + 8 * hf) * 2);
                o0 = MFMA32(v0, pa, o0); o1 = MFMA32(v1, pa, o1); }
        }
        if (pre) { LAS unsigned char* nb = lds + ((t + 1) & 1) * MLA_BUF; *(LAS u32x4*)(nb + kd0) = rk0; if (has1) *(LAS u32x4*)(nb + kd1) = rk1; *(LAS u32x4*)(nb + vd) = rv; }
        __syncthreads();
    }
    const float ltot = lrun + __shfl_xor(lrun, 32);
    const float ss = store_ot(o0, o1, 1.f / ltot, Og + row * 1024 + 512 + h * 64, hf);
    const float tot = ss + __shfl_xor(ss, 32);
    if (hf == 0) SSQ[row * 16 + 8 + h] = tot;
}
__device__ __forceinline__ void p3_attention(Frame& F) {
    PHASE_IDS();
    unsigned char* ws = F.ws;
    f16* ATT = (f16*)(ws + WS_ATT); float* SSQ = (float*)(ws + WS_SSQ_ATT);
    {
        const f16* Q = (const f16*)(ws + WS_SBQ); const f16* K = (const f16*)(ws + WS_SBK); const f16* Vt = (const f16*)(ws + WS_SBVT);
        const int gw = F.vcu * NWAVES + wave, NGW = F.G * NWAVES;
        for (int it = gw; it < NB * 8 * 128; it += NGW) { const int qblk = it & 127, h = (it >> 7) & 7, b = it >> 10; sb_item(Q, K, Vt, ATT, SSQ, b, h, qblk, lane); }
    }
    {
        const f16* Q = (const f16*)(ws + WS_MLAQ); const f16* K = (const f16*)(ws + WS_MLAK); const f16* Vt = (const f16*)(ws + WS_MLAVT);
        for (int pr = F.vcu; pr < 64 * 8; pr += F.G) { const int bh = pr >> 3, qa = pr & 7, b = bh >> 3, h = bh & 7;
            mla_unit(F.lds, Q, K, Vt, ATT, SSQ, b, h, 15 - qa, tid);
            mla_unit(F.lds, Q, K, Vt, ATT, SSQ, b, h, qa, tid); }
    }
}
__device__ __forceinline__ void p3b_norm(Frame& F, const Params& P) {
    PHASE_IDS();
    const int gw = F.vcu * NWAVES + wave, NGW = F.G * NWAVES;
    f16* ATT = (f16*)(F.ws + WS_ATT); const float* SSQ = (const float*)(F.ws + WS_SSQ_ATT);
    const f32x4 ga0 = *(const f32x4*)(P.in[13] + 8 * lane), ga1 = *(const f32x4*)(P.in[13] + 8 * lane + 4), gb0 = *(const f32x4*)(P.in[14] + 8 * lane), gb1 = *(const f32x4*)(P.in[14] + 8 * lane + 4);
    for (int row = gw; row < T; row += NGW) {
        const f32x4 a0 = *(const f32x4*)(SSQ + (size_t)row * 16), a1 = *(const f32x4*)(SSQ + (size_t)row * 16 + 4), b0 = *(const f32x4*)(SSQ + (size_t)row * 16 + 8), b1 = *(const f32x4*)(SSQ + (size_t)row * 16 + 12);
        const float ra = __builtin_amdgcn_rsqf((((a0[0] + a0[1]) + (a0[2] + a0[3])) + ((a1[0] + a1[1]) + (a1[2] + a1[3]))) * (1.f / 512.f) + EPS);
        const float rb = __builtin_amdgcn_rsqf((((b0[0] + b0[1]) + (b0[2] + b0[3])) + ((b1[0] + b1[1]) + (b1[2] + b1[3]))) * (1.f / 512.f) + EPS);
        f16* pa = ATT + (size_t)row * 1024 + 8 * lane; f16* pb = pa + 512;
        const f16x8 xa = *(const f16x8*)pa, xb = *(const f16x8*)pb;
        f32x4 va0, va1, vb0, vb1;
#pragma unroll
        for (int j = 0; j < 4; ++j) { va0[j] = (float)xa[j]; va1[j] = (float)xa[4 + j]; vb0[j] = (float)xb[j]; vb1[j] = (float)xb[4 + j]; }
        *(u32x4*)pa = pk8(va0 * ra * ga0, va1 * ra * ga1); *(u32x4*)pb = pk8(vb0 * rb * gb0, vb1 * rb * gb1);
    }
}

struct EpiWo {
    unsigned char* ws; const float* x;
    __device__ __forceinline__ void operator()(const Acc& acc, const Unit& u, int wr, int wc, int fr_, int fq_) const {
        int fr = fr_, fq = fq_; asm volatile("" : "+v"(fr), "+v"(fq));
        const int rowb = u.pm * 256 + wr * 64 + fr, colb = u.pn * 256 + 32 * wc + 8 * fq; f16* H = (f16*)(ws + WS_H1H); float* SS = (float*)(ws + WS_SSQ_H1);
#pragma unroll
        for (int ai = 0; ai < 2; ++ai)
#pragma unroll
            for (int m = 0; m < 4; ++m) { const size_t ro = (size_t)(rowb + ai * 128 + m * 16) * 1024 + colb; float s = 0.f;
#pragma unroll
                for (int bj = 0; bj < 2; ++bj) { const size_t o = ro + 128 * bj;
                    const f32x4 v0 = acc[ai][bj][m][0] + *(const f32x4*)(x + o), v1 = acc[ai][bj][m][1] + *(const f32x4*)(x + o + 4);
                    *(u32x4*)(H + o) = pk8(v0, v1); s += dot4(v0) + dot4(v1); }
                s += __shfl_xor(s, 16); s += __shfl_xor(s, 32); if (fq == 0) SS[(size_t)(rowb + ai * 128 + m * 16) * 16 + 4 * u.pn + wc] = s; }
    }
};
struct EpiMq {
    unsigned char* ws;
    __device__ __forceinline__ void operator()(const Acc& acc, const Unit& u, int wr, int wc, int fr_, int fq_) const {
        int fr = fr_, fq = fq_; asm volatile("" : "+v"(fr), "+v"(fq));
        const int rowb = u.pm * 256 + wr * 64 + fr, colb = u.pn * 256 + 32 * wc + 8 * fq; f16* Q = (f16*)(ws + WS_MQ); float* SS = (float*)(ws + WS_SSQ_MQ);
#pragma unroll
        for (int ai = 0; ai < 2; ++ai)
#pragma unroll
            for (int m = 0; m < 4; ++m) { const size_t ro = (size_t)(rowb + ai * 128 + m * 16) * 1024 + colb; float s = 0.f;
#pragma unroll
                for (int bj = 0; bj < 2; ++bj) { const f32x4 v0 = acc[ai][bj][m][0], v1 = acc[ai][bj][m][1]; *(u32x4*)(Q + ro + 128 * bj) = pk8(v0, v1); s += dot4(v0) + dot4(v1); }
                s += __shfl_xor(s, 16); s += __shfl_xor(s, 32); if (fq == 0) SS[(size_t)(rowb + ai * 128 + m * 16) * 16 + 4 * u.pn + wc] = s; }
    }
};
struct EpiMo {
    unsigned char* ws;
    __device__ __forceinline__ void operator()(const Acc& acc, const Unit& u, int wr, int wc, int fr_, int fq_) const {
        int fr = fr_, fq = fq_; asm volatile("" : "+v"(fr), "+v"(fq));
        const int rowb = u.pm * 256 + wr * 64 + fr, colb = u.pn * 256 + 32 * wc + 8 * fq; f16* H = (f16*)(ws + WS_H2H); const f16* H1 = (const f16*)(ws + WS_H1H);
#pragma unroll
        for (int ai = 0; ai < 2; ++ai)
#pragma unroll
            for (int m = 0; m < 4; ++m) { const size_t ro = (size_t)(rowb + ai * 128 + m * 16) * 1024 + colb;
#pragma unroll
                for (int bj = 0; bj < 2; ++bj) { const size_t o = ro + 128 * bj; const f16x8 hv = *(const f16x8*)(H1 + o);
                    f32x4 v0 = acc[ai][bj][m][0], v1 = acc[ai][bj][m][1];
#pragma unroll
                    for (int j = 0; j < 4; ++j) { v0[j] += (float)hv[j]; v1[j] += (float)hv[4 + j]; }
                    *(u32x4*)(H + o) = pk8(v0, v1); } }
    }
};

constexpr int MEM_ROWB = 528;
template <int RS>
__device__ __forceinline__ void mem_stage(LAS unsigned char* lds, const f16* src, int tid) {
    const unsigned voff = (unsigned)((tid >> 5) * RS + 8 * (tid & 31)) * 2u;
    const unsigned loff = (unsigned)((tid >> 5) * MEM_ROWB + (tid & 31) * 16);
#pragma unroll
    for (int bt = 0; bt < 4; ++bt) { u32x4 r[4];
#pragma unroll
        for (int i = 0; i < 4; ++i) r[i] = *(const u32x4*)((const char*)src + (size_t)(4 * bt + i) * 16 * RS * 2 + voff);
#pragma unroll
        for (int i = 0; i < 4; ++i) *(LAS u32x4*)(lds + loff + (4 * bt + i) * 16 * MEM_ROWB) = r[i]; }
}
__device__ __forceinline__ void p6_memattn(Frame& F) {
    PHASE_IDS(); unsigned char* ws = F.ws; LAS unsigned char* lds = F.lds; const int wid = wave, l16 = lane & 15, g = lane >> 4;
    const f16* MQ = (const f16*)(ws + WS_MQ); const f16* KP = (const f16*)(ws + WS_KP); const f16* MVT = (const f16*)(ws + WS_MVT); f16* MO = (f16*)(ws + WS_MO);
    const float* SSH = (const float*)(ws + WS_SSQ_H1); const float* SSM = (const float*)(ws + WS_SSQ_MQ);
    for (int un = F.vcu; un < 256; un += F.G) { const int bh = un >> 3, qc = un & 7, b = bh >> 2, h = bh & 3;
        for (int pass = 0; pass < 4; ++pass) {
            const size_t row = (size_t)b * SEQ + qc * 512 + pass * 128 + wid * 16 + l16;
            f16x8 qf[8];
#pragma unroll
            for (int ks = 0; ks < 8; ++ks) qf[ks] = *(const f16x8*)(MQ + row * 1024 + h * 256 + 32 * ks + 8 * g);
            float fac;
            { const f32x4 a0 = *(const f32x4*)(SSH + row * 16), a1 = *(const f32x4*)(SSH + row * 16 + 4), a2 = *(const f32x4*)(SSH + row * 16 + 8), a3 = *(const f32x4*)(SSH + row * 16 + 12);
              const float sh = (((a0[0] + a0[1]) + (a0[2] + a0[3])) + ((a1[0] + a1[1]) + (a1[2] + a1[3]))) + (((a2[0] + a2[1]) + (a2[2] + a2[3])) + ((a3[0] + a3[1]) + (a3[2] + a3[3])));
              const float r1 = __builtin_amdgcn_rsqf(sh * (1.f / 1024.f) + EPS);
              const f32x4 q4 = *(const f32x4*)(SSM + row * 16 + 4 * h); const float mv = ((q4[0] + q4[1]) + (q4[2] + q4[3])) * (1.f / 256.f);
              fac = r1 * __builtin_amdgcn_rsqf(r1 * r1 * mv + EPS) * (0.0625f * 1.4426950408889634f); }
            __syncthreads();
            mem_stage<256>(lds, KP + (size_t)(b * 4 + h) * 256 * 256, tid);
            __syncthreads();
            f32x4 s[16];
#pragma unroll
            for (int kb = 0; kb < 16; ++kb) { s[kb] = (f32x4){0.f, 0.f, 0.f, 0.f};
#pragma unroll
                for (int ks = 0; ks < 8; ++ks) { const f16x8 a = *(const LAS f16x8*)(lds + (16 * kb + l16) * MEM_ROWB + (32 * ks + 8 * g) * 2); s[kb] = MFMA16(a, qf[ks], s[kb]); } }
            float mx = -INFINITY;
#pragma unroll
            for (int kb = 0; kb < 16; ++kb) { s[kb] = s[kb] * fac; mx = __builtin_fmaxf(mx, __builtin_fmaxf(__builtin_fmaxf(s[kb][0], s[kb][1]), __builtin_fmaxf(s[kb][2], s[kb][3]))); }
            mx = __builtin_fmaxf(mx, __shfl_xor(mx, 16)); mx = __builtin_fmaxf(mx, __shfl_xor(mx, 32));
            float sum = 0.f; u32x4 pf[8];
#pragma unroll
            for (int s8 = 0; s8 < 8; ++s8) { f32x4 p0, p1;
#pragma unroll
                for (int j = 0; j < 4; ++j) { p0[j] = __builtin_amdgcn_exp2f(s[2 * s8][j] - mx); p1[j] = __builtin_amdgcn_exp2f(s[2 * s8 + 1][j] - mx); }
                sum += ((p0[0] + p0[1]) + (p0[2] + p0[3])) + ((p1[0] + p1[1]) + (p1[2] + p1[3]));
                pf[s8] = pk8(p0, p1); }
            sum += __shfl_xor(sum, 16); sum += __shfl_xor(sum, 32);
            const float inv = 1.f / sum;
            __syncthreads();
            mem_stage<2048>(lds, MVT + (size_t)(h * 256) * 2048 + b * 256, tid);
            __syncthreads();
#pragma unroll 4
            for (int dvb = 0; dvb < 16; ++dvb) { f32x4 o = (f32x4){0.f, 0.f, 0.f, 0.f};
#pragma unroll
                for (int s8 = 0; s8 < 8; ++s8) { const f16x8 a = *(const LAS f16x8*)(lds + (16 * dvb + l16) * MEM_ROWB + (32 * s8 + 8 * g) * 2); o = MFMA16(a, __builtin_bit_cast(f16x8, pf[s8]), o); }
                *(u32x2*)(MO + row * 1024 + h * 256 + 16 * dvb + 4 * g) = pk4(o * inv); }
        }
    }
}

__device__ __forceinline__ void p8_route(Frame& F, const Params& P) {
    PHASE_IDS(); unsigned char* ws = F.ws;
    LAS float* WR = (LAS float*)F.lds;
    LAS unsigned* hist = (LAS unsigned*)(F.lds + LDS_MISC) + 8;
    const float* w_group = P.in[24]; const float* w_router = P.in[26];
    for (int e = tid; e < 1024 * 20; e += NTHR) { const int d = e / 20, c = e % 20; WR[c * 1024 + d] = c < 4 ? w_group[d * 4 + c] : w_router[d * 16 + (c - 4)]; }
    if (tid < 24) hist[tid] = 0u;
    __syncthreads();
    const f16* H2 = (const f16*)(ws + WS_H2H); const float* gm = P.in[23];
    f32x4 g[4];
#pragma unroll
    for (int k = 0; k < 4; ++k) g[k] = *(const f32x4*)(gm + 256 * k + 4 * lane);
    float bias[20];
#pragma unroll
    for (int c = 0; c < 20; ++c) bias[c] = c < 4 ? P.in[25][c] : P.in[27][c - 4];
    int* BKT = (int*)(ws + WS_BKT); float* RR = (float*)(ws + WS_RR); float* W0 = (float*)(ws + WS_W0); float* W1 = (float*)(ws + WS_W1);
    const int gw = F.vcu * NWAVES + wave, NGW = F.G * NWAVES;
    for (int tok = gw; tok < T; tok += NGW) {
        f32x4 v[4]; float ss = 0.f;
#pragma unroll
        for (int k = 0; k < 4; ++k) { const f16x4 hx = *(const f16x4*)(H2 + (size_t)tok * 1024 + 256 * k + 4 * lane); v[k] = (f32x4){(float)hx[0], (float)hx[1], (float)hx[2], (float)hx[3]}; ss += dot4(v[k]); }
        const float r = __builtin_amdgcn_rsqf(wave_sum(ss) * (1.f / 1024.f) + EPS);
        float lg[20];
#pragma unroll
        for (int c = 0; c < 20; ++c) lg[c] = 0.f;
#pragma unroll
        for (int k = 0; k < 4; ++k) { const f32x4 tv = v[k] * r * g[k];
#pragma unroll
            for (int c = 0; c < 20; ++c) { const f32x4 w = *(const LAS f32x4*)(WR + c * 1024 + 256 * k + 4 * lane); lg[c] += (tv[0] * w[0] + tv[1] * w[1]) + (tv[2] * w[2] + tv[3] * w[3]); }
            __builtin_amdgcn_sched_barrier(0); }
#pragma unroll
        for (int c = 0; c < 20; ++c) lg[c] = wave_sum(lg[c]) + bias[c];
        int gi = 0; float gmx = lg[0];
#pragma unroll
        for (int c = 1; c < 4; ++c) if (lg[c] > gmx) { gmx = lg[c]; gi = c; }
        float gden = 0.f;
#pragma unroll
        for (int c = 0; c < 4; ++c) gden += __expf(lg[c] - gmx);
        const float gw_ = 1.f / gden;
        float el[4];
#pragma unroll
        for (int c = 0; c < 4; ++c) el[c] = gi == 0 ? lg[4 + c] : (gi == 1 ? lg[8 + c] : (gi == 2 ? lg[12 + c] : lg[16 + c]));
        int i1 = 0; float m1 = el[0];
#pragma unroll
        for (int c = 1; c < 4; ++c) if (el[c] > m1) { m1 = el[c]; i1 = c; }
        int i2 = -1; float m2 = -INFINITY;
#pragma unroll
        for (int c = 0; c < 4; ++c) if (c != i1 && el[c] > m2) { m2 = el[c]; i2 = c; }
        const float e2 = __expf(m2 - m1), wa = gw_ / (1.f + e2), wb = gw_ * e2 / (1.f + e2);
        const int lo = i1 < i2 ? i1 : i2, hi = i1 < i2 ? i2 : i1;
        const int pi = lo == 0 ? hi - 1 : (lo == 1 ? hi + 1 : 5);
        const int bk = gi * 6 + pi;
        if (lane == 0) { BKT[tok] = bk; RR[tok] = r; W0[tok] = (i1 < i2) ? wa : wb; W1[tok] = (i1 < i2) ? wb : wa; atomicAdd((unsigned*)&hist[bk], 1u); }
    }
    __syncthreads();
    if (tid < 24) { const unsigned hv = hist[tid]; if (hv) atomicAdd(F.ctl + CW_CNT + tid, hv); }
}
__device__ __forceinline__ void moe_tiles(Frame& F) {
    LAS int* tstart = (LAS int*)(F.lds + LDS_MISC) + 32;
    const int tid0 = fresh_tid();
    __syncthreads();
    if (tid0 == 0) { int acc = 0;
        for (int b = 0; b < 24; ++b) { tstart[b] = acc; acc += (int)((__hip_atomic_load(F.ctl + CW_CNT + b, __ATOMIC_RELAXED, __HIP_MEMORY_SCOPE_AGENT) + 255u) >> 8); }
        tstart[24] = acc; }
    __syncthreads();
}
__device__ __forceinline__ void p9_gather(Frame& F) {
    PHASE_IDS(); unsigned char* ws = F.ws; const int wid = wave;
    moe_tiles(F);
    LAS int* tstart = (LAS int*)(F.lds + LDS_MISC) + 32; LAS int* posarr = (LAS int*)(F.lds + LDS_MISC) + 64;
    const int* BKT = (const int*)(ws + WS_BKT); const float* RR = (const float*)(ws + WS_RR); const float* W0 = (const float*)(ws + WS_W0); const float* W1 = (const float*)(ws + WS_W1);
    int* TOK = (int*)(ws + WS_TOK); float* PR = (float*)(ws + WS_PR); float* PW0 = (float*)(ws + WS_PW0); float* PW1 = (float*)(ws + WS_PW1);
    const f16* H2H = (const f16*)(ws + WS_H2H); f16* TS = (f16*)(ws + WS_TS);
    for (int blk = F.vcu; blk < T / 128; blk += F.G) {
        if (wid < 2) { const int tok = blk * 128 + wid * 64 + lane; const int bk = BKT[tok];
            unsigned mycount = 0u, rank = 0u;
            for (int bb = 0; bb < 24; ++bb) { const unsigned long long mask = __ballot(bk == bb); const unsigned c = (unsigned)__popcll(mask);
                if (lane == bb) mycount = c;
                if (bk == bb) rank = (unsigned)__popcll(mask & ((1ull << lane) - 1ull)); }
            unsigned basev = 0u;
            if (lane < 24 && mycount) basev = atomicAdd(F.ctl + CW_CUR + lane, mycount);
            const unsigned mybase = (unsigned)__shfl((int)basev, bk);
            posarr[wid * 64 + lane] = tstart[bk] * 256 + (int)(mybase + rank); }
        __syncthreads();
#pragma unroll 4
        for (int j = 0; j < 16; ++j) { const int tl = wid * 16 + j, tok = blk * 128 + tl, pos = posarr[tl];
            const u32x4 a = *(const u32x4*)(H2H + (size_t)tok * 1024 + 8 * lane), b = *(const u32x4*)(H2H + (size_t)tok * 1024 + 512 + 8 * lane);
            *(u32x4*)(TS + (size_t)pos * 1024 + 8 * lane) = a; *(u32x4*)(TS + (size_t)pos * 1024 + 512 + 8 * lane) = b;
            if (lane == 0) { TOK[pos] = tok; PR[pos] = RR[tok]; PW0[pos] = W0[tok]; PW1[pos] = W1[tok]; } }
        __syncthreads();
    }
}

struct SchedMoe {
    const char* A; const char* B; LAS const int* tstart; int G, c, nct_log2, down;
    __device__ __forceinline__ bool next(int i, Unit& u) const {
        const int L = i * G + c, rt = L >> nct_log2, ct = L & ((1 << nct_log2) - 1);
        if (rt >= tstart[24]) return false;
        int bk = 0;
        for (int b = 1; b < 24; ++b) bk = (rt >= tstart[b]) ? b : bk;
        u.A = A + (size_t)rt * 256 * 1024 * 2; u.pm = rt; u.pn = ct; u.aux = bk;
        int lo, hi; moe_pair(bk % 6, lo, hi);
        if (down) { u.B = B + ((size_t)(4 * (bk / 6) + lo) * 1024 + ct * 256) * 512 * 2; u.B2 = B + ((size_t)(4 * (bk / 6) + hi) * 1024 + ct * 256) * 512 * 2; }
        else { const int e = 4 * (bk / 6) + ((ct >> 2) ? hi : lo); u.B = B + (size_t)(e * 4 + (ct & 3)) * 256 * 1024 * 2; u.B2 = nullptr; }
        return true;
    }
};
struct EpiGU {
    unsigned char* ws;
    __device__ __forceinline__ void operator()(const Acc& acc, const Unit& u, int wr, int wc, int fr_, int fq_) const {
        int fr = fr_, fq = fq_; asm volatile("" : "+v"(fr), "+v"(fq));
        const int rowb = u.pm * 256 + wr * 64 + fr, slot = u.pn >> 2, ffb = u.pn & 3; f16* HE = (f16*)(ws + WS_HE);
        const float* PR = (const float*)(ws + WS_PR); const float* PW = (const float*)(ws + (slot ? WS_PW1 : WS_PW0));
#pragma unroll
        for (int ai = 0; ai < 2; ++ai)
#pragma unroll
            for (int m = 0; m < 4; ++m) { const int row = rowb + ai * 128 + m * 16; const float r = PR[row], w = PW[row];
                f32x4 o[2];
#pragma unroll
                for (int n = 0; n < 2; ++n) { const f32x4 gt = acc[ai][0][m][n] * r, up = acc[ai][1][m][n] * r;
#pragma unroll
                    for (int j = 0; j < 4; ++j) { const float sg = gt[j] * __builtin_amdgcn_rcpf(1.f + __expf(-gt[j])); o[n][j] = sg * up[j] * w; } }
                *(u32x4*)(HE + (size_t)row * 1024 + slot * 512 + ffb * 128 + 32 * wc + 8 * fq) = pk8(o[0], o[1]); }
    }
};
struct EpiDown {
    unsigned char* ws; float* out;
    __device__ __forceinline__ void operator()(const Acc& acc, const Unit& u, int wr, int wc, int fr_, int fq_) const {
        int fr = fr_, fq = fq_; asm volatile("" : "+v"(fr), "+v"(fq));
        const int rowb = u.pm * 256 + wr * 64 + fr, colb = u.pn * 256 + 32 * wc + 8 * fq; const int* TOK = (const int*)(ws + WS_TOK); const f16* H2 = (const f16*)(ws + WS_H2H);
#pragma unroll
        for (int ai = 0; ai < 2; ++ai)
#pragma unroll
            for (int m = 0; m < 4; ++m) { const int tok = TOK[rowb + ai * 128 + m * 16];
                if (tok >= 0) { const size_t ro = (size_t)tok * 1024 + colb;
#pragma unroll
                    for (int bj = 0; bj < 2; ++bj) { const size_t o = ro + 128 * bj; const f16x8 hv = *(const f16x8*)(H2 + o);
                        f32x4 v0 = acc[ai][bj][m][0], v1 = acc[ai][bj][m][1];
#pragma unroll
                        for (int j = 0; j < 4; ++j) { v0[j] += (float)hv[j]; v1[j] += (float)hv[4 + j]; }
                        *(f32x4*)(out + o) = v0; *(f32x4*)(out + o + 4) = v1; } } }
    }
};

#ifndef MK_N_LAUNCHES
#define MK_N_LAUNCHES 1
#endif
constexpr int N_PHASES = 13;
__global__ void __launch_bounds__(NTHR, 2) fwd_kernel(Params P) {
    extern __shared__ __attribute__((aligned(16))) unsigned char lds_raw[];
    Frame F;
    F.lds = (LAS unsigned char*)lds_raw; F.MISC = (volatile LAS unsigned*)(F.lds + LDS_MISC);
    F.G = gridDim.x; F.bx = blockIdx.x; F.vcu = (F.G % 8 == 0) ? (F.bx % 8) * (F.G / 8) + F.bx / 8 : F.bx;
    F.ws = P.ws; F.out = P.out; F.ctl = (unsigned*)(P.ws + WS_CTL);
    for (int u = fresh_tid(); u < (LDS_BYTES - LDS_MISC) / 4; u += NTHR) ((LAS unsigned*)(F.lds + LDS_MISC))[u] = 0u;
    __syncthreads();
    const int lo = P.ph_lo, hi = P.ph_hi;
    const bool multi = (hi - lo) > 1;
    XcdBarrier bar; bar.bar = F.ctl + CW_BAR; bar.x = 0; bar.st = F.MISC;
    if (multi) bar = xcd_barrier_post(F.ctl + CW_BAR, F.MISC);
#define IN(k) (lo <= (k) && (k) < hi)
#define SEAM(k) do { if (IN(k) && IN((k) + 1)) xcd_barrier(bar); } while (0)
    unsigned char* ws = F.ws;
#ifndef PROBE_DUP
#define PROBE_DUP -1
#endif
#define RUN(k, ...) do { if (IN(k)) { __VA_ARGS__ if (PROBE_DUP == (k)) { xcd_barrier(bar); __VA_ARGS__ } } SEAM(k); } while (0)
    RUN(0, { p0_prologue(F, P); });
    RUN(1, {
        { SchedP1N S{ws, F.G, F.bx}; EpiP1N E{ws, P.in[12]}; pg8::gemm_phase<EpiP1N, SchedP1N, true>(F.lds, 1024, 1024, 1024, S, E); }
        { SchedP1S S{ws, F.G, (F.bx + F.G - 160) % F.G}; EpiP1S E{ws}; pg8::gemm_phase<EpiP1S, SchedP1S, true>(F.lds, 1024, 1024, 1024, S, E); }
    });
    RUN(2, {
        p2_kprime(F, P);
        { SchedGrid S{(const char*)(ws + WS_CQ), (const char*)(ws + WS_WUQ), (size_t)256 * 384 * 2, (size_t)256 * 384 * 2, 128, 3, F.G, F.bx}; EpiP2Q E{ws, P.in[9], P.in[10]};
          pg8::gemm_phase<EpiP2Q, SchedGrid, true>(F.lds, 384, 384, 384, S, E); }
        { SchedGrid S{(const char*)(ws + WS_CKV), (const char*)(ws + WS_WUKN), (size_t)256 * 256 * 2, (size_t)256 * 256 * 2, 128, 2, F.G, (F.bx + F.G - 128) % F.G}; EpiP2K E{ws, P.in[11]};
          pg8::gemm_phase<EpiP2K, SchedGrid, true>(F.lds, 256, 256, 256, S, E); }
        { SchedGrid S{(const char*)(ws + WS_WUKV), (const char*)(ws + WS_CKV), (size_t)256 * 256 * 2, (size_t)256 * 256 * 2, 2, 128, F.G, (F.bx + F.G - 128) % F.G}; EpiP2V E{ws};
          pg8::gemm_phase<EpiP2V, SchedGrid, true>(F.lds, 256, 256, 256, S, E); }
    });
    RUN(3, { p3_attention(F); });
    RUN(4, { p3b_norm(F, P); });
    RUN(5, { SchedGrid S{(const char*)(ws + WS_ATT), (const char*)(ws + WS_WO), (size_t)256 * 1024 * 2, (size_t)256 * 1024 * 2, 128, 4, F.G, F.bx}; EpiWo E{ws, P.in[0]};
        pg8::gemm_phase<EpiWo, SchedGrid, true>(F.lds, 1024, 1024, 1024, S, E); });
    RUN(6, { SchedGrid S{(const char*)(ws + WS_H1H), (const char*)(ws + WS_WMQ), (size_t)256 * 1024 * 2, (size_t)256 * 1024 * 2, 128, 4, F.G, F.bx}; EpiMq E{ws};
        pg8::gemm_phase<EpiMq, SchedGrid, true>(F.lds, 1024, 1024, 1024, S, E); });
    RUN(7, { p6_memattn(F); });
    RUN(8, { SchedGrid S{(const char*)(ws + WS_MO), (const char*)(ws + WS_WMO), (size_t)256 * 1024 * 2, (size_t)256 * 1024 * 2, 128, 4, F.G, F.bx}; EpiMo E{ws};
        pg8::gemm_phase<EpiMo, SchedGrid, true>(F.lds, 1024, 1024, 1024, S, E); });
    RUN(9, { p8_route(F, P); });
    RUN(10, { p9_gather(F); });
    RUN(11, { moe_tiles(F); SchedMoe S{(const char*)(ws + WS_TS), (const char*)(ws + WS_WGU), (LAS const int*)(F.lds + LDS_MISC) + 32, F.G, F.vcu, 3, 0}; EpiGU E{ws};
        pg8::gemm_phase<EpiGU, SchedMoe, true>(F.lds, 1024, 1024, 1024, S, E); });
    RUN(12, { moe_tiles(F); SchedMoe S{(const char*)(ws + WS_HE), (const char*)(ws + WS_WD2), (LAS const int*)(F.lds + LDS_MISC) + 32, F.G, F.vcu, 2, 1}; EpiDown E{ws, P.out};
        pg8::gemm_phase<EpiDown, SchedMoe, true, true>(F.lds, 1024, 1024, 512, S, E); });
#undef RUN
#undef IN
#undef SEAM
}

extern "C" void kernel_launch(void* const* d_in, const int* in_sizes, int n_in, void* d_out, int out_size, void* d_ws, size_t ws_size, hipStream_t stream) {
    static int grid = 0;
    if (grid == 0) {
        if (n_in != 31 || out_size != T * D || ws_size < WS_END) { fprintf(stderr, "kernel_launch: unexpected shapes (n_in %d, out %d, ws %zu < %zu)\n", n_in, out_size, ws_size, (size_t)WS_END); grid = -1; return; }
        int dev = 0, cus = 0, per_cu = 0;
        if (hipGetDevice(&dev) != hipSuccess || hipDeviceGetAttribute(&cus, hipDeviceAttributeMultiprocessorCount, dev) != hipSuccess) { grid = -1; return; }
        if (hipFuncSetAttribute((const void*)fwd_kernel, hipFuncAttributeMaxDynamicSharedMemorySize, LDS_BYTES) != hipSuccess) { fprintf(stderr, "kernel_launch: hipFuncSetAttribute failed\n"); grid = -1; return; }
        if (hipOccupancyMaxActiveBlocksPerMultiprocessor(&per_cu, (const void*)fwd_kernel, NTHR, LDS_BYTES) != hipSuccess || per_cu < 1) { fprintf(stderr, "kernel_launch: occupancy query says %d\n", per_cu); }
        (void)hipGetLastError();
        grid = cus;
    }
    if (grid < 0) return;
    (void)hipMemsetAsync((char*)d_ws + WS_CTL, 0, CTL_ZERO_BYTES, stream);
    Params p{};
    for (int i = 0; i < 31; ++i) p.in[i] = (const float*)d_in[i];
    p.out = (float*)d_out; p.ws = (unsigned char*)d_ws;
    if (MK_N_LAUNCHES == 1) { p.ph_lo = 0; p.ph_hi = N_PHASES; hipLaunchKernelGGL(fwd_kernel, dim3(grid), dim3(NTHR), LDS_BYTES, stream, p); }
    else { for (int k = 0; k < N_PHASES; ++k) { p.ph_lo = k; p.ph_hi = k + 1; hipLaunchKernelGGL(fwd_kernel, dim3(grid), dim3(NTHR), LDS_BYTES, stream, p); } }
}
```

```cpp
#include <hip/hip_runtime.h>
#include <cstdio>
#include <cstdint>

#define LAS __attribute__((address_space(3)))
#define GAS __attribute__((address_space(1)))
typedef _Float16 f16;
typedef _Float16 f16x8 __attribute__((ext_vector_type(8)));
typedef _Float16 f16x4 __attribute__((ext_vector_type(4)));
typedef _Float16 f16x2 __attribute__((ext_vector_type(2)));
typedef float f32x2 __attribute__((ext_vector_type(2)));
typedef float f32x4 __attribute__((ext_vector_type(4)));
typedef float f32x16 __attribute__((ext_vector_type(16)));
typedef unsigned u32x4 __attribute__((ext_vector_type(4)));
typedef unsigned u32x2 __attribute__((ext_vector_type(2)));

__device__ __forceinline__ unsigned pk2(float lo, float hi) { f16x2 v = {(f16)lo, (f16)hi}; return __builtin_bit_cast(unsigned, v); }
__device__ __forceinline__ u32x4 pk8(f32x4 a, f32x4 b) { u32x4 w; w.x = pk2(a[0], a[1]); w.y = pk2(a[2], a[3]); w.z = pk2(b[0], b[1]); w.w = pk2(b[2], b[3]); return w; }
__device__ __forceinline__ u32x2 pk4(f32x4 a) { u32x2 w; w.x = pk2(a[0], a[1]); w.y = pk2(a[2], a[3]); return w; }
__device__ __forceinline__ float dot4(f32x4 a) { return (a[0] * a[0] + a[1] * a[1]) + (a[2] * a[2] + a[3] * a[3]); }
__device__ __forceinline__ float wave_sum(float v) {
#pragma unroll
    for (int o = 1; o < 64; o <<= 1) v += __shfl_xor(v, o);
    return v;
}
__device__ __forceinline__ int L32(int q) { return 8 * ((q >> 2) & 3) + 4 * (q >> 4) + (q & 3); }

__device__ __forceinline__ int fresh_tid() { int t = (int)threadIdx.x; asm volatile("" : "+v"(t)); return t; }
constexpr int T = 32768, D = 1024, SEQ = 4096, NB = 8;
constexpr float EPS = 1e-6f;
constexpr int NPOS = 152 * 256;

namespace pg8 {
constexpr int BM = 256, BK = 64, HALF = 128, HTB = HALF * BK * 2, STAGE_BYTES = 8 * HTB;
__host__ __device__ __forceinline__ int lds_byte(int r, int c) { const int st = (r >> 4) * 2 + (c >> 5), rr = r & 15, cc = c & 31, ob = rr * 64 + cc * 2; return st * 1024 + (ob ^ (((ob >> 9) & 1) << 5)); }
__host__ __device__ __forceinline__ void stage_rc(int b, int& R, int& C) { const int st = b / 1024, sb = b % 1024, swz = sb ^ (((sb >> 9) & 1) << 5); R = (st >> 1) * 16 + swz / 64; C = (st & 1) * 32 + (swz % 64) / 2; }
struct Unit { const char* A; const char* B; const char* B2; int pm, pn, aux; };

template <class Epi, class Sched, bool ALIGN_EPI, bool SPLITB = false>
__device__ __forceinline__ void gemm_phase(LAS unsigned char* lds, const int K, const int lda, const int ldb, const Sched& S, const Epi& E) {
    const int tid = fresh_tid(), wid = __builtin_amdgcn_readfirstlane(tid >> 6), lane = tid & 63, wr = wid >> 2, wc = wid & 3, fr = lane & 15, fq = lane >> 4;
    const int nt = K / BK;
    unsigned voffA[2], voffB[2];
#pragma unroll
    for (int i = 0; i < 2; ++i) { int R, C; stage_rc(tid * 16 + i * 8192, R, C); voffA[i] = (unsigned)(R * lda + C) * 2u; voffB[i] = (unsigned)(R * ldb + C) * 2u; }
    const size_t kstep = (size_t)(BK * 2);
    const size_t hstepA = (size_t)HALF * lda * 2, hstepB = (size_t)HALF * ldb * 2;
    const unsigned ldsw = (unsigned)wid * 1024u;
    const int aoff = lds_byte(wr * 64 + fr, fq * 8), boff = lds_byte(wc * 32 + fr, fq * 8);
#define PG8_SA(b, h) (((b) * 2 + (h)) * HTB)
#define PG8_SB(b, h) ((4 + (b) * 2 + (h)) * HTB)
#define PG8_STAGE(bufoff, gbase, voff) do { _Pragma("unroll") for (int _i = 0; _i < 2; ++_i) \
        __builtin_amdgcn_global_load_lds((const unsigned*)((const char*)(gbase) + (voff)[_i]), (LAS unsigned*)(lds + (bufoff) + ldsw + _i * 8192), 16, 0, 0); } while (0)
#define PG8_LDA(dst, b, h) do { _Pragma("unroll") for (int m = 0; m < 4; ++m) _Pragma("unroll") for (int k = 0; k < 2; ++k) dst[m][k] = *(const LAS f16x8*)(lds + PG8_SA(b, h) + aoff + m * 2048 + k * 1024); } while (0)
#define PG8_LDB(dst, b, h) do { _Pragma("unroll") for (int n = 0; n < 2; ++n) _Pragma("unroll") for (int k = 0; k < 2; ++k) dst[n][k] = *(const LAS f16x8*)(lds + PG8_SB(b, h) + boff + n * 2048 + k * 1024); } while (0)
#define PG8_MMA(ai, bj, At, Bt) do { __builtin_amdgcn_s_setprio(1); _Pragma("unroll") for (int m = 0; m < 4; ++m) _Pragma("unroll") for (int n = 0; n < 2; ++n) _Pragma("unroll") for (int k = 0; k < 2; ++k) \
        acc[ai][bj][m][n] = __builtin_amdgcn_mfma_f32_16x16x32_f16(Bt[n][k], At[m][k], acc[ai][bj][m][n], 0, 0, 0); __builtin_amdgcn_s_setprio(0); } while (0)
#define PG8_WAIT_V(n) asm volatile("s_waitcnt vmcnt(" #n ")" ::: "memory")
#define PG8_WAIT_L(n) asm volatile("s_waitcnt lgkmcnt(" #n ")" ::: "memory")
#define PG8_BAR __builtin_amdgcn_s_barrier()
#define PG8_SCHED __builtin_amdgcn_sched_barrier(0)
    Unit cur, nxt; int ui = 0;
    if (!S.next(0, cur)) return;
    f32x4 acc[2][2][4][2];
#pragma unroll
    for (int a = 0; a < 2; ++a)
#pragma unroll
        for (int b = 0; b < 2; ++b)
#pragma unroll
            for (int m = 0; m < 4; ++m)
#pragma unroll
                for (int n = 0; n < 2; ++n) acc[a][b][m][n] = (f32x4){0.f, 0.f, 0.f, 0.f};
    f16x8 At[4][2], B0[2][2], B1[2][2];
    const char* cA = cur.A; const char* cB = cur.B; const char* cB2 = SPLITB ? cur.B2 : nullptr; const int th = nt >> 1;
    PG8_STAGE(PG8_SB(0, 0), cB, voffB); PG8_STAGE(PG8_SB(0, 1), cB + hstepB, voffB); PG8_STAGE(PG8_SA(0, 0), cA, voffA); PG8_STAGE(PG8_SA(0, 1), cA + hstepA, voffA);
    if (wr == 1) PG8_BAR;
    PG8_WAIT_V(2); PG8_BAR;
    PG8_STAGE(PG8_SB(1, 0), cB + kstep, voffB); PG8_STAGE(PG8_SA(1, 0), cA + kstep, voffA); PG8_STAGE(PG8_SB(1, 1), cB + hstepB + kstep, voffB);
    PG8_WAIT_V(6); PG8_BAR;
    for (;;) {
        const bool has_next = S.next(ui + 1, nxt);
        const char* nA = has_next ? nxt.A : cA; const char* nB = has_next ? nxt.B : cB; const char* nB2 = SPLITB ? (has_next ? nxt.B2 : cB2) : nullptr;
        for (int t = 0; t < nt; t += 2) {
            const bool last = (t == nt - 2);
            const char* a1 = cA + (size_t)(t + 1) * kstep;
            const char* a2 = last ? nA : cA + (size_t)(t + 2) * kstep;
            const char* b2 = last ? nB : ((SPLITB && t + 2 >= th) ? cB2 + (size_t)(t + 2 - th) * kstep : cB + (size_t)(t + 2) * kstep);
            const char* a3 = a2 + kstep; const char* b3 = b2 + kstep;
            PG8_LDB(B0, 0, 0); PG8_LDB(B1, 0, 1); PG8_SCHED; PG8_LDA(At, 0, 0); PG8_STAGE(PG8_SA(1, 1), a1 + hstepA, voffA);
            PG8_WAIT_V(8); PG8_WAIT_L(0); PG8_BAR; PG8_MMA(0, 0, At, B0); PG8_MMA(0, 1, At, B1); PG8_BAR; PG8_SCHED;
            PG8_LDA(At, 0, 1); PG8_STAGE(PG8_SB(0, 0), b2, voffB); PG8_STAGE(PG8_SB(0, 1), b2 + hstepB, voffB); PG8_STAGE(PG8_SA(0, 0), a2, voffA);
            PG8_WAIT_V(8); PG8_WAIT_L(0); PG8_BAR; PG8_MMA(1, 0, At, B0); PG8_MMA(1, 1, At, B1); PG8_BAR; PG8_SCHED;
            PG8_LDB(B0, 1, 0); PG8_LDB(B1, 1, 1); PG8_SCHED; PG8_LDA(At, 1, 0); PG8_STAGE(PG8_SA(0, 1), a2 + hstepA, voffA);
            PG8_WAIT_V(8); PG8_WAIT_L(0); PG8_BAR; PG8_MMA(0, 0, At, B0); PG8_MMA(0, 1, At, B1); PG8_BAR; PG8_SCHED;
            PG8_LDA(At, 1, 1); PG8_STAGE(PG8_SB(1, 0), b3, voffB); PG8_STAGE(PG8_SB(1, 1), b3 + hstepB, voffB); PG8_STAGE(PG8_SA(1, 0), a3, voffA);
            PG8_WAIT_V(8); PG8_WAIT_L(0); PG8_BAR; PG8_MMA(1, 0, At, B0); PG8_MMA(1, 1, At, B1); PG8_BAR; PG8_SCHED;
        }
        if constexpr (ALIGN_EPI) { if (wr == 0) PG8_BAR; }
        E(acc, cur, wr, wc, fr, fq);
        if (!has_next) break;
#pragma unroll
        for (int a = 0; a < 2; ++a)
#pragma unroll
            for (int b = 0; b < 2; ++b)
#pragma unroll
                for (int m = 0; m < 4; ++m)
#pragma unroll
                    for (int n = 0; n < 2; ++n) acc[a][b][m][n] = (f32x4){0.f, 0.f, 0.f, 0.f};
        cur = nxt; cA = nA; cB = nB; cB2 = nB2; ++ui;
        if constexpr (ALIGN_EPI) { if (wr == 1) PG8_BAR; }
    }
    PG8_WAIT_V(0);
    if constexpr (!ALIGN_EPI) { if (wr == 0) PG8_BAR; }
    PG8_BAR;
#undef PG8_SA
#undef PG8_SB
#undef PG8_STAGE
#undef PG8_LDA
#undef PG8_LDB
#undef PG8_MMA
#undef PG8_WAIT_V
#undef PG8_WAIT_L
#undef PG8_BAR
#undef PG8_SCHED
}
__device__ __forceinline__ void tile_map(int L, int nM, int nN, int& pm, int& pn) {
    const int nwg = nM * nN; int wgid = L;
    { const int q = nwg / 8, r = nwg % 8, xcd = wgid % 8, off = wgid / 8; wgid = (xcd < r ? xcd * (q + 1) : r * (q + 1) + (xcd - r) * q) + off; }
    const int nig = 8 * nN, gid = wgid / nig, fm = gid * 8, gsz = (nM - fm) < 8 ? (nM - fm) : 8;
    pm = fm + ((wgid % nig) % gsz); pn = (wgid % nig) / gsz;
}
}
using pg8::Unit;

#define XB_TMO      128
#define XB_XCNT(j)  (256  + 64 * (j))
#define XB_XSUB(j)  (1280 + 64 * (j))
#define XB_XGEN(j)  (2304 + 64 * (j))
#define XB_TOP      3328
#define XB_TOPGEN   3392
#define XCD_BAR_WORDS 3456
#define XB_SPIN_CAP (1u << 18)
__device__ __forceinline__ unsigned xb_ld(unsigned* p)              { return __hip_atomic_load(p, __ATOMIC_RELAXED, __HIP_MEMORY_SCOPE_AGENT); }
__device__ __forceinline__ unsigned xb_add(unsigned* p, unsigned v) { return __hip_atomic_fetch_add(p, v, __ATOMIC_RELAXED, __HIP_MEMORY_SCOPE_AGENT); }
__device__ __forceinline__ unsigned xb_xcc_id() { return (unsigned)__builtin_amdgcn_s_getreg((3 << 11) | 20) & 0xFu; }
#define XB_SPIN(cond, bar) do { unsigned _sp = 0; while (cond) { __builtin_amdgcn_s_sleep(1); \
    if ((++_sp & 255u) == 0u) { if (xb_ld(&(bar)[XB_TMO])) break; if (_sp > XB_SPIN_CAP) { atomicAdd(&(bar)[XB_TMO], 1u); break; } } } } while (0)
struct XcdBarrier { unsigned* bar; unsigned x; volatile LAS unsigned* st; };
__device__ __forceinline__ XcdBarrier xcd_barrier_post(unsigned* bar, volatile LAS unsigned* st) {
    XcdBarrier b; b.bar = bar; b.x = xb_xcc_id(); b.st = st;
    if (threadIdx.x == 0) (void)xb_add(&bar[XB_XCNT(b.x)], 1u);
    return b;
}
__device__ __forceinline__ void xcd_barrier_complete(unsigned* bar, unsigned x, unsigned& nloc, unsigned& nx) {
    const unsigned G = gridDim.x * gridDim.y * gridDim.z;
    unsigned sum, cnt, mine, sp = 0u;
    for (;;) {
        sum = 0u; cnt = 0u; mine = 0u;
#pragma unroll
        for (unsigned j = 0; j < 16; ++j) { const unsigned c = xb_ld(&bar[XB_XCNT(j)]); sum += c; cnt += (c > 0u) ? 1u : 0u; mine = (j == x) ? c : mine; }
        if (sum == G) break;
        __builtin_amdgcn_s_sleep(1);
        if ((++sp & 255u) == 0u) { if (xb_ld(&bar[XB_TMO])) break; if (sp > XB_SPIN_CAP) { atomicAdd(&bar[XB_TMO], 1u); break; } }
    }
    nloc = mine > 0u ? mine : 1u; nx = cnt > 0u ? cnt : 1u;
}
__device__ __forceinline__ void xcd_barrier(const XcdBarrier& b) {
    asm volatile("s_waitcnt vmcnt(0)" ::: "memory");
    __syncthreads();
    if (threadIdx.x == 0) {
        unsigned* bar = b.bar;
        __builtin_amdgcn_s_waitcnt(0);
        unsigned nloc = b.st[0], nx = b.st[1];
        if (nloc == 0u) { xcd_barrier_complete(bar, b.x, nloc, nx); b.st[0] = nloc; b.st[1] = nx; }
        const unsigned old = xb_add(&bar[XB_XSUB(b.x)], 1u);
        const unsigned gen = old / nloc;
        if (old + 1u == (gen + 1u) * nloc) {
            __builtin_amdgcn_fence(__ATOMIC_RELEASE, "agent");
            asm volatile("s_waitcnt vmcnt(0)" ::: "memory");
            const unsigned og = xb_add(&bar[XB_TOP], 1u);
            const unsigned tg = og / nx;
            if (og + 1u == (tg + 1u) * nx) xb_add(&bar[XB_TOPGEN], 1u);
            else XB_SPIN(xb_ld(&bar[XB_TOPGEN]) == tg, bar);
            __builtin_amdgcn_fence(__ATOMIC_ACQUIRE, "agent");
            xb_add(&bar[XB_XGEN(b.x)], 1u);
            asm volatile("s_waitcnt vmcnt(0)" ::: "memory");
        } else {
            XB_SPIN(xb_ld(&bar[XB_XGEN(b.x)]) == gen, bar);
            __builtin_amdgcn_fence(__ATOMIC_ACQUIRE, "agent");
            asm volatile("s_waitcnt vmcnt(0)" ::: "memory");
        }
    }
    __syncthreads();
}

constexpr size_t MiB = 1u << 20;
constexpr size_t WS_CTL = 0, CTL_ZERO_BYTES = 65536;
constexpr int CW_BAR = 1024;
constexpr int CW_CNT = 8192;
constexpr int CW_CUR = 8192 + 64;
constexpr size_t WS_SSQ_CQ  = 1 * MiB;
constexpr size_t WS_SSQ_CKV = 2 * MiB;
constexpr size_t WS_SSQ_MK  = 2 * MiB + 512 * 1024;
constexpr size_t WS_SSQ_ATT = 3 * MiB;
constexpr size_t WS_SSQ_H1  = 5 * MiB;
constexpr size_t WS_SSQ_MQ  = 7 * MiB;
constexpr size_t WS_COS     = 9 * MiB;
constexpr size_t WS_SIN     = 11 * MiB;
constexpr size_t WS_BKT     = 13 * MiB;
constexpr size_t WS_RR      = 13 * MiB + 128 * 1024;
constexpr size_t WS_W0      = 13 * MiB + 256 * 1024;
constexpr size_t WS_W1      = 13 * MiB + 384 * 1024;
constexpr size_t WS_TOK     = 13 * MiB + 512 * 1024;
constexpr size_t WS_PR      = 13 * MiB + 704 * 1024;
constexpr size_t WS_PW0     = 14 * MiB;
constexpr size_t WS_PW1     = 14 * MiB + 192 * 1024;
constexpr size_t WS_KRF     = 14 * MiB + 512 * 1024;
constexpr size_t WS_WIN  = 17 * MiB;
constexpr size_t WS_WSV  = WS_WIN  + 3584 * 1024;
constexpr size_t WS_WMK  = WS_WSV  + 1 * MiB;
constexpr size_t WS_WMV  = WS_WMK  + 2 * MiB;
constexpr size_t WS_WUQ  = WS_WMV  + 2 * MiB;
constexpr size_t WS_WUKN = WS_WUQ  + 1 * MiB;
constexpr size_t WS_WUKV = WS_WUKN + 256 * 1024;
constexpr size_t WS_WO   = WS_WUKV + 256 * 1024;
constexpr size_t WS_WMQ  = WS_WO   + 2 * MiB;
constexpr size_t WS_WMO  = WS_WMQ  + 2 * MiB;
constexpr size_t WS_WGU  = WS_WMO  + 2 * MiB;
constexpr size_t WS_WD2  = WS_WGU  + 32 * MiB;
constexpr size_t WS_WEND = WS_WD2  + 48 * MiB;
constexpr size_t WS_MN   = 114 * MiB;
constexpr size_t WS_MKR  = 118 * MiB;
constexpr size_t WS_MVT  = 122 * MiB;
constexpr size_t WS_KP   = 126 * MiB;
constexpr size_t WS_R1   = 130 * MiB;
constexpr size_t WS_R2   = 194 * MiB;
constexpr size_t WS_R3   = 290 * MiB;
constexpr size_t WS_R4   = 330 * MiB;
constexpr size_t WS_END  = 458 * MiB;
static_assert(WS_WEND <= WS_MN, "ws map");
constexpr size_t WS_HN = WS_R1, WS_ATT = WS_R1, WS_MQ = WS_R1, WS_H2H = WS_R1;
constexpr size_t WS_SBQ = WS_R2, WS_SBK = WS_R2 + 32 * MiB, WS_SBVT = WS_R2 + 64 * MiB, WS_H1H = WS_R2, WS_TS = WS_R2;
constexpr size_t WS_CQ = WS_R3, WS_CKV = WS_R3 + 24 * MiB;
constexpr size_t WS_MLAQ = WS_R4, WS_MLAK = WS_R4 + 48 * MiB, WS_MLAVT = WS_R4 + 96 * MiB, WS_HE = WS_R4, WS_MO = WS_R4;

constexpr int LDS_BYTES = 147456;
constexpr int LDS_MISC = 143360;
constexpr int NWAVES = 8, NTHR = 512;

struct Params { const float* in[31]; float* out; unsigned char* ws; int ph_lo, ph_hi; };

struct Frame {
    LAS unsigned char* lds; volatile LAS unsigned* MISC;
    int vcu, G, bx;
    unsigned char* ws; float* out; unsigned* ctl;
};
#define PHASE_IDS() const int tid = fresh_tid(), lane = tid & 63, wave = __builtin_amdgcn_readfirstlane(tid >> 6); (void)lane; (void)wave

__device__ __forceinline__ void conv_item(const float* src, int ld, int srccol0, int mode, int ksrc0, const float* kscale, f16* dst, int K, int row0, int k0, LAS float* scr, int lane) {
    if (mode != 2) {
        const float* base = src + (size_t)ksrc0 * ld + srccol0;
        const unsigned voff = (unsigned)((lane >> 5) * ld + (lane & 31)) * 4u;
        float v[32];
#pragma unroll
        for (int i = 0; i < 32; ++i) v[i] = *(const float*)((const char*)(base + (size_t)2 * i * ld) + voff);
#pragma unroll
        for (int i = 0; i < 32; ++i) scr[(2 * i + (lane >> 5)) * 33 + (lane & 31)] = v[i];
    }
    asm volatile("s_waitcnt lgkmcnt(0)" ::: "memory");
    const int c = lane & 7;
    f32x4 ks0 = (f32x4){1.f, 1.f, 1.f, 1.f}, ks1 = ks0;
    if (kscale) { ks0 = *(const f32x4*)(kscale + ksrc0 + 8 * c); ks1 = *(const f32x4*)(kscale + ksrc0 + 8 * c + 4); }
#pragma unroll
    for (int j = 0; j < 4; ++j) { const int q = (lane >> 3) + 8 * j; const int lc = (mode == 1) ? L32(q) : q; const LAS float* s = scr + (8 * c) * 33 + lc;
        u32x4 o;
        if (mode == 2) { o = (u32x4){0u, 0u, 0u, 0u}; }
        else { o.x = pk2(s[0 * 33] * ks0[0], s[1 * 33] * ks0[1]); o.y = pk2(s[2 * 33] * ks0[2], s[3 * 33] * ks0[3]); o.z = pk2(s[4 * 33] * ks1[0], s[5 * 33] * ks1[1]); o.w = pk2(s[6 * 33] * ks1[2], s[7 * 33] * ks1[3]); }
        *(u32x4*)(dst + (size_t)(row0 + q) * K + k0 + 8 * c) = o; }
    asm volatile("s_waitcnt lgkmcnt(0)" ::: "memory");
}
__device__ __forceinline__ void rms_rows2_to_f16(const float* x, const float* g, f16* o, int m0, int m1, bool has1, int lane) {
    const f32x4* x0 = (const f32x4*)(x + (size_t)m0 * D) + lane; const f32x4* x1 = (const f32x4*)(x + (size_t)m1 * D) + lane; const f32x4* gr = (const f32x4*)g + lane;
    f32x4 v[4], w[4]; float s0 = 0.f, s1 = 0.f;
#pragma unroll
    for (int j = 0; j < 4; ++j) v[j] = x0[64 * j];
    if (has1) {
#pragma unroll
        for (int j = 0; j < 4; ++j) w[j] = x1[64 * j];
    } else {
#pragma unroll
        for (int j = 0; j < 4; ++j) w[j] = (f32x4){0.f, 0.f, 0.f, 0.f};
    }
#pragma unroll
    for (int j = 0; j < 4; ++j) { s0 += dot4(v[j]); s1 += dot4(w[j]); }
#pragma unroll
    for (int o_ = 1; o_ < 64; o_ <<= 1) { s0 += __shfl_xor(s0, o_); s1 += __shfl_xor(s1, o_); }
    const float r0 = __builtin_amdgcn_rsqf(s0 * (1.f / 1024.f) + EPS), r1 = __builtin_amdgcn_rsqf(s1 * (1.f / 1024.f) + EPS);
    u32x2* o0 = (u32x2*)(o + (size_t)m0 * D) + lane; u32x2* o1 = (u32x2*)(o + (size_t)m1 * D) + lane;
#pragma unroll
    for (int j = 0; j < 4; ++j) { const f32x4 gg = gr[64 * j]; o0[64 * j] = pk4(v[j] * r0 * gg); if (has1) o1[64 * j] = pk4(w[j] * r1 * gg); }
}
__device__ __forceinline__ void moe_pair(int pi, int& lo, int& hi) { lo = pi < 3 ? 0 : (pi < 5 ? 1 : 2); hi = pi < 3 ? pi + 1 : (pi < 5 ? pi - 1 : 3); }

__device__ __forceinline__ void p0_prologue(Frame& F, const Params& P) {
    PHASE_IDS();
    LAS float* scr = (LAS float*)(F.lds + wave * 16384);
    const int gw = F.vcu * NWAVES + wave, NGW = F.G * NWAVES;
    unsigned char* ws = F.ws;
    const float* w_in = P.in[4]; const float* w_uq = P.in[6]; const float* w_ukv = P.in[8]; const float* w_o = P.in[15];
    const float* w_mq = P.in[18]; const float* w_mkv = P.in[19]; const float* w_mo = P.in[22];
    const float* w_gate = P.in[28]; const float* w_up = P.in[29]; const float* w_down = P.in[30];
    for (int it = gw; it < 56 * 16; it += NGW) { const int rb = it >> 4, kb = it & 15, tile = rb >> 3, g = rb & 7, bj = g >> 2, wc = g & 3; int col, mode = 1;
        if (tile < 2) col = (4 * tile + wc) * 64 + 32 * bj;
        else if (tile < 4) col = 512 + (4 * (tile - 2) + wc) * 64 + 32 * bj;
        else if (tile == 4) col = 1536 + 64 * wc + 32 * bj;
        else if (tile == 5) { if (bj == 0) col = 1536 + 256 + 32 * wc; else if (wc == 0) { col = 2176; mode = 0; } else { col = 0; mode = 2; } }
        else col = 1920 + 64 * wc + 32 * bj;
        conv_item(w_in, 2208, col, mode, kb * 64, nullptr, (f16*)(ws + WS_WIN), 1024, rb * 32, kb * 64, scr, lane); }
    for (int it = gw; it < 16 * 16; it += NGW) { const int rb = it >> 4, kb = it & 15; conv_item(w_in, 2208, 1024 + 32 * rb, 0, kb * 64, nullptr, (f16*)(ws + WS_WSV), 1024, rb * 32, kb * 64, scr, lane); }
    for (int it = gw; it < 32 * 16; it += NGW) { const int rb = it >> 4, kb = it & 15, tile = rb >> 3, g = rb & 7, bj = g >> 2, wc = g & 3;
        conv_item(w_mkv, 2048, 256 * tile + 64 * wc + 32 * bj, 1, kb * 64, nullptr, (f16*)(ws + WS_WMK), 1024, rb * 32, kb * 64, scr, lane); }
    for (int it = gw; it < 32 * 16; it += NGW) { const int rb = it >> 4, kb = it & 15; conv_item(w_mkv, 2048, 1024 + 32 * rb, 0, kb * 64, nullptr, (f16*)(ws + WS_WMV), 1024, rb * 32, kb * 64, scr, lane); }
    for (int it = gw; it < 24 * 6; it += NGW) { const int rb = it / 6, kb = it % 6, tile = rb >> 3, g = rb & 7, bj = g >> 2, wc = g & 3; int col, mode = 1;
        if (tile < 2) col = (4 * tile + wc) * 96 + 32 * bj; else { col = (4 * bj + wc) * 96 + 64; mode = 0; }
        conv_item(w_uq, 768, col, mode, kb * 64, P.in[5], (f16*)(ws + WS_WUQ), 384, rb * 32, kb * 64, scr, lane); }
    for (int it = gw; it < 16 * 4; it += NGW) { const int rb = it >> 2, kb = it & 3, tile = rb >> 3, g = rb & 7, bj = g >> 2, wc = g & 3;
        conv_item(w_ukv, 1024, (4 * tile + wc) * 128 + 32 * bj, 1, kb * 64, P.in[7], (f16*)(ws + WS_WUKN), 256, rb * 32, kb * 64, scr, lane); }
    for (int it = gw; it < 16 * 4; it += NGW) { const int rb = it >> 2, kb = it & 3;
        conv_item(w_ukv, 1024, (rb >> 1) * 128 + 64 + 32 * (rb & 1), 0, kb * 64, P.in[7], (f16*)(ws + WS_WUKV), 256, rb * 32, kb * 64, scr, lane); }
    for (int it = gw; it < 32 * 16; it += NGW) { const int rb = it >> 4, kb = it & 15; conv_item(w_o, 1024, 32 * rb, 1, kb * 64, nullptr, (f16*)(ws + WS_WO), 1024, rb * 32, kb * 64, scr, lane); }
    for (int it = gw; it < 32 * 16; it += NGW) { const int rb = it >> 4, kb = it & 15; conv_item(w_mq, 1024, 32 * rb, 1, kb * 64, P.in[16], (f16*)(ws + WS_WMQ), 1024, rb * 32, kb * 64, scr, lane); }
    for (int it = gw; it < 32 * 16; it += NGW) { const int rb = it >> 4, kb = it & 15; conv_item(w_mo, 1024, 32 * rb, 1, kb * 64, nullptr, (f16*)(ws + WS_WMO), 1024, rb * 32, kb * 64, scr, lane); }
    for (int it = gw; it < 64 * 8 * 16; it += NGW) { const int kb = it & 15, rb = (it >> 4) & 7, tile = it >> 7, e = tile >> 2, ffb = tile & 3, bj = rb >> 2, wc = rb & 3;
        conv_item((bj ? w_up : w_gate) + (size_t)e * 1024 * 512, 512, ffb * 128 + 32 * wc, 1, kb * 64, P.in[23], (f16*)(ws + WS_WGU) + (size_t)tile * 256 * 1024, 1024, rb * 32, kb * 64, scr, lane); }
    for (int it = gw; it < 16 * 32 * 8; it += NGW) { const int kb = it & 7, rb = (it >> 3) & 31, e = it >> 8;
        conv_item(w_down + (size_t)e * 512 * 1024, 1024, 32 * rb, 1, kb * 64, nullptr, (f16*)(ws + WS_WD2) + (size_t)e * 1024 * 512, 512, rb * 32, kb * 64, scr, lane); }
    for (int m = gw; m < T; m += 2 * NGW) rms_rows2_to_f16(P.in[0], P.in[3], (f16*)(ws + WS_HN), m, m + NGW, m + NGW < T, lane);
    for (int m = gw; m < 2048; m += 2 * NGW) rms_rows2_to_f16(P.in[1], P.in[17], (f16*)(ws + WS_MN), m, m + NGW, m + NGW < 2048, lane);
    {
        const int gt = F.vcu * NTHR + tid, NGT = F.G * NTHR; const int* pos = (const int*)P.in[2];
        float* COS = (float*)(ws + WS_COS); float* SIN = (float*)(ws + WS_SIN);
        for (int e = gt; e < T * 16; e += NGT) { const int tok = e >> 4, i = e & 15;
            const float invf = i == 0 ? 1.000000000e+00f : i == 1 ? 5.623413324e-01f : i == 2 ? 3.162277639e-01f : i == 3 ? 1.778279394e-01f : i == 4 ? 1.000000015e-01f : i == 5 ? 5.623413250e-02f : i == 6 ? 3.162277490e-02f : i == 7 ? 1.778279431e-02f :
                               i == 8 ? 9.999999776e-03f : i == 9 ? 5.623413250e-03f : i == 10 ? 3.162277630e-03f : i == 11 ? 1.778279431e-03f : i == 12 ? 1.000000047e-03f : i == 13 ? 5.623413017e-04f : i == 14 ? 3.162277571e-04f : 1.778279402e-04f;
            const float ang = (float)pos[tok] * invf;
            const double x = (double)ang; const double n = __builtin_rint(x * 0.15915494309189535); const float rev = (float)(x * 0.15915494309189535 - n);
            COS[e] = __builtin_amdgcn_cosf(rev); SIN[e] = __builtin_amdgcn_sinf(rev); }
        int* TOK = (int*)(ws + WS_TOK);
        for (int e = gt; e < NPOS; e += NGT) TOK[e] = -1;
    }
}

typedef f32x4 Acc[2][2][4][2];
template <bool SSQ>
__device__ __forceinline__ void store_w64(const Acc& acc, int rowb, f16* dst, int ld, int colb, float scale, float* ssq, int ldq, int slot, int fq) {
#pragma unroll
    for (int ai = 0; ai < 2; ++ai)
#pragma unroll
        for (int m = 0; m < 4; ++m) { const int row = rowb + ai * 128 + m * 16; float s = 0.f;
#pragma unroll
            for (int bj = 0; bj < 2; ++bj) { const f32x4 v0 = acc[ai][bj][m][0] * scale, v1 = acc[ai][bj][m][1] * scale;
                if (SSQ) s += dot4(v0) + dot4(v1);
                *(u32x4*)(dst + (size_t)row * ld + colb + bj * 32 + 8 * fq) = pk8(v0, v1); }
            if (SSQ) { s += __shfl_xor(s, 16); s += __shfl_xor(s, 32); if (fq == 0) ssq[(size_t)row * ldq + slot] = s; } }
}

struct EpiP1N {
    unsigned char* ws; const float* krg;
    __device__ __forceinline__ void operator()(const Acc& acc, const Unit& u, int wr, int wc, int fr_, int fq_) const {
        int fr = fr_, fq = fq_; asm volatile("" : "+v"(fr), "+v"(fq));
        const int rowb = u.pm * 256 + wr * 64 + fr;
        if (u.aux == 0) { store_w64<false>(acc, rowb, (f16*)(ws + WS_SBQ), 512, (4 * u.pn + wc) * 64, 0.125f * 1.4426950408889634f, nullptr, 0, 0, fq); }
        else if (u.aux == 1) { store_w64<false>(acc, rowb, (f16*)(ws + WS_SBK), 512, (4 * u.pn + wc) * 64, 1.f, nullptr, 0, 0, fq); }
        else if (u.aux == 2) { store_w64<true>(acc, rowb, (f16*)(ws + WS_CQ), 384, 64 * wc, 1.f, (float*)(ws + WS_SSQ_CQ), 8, wc, fq); }
        else if (u.aux == 4) { store_w64<true>(acc, rowb, (f16*)(ws + WS_CKV), 256, 64 * wc, 1.f, (float*)(ws + WS_SSQ_CKV), 4, wc, fq); }
        else if (u.aux == 5) { store_w64<true>(acc, rowb, (f16*)(ws + WS_MKR), 1024, 256 * u.pn + 64 * wc, 1.f, (float*)(ws + WS_SSQ_MK), 16, 4 * u.pn + wc, fq); }
        else {
            f16* CQ = (f16*)(ws + WS_CQ); float* SS = (float*)(ws + WS_SSQ_CQ);
#pragma unroll
            for (int ai = 0; ai < 2; ++ai)
#pragma unroll
                for (int m = 0; m < 4; ++m) { const int row = rowb + ai * 128 + m * 16;
                    const f32x4 v0 = acc[ai][0][m][0], v1 = acc[ai][0][m][1]; float s = dot4(v0) + dot4(v1);
                    *(u32x4*)(CQ + (size_t)row * 384 + 256 + 32 * wc + 8 * fq) = pk8(v0, v1);
                    s += __shfl_xor(s, 16); s += __shfl_xor(s, 32); if (fq == 0) SS[(size_t)row * 8 + 4 + wc] = s; }
            if (wc == 0) {
                const float* COS = (const float*)(ws + WS_COS); const float* SIN = (const float*)(ws + WS_SIN); f16* KRF = (f16*)(ws + WS_KRF);
                const f32x4 g1 = *(const f32x4*)(krg + 4 * fq), g2 = *(const f32x4*)(krg + 16 + 4 * fq);
#pragma unroll
                for (int ai = 0; ai < 2; ++ai)
#pragma unroll
                    for (int m = 0; m < 4; ++m) { const int row = rowb + ai * 128 + m * 16;
                        f32x4 x1 = acc[ai][1][m][0], x2 = acc[ai][1][m][1]; float s = dot4(x1) + dot4(x2);
                        s += __shfl_xor(s, 16); s += __shfl_xor(s, 32);
                        const float rn = __builtin_amdgcn_rsqf(s * (1.f / 32.f) + EPS);
                        x1 = x1 * rn * g1; x2 = x2 * rn * g2;
                        const f32x4 c = *(const f32x4*)(COS + (size_t)row * 16 + 4 * fq), sn = *(const f32x4*)(SIN + (size_t)row * 16 + 4 * fq);
                        const f32x4 o1 = x1 * c - x2 * sn, o2 = x2 * c + x1 * sn;
                        *(u32x2*)(KRF + (size_t)row * 32 + 4 * fq) = pk4(o1); *(u32x2*)(KRF + (size_t)row * 32 + 16 + 4 * fq) = pk4(o2); }
            }
        }
    }
};
struct SchedP1N {
    unsigned char* ws; int G, c;
    __device__ __forceinline__ bool next(int i, Unit& u) const {
        int L = i * G + c;
        if (L < 896) { int pm, pn; pg8::tile_map(L, 128, 7, pm, pn);
            u.A = (const char*)(ws + WS_HN) + (size_t)pm * 256 * 1024 * 2; u.B = (const char*)(ws + WS_WIN) + (size_t)pn * 256 * 1024 * 2; u.pm = pm;
            u.aux = pn < 2 ? 0 : (pn < 4 ? 1 : pn - 2); u.pn = pn < 2 ? pn : (pn < 4 ? pn - 2 : 0); return true; }
        L -= 896; if (L >= 32) return false;
        int pm, pn; pg8::tile_map(L, 8, 4, pm, pn);
        u.A = (const char*)(ws + WS_MN) + (size_t)pm * 256 * 1024 * 2; u.B = (const char*)(ws + WS_WMK) + (size_t)pn * 256 * 1024 * 2; u.pm = pm; u.pn = pn; u.aux = 5; return true;
    }
};
struct EpiP1S {
    unsigned char* ws;
    __device__ __forceinline__ void operator()(const Acc& acc, const Unit& u, int wr, int wc, int fr_, int fq_) const {
        int fr = fr_, fq = fq_; asm volatile("" : "+v"(fr), "+v"(fq));
        const int rowb = u.pm * 256 + wr * 64 + fr;
        if (u.aux == 0) { f16* dst = (f16*)(ws + WS_SBVT);
#pragma unroll
            for (int ai = 0; ai < 2; ++ai)
#pragma unroll
                for (int m = 0; m < 4; ++m) { const size_t ro = (size_t)(rowb + ai * 128 + m * 16) * T + u.pn * 256 + 32 * wc + 8 * (fq & 1) + 4 * (fq >> 1);
#pragma unroll
                    for (int bj = 0; bj < 2; ++bj)
#pragma unroll
                        for (int n = 0; n < 2; ++n) *(u32x2*)(dst + ro + 128 * bj + 16 * n) = pk4(acc[ai][bj][m][n]); }
        } else { f16* dst = (f16*)(ws + WS_MVT);
#pragma unroll
            for (int ai = 0; ai < 2; ++ai)
#pragma unroll
                for (int m = 0; m < 4; ++m) { const size_t ro = (size_t)(rowb + ai * 128 + m * 16) * 2048 + u.pn * 256 + 32 * wc + 8 * fq;
#pragma unroll
                    for (int bj = 0; bj < 2; ++bj)
#pragma unroll
                        for (int n = 0; n < 2; ++n) *(u32x2*)(dst + ro + 128 * bj + 4 * n) = pk4(acc[ai][bj][m][n]); }
        }
    }
};
struct SchedP1S {
    unsigned char* ws; int G, c;
    __device__ __forceinline__ bool next(int i, Unit& u) const {
        int L = i * G + c;
        if (L < 256) { int pm, pn; pg8::tile_map(L, 2, 128, pm, pn);
            u.A = (const char*)(ws + WS_WSV) + (size_t)pm * 256 * 1024 * 2; u.B = (const char*)(ws + WS_HN) + (size_t)pn * 256 * 1024 * 2; u.pm = pm; u.pn = pn; u.aux = 0; return true; }
        L -= 256; if (L >= 32) return false;
        int pm, pn; pg8::tile_map(L, 4, 8, pm, pn);
        u.A = (const char*)(ws + WS_WMV) + (size_t)pm * 256 * 1024 * 2; u.B = (const char*)(ws + WS_MN) + (size_t)pn * 256 * 1024 * 2; u.pm = pm; u.pn = pn; u.aux = 1; return true;
    }
};

constexpr float MLA_QSCALE = 0.10206207261596575f * 1.4426950408889634f;
__device__ __forceinline__ float rq_of(const float* SS8, int row) { const f32x4 a = *(const f32x4*)(SS8 + (size_t)row * 8), b = *(const f32x4*)(SS8 + (size_t)row * 8 + 4);
    return __builtin_amdgcn_rsqf((((a[0] + a[1]) + (a[2] + a[3])) + ((b[0] + b[1]) + (b[2] + b[3]))) * (1.f / 384.f) + EPS); }
__device__ __forceinline__ float rkv_of(const float* SS4, int row) { const f32x4 a = *(const f32x4*)(SS4 + (size_t)row * 4);
    return __builtin_amdgcn_rsqf(((a[0] + a[1]) + (a[2] + a[3])) * (1.f / 256.f) + EPS); }
struct EpiP2Q {
    unsigned char* ws; const float* qng; const float* qrg;
    __device__ __forceinline__ void operator()(const Acc& acc, const Unit& u, int wr, int wc, int fr_, int fq_) const {
        int fr = fr_, fq = fq_; asm volatile("" : "+v"(fr), "+v"(fq));
        const int rowb = u.pm * 256 + wr * 64 + fr; const float* SS = (const float*)(ws + WS_SSQ_CQ); f16* Q = (f16*)(ws + WS_MLAQ);
        if (u.pn < 2) { const int h = 4 * u.pn + wc;
            f32x4 g[2][2];
#pragma unroll
            for (int bj = 0; bj < 2; ++bj)
#pragma unroll
                for (int n = 0; n < 2; ++n) g[bj][n] = *(const f32x4*)(qng + 32 * bj + 8 * fq + 4 * n) * MLA_QSCALE;
#pragma unroll
            for (int ai = 0; ai < 2; ++ai)
#pragma unroll
                for (int m = 0; m < 4; ++m) { const int row = rowb + ai * 128 + m * 16; const float rq = rq_of(SS, row);
                    f32x4 v[2][2]; float s = 0.f;
#pragma unroll
                    for (int bj = 0; bj < 2; ++bj)
#pragma unroll
                        for (int n = 0; n < 2; ++n) { v[bj][n] = acc[ai][bj][m][n] * rq; s += dot4(v[bj][n]); }
                    s += __shfl_xor(s, 16); s += __shfl_xor(s, 32);
                    const float rn = __builtin_amdgcn_rsqf(s * (1.f / 64.f) + EPS);
#pragma unroll
                    for (int bj = 0; bj < 2; ++bj) *(u32x4*)(Q + (size_t)row * 768 + h * 96 + 32 * bj + 8 * fq) = pk8(v[bj][0] * rn * g[bj][0], v[bj][1] * rn * g[bj][1]); }
        } else {
            const float* COS = (const float*)(ws + WS_COS); const float* SIN = (const float*)(ws + WS_SIN);
            const f32x4 g1 = *(const f32x4*)(qrg + 4 * fq) * MLA_QSCALE, g2 = *(const f32x4*)(qrg + 16 + 4 * fq) * MLA_QSCALE;
#pragma unroll
            for (int ai = 0; ai < 2; ++ai)
#pragma unroll
                for (int m = 0; m < 4; ++m) { const int row = rowb + ai * 128 + m * 16; const float rq = rq_of(SS, row);
                    const f32x4 c = *(const f32x4*)(COS + (size_t)row * 16 + 4 * fq), sn = *(const f32x4*)(SIN + (size_t)row * 16 + 4 * fq);
#pragma unroll
                    for (int bj = 0; bj < 2; ++bj) { const int h = 4 * bj + wc;
                        f32x4 x1 = acc[ai][bj][m][0] * rq, x2 = acc[ai][bj][m][1] * rq; float s = dot4(x1) + dot4(x2);
                        s += __shfl_xor(s, 16); s += __shfl_xor(s, 32);
                        const float rn = __builtin_amdgcn_rsqf(s * (1.f / 32.f) + EPS);
                        x1 = x1 * rn * g1; x2 = x2 * rn * g2;
                        const f32x4 o1 = x1 * c - x2 * sn, o2 = x2 * c + x1 * sn;
                        *(u32x2*)(Q + (size_t)row * 768 + h * 96 + 64 + 4 * fq) = pk4(o1); *(u32x2*)(Q + (size_t)row * 768 + h * 96 + 80 + 4 * fq) = pk4(o2); } }
        }
    }
};
struct EpiP2K {
    unsigned char* ws; const float* kng;
    __device__ __forceinline__ void operator()(const Acc& acc, const Unit& u, int wr, int wc, int fr_, int fq_) const {
        int fr = fr_, fq = fq_; asm volatile("" : "+v"(fr), "+v"(fq));
        const int rowb = u.pm * 256 + wr * 64 + fr; const float* SS = (const float*)(ws + WS_SSQ_CKV); f16* Kd = (f16*)(ws + WS_MLAK); const f16* KRF = (const f16*)(ws + WS_KRF);
        const int h = 4 * u.pn + wc;
        f32x4 g[2][2];
#pragma unroll
        for (int bj = 0; bj < 2; ++bj)
#pragma unroll
            for (int n = 0; n < 2; ++n) g[bj][n] = *(const f32x4*)(kng + 32 * bj + 8 * fq + 4 * n);
#pragma unroll
        for (int ai = 0; ai < 2; ++ai)
#pragma unroll
            for (int m = 0; m < 4; ++m) { const int row = rowb + ai * 128 + m * 16; const float rk = rkv_of(SS, row);
                f32x4 v[2][2]; float s = 0.f;
#pragma unroll
                for (int bj = 0; bj < 2; ++bj)
#pragma unroll
                    for (int n = 0; n < 2; ++n) { v[bj][n] = acc[ai][bj][m][n] * rk; s += dot4(v[bj][n]); }
                s += __shfl_xor(s, 16); s += __shfl_xor(s, 32);
                const float rn = __builtin_amdgcn_rsqf(s * (1.f / 64.f) + EPS);
#pragma unroll
                for (int bj = 0; bj < 2; ++bj) *(u32x4*)(Kd + (size_t)row * 768 + h * 96 + 32 * bj + 8 * fq) = pk8(v[bj][0] * rn * g[bj][0], v[bj][1] * rn * g[bj][1]);
                *(u32x4*)(Kd + (size_t)row * 768 + h * 96 + 64 + 8 * fq) = *(const u32x4*)(KRF + (size_t)row * 32 + 8 * fq); }
    }
};
struct EpiP2V {
    unsigned char* ws;
    __device__ __forceinline__ void operator()(const Acc& acc, const Unit& u, int wr, int wc, int fr_, int fq_) const {
        int fr = fr_, fq = fq_; asm volatile("" : "+v"(fr), "+v"(fq));
        const int rowb = u.pm * 256 + wr * 64 + fr; const float* SS = (const float*)(ws + WS_SSQ_CKV); f16* dst = (f16*)(ws + WS_MLAVT);
        f32x4 rk[2][2];
#pragma unroll
        for (int bj = 0; bj < 2; ++bj)
#pragma unroll
            for (int n = 0; n < 2; ++n) { const int tok = u.pn * 256 + 128 * bj + 32 * wc + 16 * n + 4 * fq;
#pragma unroll
                for (int j = 0; j < 4; ++j) rk[bj][n][j] = rkv_of(SS, tok + j); }
#pragma unroll
        for (int ai = 0; ai < 2; ++ai)
#pragma unroll
            for (int m = 0; m < 4; ++m) { const size_t ro = (size_t)(rowb + ai * 128 + m * 16) * T + u.pn * 256 + 32 * wc + 8 * (fq & 1) + 4 * (fq >> 1);
#pragma unroll
                for (int bj = 0; bj < 2; ++bj)
#pragma unroll
                    for (int n = 0; n < 2; ++n) *(u32x2*)(dst + ro + 128 * bj + 16 * n) = pk4(acc[ai][bj][m][n] * rk[bj][n]); }
    }
};
struct SchedGrid {
    const char* A; const char* B; size_t sA, sB; int nM, nN, G, c;
    __device__ __forceinline__ bool next(int i, Unit& u) const {
        const int L = i * G + c; if (L >= nM * nN) return false;
        int pm, pn; pg8::tile_map(L, nM, nN, pm, pn);
        u.A = A + (size_t)pm * sA; u.B = B + (size_t)pn * sB; u.pm = pm; u.pn = pn; u.aux = 0; return true;
    }
};
__device__ __forceinline__ void p2_kprime(Frame& F, const Params& P) {
    PHASE_IDS();
    const int gw = F.vcu * NWAVES + wave, NGW = F.G * NWAVES;
    const f16* MKR = (const f16*)(F.ws + WS_MKR); const float* SS = (const float*)(F.ws + WS_SSQ_MK); f16* KP = (f16*)(F.ws + WS_KP);
    const f32x4 gg = *(const f32x4*)(P.in[21] + 4 * lane) * *(const f32x4*)(P.in[20] + 4 * lane);
    for (int it = gw; it < 2048 * 4; it += NGW) { const int row = it >> 2, h = it & 3, b = row >> 8, key = row & 255;
        const f32x4 a = *(const f32x4*)(SS + (size_t)row * 16 + 4 * h); const float r = __builtin_amdgcn_rsqf(((a[0] + a[1]) + (a[2] + a[3])) * (1.f / 256.f) + EPS);
        const f16x4 x = *(const f16x4*)(MKR + (size_t)row * 1024 + 256 * h + 4 * lane);
        const f32x4 v = (f32x4){(float)x[0], (float)x[1], (float)x[2], (float)x[3]} * r * gg;
        *(u32x2*)(KP + ((size_t)((b * 4 + h) * 256 + key)) * 256 + 4 * lane) = pk4(v); }
}

__device__ __forceinline__ void swap32(float x, float& a, float& b) { const auto rr = __builtin_amdgcn_permlane32_swap(__float_as_uint(x), __float_as_uint(x), false, false); a = __uint_as_float(rr[0]); b = __uint_as_float(rr[1]); }
__device__ __forceinline__ float sum32(float x) { float a, b; swap32(x, a, b); return a + b; }
#define MFMA32(a, b, c) __builtin_amdgcn_mfma_f32_32x32x16_f16((a), (b), (c), 0, 0, 0)
#define MFMA16(a, b, c) __builtin_amdgcn_mfma_f32_16x16x32_f16((a), (b), (c), 0, 0, 0)
__device__ __forceinline__ f16x8 pack8(const f32x16& s, int base) {
    u32x4 w; w.x = pk2(s[base + 0], s[base + 1]); w.y = pk2(s[base + 2], s[base + 3]); w.z = pk2(s[base + 4], s[base + 5]); w.w = pk2(s[base + 6], s[base + 7]);
    return __builtin_bit_cast(f16x8, w);
}
__device__ __forceinline__ f16x8 pack8z(const f32x16& s, int base) {
    typedef __fp16 h2 __attribute__((ext_vector_type(2)));
    const h2 a = __builtin_amdgcn_cvt_pkrtz(s[base + 0], s[base + 1]), b = __builtin_amdgcn_cvt_pkrtz(s[base + 2], s[base + 3]), c = __builtin_amdgcn_cvt_pkrtz(s[base + 4], s[base + 5]), d = __builtin_amdgcn_cvt_pkrtz(s[base + 6], s[base + 7]);
    u32x4 w; w.x = __builtin_bit_cast(unsigned, a); w.y = __builtin_bit_cast(unsigned, b); w.z = __builtin_bit_cast(unsigned, c); w.w = __builtin_bit_cast(unsigned, d);
    return __builtin_bit_cast(f16x8, w);
}
__device__ __forceinline__ float store_ot(const f32x16& o0, const f32x16& o1, float inv, f16* dst, int hf) {
    float ss = 0.f;
#pragma unroll
    for (int g4 = 0; g4 < 4; ++g4) {
        const f32x4 a = (f32x4){o0[4 * g4], o0[4 * g4 + 1], o0[4 * g4 + 2], o0[4 * g4 + 3]} * inv, b = (f32x4){o1[4 * g4], o1[4 * g4 + 1], o1[4 * g4 + 2], o1[4 * g4 + 3]} * inv;
        ss += dot4(a) + dot4(b);
        *(u32x2*)(dst + 8 * g4 + 4 * hf) = pk4(a); *(u32x2*)(dst + 32 + 8 * g4 + 4 * hf) = pk4(b); }
    return ss;
}
struct SbFrag { f16x8 k[4]; f16x8 v[2][2]; };
__device__ __forceinline__ void sb_load(SbFrag& f, const f16* kp, const f16* vp) {
#pragma unroll
    for (int ks = 0; ks < 4; ++ks) f.k[ks] = *(const f16x8*)(kp + 16 * ks);
#pragma unroll
    for (int dvb = 0; dvb < 2; ++dvb)
#pragma unroll
        for (int kk = 0; kk < 2; ++kk) f.v[dvb][kk] = *(const f16x8*)(vp + (size_t)dvb * 32 * T + 16 * kk);
}
__device__ __forceinline__ bool sb_step(const SbFrag& f, const f16x8 (&qf)[4], f32x16& o0, f32x16& o1, float& C, bool diag, int t0, int t, int hf) {
    f32x16 s = {};
#pragma unroll
    for (int ks = 0; ks < 4; ++ks) s = MFMA32(f.k[ks], qf[ks], s);
    float be[16], om[16];
#pragma unroll
    for (int r = 0; r < 16; ++r) { const float z = __builtin_amdgcn_fmed3f(s[r], -115.f, 115.f);
        const float e = __builtin_amdgcn_exp2f(-z); const float bt = __builtin_amdgcn_rcpf(1.f + e);
        be[r] = bt; om[r] = e * bt; }
    if (diag) {
#pragma unroll
        for (int r = 0; r < 16; ++r) { const int key = t0 + 8 * (r >> 2) + 4 * hf + (r & 3); const bool vis = key < t; be[r] = vis ? be[r] : 0.f; om[r] = vis ? om[r] : 1.f; }
    }
    float G[4], PG[4];
#pragma unroll
    for (int q4 = 0; q4 < 4; ++q4) { G[q4] = (om[4 * q4] * om[4 * q4 + 1]) * (om[4 * q4 + 2] * om[4 * q4 + 3]); float a_, b_; swap32(G[q4], a_, b_); PG[q4] = hf == 0 ? b_ : a_; }
    float run = C;
#pragma unroll
    for (int q4 = 3; q4 >= 0; --q4) { float a = hf == 0 ? run * PG[q4] : run;
#pragma unroll
        for (int j = 3; j >= 0; --j) { const int r = 4 * q4 + j; s[r] = be[r] * a; a *= om[r]; }
        run *= G[q4] * PG[q4]; }
    C = run;
#pragma unroll
    for (int kk = 0; kk < 2; ++kk) { const f16x8 pa = pack8(s, 8 * kk); o0 = MFMA32(f.v[0][kk], pa, o0); o1 = MFMA32(f.v[1][kk], pa, o1); }
    return __all(C == 0.f);
}
__device__ __forceinline__ void sb_item(const f16* __restrict__ Qg, const f16* __restrict__ Kg, const f16* __restrict__ Vt, f16* Og, float* SSQ, int b, int h, int qblk, int lane) {
    const int r32 = lane & 31, hf = lane >> 5;
    const int t0 = qblk * 32, t = t0 + r32; const size_t row = (size_t)b * SEQ + t;
    f16x8 qf[4];
#pragma unroll
    for (int ks = 0; ks < 4; ++ks) qf[ks] = *(const f16x8*)(Qg + row * 512 + h * 64 + 16 * ks + 8 * hf);
    f32x16 o0 = {}, o1 = {};
    float C = 1.f;
    const f16* kp = Kg + ((size_t)b * SEQ + t0 + r32) * 512 + h * 64 + 8 * hf;
    const f16* vp = Vt + ((size_t)(h * 64 + r32)) * T + (size_t)b * SEQ + t0 + 8 * hf;
    SbFrag f0, f1, f2;
    sb_load(f0, kp, vp);
    { const int d = qblk >= 1 ? 1 : 0; sb_load(f1, kp - d * 32 * 512, vp - d * 32); }
    int st = qblk;
    for (;;) {
        { const int d = st >= 2 ? 2 : 0; sb_load(f2, kp - d * 32 * 512, vp - d * 32); }
        if (sb_step(f0, qf, o0, o1, C, st == qblk, t0, t, hf)) break;
        if (--st < 0) break; kp -= 32 * 512; vp -= 32;
        { const int d = st >= 2 ? 2 : 0; sb_load(f0, kp - d * 32 * 512, vp - d * 32); }
        if (sb_step(f1, qf, o0, o1, C, false, t0, t, hf)) break;
        if (--st < 0) break; kp -= 32 * 512; vp -= 32;
        { const int d = st >= 2 ? 2 : 0; sb_load(f1, kp - d * 32 * 512, vp - d * 32); }
        if (sb_step(f2, qf, o0, o1, C, false, t0, t, hf)) break;
        if (--st < 0) break; kp -= 32 * 512; vp -= 32;
    }
    const float ss = store_ot(o0, o1, 1.f, Og + row * 1024 + h * 64, hf);
    const float tot = sum32(ss);
    if (hf == 0) SSQ[row * 16 + h] = tot;
}
constexpr int MLA_KROW = 208, MLA_VROW = 144, MLA_KBYTES = 64 * MLA_KROW, MLA_VBYTES = 64 * MLA_VROW, MLA_BUF = MLA_KBYTES + MLA_VBYTES;
__device__ __forceinline__ float max3f(float a, float b, float c) { float r; asm("v_max3_f32 %0, %1, %2, %3" : "=v"(r) : "v"(a), "v"(b), "v"(c)); return r; }
__device__ __forceinline__ float max2f(float a, float b) { float r; asm("v_max_f32_e32 %0, %1, %2" : "=v"(r) : "v"(a), "v"(b)); return r; }
__device__ __forceinline__ void mla_unit(LAS unsigned char* lds, const f16* __restrict__ Qg, const f16* __restrict__ Kg, const f16* __restrict__ Vt, f16* Og, float* SSQ, int b, int h, int qb, int tid) {
    const int lane = tid & 63, wid = __builtin_amdgcn_readfirstlane(tid >> 6), r32 = lane & 31, hf = lane >> 5;
    const size_t row = (size_t)b * SEQ + qb * 256 + wid * 32 + r32;
    const int NT = 4 * qb + 4, my_last = 4 * qb + (wid >> 1);
    const char* src[3]; unsigned dsto[3]; unsigned tstep[3];
#pragma unroll
    for (int i = 0; i < 3; ++i) { int I = wid + 8 * i; if (I >= 22) I -= 2;
        if (I < 13) { const int p = 64 * I + lane, key = p / 13, c = p % 13;
            src[i] = (const char*)(Kg + ((size_t)b * SEQ + key) * 768 + h * 96 + 8 * (c < 12 ? c : 11)); tstep[i] = 64u * 768u * 2u; }
        else { const int p = 64 * (I - 13) + lane, dv = p / 9, c = p % 9;
            src[i] = (const char*)(Vt + (size_t)(h * 64 + dv) * T + (size_t)b * SEQ + 8 * (c < 8 ? c : 7)); tstep[i] = 128u; }
        dsto[i] = (unsigned)(I < 13 ? 1024 * I : MLA_KBYTES + 1024 * (I - 13)); }
#define MLA_ISSUE(tile, bufi) do { _Pragma("unroll") for (int _i = 0; _i < 3; ++_i) \
        __builtin_amdgcn_global_load_lds((const unsigned*)(src[_i] + (size_t)(tile) * tstep[_i]), (LAS unsigned*)(lds + (bufi) * MLA_BUF + __builtin_amdgcn_readfirstlane(dsto[_i])), 16, 0, 0); } while (0)
    f16x8 qf[6];
#pragma unroll
    for (int ks = 0; ks < 6; ++ks) qf[ks] = *(const f16x8*)(Qg + row * 768 + h * 96 + 16 * ks + 8 * hf);
    asm volatile("s_waitcnt vmcnt(0)" ::: "memory");
    __builtin_amdgcn_s_barrier();
    MLA_ISSUE(0, 0); MLA_ISSUE(1, 1);
    f32x16 o0 = {}, o1 = {};
    float lrun = 0.f;
    f32x16 negm;
#pragma unroll
    for (int r = 0; r < 16; ++r) negm[r] = 64.f;
    int bi = 0;
    for (int t = 0; t < NT; ++t) {
        if (t + 1 < NT) asm volatile("s_waitcnt vmcnt(3)" ::: "memory"); else asm volatile("s_waitcnt vmcnt(0)" ::: "memory");
        __builtin_amdgcn_s_barrier();
        asm volatile("" ::: "memory");
        if (t + 2 < NT) { const int nb = bi == 0 ? 2 : bi - 1; MLA_ISSUE(t + 2, nb); }
        if (t <= my_last) {
            const LAS unsigned char* kb_ = lds + bi * MLA_BUF; const LAS unsigned char* vb_ = kb_ + MLA_KBYTES;
            f32x16 s0 = negm, s1 = negm;
#pragma unroll
            for (int ks = 0; ks < 6; ++ks) {
                const f16x8 k0 = *(const LAS f16x8*)(kb_ + r32 * MLA_KROW + (16 * ks + 8 * hf) * 2);
                const f16x8 k1 = *(const LAS f16x8*)(kb_ + (32 + r32) * MLA_KROW + (16 * ks + 8 * hf) * 2);
                s0 = MFMA32(k0, qf[ks], s0); s1 = MFMA32(k1, qf[ks], s1); }
            f16x8 vf0[4], vf1[4];
#pragma unroll
            for (int kk = 0; kk < 4; ++kk) { vf0[kk] = *(const LAS f16x8*)(vb_ + r32 * MLA_VROW + (16 * kk + 8 * hf) * 2); vf1[kk] = *(const LAS f16x8*)(vb_ + (32 + r32) * MLA_VROW + (16 * kk + 8 * hf) * 2); }
            float ta = max3f(s0[0], s1[0], s0[1]), tb = max3f(s1[1], s0[2], s1[2]);
#pragma unroll
            for (int r = 3; r < 15; r += 2) { ta = max3f(ta, s0[r], s1[r]); tb = max3f(tb, s0[r + 1], s1[r + 1]); }
            float tm = max3f(ta, tb, max2f(s0[15], s1[15]));
            { float a_, b_; swap32(tm, a_, b_); tm = max2f(a_, b_); }
            if (__any(tm > 0.f)) {
                const float delta = max2f(tm, 0.f), alpha = __builtin_amdgcn_exp2f(-delta);
                lrun *= alpha; o0 = o0 * alpha; o1 = o1 * alpha;
#pragma unroll
                for (int r = 0; r < 16; ++r) { s0[r] -= delta; s1[r] -= delta; negm[r] -= delta; }
            }
            float ps = 0.f, ps2 = 0.f;
#pragma unroll
            for (int r = 0; r < 16; ++r) { s0[r] = __builtin_amdgcn_exp2f(s0[r]); s1[r] = __builtin_amdgcn_exp2f(s1[r]); ps += s0[r]; ps2 += s1[r]; }
            lrun += ps + ps2;
#pragma unroll
            for (int kk = 0; kk < 4; ++kk) { const f16x8 pa = (kk < 2) ? pack8z(s0, 8 * (kk & 1)) : pack8z(s1, 8 * (kk & 1));
                o0 = MFMA32(vf0[kk], pa, o0); o1 = MFMA32(vf1[kk], pa, o1); }
        }
        bi = bi == 2 ? 0 : bi + 1;
    }
#undef MLA_ISSUE
    const float ltot = sum32(lrun);
    const float ss = store_ot(o0, o1, 1.f / ltot, Og + row * 1024 + 512 + h * 64, hf);
    const float tot = sum32(ss);
    if (hf == 0) SSQ[row * 16 + 8 + h] = tot;
}
template <bool DO_SB = true, bool DO_MLA = true>
__device__ __forceinline__ void p3_attention(Frame& F) {
    PHASE_IDS();
    unsigned char* ws = F.ws;
    f16* ATT = (f16*)(ws + WS_ATT); float* SSQ = (float*)(ws + WS_SSQ_ATT);
    if (DO_SB) {
        const f16* Q = (const f16*)(ws + WS_SBQ); const f16* K = (const f16*)(ws + WS_SBK); const f16* Vt = (const f16*)(ws + WS_SBVT);
        const int gw = F.vcu * NWAVES + wave, NGW = F.G * NWAVES;
        for (int it = gw; it < NB * 8 * 128; it += NGW) { const int qblk = it & 127, h = (it >> 7) & 7, b = it >> 10; sb_item(Q, K, Vt, ATT, SSQ, b, h, qblk, lane); }
    }
    if (DO_MLA) {
        const f16* Q = (const f16*)(ws + WS_MLAQ); const f16* K = (const f16*)(ws + WS_MLAK); const f16* Vt = (const f16*)(ws + WS_MLAVT);
        for (int pr = F.vcu; pr < 64 * 8; pr += F.G) { const int bh = pr >> 3, qa = pr & 7, b = bh >> 3, h = bh & 7;
            mla_unit(F.lds, Q, K, Vt, ATT, SSQ, b, h, 15 - qa, tid);
            mla_unit(F.lds, Q, K, Vt, ATT, SSQ, b, h, qa, tid); }
    }
}
__device__ __forceinline__ void p3b_norm(Frame& F, const Params& P) {
    PHASE_IDS();
    const int gw = F.vcu * NWAVES + wave, NGW = F.G * NWAVES;
    f16* ATT = (f16*)(F.ws + WS_ATT); const float* SSQ = (const float*)(F.ws + WS_SSQ_ATT);
    const f32x4 ga0 = *(const f32x4*)(P.in[13] + 8 * lane), ga1 = *(const f32x4*)(P.in[13] + 8 * lane + 4), gb0 = *(const f32x4*)(P.in[14] + 8 * lane), gb1 = *(const f32x4*)(P.in[14] + 8 * lane + 4);
    for (int row = gw; row < T; row += NGW) {
        const f32x4 a0 = *(const f32x4*)(SSQ + (size_t)row * 16), a1 = *(const f32x4*)(SSQ + (size_t)row * 16 + 4), b0 = *(const f32x4*)(SSQ + (size_t)row * 16 + 8), b1 = *(const f32x4*)(SSQ + (size_t)row * 16 + 12);
        const float ra = __builtin_amdgcn_rsqf((((a0[0] + a0[1]) + (a0[2] + a0[3])) + ((a1[0] + a1[1]) + (a1[2] + a1[3]))) * (1.f / 512.f) + EPS);
        const float rb = __builtin_amdgcn_rsqf((((b0[0] + b0[1]) + (b0[2] + b0[3])) + ((b1[0] + b1[1]) + (b1[2] + b1[3]))) * (1.f / 512.f) + EPS);
        f16* pa = ATT + (size_t)row * 1024 + 8 * lane; f16* pb = pa + 512;
        const f16x8 xa = *(const f16x8*)pa, xb = *(const f16x8*)pb;
        f32x4 va0, va1, vb0, vb1;
#pragma unroll
        for (int j = 0; j < 4; ++j) { va0[j] = (float)xa[j]; va1[j] = (float)xa[4 + j]; vb0[j] = (float)xb[j]; vb1[j] = (float)xb[4 + j]; }
        *(u32x4*)pa = pk8(va0 * ra * ga0, va1 * ra * ga1); *(u32x4*)pb = pk8(vb0 * rb * gb0, vb1 * rb * gb1);
    }
}

struct EpiWo {
    unsigned char* ws; const float* x;
    __device__ __forceinline__ void operator()(const Acc& acc, const Unit& u, int wr, int wc, int fr_, int fq_) const {
        int fr = fr_, fq = fq_; asm volatile("" : "+v"(fr), "+v"(fq));
        const int rowb = u.pm * 256 + wr * 64 + fr, colb = u.pn * 256 + 32 * wc + 8 * fq; f16* H = (f16*)(ws + WS_H1H); float* SS = (float*)(ws + WS_SSQ_H1);
#pragma unroll
        for (int ai = 0; ai < 2; ++ai)
#pragma unroll
            for (int m = 0; m < 4; ++m) { const size_t ro = (size_t)(rowb + ai * 128 + m * 16) * 1024 + colb; float s = 0.f;
#pragma unroll
                for (int bj = 0; bj < 2; ++bj) { const size_t o = ro + 128 * bj;
                    const f32x4 v0 = acc[ai][bj][m][0] + *(const f32x4*)(x + o), v1 = acc[ai][bj][m][1] + *(const f32x4*)(x + o + 4);
                    *(u32x4*)(H + o) = pk8(v0, v1); s += dot4(v0) + dot4(v1); }
                s += __shfl_xor(s, 16); s += __shfl_xor(s, 32); if (fq == 0) SS[(size_t)(rowb + ai * 128 + m * 16) * 16 + 4 * u.pn + wc] = s; }
    }
};
struct EpiMq {
    unsigned char* ws;
    __device__ __forceinline__ void operator()(const Acc& acc, const Unit& u, int wr, int wc, int fr_, int fq_) const {
        int fr = fr_, fq = fq_; asm volatile("" : "+v"(fr), "+v"(fq));
        const int rowb = u.pm * 256 + wr * 64 + fr, colb = u.pn * 256 + 32 * wc + 8 * fq; f16* Q = (f16*)(ws + WS_MQ); float* SS = (float*)(ws + WS_SSQ_MQ);
#pragma unroll
        for (int ai = 0; ai < 2; ++ai)
#pragma unroll
            for (int m = 0; m < 4; ++m) { const size_t ro = (size_t)(rowb + ai * 128 + m * 16) * 1024 + colb; float s = 0.f;
#pragma unroll
                for (int bj = 0; bj < 2; ++bj) { const f32x4 v0 = acc[ai][bj][m][0], v1 = acc[ai][bj][m][1]; *(u32x4*)(Q + ro + 128 * bj) = pk8(v0, v1); s += dot4(v0) + dot4(v1); }
                s += __shfl_xor(s, 16); s += __shfl_xor(s, 32); if (fq == 0) SS[(size_t)(rowb + ai * 128 + m * 16) * 16 + 4 * u.pn + wc] = s; }
    }
};
struct EpiMo {
    unsigned char* ws;
    __device__ __forceinline__ void operator()(const Acc& acc, const Unit& u, int wr, int wc, int fr_, int fq_) const {
        int fr = fr_, fq = fq_; asm volatile("" : "+v"(fr), "+v"(fq));
        const int rowb = u.pm * 256 + wr * 64 + fr, colb = u.pn * 256 + 32 * wc + 8 * fq; f16* H = (f16*)(ws + WS_H2H); const f16* H1 = (const f16*)(ws + WS_H1H);
#pragma unroll
        for (int ai = 0; ai < 2; ++ai)
#pragma unroll
            for (int m = 0; m < 4; ++m) { const size_t ro = (size_t)(rowb + ai * 128 + m * 16) * 1024 + colb;
#pragma unroll
                for (int bj = 0; bj < 2; ++bj) { const size_t o = ro + 128 * bj; const f16x8 hv = *(const f16x8*)(H1 + o);
                    f32x4 v0 = acc[ai][bj][m][0], v1 = acc[ai][bj][m][1];
#pragma unroll
                    for (int j = 0; j < 4; ++j) { v0[j] += (float)hv[j]; v1[j] += (float)hv[4 + j]; }
                    *(u32x4*)(H + o) = pk8(v0, v1); } }
    }
};

constexpr int MEM_ROWB = 528;
template <int RS>
__device__ __forceinline__ void mem_stage(LAS unsigned char* lds, const f16* src, int tid) {
    const unsigned voff = (unsigned)((tid >> 5) * RS + 8 * (tid & 31)) * 2u;
    const unsigned loff = (unsigned)((tid >> 5) * MEM_ROWB + (tid & 31) * 16);
#pragma unroll
    for (int bt = 0; bt < 4; ++bt) { u32x4 r[4];
#pragma unroll
        for (int i = 0; i < 4; ++i) r[i] = *(const u32x4*)((const char*)src + (size_t)(4 * bt + i) * 16 * RS * 2 + voff);
#pragma unroll
        for (int i = 0; i < 4; ++i) *(LAS u32x4*)(lds + loff + (4 * bt + i) * 16 * MEM_ROWB) = r[i]; }
}
__device__ __forceinline__ void p6_memattn(Frame& F) {
    PHASE_IDS(); unsigned char* ws = F.ws; LAS unsigned char* lds = F.lds; const int wid = wave, l16 = lane & 15, g = lane >> 4;
    const f16* MQ = (const f16*)(ws + WS_MQ); const f16* KP = (const f16*)(ws + WS_KP); const f16* MVT = (const f16*)(ws + WS_MVT); f16* MO = (f16*)(ws + WS_MO);
    const float* SSH = (const float*)(ws + WS_SSQ_H1); const float* SSM = (const float*)(ws + WS_SSQ_MQ);
    for (int un = F.vcu; un < 256; un += F.G) { const int bh = un >> 3, qc = un & 7, b = bh >> 2, h = bh & 3;
        for (int pass = 0; pass < 4; ++pass) {
            const size_t row = (size_t)b * SEQ + qc * 512 + pass * 128 + wid * 16 + l16;
            f16x8 qf[8];
#pragma unroll
            for (int ks = 0; ks < 8; ++ks) qf[ks] = *(const f16x8*)(MQ + row * 1024 + h * 256 + 32 * ks + 8 * g);
            float fac;
            { const f32x4 a0 = *(const f32x4*)(SSH + row * 16), a1 = *(const f32x4*)(SSH + row * 16 + 4), a2 = *(const f32x4*)(SSH + row * 16 + 8), a3 = *(const f32x4*)(SSH + row * 16 + 12);
              const float sh = (((a0[0] + a0[1]) + (a0[2] + a0[3])) + ((a1[0] + a1[1]) + (a1[2] + a1[3]))) + (((a2[0] + a2[1]) + (a2[2] + a2[3])) + ((a3[0] + a3[1]) + (a3[2] + a3[3])));
              const float r1 = __builtin_amdgcn_rsqf(sh * (1.f / 1024.f) + EPS);
              const f32x4 q4 = *(const f32x4*)(SSM + row * 16 + 4 * h); const float mv = ((q4[0] + q4[1]) + (q4[2] + q4[3])) * (1.f / 256.f);
              fac = r1 * __builtin_amdgcn_rsqf(r1 * r1 * mv + EPS) * (0.0625f * 1.4426950408889634f); }
            __syncthreads();
            mem_stage<256>(lds, KP + (size_t)(b * 4 + h) * 256 * 256, tid);
            __syncthreads();
            f32x4 s[16];
#pragma unroll
            for (int kb = 0; kb < 16; ++kb) { s[kb] = (f32x4){0.f, 0.f, 0.f, 0.f};
#pragma unroll
                for (int ks = 0; ks < 8; ++ks) { const f16x8 a = *(const LAS f16x8*)(lds + (16 * kb + l16) * MEM_ROWB + (32 * ks + 8 * g) * 2); s[kb] = MFMA16(a, qf[ks], s[kb]); } }
            float mx = -INFINITY;
#pragma unroll
            for (int kb = 0; kb < 16; ++kb) { s[kb] = s[kb] * fac; mx = __builtin_fmaxf(mx, __builtin_fmaxf(__builtin_fmaxf(s[kb][0], s[kb][1]), __builtin_fmaxf(s[kb][2], s[kb][3]))); }
            mx = __builtin_fmaxf(mx, __shfl_xor(mx, 16)); mx = __builtin_fmaxf(mx, __shfl_xor(mx, 32));
            float sum = 0.f; u32x4 pf[8];
#pragma unroll
            for (int s8 = 0; s8 < 8; ++s8) { f32x4 p0, p1;
#pragma unroll
                for (int j = 0; j < 4; ++j) { p0[j] = __builtin_amdgcn_exp2f(s[2 * s8][j] - mx); p1[j] = __builtin_amdgcn_exp2f(s[2 * s8 + 1][j] - mx); }
                sum += ((p0[0] + p0[1]) + (p0[2] + p0[3])) + ((p1[0] + p1[1]) + (p1[2] + p1[3]));
                pf[s8] = pk8(p0, p1); }
            sum += __shfl_xor(sum, 16); sum += __shfl_xor(sum, 32);
            const float inv = 1.f / sum;
            __syncthreads();
            mem_stage<2048>(lds, MVT + (size_t)(h * 256) * 2048 + b * 256, tid);
            __syncthreads();
#pragma unroll 4
            for (int dvb = 0; dvb < 16; ++dvb) { f32x4 o = (f32x4){0.f, 0.f, 0.f, 0.f};
#pragma unroll
                for (int s8 = 0; s8 < 8; ++s8) { const f16x8 a = *(const LAS f16x8*)(lds + (16 * dvb + l16) * MEM_ROWB + (32 * s8 + 8 * g) * 2); o = MFMA16(a, __builtin_bit_cast(f16x8, pf[s8]), o); }
                *(u32x2*)(MO + row * 1024 + h * 256 + 16 * dvb + 4 * g) = pk4(o * inv); }
        }
    }
}

__device__ __forceinline__ void p8_route(Frame& F, const Params& P) {
    PHASE_IDS(); unsigned char* ws = F.ws;
    LAS float* WR = (LAS float*)F.lds;
    LAS unsigned* hist = (LAS unsigned*)(F.lds + LDS_MISC) + 8;
    const float* w_group = P.in[24]; const float* w_router = P.in[26];
    for (int e = tid; e < 1024 * 20; e += NTHR) { const int d = e / 20, c = e % 20; WR[c * 1024 + d] = c < 4 ? w_group[d * 4 + c] : w_router[d * 16 + (c - 4)]; }
    if (tid < 24) hist[tid] = 0u;
    __syncthreads();
    const f16* H2 = (const f16*)(ws + WS_H2H); const float* gm = P.in[23];
    f32x4 g[4];
#pragma unroll
    for (int k = 0; k < 4; ++k) g[k] = *(const f32x4*)(gm + 256 * k + 4 * lane);
    float bias[20];
#pragma unroll
    for (int c = 0; c < 20; ++c) bias[c] = c < 4 ? P.in[25][c] : P.in[27][c - 4];
    int* BKT = (int*)(ws + WS_BKT); float* RR = (float*)(ws + WS_RR); float* W0 = (float*)(ws + WS_W0); float* W1 = (float*)(ws + WS_W1);
    const int gw = F.vcu * NWAVES + wave, NGW = F.G * NWAVES;
    for (int tok = gw; tok < T; tok += NGW) {
        f32x4 v[4]; float ss = 0.f;
#pragma unroll
        for (int k = 0; k < 4; ++k) { const f16x4 hx = *(const f16x4*)(H2 + (size_t)tok * 1024 + 256 * k + 4 * lane); v[k] = (f32x4){(float)hx[0], (float)hx[1], (float)hx[2], (float)hx[3]}; ss += dot4(v[k]); }
        const float r = __builtin_amdgcn_rsqf(wave_sum(ss) * (1.f / 1024.f) + EPS);
        float lg[20];
#pragma unroll
        for (int c = 0; c < 20; ++c) lg[c] = 0.f;
#pragma unroll
        for (int k = 0; k < 4; ++k) { const f32x4 tv = v[k] * r * g[k];
#pragma unroll
            for (int c = 0; c < 20; ++c) { const f32x4 w = *(const LAS f32x4*)(WR + c * 1024 + 256 * k + 4 * lane); lg[c] += (tv[0] * w[0] + tv[1] * w[1]) + (tv[2] * w[2] + tv[3] * w[3]); }
            __builtin_amdgcn_sched_barrier(0); }
#pragma unroll
        for (int c = 0; c < 20; ++c) lg[c] = wave_sum(lg[c]) + bias[c];
        int gi = 0; float gmx = lg[0];
#pragma unroll
        for (int c = 1; c < 4; ++c) if (lg[c] > gmx) { gmx = lg[c]; gi = c; }
        float gden = 0.f;
#pragma unroll
        for (int c = 0; c < 4; ++c) gden += __expf(lg[c] - gmx);
        const float gw_ = 1.f / gden;
        float el[4];
#pragma unroll
        for (int c = 0; c < 4; ++c) el[c] = gi == 0 ? lg[4 + c] : (gi == 1 ? lg[8 + c] : (gi == 2 ? lg[12 + c] : lg[16 + c]));
        int i1 = 0; float m1 = el[0];
#pragma unroll
        for (int c = 1; c < 4; ++c) if (el[c] > m1) { m1 = el[c]; i1 = c; }
        int i2 = -1; float m2 = -INFINITY;
#pragma unroll
        for (int c = 0; c < 4; ++c) if (c != i1 && el[c] > m2) { m2 = el[c]; i2 = c; }
        const float e2 = __expf(m2 - m1), wa = gw_ / (1.f + e2), wb = gw_ * e2 / (1.f + e2);
        const int lo = i1 < i2 ? i1 : i2, hi = i1 < i2 ? i2 : i1;
        const int pi = lo == 0 ? hi - 1 : (lo == 1 ? hi + 1 : 5);
        const int bk = gi * 6 + pi;
        if (lane == 0) { BKT[tok] = bk; RR[tok] = r; W0[tok] = (i1 < i2) ? wa : wb; W1[tok] = (i1 < i2) ? wb : wa; atomicAdd((unsigned*)&hist[bk], 1u); }
    }
    __syncthreads();
    if (tid < 24) { const unsigned hv = hist[tid]; if (hv) atomicAdd(F.ctl + CW_CNT + tid, hv); }
}
__device__ __forceinline__ void moe_tiles(Frame& F) {
    LAS int* tstart = (LAS int*)(F.lds + LDS_MISC) + 32;
    const int tid0 = fresh_tid();
    __syncthreads();
    if (tid0 == 0) { int acc = 0;
        for (int b = 0; b < 24; ++b) { tstart[b] = acc; acc += (int)((__hip_atomic_load(F.ctl + CW_CNT + b, __ATOMIC_RELAXED, __HIP_MEMORY_SCOPE_AGENT) + 255u) >> 8); }
        tstart[24] = acc; }
    __syncthreads();
}
__device__ __forceinline__ void p9_gather(Frame& F) {
    PHASE_IDS(); unsigned char* ws = F.ws; const int wid = wave;
    moe_tiles(F);
    LAS int* tstart = (LAS int*)(F.lds + LDS_MISC) + 32; LAS int* posarr = (LAS int*)(F.lds + LDS_MISC) + 64;
    const int* BKT = (const int*)(ws + WS_BKT); const float* RR = (const float*)(ws + WS_RR); const float* W0 = (const float*)(ws + WS_W0); const float* W1 = (const float*)(ws + WS_W1);
    int* TOK = (int*)(ws + WS_TOK); float* PR = (float*)(ws + WS_PR); float* PW0 = (float*)(ws + WS_PW0); float* PW1 = (float*)(ws + WS_PW1);
    const f16* H2H = (const f16*)(ws + WS_H2H); f16* TS = (f16*)(ws + WS_TS);
    for (int blk = F.vcu; blk < T / 128; blk += F.G) {
        if (wid < 2) { const int tok = blk * 128 + wid * 64 + lane; const int bk = BKT[tok];
            unsigned mycount = 0u, rank = 0u;
            for (int bb = 0; bb < 24; ++bb) { const unsigned long long mask = __ballot(bk == bb); const unsigned c = (unsigned)__popcll(mask);
                if (lane == bb) mycount = c;
                if (bk == bb) rank = (unsigned)__popcll(mask & ((1ull << lane) - 1ull)); }
            unsigned basev = 0u;
            if (lane < 24 && mycount) basev = atomicAdd(F.ctl + CW_CUR + lane, mycount);
            const unsigned mybase = (unsigned)__shfl((int)basev, bk);
            posarr[wid * 64 + lane] = tstart[bk] * 256 + (int)(mybase + rank); }
        __syncthreads();
#pragma unroll 4
        for (int j = 0; j < 16; ++j) { const int tl = wid * 16 + j, tok = blk * 128 + tl, pos = posarr[tl];
            const u32x4 a = *(const u32x4*)(H2H + (size_t)tok * 1024 + 8 * lane), b = *(const u32x4*)(H2H + (size_t)tok * 1024 + 512 + 8 * lane);
            *(u32x4*)(TS + (size_t)pos * 1024 + 8 * lane) = a; *(u32x4*)(TS + (size_t)pos * 1024 + 512 + 8 * lane) = b;
            if (lane == 0) { TOK[pos] = tok; PR[pos] = RR[tok]; PW0[pos] = W0[tok]; PW1[pos] = W1[tok]; } }
        __syncthreads();
    }
}

struct SchedMoe {
    const char* A; const char* B; LAS const int* tstart; int G, c, nct_log2, down;
    __device__ __forceinline__ bool next(int i, Unit& u) const {
        const int L = i * G + c, rt = L >> nct_log2, ct = L & ((1 << nct_log2) - 1);
        if (rt >= tstart[24]) return false;
        int bk = 0;
        for (int b = 1; b < 24; ++b) bk = (rt >= tstart[b]) ? b : bk;
        u.A = A + (size_t)rt * 256 * 1024 * 2; u.pm = rt; u.pn = ct; u.aux = bk;
        int lo, hi; moe_pair(bk % 6, lo, hi);
        if (down) { u.B = B + ((size_t)(4 * (bk / 6) + lo) * 1024 + ct * 256) * 512 * 2; u.B2 = B + ((size_t)(4 * (bk / 6) + hi) * 1024 + ct * 256) * 512 * 2; }
        else { const int e = 4 * (bk / 6) + ((ct >> 2) ? hi : lo); u.B = B + (size_t)(e * 4 + (ct & 3)) * 256 * 1024 * 2; u.B2 = nullptr; }
        return true;
    }
};
struct EpiGU {
    unsigned char* ws;
    __device__ __forceinline__ void operator()(const Acc& acc, const Unit& u, int wr, int wc, int fr_, int fq_) const {
        int fr = fr_, fq = fq_; asm volatile("" : "+v"(fr), "+v"(fq));
        const int rowb = u.pm * 256 + wr * 64 + fr, slot = u.pn >> 2, ffb = u.pn & 3; f16* HE = (f16*)(ws + WS_HE);
        const float* PR = (const float*)(ws + WS_PR); const float* PW = (const float*)(ws + (slot ? WS_PW1 : WS_PW0));
#pragma unroll
        for (int ai = 0; ai < 2; ++ai)
#pragma unroll
            for (int m = 0; m < 4; ++m) { const int row = rowb + ai * 128 + m * 16; const float r = PR[row], w = PW[row];
                f32x4 o[2];
#pragma unroll
                for (int n = 0; n < 2; ++n) { const f32x4 gt = acc[ai][0][m][n] * r, up = acc[ai][1][m][n] * r;
#pragma unroll
                    for (int j = 0; j < 4; ++j) { const float sg = gt[j] * __builtin_amdgcn_rcpf(1.f + __expf(-gt[j])); o[n][j] = sg * up[j] * w; } }
                *(u32x4*)(HE + (size_t)row * 1024 + slot * 512 + ffb * 128 + 32 * wc + 8 * fq) = pk8(o[0], o[1]); }
    }
};
struct EpiDown {
    unsigned char* ws; float* out;
    __device__ __forceinline__ void operator()(const Acc& acc, const Unit& u, int wr, int wc, int fr_, int fq_) const {
        int fr = fr_, fq = fq_; asm volatile("" : "+v"(fr), "+v"(fq));
        const int rowb = u.pm * 256 + wr * 64 + fr, colb = u.pn * 256 + 32 * wc + 8 * fq; const int* TOK = (const int*)(ws + WS_TOK); const f16* H2 = (const f16*)(ws + WS_H2H);
#pragma unroll
        for (int ai = 0; ai < 2; ++ai)
#pragma unroll
            for (int m = 0; m < 4; ++m) { const int tok = TOK[rowb + ai * 128 + m * 16];
                if (tok >= 0) { const size_t ro = (size_t)tok * 1024 + colb;
#pragma unroll
                    for (int bj = 0; bj < 2; ++bj) { const size_t o = ro + 128 * bj; const f16x8 hv = *(const f16x8*)(H2 + o);
                        f32x4 v0 = acc[ai][bj][m][0], v1 = acc[ai][bj][m][1];
#pragma unroll
                        for (int j = 0; j < 4; ++j) { v0[j] += (float)hv[j]; v1[j] += (float)hv[4 + j]; }
                        *(f32x4*)(out + o) = v0; *(f32x4*)(out + o + 4) = v1; } } }
    }
};

#ifndef MK_N_LAUNCHES
#define MK_N_LAUNCHES 1
#endif
constexpr int N_PHASES = 13;
__global__ void __launch_bounds__(NTHR, 2) fwd_kernel(Params P) {
    extern __shared__ __attribute__((aligned(16))) unsigned char lds_raw[];
    Frame F;
    F.lds = (LAS unsigned char*)lds_raw; F.MISC = (volatile LAS unsigned*)(F.lds + LDS_MISC);
    F.G = gridDim.x; F.bx = blockIdx.x; F.vcu = (F.G % 8 == 0) ? (F.bx % 8) * (F.G / 8) + F.bx / 8 : F.bx;
    F.ws = P.ws; F.out = P.out; F.ctl = (unsigned*)(P.ws + WS_CTL);
    for (int u = fresh_tid(); u < (LDS_BYTES - LDS_MISC) / 4; u += NTHR) ((LAS unsigned*)(F.lds + LDS_MISC))[u] = 0u;
    __syncthreads();
    const int lo = P.ph_lo, hi = P.ph_hi;
    const bool multi = (hi - lo) > 1;
    XcdBarrier bar; bar.bar = F.ctl + CW_BAR; bar.x = 0; bar.st = F.MISC;
    if (multi) bar = xcd_barrier_post(F.ctl + CW_BAR, F.MISC);
#define IN(k) (lo <= (k) && (k) < hi)
#define SEAM(k) do { if (IN(k) && IN((k) + 1)) xcd_barrier(bar); } while (0)
    unsigned char* ws = F.ws;
#ifndef PROBE_DUP
#define PROBE_DUP -1
#endif
#define RUN(k, ...) do { if (IN(k)) { __VA_ARGS__ if (PROBE_DUP == (k)) { xcd_barrier(bar); __VA_ARGS__ } } SEAM(k); } while (0)
    RUN(0, { p0_prologue(F, P); });
    RUN(1, {
        { SchedP1N S{ws, F.G, F.bx}; EpiP1N E{ws, P.in[12]}; pg8::gemm_phase<EpiP1N, SchedP1N, true>(F.lds, 1024, 1024, 1024, S, E); }
        { SchedP1S S{ws, F.G, (F.bx + F.G - 160) % F.G}; EpiP1S E{ws}; pg8::gemm_phase<EpiP1S, SchedP1S, true>(F.lds, 1024, 1024, 1024, S, E); }
    });
    RUN(2, {
        p2_kprime(F, P);
        { SchedGrid S{(const char*)(ws + WS_CQ), (const char*)(ws + WS_WUQ), (size_t)256 * 384 * 2, (size_t)256 * 384 * 2, 128, 3, F.G, F.bx}; EpiP2Q E{ws, P.in[9], P.in[10]};
          pg8::gemm_phase<EpiP2Q, SchedGrid, true>(F.lds, 384, 384, 384, S, E); }
        { SchedGrid S{(const char*)(ws + WS_CKV), (const char*)(ws + WS_WUKN), (size_t)256 * 256 * 2, (size_t)256 * 256 * 2, 128, 2, F.G, (F.bx + F.G - 128) % F.G}; EpiP2K E{ws, P.in[11]};
          pg8::gemm_phase<EpiP2K, SchedGrid, true>(F.lds, 256, 256, 256, S, E); }
        { SchedGrid S{(const char*)(ws + WS_WUKV), (const char*)(ws + WS_CKV), (size_t)256 * 256 * 2, (size_t)256 * 256 * 2, 2, 128, F.G, (F.bx + F.G - 128) % F.G}; EpiP2V E{ws};
          pg8::gemm_phase<EpiP2V, SchedGrid, true>(F.lds, 256, 256, 256, S, E); }
    });
    RUN(3, { p3_attention(F); });
    if (PROBE_DUP == 31 && IN(3)) { p3_attention<true, false>(F); xcd_barrier(bar); }
    if (PROBE_DUP == 32 && IN(3)) { p3_attention<false, true>(F); xcd_barrier(bar); }
    RUN(4, { p3b_norm(F, P); });
    RUN(5, { SchedGrid S{(const char*)(ws + WS_ATT), (const char*)(ws + WS_WO), (size_t)256 * 1024 * 2, (size_t)256 * 1024 * 2, 128, 4, F.G, F.bx}; EpiWo E{ws, P.in[0]};
        pg8::gemm_phase<EpiWo, SchedGrid, true>(F.lds, 1024, 1024, 1024, S, E); });
    RUN(6, { SchedGrid S{(const char*)(ws + WS_H1H), (const char*)(ws + WS_WMQ), (size_t)256 * 1024 * 2, (size_t)256 * 1024 * 2, 128, 4, F.G, F.bx}; EpiMq E{ws};
        pg8::gemm_phase<EpiMq, SchedGrid, true>(F.lds, 1024, 1024, 1024, S, E); });
    RUN(7, { p6_memattn(F); });
    RUN(8, { SchedGrid S{(const char*)(ws + WS_MO), (const char*)(ws + WS_WMO), (size_t)256 * 1024 * 2, (size_t)256 * 1024 * 2, 128, 4, F.G, F.bx}; EpiMo E{ws};
        pg8::gemm_phase<EpiMo, SchedGrid, true>(F.lds, 1024, 1024, 1024, S, E); });
    RUN(9, { p8_route(F, P); });
    RUN(10, { p9_gather(F); });
    RUN(11, { moe_tiles(F); SchedMoe S{(const char*)(ws + WS_TS), (const char*)(ws + WS_WGU), (LAS const int*)(F.lds + LDS_MISC) + 32, F.G, F.vcu, 3, 0}; EpiGU E{ws};
        pg8::gemm_phase<EpiGU, SchedMoe, true>(F.lds, 1024, 1024, 1024, S, E); });
    RUN(12, { moe_tiles(F); SchedMoe S{(const char*)(ws + WS_HE), (const char*)(ws + WS_WD2), (LAS const int*)(F.lds + LDS_MISC) + 32, F.G, F.vcu, 2, 1}; EpiDown E{ws, P.out};
        pg8::gemm_phase<EpiDown, SchedMoe, true, true>(F.lds, 1024, 1024, 512, S, E); });
#undef RUN
#undef IN
#undef SEAM
}

extern "C" void kernel_launch(void* const* d_in, const int* in_sizes, int n_in, void* d_out, int out_size, void* d_ws, size_t ws_size, hipStream_t stream) {
    static int grid = 0;
    if (grid == 0) {
        if (n_in != 31 || out_size != T * D || ws_size < WS_END) { fprintf(stderr, "kernel_launch: unexpected shapes (n_in %d, out %d, ws %zu < %zu)\n", n_in, out_size, ws_size, (size_t)WS_END); grid = -1; return; }
        int dev = 0, cus = 0, per_cu = 0;
        if (hipGetDevice(&dev) != hipSuccess || hipDeviceGetAttribute(&cus, hipDeviceAttributeMultiprocessorCount, dev) != hipSuccess) { grid = -1; return; }
        if (hipFuncSetAttribute((const void*)fwd_kernel, hipFuncAttributeMaxDynamicSharedMemorySize, LDS_BYTES) != hipSuccess) { fprintf(stderr, "kernel_launch: hipFuncSetAttribute failed\n"); grid = -1; return; }
        if (hipOccupancyMaxActiveBlocksPerMultiprocessor(&per_cu, (const void*)fwd_kernel, NTHR, LDS_BYTES) != hipSuccess || per_cu < 1) { fprintf(stderr, "kernel_launch: occupancy query says %d\n", per_cu); }
        (void)hipGetLastError();
        grid = cus;
    }
    if (grid < 0) return;
    (void)hipMemsetAsync((char*)d_ws + WS_CTL, 0, CTL_ZERO_BYTES, stream);
    Params p{};
    for (int i = 0; i < 31; ++i) p.in[i] = (const float*)d_in[i];
    p.out = (float*)d_out; p.ws = (unsigned char*)d_ws;
    if (MK_N_LAUNCHES == 1) { p.ph_lo = 0; p.ph_hi = N_PHASES; hipLaunchKernelGGL(fwd_kernel, dim3(grid), dim3(NTHR), LDS_BYTES, stream, p); }
    else { for (int k = 0; k < N_PHASES; ++k) { p.ph_lo = k; p.ph_hi = k + 1; hipLaunchKernelGGL(fwd_kernel, dim3(grid), dim3(NTHR), LDS_BYTES, stream, p); } }
}
```

```cpp
#include <hip/hip_runtime.h>
#include <cstdio>
#include <cstdint>

#define LAS __attribute__((address_space(3)))
#define GAS __attribute__((address_space(1)))
typedef _Float16 f16;
typedef _Float16 f16x8 __attribute__((ext_vector_type(8)));
typedef _Float16 f16x4 __attribute__((ext_vector_type(4)));
typedef _Float16 f16x2 __attribute__((ext_vector_type(2)));
typedef float f32x2 __attribute__((ext_vector_type(2)));
typedef float f32x4 __attribute__((ext_vector_type(4)));
typedef float f32x16 __attribute__((ext_vector_type(16)));
typedef unsigned u32x4 __attribute__((ext_vector_type(4)));
typedef unsigned u32x2 __attribute__((ext_vector_type(2)));

__device__ __forceinline__ unsigned pk2(float lo, float hi) { f16x2 v = {(f16)lo, (f16)hi}; return __builtin_bit_cast(unsigned, v); }
__device__ __forceinline__ u32x4 pk8(f32x4 a, f32x4 b) { u32x4 w; w.x = pk2(a[0], a[1]); w.y = pk2(a[2], a[3]); w.z = pk2(b[0], b[1]); w.w = pk2(b[2], b[3]); return w; }
__device__ __forceinline__ u32x2 pk4(f32x4 a) { u32x2 w; w.x = pk2(a[0], a[1]); w.y = pk2(a[2], a[3]); return w; }
__device__ __forceinline__ float dot4(f32x4 a) { return (a[0] * a[0] + a[1] * a[1]) + (a[2] * a[2] + a[3] * a[3]); }
template <int CTRL> __device__ __forceinline__ float dpp_add(float v) { const int t = __builtin_amdgcn_update_dpp(0, __builtin_bit_cast(int, v), CTRL, 0xf, 0xf, true); return v + __builtin_bit_cast(float, t); }
__device__ __forceinline__ float sum_x16(float x) { const auto rr = __builtin_amdgcn_permlane16_swap(__float_as_uint(x), __float_as_uint(x), false, false); const unsigned a = rr[0], b = rr[1]; return __uint_as_float(a) + __uint_as_float(b); }
__device__ __forceinline__ float sum_x32(float x) { const auto rr = __builtin_amdgcn_permlane32_swap(__float_as_uint(x), __float_as_uint(x), false, false); const unsigned a = rr[0], b = rr[1]; return __uint_as_float(a) + __uint_as_float(b); }
__device__ __forceinline__ float wave_sum(float v) {
    v = dpp_add<0xB1>(v);
    v = dpp_add<0x4E>(v);
    v = dpp_add<0x141>(v);
    v = dpp_add<0x140>(v);
    return sum_x32(sum_x16(v));
}
__device__ __forceinline__ int L32(int q) { return 8 * ((q >> 2) & 3) + 4 * (q >> 4) + (q & 3); }

__device__ __forceinline__ int fresh_tid() { int t = (int)threadIdx.x; asm volatile("" : "+v"(t)); return t; }
constexpr int T = 32768, D = 1024, SEQ = 4096, NB = 8;
constexpr float EPS = 1e-6f;
constexpr int NPOS = 152 * 256;

namespace pg8 {
constexpr int BM = 256, BK = 64, HALF = 128, HTB = HALF * BK * 2, STAGE_BYTES = 8 * HTB;
__host__ __device__ __forceinline__ int lds_byte(int r, int c) { const int st = (r >> 4) * 2 + (c >> 5), rr = r & 15, cc = c & 31, ob = rr * 64 + cc * 2; return st * 1024 + (ob ^ (((ob >> 9) & 1) << 5)); }
__host__ __device__ __forceinline__ void stage_rc(int b, int& R, int& C) { const int st = b / 1024, sb = b % 1024, swz = sb ^ (((sb >> 9) & 1) << 5); R = (st >> 1) * 16 + swz / 64; C = (st & 1) * 32 + (swz % 64) / 2; }
struct Unit { const char* A; const char* B; const char* B2; int pm, pn, aux; };

template <class Epi, class Sched, bool ALIGN_EPI, bool SPLITB = false>
__device__ __forceinline__ void gemm_phase(LAS unsigned char* lds, const int K, const int lda, const int ldb, const Sched& S, const Epi& E) {
    const int tid = fresh_tid(), wid = __builtin_amdgcn_readfirstlane(tid >> 6), lane = tid & 63, wr = wid >> 2, wc = wid & 3, fr = lane & 15, fq = lane >> 4;
    const int nt = K / BK;
    unsigned voffA[2], voffB[2];
#pragma unroll
    for (int i = 0; i < 2; ++i) { int R, C; stage_rc(tid * 16 + i * 8192, R, C); voffA[i] = (unsigned)(R * lda + C) * 2u; voffB[i] = (unsigned)(R * ldb + C) * 2u; }
    const size_t kstep = (size_t)(BK * 2);
    const size_t hstepA = (size_t)HALF * lda * 2, hstepB = (size_t)HALF * ldb * 2;
    const unsigned ldsw = (unsigned)wid * 1024u;
    const int aoff = lds_byte(wr * 64 + fr, fq * 8), boff = lds_byte(wc * 32 + fr, fq * 8);
#define PG8_SA(b, h) (((b) * 2 + (h)) * HTB)
#define PG8_SB(b, h) ((4 + (b) * 2 + (h)) * HTB)
#define PG8_STAGE(bufoff, gbase, voff) do { _Pragma("unroll") for (int _i = 0; _i < 2; ++_i) \
        __builtin_amdgcn_global_load_lds((const unsigned*)((const char*)(gbase) + (voff)[_i]), (LAS unsigned*)(lds + (bufoff) + ldsw + _i * 8192), 16, 0, 0); } while (0)
#define PG8_LDA(dst, b, h) do { _Pragma("unroll") for (int m = 0; m < 4; ++m) _Pragma("unroll") for (int k = 0; k < 2; ++k) dst[m][k] = *(const LAS f16x8*)(lds + PG8_SA(b, h) + aoff + m * 2048 + k * 1024); } while (0)
#define PG8_LDB(dst, b, h) do { _Pragma("unroll") for (int n = 0; n < 2; ++n) _Pragma("unroll") for (int k = 0; k < 2; ++k) dst[n][k] = *(const LAS f16x8*)(lds + PG8_SB(b, h) + boff + n * 2048 + k * 1024); } while (0)
#define PG8_MMA(ai, bj, At, Bt) do { __builtin_amdgcn_s_setprio(1); _Pragma("unroll") for (int m = 0; m < 4; ++m) _Pragma("unroll") for (int n = 0; n < 2; ++n) _Pragma("unroll") for (int k = 0; k < 2; ++k) \
        acc[ai][bj][m][n] = __builtin_amdgcn_mfma_f32_16x16x32_f16(Bt[n][k], At[m][k], acc[ai][bj][m][n], 0, 0, 0); __builtin_amdgcn_s_setprio(0); } while (0)
#define PG8_WAIT_V(n) asm volatile("s_waitcnt vmcnt(" #n ")" ::: "memory")
#define PG8_WAIT_L(n) asm volatile("s_waitcnt lgkmcnt(" #n ")" ::: "memory")
#define PG8_BAR __builtin_amdgcn_s_barrier()
#define PG8_SCHED __builtin_amdgcn_sched_barrier(0)
    Unit cur, nxt; int ui = 0;
    if (!S.next(0, cur)) return;
    f32x4 acc[2][2][4][2];
#pragma unroll
    for (int a = 0; a < 2; ++a)
#pragma unroll
        for (int b = 0; b < 2; ++b)
#pragma unroll
            for (int m = 0; m < 4; ++m)
#pragma unroll
                for (int n = 0; n < 2; ++n) acc[a][b][m][n] = (f32x4){0.f, 0.f, 0.f, 0.f};
    f16x8 At[4][2], B0[2][2], B1[2][2];
    const char* cA = cur.A; const char* cB = cur.B; const char* cB2 = SPLITB ? cur.B2 : nullptr; const int th = nt >> 1;
    PG8_STAGE(PG8_SB(0, 0), cB, voffB); PG8_STAGE(PG8_SB(0, 1), cB + hstepB, voffB); PG8_STAGE(PG8_SA(0, 0), cA, voffA); PG8_STAGE(PG8_SA(0, 1), cA + hstepA, voffA);
    if (wr == 1) PG8_BAR;
    PG8_WAIT_V(2); PG8_BAR;
    PG8_STAGE(PG8_SB(1, 0), cB + kstep, voffB); PG8_STAGE(PG8_SA(1, 0), cA + kstep, voffA); PG8_STAGE(PG8_SB(1, 1), cB + hstepB + kstep, voffB);
    PG8_WAIT_V(6); PG8_BAR;
    for (;;) {
        const bool has_next = S.next(ui + 1, nxt);
        const char* nA = has_next ? nxt.A : cA; const char* nB = has_next ? nxt.B : cB; const char* nB2 = SPLITB ? (has_next ? nxt.B2 : cB2) : nullptr;
        for (int t = 0; t < nt; t += 2) {
            const bool last = (t == nt - 2);
            const char* a1 = cA + (size_t)(t + 1) * kstep;
            const char* a2 = last ? nA : cA + (size_t)(t + 2) * kstep;
            const char* b2 = last ? nB : ((SPLITB && t + 2 >= th) ? cB2 + (size_t)(t + 2 - th) * kstep : cB + (size_t)(t + 2) * kstep);
            const char* a3 = a2 + kstep; const char* b3 = b2 + kstep;
            PG8_LDB(B0, 0, 0); PG8_LDB(B1, 0, 1); PG8_SCHED; PG8_LDA(At, 0, 0); PG8_STAGE(PG8_SA(1, 1), a1 + hstepA, voffA);
            PG8_WAIT_V(8); PG8_WAIT_L(0); PG8_BAR; PG8_MMA(0, 0, At, B0); PG8_MMA(0, 1, At, B1); PG8_BAR; PG8_SCHED;
            PG8_LDA(At, 0, 1); PG8_STAGE(PG8_SB(0, 0), b2, voffB); PG8_STAGE(PG8_SB(0, 1), b2 + hstepB, voffB); PG8_STAGE(PG8_SA(0, 0), a2, voffA);
            PG8_WAIT_V(8); PG8_WAIT_L(0); PG8_BAR; PG8_MMA(1, 0, At, B0); PG8_MMA(1, 1, At, B1); PG8_BAR; PG8_SCHED;
            PG8_LDB(B0, 1, 0); PG8_LDB(B1, 1, 1); PG8_SCHED; PG8_LDA(At, 1, 0); PG8_STAGE(PG8_SA(0, 1), a2 + hstepA, voffA);
            PG8_WAIT_V(8); PG8_WAIT_L(0); PG8_BAR; PG8_MMA(0, 0, At, B0); PG8_MMA(0, 1, At, B1); PG8_BAR; PG8_SCHED;
            PG8_LDA(At, 1, 1); PG8_STAGE(PG8_SB(1, 0), b3, voffB); PG8_STAGE(PG8_SB(1, 1), b3 + hstepB, voffB); PG8_STAGE(PG8_SA(1, 0), a3, voffA);
            PG8_WAIT_V(8); PG8_WAIT_L(0); PG8_BAR; PG8_MMA(1, 0, At, B0); PG8_MMA(1, 1, At, B1); PG8_BAR; PG8_SCHED;
        }
        if constexpr (ALIGN_EPI) { if (wr == 0) PG8_BAR; }
        E(acc, cur, wr, wc, fr, fq);
        if (!has_next) break;
#pragma unroll
        for (int a = 0; a < 2; ++a)
#pragma unroll
            for (int b = 0; b < 2; ++b)
#pragma unroll
                for (int m = 0; m < 4; ++m)
#pragma unroll
                    for (int n = 0; n < 2; ++n) acc[a][b][m][n] = (f32x4){0.f, 0.f, 0.f, 0.f};
        cur = nxt; cA = nA; cB = nB; cB2 = nB2; ++ui;
        if constexpr (ALIGN_EPI) { if (wr == 1) PG8_BAR; }
    }
    PG8_WAIT_V(0);
    if constexpr (!ALIGN_EPI) { if (wr == 0) PG8_BAR; }
    PG8_BAR;
#undef PG8_SA
#undef PG8_SB
#undef PG8_STAGE
#undef PG8_LDA
#undef PG8_LDB
#undef PG8_MMA
#undef PG8_WAIT_V
#undef PG8_WAIT_L
#undef PG8_BAR
#undef PG8_SCHED
}
__device__ __forceinline__ void tile_map(int L, int nM, int nN, int& pm, int& pn) {
    const int nwg = nM * nN; int wgid = L;
    { const int q = nwg / 8, r = nwg % 8, xcd = wgid % 8, off = wgid / 8; wgid = (xcd < r ? xcd * (q + 1) : r * (q + 1) + (xcd - r) * q) + off; }
    const int nig = 8 * nN, gid = wgid / nig, fm = gid * 8, gsz = (nM - fm) < 8 ? (nM - fm) : 8;
    pm = fm + ((wgid % nig) % gsz); pn = (wgid % nig) / gsz;
}
}
using pg8::Unit;

#define XB_TMO      128
#define XB_XCNT(j)  (256  + 64 * (j))
#define XB_XSUB(j)  (1280 + 64 * (j))
#define XB_XGEN(j)  (2304 + 64 * (j))
#define XB_TOP      3328
#define XB_TOPGEN   3392
#define XCD_BAR_WORDS 3456
#define XB_SPIN_CAP (1u << 18)
__device__ __forceinline__ unsigned xb_ld(unsigned* p)              { return __hip_atomic_load(p, __ATOMIC_RELAXED, __HIP_MEMORY_SCOPE_AGENT); }
__device__ __forceinline__ unsigned xb_add(unsigned* p, unsigned v) { return __hip_atomic_fetch_add(p, v, __ATOMIC_RELAXED, __HIP_MEMORY_SCOPE_AGENT); }
__device__ __forceinline__ unsigned xb_xcc_id() { return (unsigned)__builtin_amdgcn_s_getreg((3 << 11) | 20) & 0xFu; }
#define XB_SPIN(cond, bar) do { unsigned _sp = 0; while (cond) { __builtin_amdgcn_s_sleep(1); \
    if ((++_sp & 255u) == 0u) { if (xb_ld(&(bar)[XB_TMO])) break; if (_sp > XB_SPIN_CAP) { atomicAdd(&(bar)[XB_TMO], 1u); break; } } } } while (0)
struct XcdBarrier { unsigned* bar; unsigned x; volatile LAS unsigned* st; };
__device__ __forceinline__ XcdBarrier xcd_barrier_post(unsigned* bar, volatile LAS unsigned* st) {
    XcdBarrier b; b.bar = bar; b.x = xb_xcc_id(); b.st = st;
    if (threadIdx.x == 0) (void)xb_add(&bar[XB_XCNT(b.x)], 1u);
    return b;
}
__device__ __forceinline__ void xcd_barrier_complete(unsigned* bar, unsigned x, unsigned& nloc, unsigned& nx) {
    const unsigned G = gridDim.x * gridDim.y * gridDim.z;
    unsigned sum, cnt, mine, sp = 0u;
    for (;;) {
        sum = 0u; cnt = 0u; mine = 0u;
#pragma unroll
        for (unsigned j = 0; j < 16; ++j) { const unsigned c = xb_ld(&bar[XB_XCNT(j)]); sum += c; cnt += (c > 0u) ? 1u : 0u; mine = (j == x) ? c : mine; }
        if (sum == G) break;
        __builtin_amdgcn_s_sleep(1);
        if ((++sp & 255u) == 0u) { if (xb_ld(&bar[XB_TMO])) break; if (sp > XB_SPIN_CAP) { atomicAdd(&bar[XB_TMO], 1u); break; } }
    }
    nloc = mine > 0u ? mine : 1u; nx = cnt > 0u ? cnt : 1u;
}
__device__ __forceinline__ void xcd_barrier(const XcdBarrier& b) {
    asm volatile("s_waitcnt vmcnt(0)" ::: "memory");
    __syncthreads();
    if (threadIdx.x == 0) {
        unsigned* bar = b.bar;
        __builtin_amdgcn_s_waitcnt(0);
        unsigned nloc = b.st[0], nx = b.st[1];
        if (nloc == 0u) { xcd_barrier_complete(bar, b.x, nloc, nx); b.st[0] = nloc; b.st[1] = nx; }
        const unsigned old = xb_add(&bar[XB_XSUB(b.x)], 1u);
        const unsigned gen = old / nloc;
        if (old + 1u == (gen + 1u) * nloc) {
            __builtin_amdgcn_fence(__ATOMIC_RELEASE, "agent");
            asm volatile("s_waitcnt vmcnt(0)" ::: "memory");
            const unsigned og = xb_add(&bar[XB_TOP], 1u);
            const unsigned tg = og / nx;
            if (og + 1u == (tg + 1u) * nx) xb_add(&bar[XB_TOPGEN], 1u);
            else XB_SPIN(xb_ld(&bar[XB_TOPGEN]) == tg, bar);
            __builtin_amdgcn_fence(__ATOMIC_ACQUIRE, "agent");
            xb_add(&bar[XB_XGEN(b.x)], 1u);
            asm volatile("s_waitcnt vmcnt(0)" ::: "memory");
        } else {
            XB_SPIN(xb_ld(&bar[XB_XGEN(b.x)]) == gen, bar);
            __builtin_amdgcn_fence(__ATOMIC_ACQUIRE, "agent");
            asm volatile("s_waitcnt vmcnt(0)" ::: "memory");
        }
    }
    __syncthreads();
}

constexpr size_t MiB = 1u << 20;
constexpr size_t WS_CTL = 0, CTL_ZERO_BYTES = 65536;
constexpr int CW_BAR = 1024;
constexpr int CW_CNT = 8192;
constexpr int CW_CUR = 8192 + 64;
constexpr size_t WS_SSQ_CQ  = 1 * MiB;
constexpr size_t WS_SSQ_CKV = 2 * MiB;
constexpr size_t WS_SSQ_MK  = 2 * MiB + 512 * 1024;
constexpr size_t WS_SSQ_ATT = 3 * MiB;
constexpr size_t WS_SSQ_H1  = 5 * MiB;
constexpr size_t WS_SSQ_MQ  = 7 * MiB;
constexpr size_t WS_COS     = 9 * MiB;
constexpr size_t WS_SIN     = 11 * MiB;
constexpr size_t WS_BKT     = 13 * MiB;
constexpr size_t WS_RR      = 13 * MiB + 128 * 1024;
constexpr size_t WS_W0      = 13 * MiB + 256 * 1024;
constexpr size_t WS_W1      = 13 * MiB + 384 * 1024;
constexpr size_t WS_TOK     = 13 * MiB + 512 * 1024;
constexpr size_t WS_PR      = 13 * MiB + 704 * 1024;
constexpr size_t WS_PW0     = 14 * MiB;
constexpr size_t WS_PW1     = 14 * MiB + 192 * 1024;
constexpr size_t WS_KRF     = 14 * MiB + 512 * 1024;
constexpr size_t WS_WIN  = 17 * MiB;
constexpr size_t WS_WSV  = WS_WIN  + 3584 * 1024;
constexpr size_t WS_WMK  = WS_WSV  + 1 * MiB;
constexpr size_t WS_WMV  = WS_WMK  + 2 * MiB;
constexpr size_t WS_WUQ  = WS_WMV  + 2 * MiB;
constexpr size_t WS_WUKN = WS_WUQ  + 1 * MiB;
constexpr size_t WS_WUKV = WS_WUKN + 256 * 1024;
constexpr size_t WS_WO   = WS_WUKV + 256 * 1024;
constexpr size_t WS_WMQ  = WS_WO   + 2 * MiB;
constexpr size_t WS_WMO  = WS_WMQ  + 2 * MiB;
constexpr size_t WS_WGU  = WS_WMO  + 2 * MiB;
constexpr size_t WS_WD2  = WS_WGU  + 32 * MiB;
constexpr size_t WS_WEND = WS_WD2  + 48 * MiB;
constexpr size_t WS_MN   = 114 * MiB;
constexpr size_t WS_MKR  = 118 * MiB;
constexpr size_t WS_MVT  = 122 * MiB;
constexpr size_t WS_KP   = 126 * MiB;
constexpr size_t WS_R1   = 130 * MiB;
constexpr size_t WS_R2   = 194 * MiB;
constexpr size_t WS_R3   = 290 * MiB;
constexpr size_t WS_R4   = 330 * MiB;
constexpr size_t WS_END  = 458 * MiB;
static_assert(WS_WEND <= WS_MN, "ws map");
constexpr size_t WS_HN = WS_R1, WS_ATT = WS_R1, WS_MQ = WS_R1, WS_H2H = WS_R1;
constexpr size_t WS_SBQ = WS_R2, WS_SBK = WS_R2 + 32 * MiB, WS_SBVT = WS_R2 + 64 * MiB, WS_H1H = WS_R2, WS_TS = WS_R2;
constexpr size_t WS_CQ = WS_R3, WS_CKV = WS_R3 + 24 * MiB;
constexpr size_t WS_MLAQ = WS_R4, WS_MLAK = WS_R4 + 48 * MiB, WS_MLAVT = WS_R4 + 96 * MiB, WS_HE = WS_R4, WS_MO = WS_R4;

constexpr int LDS_BYTES = 147456;
constexpr int LDS_MISC = 143360;
constexpr int NWAVES = 8, NTHR = 512;

struct Params { const float* in[31]; float* out; unsigned char* ws; int ph_lo, ph_hi; };

struct Frame {
    LAS unsigned char* lds; volatile LAS unsigned* MISC;
    int vcu, G, bx;
    unsigned char* ws; float* out; unsigned* ctl;
};
#define PHASE_IDS() const int tid = fresh_tid(), lane = tid & 63, wave = __builtin_amdgcn_readfirstlane(tid >> 6); (void)lane; (void)wave

__device__ __forceinline__ void conv_item(const float* src, int ld, int srccol0, int mode, int ksrc0, const float* kscale, f16* dst, int K, int row0, int k0, LAS float* scr, int lane) {
    if (mode != 2) {
        const float* base = src + (size_t)ksrc0 * ld + srccol0;
        const unsigned voff = (unsigned)((lane >> 5) * ld + (lane & 31)) * 4u;
        float v[32];
#pragma unroll
        for (int i = 0; i < 32; ++i) v[i] = *(const float*)((const char*)(base + (size_t)2 * i * ld) + voff);
#pragma unroll
        for (int i = 0; i < 32; ++i) scr[(2 * i + (lane >> 5)) * 33 + (lane & 31)] = v[i];
    }
    asm volatile("s_waitcnt lgkmcnt(0)" ::: "memory");
    const int c = lane & 7;
    f32x4 ks0 = (f32x4){1.f, 1.f, 1.f, 1.f}, ks1 = ks0;
    if (kscale) { ks0 = *(const f32x4*)(kscale + ksrc0 + 8 * c); ks1 = *(const f32x4*)(kscale + ksrc0 + 8 * c + 4); }
#pragma unroll
    for (int j = 0; j < 4; ++j) { const int q = (lane >> 3) + 8 * j; const int lc = (mode == 1) ? L32(q) : q; const LAS float* s = scr + (8 * c) * 33 + lc;
        u32x4 o;
        if (mode == 2) { o = (u32x4){0u, 0u, 0u, 0u}; }
        else { o.x = pk2(s[0 * 33] * ks0[0], s[1 * 33] * ks0[1]); o.y = pk2(s[2 * 33] * ks0[2], s[3 * 33] * ks0[3]); o.z = pk2(s[4 * 33] * ks1[0], s[5 * 33] * ks1[1]); o.w = pk2(s[6 * 33] * ks1[2], s[7 * 33] * ks1[3]); }
        *(u32x4*)(dst + (size_t)(row0 + q) * K + k0 + 8 * c) = o; }
    asm volatile("s_waitcnt lgkmcnt(0)" ::: "memory");
}
__device__ __forceinline__ void rms_rows2_to_f16(const float* x, const float* g, f16* o, int m0, int m1, bool has1, int lane) {
    const f32x4* x0 = (const f32x4*)(x + (size_t)m0 * D) + lane; const f32x4* x1 = (const f32x4*)(x + (size_t)m1 * D) + lane; const f32x4* gr = (const f32x4*)g + lane;
    f32x4 v[4], w[4]; float s0 = 0.f, s1 = 0.f;
#pragma unroll
    for (int j = 0; j < 4; ++j) v[j] = x0[64 * j];
    if (has1) {
#pragma unroll
        for (int j = 0; j < 4; ++j) w[j] = x1[64 * j];
    } else {
#pragma unroll
        for (int j = 0; j < 4; ++j) w[j] = (f32x4){0.f, 0.f, 0.f, 0.f};
    }
#pragma unroll
    for (int j = 0; j < 4; ++j) { s0 += dot4(v[j]); s1 += dot4(w[j]); }
    s0 = wave_sum(s0); s1 = wave_sum(s1);
    const float r0 = __builtin_amdgcn_rsqf(s0 * (1.f / 1024.f) + EPS), r1 = __builtin_amdgcn_rsqf(s1 * (1.f / 1024.f) + EPS);
    u32x2* o0 = (u32x2*)(o + (size_t)m0 * D) + lane; u32x2* o1 = (u32x2*)(o + (size_t)m1 * D) + lane;
#pragma unroll
    for (int j = 0; j < 4; ++j) { const f32x4 gg = gr[64 * j]; o0[64 * j] = pk4(v[j] * r0 * gg); if (has1) o1[64 * j] = pk4(w[j] * r1 * gg); }
}
__device__ __forceinline__ void moe_pair(int pi, int& lo, int& hi) { lo = pi < 3 ? 0 : (pi < 5 ? 1 : 2); hi = pi < 3 ? pi + 1 : (pi < 5 ? pi - 1 : 3); }

__device__ __forceinline__ void p0_prologue(Frame& F, const Params& P) {
    PHASE_IDS();
    LAS float* scr = (LAS float*)(F.lds + wave * 16384);
    const int gw = F.vcu * NWAVES + wave, NGW = F.G * NWAVES;
    unsigned char* ws = F.ws;
    const float* w_in = P.in[4]; const float* w_uq = P.in[6]; const float* w_ukv = P.in[8]; const float* w_o = P.in[15];
    const float* w_mq = P.in[18]; const float* w_mkv = P.in[19]; const float* w_mo = P.in[22];
    const float* w_gate = P.in[28]; const float* w_up = P.in[29]; const float* w_down = P.in[30];
    for (int it = gw; it < 56 * 16; it += NGW) { const int rb = it >> 4, kb = it & 15, tile = rb >> 3, g = rb & 7, bj = g >> 2, wc = g & 3; int col, mode = 1;
        if (tile < 2) col = (4 * tile + wc) * 64 + 32 * bj;
        else if (tile < 4) col = 512 + (4 * (tile - 2) + wc) * 64 + 32 * bj;
        else if (tile == 4) col = 1536 + 64 * wc + 32 * bj;
        else if (tile == 5) { if (bj == 0) col = 1536 + 256 + 32 * wc; else if (wc == 0) { col = 2176; mode = 0; } else { col = 0; mode = 2; } }
        else col = 1920 + 64 * wc + 32 * bj;
        conv_item(w_in, 2208, col, mode, kb * 64, nullptr, (f16*)(ws + WS_WIN), 1024, rb * 32, kb * 64, scr, lane); }
    for (int it = gw; it < 16 * 16; it += NGW) { const int rb = it >> 4, kb = it & 15; conv_item(w_in, 2208, 1024 + 32 * rb, 0, kb * 64, nullptr, (f16*)(ws + WS_WSV), 1024, rb * 32, kb * 64, scr, lane); }
    for (int it = gw; it < 32 * 16; it += NGW) { const int rb = it >> 4, kb = it & 15, tile = rb >> 3, g = rb & 7, bj = g >> 2, wc = g & 3;
        conv_item(w_mkv, 2048, 256 * tile + 64 * wc + 32 * bj, 1, kb * 64, nullptr, (f16*)(ws + WS_WMK), 1024, rb * 32, kb * 64, scr, lane); }
    for (int it = gw; it < 32 * 16; it += NGW) { const int rb = it >> 4, kb = it & 15; conv_item(w_mkv, 2048, 1024 + 32 * rb, 0, kb * 64, nullptr, (f16*)(ws + WS_WMV), 1024, rb * 32, kb * 64, scr, lane); }
    for (int it = gw; it < 24 * 6; it += NGW) { const int rb = it / 6, kb = it % 6, tile = rb >> 3, g = rb & 7, bj = g >> 2, wc = g & 3; int col, mode = 1;
        if (tile < 2) col = (4 * tile + wc) * 96 + 32 * bj; else { col = (4 * bj + wc) * 96 + 64; mode = 0; }
        conv_item(w_uq, 768, col, mode, kb * 64, P.in[5], (f16*)(ws + WS_WUQ), 384, rb * 32, kb * 64, scr, lane); }
    for (int it = gw; it < 16 * 4; it += NGW) { const int rb = it >> 2, kb = it & 3, tile = rb >> 3, g = rb & 7, bj = g >> 2, wc = g & 3;
        conv_item(w_ukv, 1024, (4 * tile + wc) * 128 + 32 * bj, 1, kb * 64, P.in[7], (f16*)(ws + WS_WUKN), 256, rb * 32, kb * 64, scr, lane); }
    for (int it = gw; it < 16 * 4; it += NGW) { const int rb = it >> 2, kb = it & 3;
        conv_item(w_ukv, 1024, (rb >> 1) * 128 + 64 + 32 * (rb & 1), 0, kb * 64, P.in[7], (f16*)(ws + WS_WUKV), 256, rb * 32, kb * 64, scr, lane); }
    for (int it = gw; it < 32 * 16; it += NGW) { const int rb = it >> 4, kb = it & 15; conv_item(w_o, 1024, 32 * rb, 1, kb * 64, nullptr, (f16*)(ws + WS_WO), 1024, rb * 32, kb * 64, scr, lane); }
    for (int it = gw; it < 32 * 16; it += NGW) { const int rb = it >> 4, kb = it & 15; conv_item(w_mq, 1024, 32 * rb, 1, kb * 64, P.in[16], (f16*)(ws + WS_WMQ), 1024, rb * 32, kb * 64, scr, lane); }
    for (int it = gw; it < 32 * 16; it += NGW) { const int rb = it >> 4, kb = it & 15; conv_item(w_mo, 1024, 32 * rb, 1, kb * 64, nullptr, (f16*)(ws + WS_WMO), 1024, rb * 32, kb * 64, scr, lane); }
    for (int it = gw; it < 64 * 8 * 16; it += NGW) { const int kb = it & 15, rb = (it >> 4) & 7, tile = it >> 7, e = tile >> 2, ffb = tile & 3, bj = rb >> 2, wc = rb & 3;
        conv_item((bj ? w_up : w_gate) + (size_t)e * 1024 * 512, 512, ffb * 128 + 32 * wc, 1, kb * 64, P.in[23], (f16*)(ws + WS_WGU) + (size_t)tile * 256 * 1024, 1024, rb * 32, kb * 64, scr, lane); }
    for (int it = gw; it < 16 * 32 * 8; it += NGW) { const int kb = it & 7, rb = (it >> 3) & 31, e = it >> 8;
        conv_item(w_down + (size_t)e * 512 * 1024, 1024, 32 * rb, 1, kb * 64, nullptr, (f16*)(ws + WS_WD2) + (size_t)e * 1024 * 512, 512, rb * 32, kb * 64, scr, lane); }
    for (int m = gw; m < T; m += 2 * NGW) rms_rows2_to_f16(P.in[0], P.in[3], (f16*)(ws + WS_HN), m, m + NGW, m + NGW < T, lane);
    for (int m = gw; m < 2048; m += 2 * NGW) rms_rows2_to_f16(P.in[1], P.in[17], (f16*)(ws + WS_MN), m, m + NGW, m + NGW < 2048, lane);
    {
        const int gt = F.vcu * NTHR + tid, NGT = F.G * NTHR; const int* pos = (const int*)P.in[2];
        float* COS = (float*)(ws + WS_COS); float* SIN = (float*)(ws + WS_SIN);
        for (int e = gt; e < T * 16; e += NGT) { const int tok = e >> 4, i = e & 15;
            const float invf = i == 0 ? 1.000000000e+00f : i == 1 ? 5.623413324e-01f : i == 2 ? 3.162277639e-01f : i == 3 ? 1.778279394e-01f : i == 4 ? 1.000000015e-01f : i == 5 ? 5.623413250e-02f : i == 6 ? 3.162277490e-02f : i == 7 ? 1.778279431e-02f :
                               i == 8 ? 9.999999776e-03f : i == 9 ? 5.623413250e-03f : i == 10 ? 3.162277630e-03f : i == 11 ? 1.778279431e-03f : i == 12 ? 1.000000047e-03f : i == 13 ? 5.623413017e-04f : i == 14 ? 3.162277571e-04f : 1.778279402e-04f;
            const float ang = (float)pos[tok] * invf;
            const double x = (double)ang; const double n = __builtin_rint(x * 0.15915494309189535); const float rev = (float)(x * 0.15915494309189535 - n);
            COS[e] = __builtin_amdgcn_cosf(rev); SIN[e] = __builtin_amdgcn_sinf(rev); }
        int* TOK = (int*)(ws + WS_TOK);
        for (int e = gt; e < NPOS; e += NGT) TOK[e] = -1;
    }
}

typedef f32x4 Acc[2][2][4][2];
template <bool SSQ>
__device__ __forceinline__ void store_w64(const Acc& acc, int rowb, f16* dst, int ld, int colb, float scale, float* ssq, int ldq, int slot, int fq) {
#pragma unroll
    for (int ai = 0; ai < 2; ++ai)
#pragma unroll
        for (int m = 0; m < 4; ++m) { const int row = rowb + ai * 128 + m * 16; float s = 0.f;
#pragma unroll
            for (int bj = 0; bj < 2; ++bj) { const f32x4 v0 = acc[ai][bj][m][0] * scale, v1 = acc[ai][bj][m][1] * scale;
                if (SSQ) s += dot4(v0) + dot4(v1);
                *(u32x4*)(dst + (size_t)row * ld + colb + bj * 32 + 8 * fq) = pk8(v0, v1); }
            if (SSQ) { s = sum_x32(sum_x16(s)); if (fq == 0) ssq[(size_t)row * ldq + slot] = s; } }
}

struct EpiP1N {
    unsigned char* ws; const float* krg;
    __device__ __forceinline__ void operator()(const Acc& acc, const Unit& u, int wr, int wc, int fr_, int fq_) const {
        int fr = fr_, fq = fq_; asm volatile("" : "+v"(fr), "+v"(fq));
        const int rowb = u.pm * 256 + wr * 64 + fr;
        if (u.aux == 0) { store_w64<false>(acc, rowb, (f16*)(ws + WS_SBQ), 512, (4 * u.pn + wc) * 64, 0.125f * 1.4426950408889634f, nullptr, 0, 0, fq); }
        else if (u.aux == 1) { store_w64<false>(acc, rowb, (f16*)(ws + WS_SBK), 512, (4 * u.pn + wc) * 64, 1.f, nullptr, 0, 0, fq); }
        else if (u.aux == 2) { store_w64<true>(acc, rowb, (f16*)(ws + WS_CQ), 384, 64 * wc, 1.f, (float*)(ws + WS_SSQ_CQ), 8, wc, fq); }
        else if (u.aux == 4) { store_w64<true>(acc, rowb, (f16*)(ws + WS_CKV), 256, 64 * wc, 1.f, (float*)(ws + WS_SSQ_CKV), 4, wc, fq); }
        else if (u.aux == 5) { store_w64<true>(acc, rowb, (f16*)(ws + WS_MKR), 1024, 256 * u.pn + 64 * wc, 1.f, (float*)(ws + WS_SSQ_MK), 16, 4 * u.pn + wc, fq); }
        else {
            f16* CQ = (f16*)(ws + WS_CQ); float* SS = (float*)(ws + WS_SSQ_CQ);
#pragma unroll
            for (int ai = 0; ai < 2; ++ai)
#pragma unroll
                for (int m = 0; m < 4; ++m) { const int row = rowb + ai * 128 + m * 16;
                    const f32x4 v0 = acc[ai][0][m][0], v1 = acc[ai][0][m][1]; float s = dot4(v0) + dot4(v1);
                    *(u32x4*)(CQ + (size_t)row * 384 + 256 + 32 * wc + 8 * fq) = pk8(v0, v1);
                    s = sum_x32(sum_x16(s)); if (fq == 0) SS[(size_t)row * 8 + 4 + wc] = s; }
            if (wc == 0) {
                const float* COS = (const float*)(ws + WS_COS); const float* SIN = (const float*)(ws + WS_SIN); f16* KRF = (f16*)(ws + WS_KRF);
                const f32x4 g1 = *(const f32x4*)(krg + 4 * fq), g2 = *(const f32x4*)(krg + 16 + 4 * fq);
#pragma unroll
                for (int ai = 0; ai < 2; ++ai)
#pragma unroll
                    for (int m = 0; m < 4; ++m) { const int row = rowb + ai * 128 + m * 16;
                        f32x4 x1 = acc[ai][1][m][0], x2 = acc[ai][1][m][1]; float s = dot4(x1) + dot4(x2);
                        s = sum_x32(sum_x16(s));
                        const float rn = __builtin_amdgcn_rsqf(s * (1.f / 32.f) + EPS);
                        x1 = x1 * rn * g1; x2 = x2 * rn * g2;
                        const f32x4 c = *(const f32x4*)(COS + (size_t)row * 16 + 4 * fq), sn = *(const f32x4*)(SIN + (size_t)row * 16 + 4 * fq);
                        const f32x4 o1 = x1 * c - x2 * sn, o2 = x2 * c + x1 * sn;
                        *(u32x2*)(KRF + (size_t)row * 32 + 4 * fq) = pk4(o1); *(u32x2*)(KRF + (size_t)row * 32 + 16 + 4 * fq) = pk4(o2); }
            }
        }
    }
};
struct SchedP1N {
    unsigned char* ws; int G, c;
    __device__ __forceinline__ bool next(int i, Unit& u) const {
        int L = i * G + c;
        if (L < 896) { int pm, pn; pg8::tile_map(L, 128, 7, pm, pn);
            u.A = (const char*)(ws + WS_HN) + (size_t)pm * 256 * 1024 * 2; u.B = (const char*)(ws + WS_WIN) + (size_t)pn * 256 * 1024 * 2; u.pm = pm;
            u.aux = pn < 2 ? 0 : (pn < 4 ? 1 : pn - 2); u.pn = pn < 2 ? pn : (pn < 4 ? pn - 2 : 0); return true; }
        L -= 896; if (L >= 32) return false;
        int pm, pn; pg8::tile_map(L, 8, 4, pm, pn);
        u.A = (const char*)(ws + WS_MN) + (size_t)pm * 256 * 1024 * 2; u.B = (const char*)(ws + WS_WMK) + (size_t)pn * 256 * 1024 * 2; u.pm = pm; u.pn = pn; u.aux = 5; return true;
    }
};
struct EpiP1S {
    unsigned char* ws;
    __device__ __forceinline__ void operator()(const Acc& acc, const Unit& u, int wr, int wc, int fr_, int fq_) const {
        int fr = fr_, fq = fq_; asm volatile("" : "+v"(fr), "+v"(fq));
        const int rowb = u.pm * 256 + wr * 64 + fr;
        if (u.aux == 0) { f16* dst = (f16*)(ws + WS_SBVT);
#pragma unroll
            for (int ai = 0; ai < 2; ++ai)
#pragma unroll
                for (int m = 0; m < 4; ++m) { const size_t ro = (size_t)(rowb + ai * 128 + m * 16) * T + u.pn * 256 + 32 * wc + 8 * (fq & 1) + 4 * (fq >> 1);
#pragma unroll
                    for (int bj = 0; bj < 2; ++bj)
#pragma unroll
                        for (int n = 0; n < 2; ++n) *(u32x2*)(dst + ro + 128 * bj + 16 * n) = pk4(acc[ai][bj][m][n]); }
        } else { f16* dst = (f16*)(ws + WS_MVT);
#pragma unroll
            for (int ai = 0; ai < 2; ++ai)
#pragma unroll
                for (int m = 0; m < 4; ++m) { const size_t ro = (size_t)(rowb + ai * 128 + m * 16) * 2048 + u.pn * 256 + 32 * wc + 8 * fq;
#pragma unroll
                    for (int bj = 0; bj < 2; ++bj)
#pragma unroll
                        for (int n = 0; n < 2; ++n) *(u32x2*)(dst + ro + 128 * bj + 4 * n) = pk4(acc[ai][bj][m][n]); }
        }
    }
};
struct SchedP1S {
    unsigned char* ws; int G, c;
    __device__ __forceinline__ bool next(int i, Unit& u) const {
        int L = i * G + c;
        if (L < 256) { int pm, pn; pg8::tile_map(L, 2, 128, pm, pn);
            u.A = (const char*)(ws + WS_WSV) + (size_t)pm * 256 * 1024 * 2; u.B = (const char*)(ws + WS_HN) + (size_t)pn * 256 * 1024 * 2; u.pm = pm; u.pn = pn; u.aux = 0; return true; }
        L -= 256; if (L >= 32) return false;
        int pm, pn; pg8::tile_map(L, 4, 8, pm, pn);
        u.A = (const char*)(ws + WS_WMV) + (size_t)pm * 256 * 1024 * 2; u.B = (const char*)(ws + WS_MN) + (size_t)pn * 256 * 1024 * 2; u.pm = pm; u.pn = pn; u.aux = 1; return true;
    }
};

constexpr float MLA_QSCALE = 0.10206207261596575f * 1.4426950408889634f;
__device__ __forceinline__ float rq_of(const float* SS8, int row) { const f32x4 a = *(const f32x4*)(SS8 + (size_t)row * 8), b = *(const f32x4*)(SS8 + (size_t)row * 8 + 4);
    return __builtin_amdgcn_rsqf((((a[0] + a[1]) + (a[2] + a[3])) + ((b[0] + b[1]) + (b[2] + b[3]))) * (1.f / 384.f) + EPS); }
__device__ __forceinline__ float rkv_of(const float* SS4, int row) { const f32x4 a = *(const f32x4*)(SS4 + (size_t)row * 4);
    return __builtin_amdgcn_rsqf(((a[0] + a[1]) + (a[2] + a[3])) * (1.f / 256.f) + EPS); }
struct EpiP2Q {
    unsigned char* ws; const float* qng; const float* qrg;
    __device__ __forceinline__ void operator()(const Acc& acc, const Unit& u, int wr, int wc, int fr_, int fq_) const {
        int fr = fr_, fq = fq_; asm volatile("" : "+v"(fr), "+v"(fq));
        const int rowb = u.pm * 256 + wr * 64 + fr; const float* SS = (const float*)(ws + WS_SSQ_CQ); f16* Q = (f16*)(ws + WS_MLAQ);
        if (u.pn < 2) { const int h = 4 * u.pn + wc;
            f32x4 g[2][2];
#pragma unroll
            for (int bj = 0; bj < 2; ++bj)
#pragma unroll
                for (int n = 0; n < 2; ++n) g[bj][n] = *(const f32x4*)(qng + 32 * bj + 8 * fq + 4 * n) * MLA_QSCALE;
#pragma unroll
            for (int ai = 0; ai < 2; ++ai)
#pragma unroll
                for (int m = 0; m < 4; ++m) { const int row = rowb + ai * 128 + m * 16; const float rq = rq_of(SS, row);
                    f32x4 v[2][2]; float s = 0.f;
#pragma unroll
                    for (int bj = 0; bj < 2; ++bj)
#pragma unroll
                        for (int n = 0; n < 2; ++n) { v[bj][n] = acc[ai][bj][m][n] * rq; s += dot4(v[bj][n]); }
                    s = sum_x32(sum_x16(s));
                    const float rn = __builtin_amdgcn_rsqf(s * (1.f / 64.f) + EPS);
#pragma unroll
                    for (int bj = 0; bj < 2; ++bj) *(u32x4*)(Q + (size_t)row * 768 + h * 96 + 32 * bj + 8 * fq) = pk8(v[bj][0] * rn * g[bj][0], v[bj][1] * rn * g[bj][1]); }
        } else {
            const float* COS = (const float*)(ws + WS_COS); const float* SIN = (const float*)(ws + WS_SIN);
            const f32x4 g1 = *(const f32x4*)(qrg + 4 * fq) * MLA_QSCALE, g2 = *(const f32x4*)(qrg + 16 + 4 * fq) * MLA_QSCALE;
#pragma unroll
            for (int ai = 0; ai < 2; ++ai)
#pragma unroll
                for (int m = 0; m < 4; ++m) { const int row = rowb + ai * 128 + m * 16; const float rq = rq_of(SS, row);
                    const f32x4 c = *(const f32x4*)(COS + (size_t)row * 16 + 4 * fq), sn = *(const f32x4*)(SIN + (size_t)row * 16 + 4 * fq);
#pragma unroll
                    for (int bj = 0; bj < 2; ++bj) { const int h = 4 * bj + wc;
                        f32x4 x1 = acc[ai][bj][m][0] * rq, x2 = acc[ai][bj][m][1] * rq; float s = dot4(x1) + dot4(x2);
                        s = sum_x32(sum_x16(s));
                        const float rn = __builtin_amdgcn_rsqf(s * (1.f / 32.f) + EPS);
                        x1 = x1 * rn * g1; x2 = x2 * rn * g2;
                        const f32x4 o1 = x1 * c - x2 * sn, o2 = x2 * c + x1 * sn;
                        *(u32x2*)(Q + (size_t)row * 768 + h * 96 + 64 + 4 * fq) = pk4(o1); *(u32x2*)(Q + (size_t)row * 768 + h * 96 + 80 + 4 * fq) = pk4(o2); } }
        }
    }
};
struct EpiP2K {
    unsigned char* ws; const float* kng;
    __device__ __forceinline__ void operator()(const Acc& acc, const Unit& u, int wr, int wc, int fr_, int fq_) const {
        int fr = fr_, fq = fq_; asm volatile("" : "+v"(fr), "+v"(fq));
        const int rowb = u.pm * 256 + wr * 64 + fr; const float* SS = (const float*)(ws + WS_SSQ_CKV); f16* Kd = (f16*)(ws + WS_MLAK); const f16* KRF = (const f16*)(ws + WS_KRF);
        const int h = 4 * u.pn + wc;
        f32x4 g[2][2];
#pragma unroll
        for (int bj = 0; bj < 2; ++bj)
#pragma unroll
            for (int n = 0; n < 2; ++n) g[bj][n] = *(const f32x4*)(kng + 32 * bj + 8 * fq + 4 * n);
#pragma unroll
        for (int ai = 0; ai < 2; ++ai)
#pragma unroll
            for (int m = 0; m < 4; ++m) { const int row = rowb + ai * 128 + m * 16; const float rk = rkv_of(SS, row);
                f32x4 v[2][2]; float s = 0.f;
#pragma unroll
                for (int bj = 0; bj < 2; ++bj)
#pragma unroll
                    for (int n = 0; n < 2; ++n) { v[bj][n] = acc[ai][bj][m][n] * rk; s += dot4(v[bj][n]); }
                s = sum_x32(sum_x16(s));
                const float rn = __builtin_amdgcn_rsqf(s * (1.f / 64.f) + EPS);
#pragma unroll
                for (int bj = 0; bj < 2; ++bj) *(u32x4*)(Kd + (size_t)row * 768 + h * 96 + 32 * bj + 8 * fq) = pk8(v[bj][0] * rn * g[bj][0], v[bj][1] * rn * g[bj][1]);
                *(u32x4*)(Kd + (size_t)row * 768 + h * 96 + 64 + 8 * fq) = *(const u32x4*)(KRF + (size_t)row * 32 + 8 * fq); }
    }
};
struct EpiP2V {
    unsigned char* ws;
    __device__ __forceinline__ void operator()(const Acc& acc, const Unit& u, int wr, int wc, int fr_, int fq_) const {
        int fr = fr_, fq = fq_; asm volatile("" : "+v"(fr), "+v"(fq));
        const int rowb = u.pm * 256 + wr * 64 + fr; const float* SS = (const float*)(ws + WS_SSQ_CKV); f16* dst = (f16*)(ws + WS_MLAVT);
        f32x4 rk[2][2];
#pragma unroll
        for (int bj = 0; bj < 2; ++bj)
#pragma unroll
            for (int n = 0; n < 2; ++n) { const int tok = u.pn * 256 + 128 * bj + 32 * wc + 16 * n + 4 * fq;
#pragma unroll
                for (int j = 0; j < 4; ++j) rk[bj][n][j] = rkv_of(SS, tok + j); }
#pragma unroll
        for (int ai = 0; ai < 2; ++ai)
#pragma unroll
            for (int m = 0; m < 4; ++m) { const size_t ro = (size_t)(rowb + ai * 128 + m * 16) * T + u.pn * 256 + 32 * wc + 8 * (fq & 1) + 4 * (fq >> 1);
#pragma unroll
                for (int bj = 0; bj < 2; ++bj)
#pragma unroll
                    for (int n = 0; n < 2; ++n) *(u32x2*)(dst + ro + 128 * bj + 16 * n) = pk4(acc[ai][bj][m][n] * rk[bj][n]); }
    }
};
struct SchedGrid {
    const char* A; const char* B; size_t sA, sB; int nM, nN, G, c;
    __device__ __forceinline__ bool next(int i, Unit& u) const {
        const int L = i * G + c; if (L >= nM * nN) return false;
        int pm, pn; pg8::tile_map(L, nM, nN, pm, pn);
        u.A = A + (size_t)pm * sA; u.B = B + (size_t)pn * sB; u.pm = pm; u.pn = pn; u.aux = 0; return true;
    }
};
__device__ __forceinline__ void p2_kprime(Frame& F, const Params& P) {
    PHASE_IDS();
    const int gw = F.vcu * NWAVES + wave, NGW = F.G * NWAVES;
    const f16* MKR = (const f16*)(F.ws + WS_MKR); const float* SS = (const float*)(F.ws + WS_SSQ_MK); f16* KP = (f16*)(F.ws + WS_KP);
    const f32x4 gg = *(const f32x4*)(P.in[21] + 4 * lane) * *(const f32x4*)(P.in[20] + 4 * lane);
    for (int it = gw; it < 2048 * 4; it += NGW) { const int row = it >> 2, h = it & 3, b = row >> 8, key = row & 255;
        const f32x4 a = *(const f32x4*)(SS + (size_t)row * 16 + 4 * h); const float r = __builtin_amdgcn_rsqf(((a[0] + a[1]) + (a[2] + a[3])) * (1.f / 256.f) + EPS);
        const f16x4 x = *(const f16x4*)(MKR + (size_t)row * 1024 + 256 * h + 4 * lane);
        const f32x4 v = (f32x4){(float)x[0], (float)x[1], (float)x[2], (float)x[3]} * r * gg;
        *(u32x2*)(KP + ((size_t)((b * 4 + h) * 256 + key)) * 256 + 4 * lane) = pk4(v); }
}

__device__ __forceinline__ void swap32(float x, float& a, float& b) { const auto rr = __builtin_amdgcn_permlane32_swap(__float_as_uint(x), __float_as_uint(x), false, false); a = __uint_as_float(rr[0]); b = __uint_as_float(rr[1]); }
__device__ __forceinline__ float sum32(float x) { float a, b; swap32(x, a, b); return a + b; }
#define MFMA32(a, b, c) __builtin_amdgcn_mfma_f32_32x32x16_f16((a), (b), (c), 0, 0, 0)
#define MFMA16(a, b, c) __builtin_amdgcn_mfma_f32_16x16x32_f16((a), (b), (c), 0, 0, 0)
__device__ __forceinline__ f16x8 pack8(const f32x16& s, int base) {
    u32x4 w; w.x = pk2(s[base + 0], s[base + 1]); w.y = pk2(s[base + 2], s[base + 3]); w.z = pk2(s[base + 4], s[base + 5]); w.w = pk2(s[base + 6], s[base + 7]);
    return __builtin_bit_cast(f16x8, w);
}
__device__ __forceinline__ f16x8 pack8z(const f32x16& s, int base) {
    typedef __fp16 h2 __attribute__((ext_vector_type(2)));
    const h2 a = __builtin_amdgcn_cvt_pkrtz(s[base + 0], s[base + 1]), b = __builtin_amdgcn_cvt_pkrtz(s[base + 2], s[base + 3]), c = __builtin_amdgcn_cvt_pkrtz(s[base + 4], s[base + 5]), d = __builtin_amdgcn_cvt_pkrtz(s[base + 6], s[base + 7]);
    u32x4 w; w.x = __builtin_bit_cast(unsigned, a); w.y = __builtin_bit_cast(unsigned, b); w.z = __builtin_bit_cast(unsigned, c); w.w = __builtin_bit_cast(unsigned, d);
    return __builtin_bit_cast(f16x8, w);
}
__device__ __forceinline__ float store_ot(const f32x16& o0, const f32x16& o1, float inv, f16* dst, int hf) {
    float ss = 0.f;
#pragma unroll
    for (int g4 = 0; g4 < 4; ++g4) {
        const f32x4 a = (f32x4){o0[4 * g4], o0[4 * g4 + 1], o0[4 * g4 + 2], o0[4 * g4 + 3]} * inv, b = (f32x4){o1[4 * g4], o1[4 * g4 + 1], o1[4 * g4 + 2], o1[4 * g4 + 3]} * inv;
        ss += dot4(a) + dot4(b);
        *(u32x2*)(dst + 8 * g4 + 4 * hf) = pk4(a); *(u32x2*)(dst + 32 + 8 * g4 + 4 * hf) = pk4(b); }
    return ss;
}
struct SbFrag { f16x8 k[4]; f16x8 v[2][2]; };
__device__ __forceinline__ void sb_load(SbFrag& f, const f16* kp, const f16* vp) {
#pragma unroll
    for (int ks = 0; ks < 4; ++ks) f.k[ks] = *(const f16x8*)(kp + 16 * ks);
#pragma unroll
    for (int dvb = 0; dvb < 2; ++dvb)
#pragma unroll
        for (int kk = 0; kk < 2; ++kk) f.v[dvb][kk] = *(const f16x8*)(vp + (size_t)dvb * 32 * T + 16 * kk);
}
__device__ __forceinline__ bool sb_step(const SbFrag& f, const f16x8 (&qf)[4], f32x16& o0, f32x16& o1, float& C, bool diag, int t0, int t, int hf) {
    f32x16 s = {};
#pragma unroll
    for (int ks = 0; ks < 4; ++ks) s = MFMA32(f.k[ks], qf[ks], s);
    float be[16], om[16];
#pragma unroll
    for (int r = 0; r < 16; ++r) { const float z = __builtin_amdgcn_fmed3f(s[r], -115.f, 115.f);
        const float e = __builtin_amdgcn_exp2f(-z); const float bt = __builtin_amdgcn_rcpf(1.f + e);
        be[r] = bt; om[r] = e * bt; }
    if (diag) {
#pragma unroll
        for (int r = 0; r < 16; ++r) { const int key = t0 + 8 * (r >> 2) + 4 * hf + (r & 3); const bool vis = key < t; be[r] = vis ? be[r] : 0.f; om[r] = vis ? om[r] : 1.f; }
    }
    float G[4], PG[4];
#pragma unroll
    for (int q4 = 0; q4 < 4; ++q4) { G[q4] = (om[4 * q4] * om[4 * q4 + 1]) * (om[4 * q4 + 2] * om[4 * q4 + 3]); float a_, b_; swap32(G[q4], a_, b_); PG[q4] = hf == 0 ? b_ : a_; }
    float run = C;
#pragma unroll
    for (int q4 = 3; q4 >= 0; --q4) { float a = hf == 0 ? run * PG[q4] : run;
#pragma unroll
        for (int j = 3; j >= 0; --j) { const int r = 4 * q4 + j; s[r] = be[r] * a; a *= om[r]; }
        run *= G[q4] * PG[q4]; }
    C = run;
#pragma unroll
    for (int kk = 0; kk < 2; ++kk) { const f16x8 pa = pack8(s, 8 * kk); o0 = MFMA32(f.v[0][kk], pa, o0); o1 = MFMA32(f.v[1][kk], pa, o1); }
    return __all(C == 0.f);
}
__device__ __forceinline__ void sb_item(const f16* __restrict__ Qg, const f16* __restrict__ Kg, const f16* __restrict__ Vt, f16* Og, float* SSQ, int b, int h, int qblk, int lane) {
    const int r32 = lane & 31, hf = lane >> 5;
    const int t0 = qblk * 32, t = t0 + r32; const size_t row = (size_t)b * SEQ + t;
    f16x8 qf[4];
#pragma unroll
    for (int ks = 0; ks < 4; ++ks) qf[ks] = *(const f16x8*)(Qg + row * 512 + h * 64 + 16 * ks + 8 * hf);
    f32x16 o0 = {}, o1 = {};
    float C = 1.f;
    const f16* kp = Kg + ((size_t)b * SEQ + t0 + r32) * 512 + h * 64 + 8 * hf;
    const f16* vp = Vt + ((size_t)(h * 64 + r32)) * T + (size_t)b * SEQ + t0 + 8 * hf;
    SbFrag f0, f1, f2;
    sb_load(f0, kp, vp);
    { const int d = qblk >= 1 ? 1 : 0; sb_load(f1, kp - d * 32 * 512, vp - d * 32); }
    int st = qblk;
    for (;;) {
        { const int d = st >= 2 ? 2 : 0; sb_load(f2, kp - d * 32 * 512, vp - d * 32); }
        if (sb_step(f0, qf, o0, o1, C, st == qblk, t0, t, hf)) break;
        if (--st < 0) break; kp -= 32 * 512; vp -= 32;
        { const int d = st >= 2 ? 2 : 0; sb_load(f0, kp - d * 32 * 512, vp - d * 32); }
        if (sb_step(f1, qf, o0, o1, C, false, t0, t, hf)) break;
        if (--st < 0) break; kp -= 32 * 512; vp -= 32;
        { const int d = st >= 2 ? 2 : 0; sb_load(f1, kp - d * 32 * 512, vp - d * 32); }
        if (sb_step(f2, qf, o0, o1, C, false, t0, t, hf)) break;
        if (--st < 0) break; kp -= 32 * 512; vp -= 32;
    }
    const float ss = store_ot(o0, o1, 1.f, Og + row * 1024 + h * 64, hf);
    const float tot = sum32(ss);
    if (hf == 0) SSQ[row * 16 + h] = tot;
}
constexpr int MLA_KROW = 208, MLA_VROW = 144, MLA_KBYTES = 64 * MLA_KROW, MLA_VBYTES = 64 * MLA_VROW, MLA_BUF = MLA_KBYTES + MLA_VBYTES;
__device__ __forceinline__ float max3f(float a, float b, float c) { float r; asm("v_max3_f32 %0, %1, %2, %3" : "=v"(r) : "v"(a), "v"(b), "v"(c)); return r; }
__device__ __forceinline__ float max2f(float a, float b) { float r; asm("v_max_f32_e32 %0, %1, %2" : "=v"(r) : "v"(a), "v"(b)); return r; }
__device__ __forceinline__ void mla_unit(LAS unsigned char* lds, const f16* __restrict__ Qg, const f16* __restrict__ Kg, const f16* __restrict__ Vt, f16* Og, float* SSQ, int b, int h, int qb, int tid) {
    const int lane = tid & 63, wid = __builtin_amdgcn_readfirstlane(tid >> 6), r32 = lane & 31, hf = lane >> 5;
    const size_t row = (size_t)b * SEQ + qb * 256 + wid * 32 + r32;
    const int NT = 4 * qb + 4, my_last = 4 * qb + (wid >> 1);
    const char* src[3]; unsigned dsto[3]; unsigned tstep[3];
#pragma unroll
    for (int i = 0; i < 3; ++i) { int I = wid + 8 * i; if (I >= 22) I -= 2;
        if (I < 13) { const int p = 64 * I + lane, key = p / 13, c = p % 13;
            src[i] = (const char*)(Kg + ((size_t)b * SEQ + key) * 768 + h * 96 + 8 * (c < 12 ? c : 11)); tstep[i] = 64u * 768u * 2u; }
        else { const int p = 64 * (I - 13) + lane, dv = p / 9, c = p % 9;
            src[i] = (const char*)(Vt + (size_t)(h * 64 + dv) * T + (size_t)b * SEQ + 8 * (c < 8 ? c : 7)); tstep[i] = 128u; }
        dsto[i] = (unsigned)(I < 13 ? 1024 * I : MLA_KBYTES + 1024 * (I - 13)); }
#define MLA_ISSUE(tile, bufi) do { _Pragma("unroll") for (int _i = 0; _i < 3; ++_i) \
        __builtin_amdgcn_global_load_lds((const unsigned*)(src[_i] + (size_t)(tile) * tstep[_i]), (LAS unsigned*)(lds + (bufi) * MLA_BUF + __builtin_amdgcn_readfirstlane(dsto[_i])), 16, 0, 0); } while (0)
    f16x8 qf[6];
#pragma unroll
    for (int ks = 0; ks < 6; ++ks) qf[ks] = *(const f16x8*)(Qg + row * 768 + h * 96 + 16 * ks + 8 * hf);
    asm volatile("s_waitcnt vmcnt(0)" ::: "memory");
    __builtin_amdgcn_s_barrier();
    MLA_ISSUE(0, 0); MLA_ISSUE(1, 1);
    f32x16 o0 = {}, o1 = {};
    float lrun = 0.f;
    f32x16 negm;
#pragma unroll
    for (int r = 0; r < 16; ++r) negm[r] = 64.f;
    int bi = 0;
    for (int t = 0; t < NT; ++t) {
        if (t + 1 < NT) asm volatile("s_waitcnt vmcnt(3)" ::: "memory"); else asm volatile("s_waitcnt vmcnt(0)" ::: "memory");
        __builtin_amdgcn_s_barrier();
        asm volatile("" ::: "memory");
        if (t + 2 < NT) { const int nb = bi == 0 ? 2 : bi - 1; MLA_ISSUE(t + 2, nb); }
        if (t <= my_last) {
            const LAS unsigned char* kb_ = lds + bi * MLA_BUF; const LAS unsigned char* vb_ = kb_ + MLA_KBYTES;
            f32x16 s0 = negm, s1 = negm;
#pragma unroll
            for (int ks = 0; ks < 6; ++ks) {
                const f16x8 k0 = *(const LAS f16x8*)(kb_ + r32 * MLA_KROW + (16 * ks + 8 * hf) * 2);
                const f16x8 k1 = *(const LAS f16x8*)(kb_ + (32 + r32) * MLA_KROW + (16 * ks + 8 * hf) * 2);
                s0 = MFMA32(k0, qf[ks], s0); s1 = MFMA32(k1, qf[ks], s1); }
            f16x8 vf0[4], vf1[4];
#pragma unroll
            for (int kk = 0; kk < 4; ++kk) { vf0[kk] = *(const LAS f16x8*)(vb_ + r32 * MLA_VROW + (16 * kk + 8 * hf) * 2); vf1[kk] = *(const LAS f16x8*)(vb_ + (32 + r32) * MLA_VROW + (16 * kk + 8 * hf) * 2); }
            float ta = max3f(s0[0], s1[0], s0[1]), tb = max3f(s1[1], s0[2], s1[2]);
#pragma unroll
            for (int r = 3; r < 15; r += 2) { ta = max3f(ta, s0[r], s1[r]); tb = max3f(tb, s0[r + 1], s1[r + 1]); }
            float tm = max3f(ta, tb, max2f(s0[15], s1[15]));
            { float a_, b_; swap32(tm, a_, b_); tm = max2f(a_, b_); }
            if (__any(tm > 0.f)) {
                const float delta = max2f(tm, 0.f), alpha = __builtin_amdgcn_exp2f(-delta);
                lrun *= alpha; o0 = o0 * alpha; o1 = o1 * alpha;
#pragma unroll
                for (int r = 0; r < 16; ++r) { s0[r] -= delta; s1[r] -= delta; negm[r] -= delta; }
            }
            float ps = 0.f, ps2 = 0.f;
#pragma unroll
            for (int r = 0; r < 16; ++r) { s0[r] = __builtin_amdgcn_exp2f(s0[r]); s1[r] = __builtin_amdgcn_exp2f(s1[r]); ps += s0[r]; ps2 += s1[r]; }
            lrun += ps + ps2;
#pragma unroll
            for (int kk = 0; kk < 4; ++kk) { const f16x8 pa = (kk < 2) ? pack8z(s0, 8 * (kk & 1)) : pack8z(s1, 8 * (kk & 1));
                o0 = MFMA32(vf0[kk], pa, o0); o1 = MFMA32(vf1[kk], pa, o1); }
        }
        bi = bi == 2 ? 0 : bi + 1;
    }
#undef MLA_ISSUE
    const float ltot = sum32(lrun);
    const float ss = store_ot(o0, o1, 1.f / ltot, Og + row * 1024 + 512 + h * 64, hf);
    const float tot = sum32(ss);
    if (hf == 0) SSQ[row * 16 + 8 + h] = tot;
}
template <bool DO_SB = true, bool DO_MLA = true>
__device__ __forceinline__ void p3_attention(Frame& F) {
    PHASE_IDS();
    unsigned char* ws = F.ws;
    f16* ATT = (f16*)(ws + WS_ATT); float* SSQ = (float*)(ws + WS_SSQ_ATT);
    if (DO_SB) {
        const f16* Q = (const f16*)(ws + WS_SBQ); const f16* K = (const f16*)(ws + WS_SBK); const f16* Vt = (const f16*)(ws + WS_SBVT);
        const int gw = F.vcu * NWAVES + wave, NGW = F.G * NWAVES;
        for (int it = gw; it < NB * 8 * 128; it += NGW) { const int qblk = it & 127, h = (it >> 7) & 7, b = it >> 10; sb_item(Q, K, Vt, ATT, SSQ, b, h, qblk, lane); }
    }
    if (DO_MLA) {
        const f16* Q = (const f16*)(ws + WS_MLAQ); const f16* K = (const f16*)(ws + WS_MLAK); const f16* Vt = (const f16*)(ws + WS_MLAVT);
        for (int pr = F.vcu; pr < 64 * 8; pr += F.G) { const int bh = pr >> 3, qa = pr & 7, b = bh >> 3, h = bh & 7;
            mla_unit(F.lds, Q, K, Vt, ATT, SSQ, b, h, 15 - qa, tid);
            mla_unit(F.lds, Q, K, Vt, ATT, SSQ, b, h, qa, tid); }
    }
}
__device__ __forceinline__ void p3b_norm(Frame& F, const Params& P) {
    PHASE_IDS();
    const int gw = F.vcu * NWAVES + wave, NGW = F.G * NWAVES;
    f16* ATT = (f16*)(F.ws + WS_ATT); const float* SSQ = (const float*)(F.ws + WS_SSQ_ATT);
    const f32x4 ga0 = *(const f32x4*)(P.in[13] + 8 * lane), ga1 = *(const f32x4*)(P.in[13] + 8 * lane + 4), gb0 = *(const f32x4*)(P.in[14] + 8 * lane), gb1 = *(const f32x4*)(P.in[14] + 8 * lane + 4);
    for (int row = gw; row < T; row += NGW) {
        const f32x4 a0 = *(const f32x4*)(SSQ + (size_t)row * 16), a1 = *(const f32x4*)(SSQ + (size_t)row * 16 + 4), b0 = *(const f32x4*)(SSQ + (size_t)row * 16 + 8), b1 = *(const f32x4*)(SSQ + (size_t)row * 16 + 12);
        const float ra = __builtin_amdgcn_rsqf((((a0[0] + a0[1]) + (a0[2] + a0[3])) + ((a1[0] + a1[1]) + (a1[2] + a1[3]))) * (1.f / 512.f) + EPS);
        const float rb = __builtin_amdgcn_rsqf((((b0[0] + b0[1]) + (b0[2] + b0[3])) + ((b1[0] + b1[1]) + (b1[2] + b1[3]))) * (1.f / 512.f) + EPS);
        f16* pa = ATT + (size_t)row * 1024 + 8 * lane; f16* pb = pa + 512;
        const f16x8 xa = *(const f16x8*)pa, xb = *(const f16x8*)pb;
        f32x4 va0, va1, vb0, vb1;
#pragma unroll
        for (int j = 0; j < 4; ++j) { va0[j] = (float)xa[j]; va1[j] = (float)xa[4 + j]; vb0[j] = (float)xb[j]; vb1[j] = (float)xb[4 + j]; }
        *(u32x4*)pa = pk8(va0 * ra * ga0, va1 * ra * ga1); *(u32x4*)pb = pk8(vb0 * rb * gb0, vb1 * rb * gb1);
    }
}

struct EpiWo {
    unsigned char* ws; const float* x;
    __device__ __forceinline__ void operator()(const Acc& acc, const Unit& u, int wr, int wc, int fr_, int fq_) const {
        int fr = fr_, fq = fq_; asm volatile("" : "+v"(fr), "+v"(fq));
        const int rowb = u.pm * 256 + wr * 64 + fr, colb = u.pn * 256 + 32 * wc + 8 * fq; f16* H = (f16*)(ws + WS_H1H); float* SS = (float*)(ws + WS_SSQ_H1);
#pragma unroll
        for (int ai = 0; ai < 2; ++ai)
#pragma unroll
            for (int m = 0; m < 4; ++m) { const size_t ro = (size_t)(rowb + ai * 128 + m * 16) * 1024 + colb; float s = 0.f;
#pragma unroll
                for (int bj = 0; bj < 2; ++bj) { const size_t o = ro + 128 * bj;
                    const f32x4 v0 = acc[ai][bj][m][0] + *(const f32x4*)(x + o), v1 = acc[ai][bj][m][1] + *(const f32x4*)(x + o + 4);
                    *(u32x4*)(H + o) = pk8(v0, v1); s += dot4(v0) + dot4(v1); }
                s = sum_x32(sum_x16(s)); if (fq == 0) SS[(size_t)(rowb + ai * 128 + m * 16) * 16 + 4 * u.pn + wc] = s; }
    }
};
struct EpiMq {
    unsigned char* ws;
    __device__ __forceinline__ void operator()(const Acc& acc, const Unit& u, int wr, int wc, int fr_, int fq_) const {
        int fr = fr_, fq = fq_; asm volatile("" : "+v"(fr), "+v"(fq));
        const int rowb = u.pm * 256 + wr * 64 + fr, colb = u.pn * 256 + 32 * wc + 8 * fq; f16* Q = (f16*)(ws + WS_MQ); float* SS = (float*)(ws + WS_SSQ_MQ);
#pragma unroll
        for (int ai = 0; ai < 2; ++ai)
#pragma unroll
            for (int m = 0; m < 4; ++m) { const size_t ro = (size_t)(rowb + ai * 128 + m * 16) * 1024 + colb; float s = 0.f;
#pragma unroll
                for (int bj = 0; bj < 2; ++bj) { const f32x4 v0 = acc[ai][bj][m][0], v1 = acc[ai][bj][m][1]; *(u32x4*)(Q + ro + 128 * bj) = pk8(v0, v1); s += dot4(v0) + dot4(v1); }
                s = sum_x32(sum_x16(s)); if (fq == 0) SS[(size_t)(rowb + ai * 128 + m * 16) * 16 + 4 * u.pn + wc] = s; }
    }
};
struct EpiMo {
    unsigned char* ws;
    __device__ __forceinline__ void operator()(const Acc& acc, const Unit& u, int wr, int wc, int fr_, int fq_) const {
        int fr = fr_, fq = fq_; asm volatile("" : "+v"(fr), "+v"(fq));
        const int rowb = u.pm * 256 + wr * 64 + fr, colb = u.pn * 256 + 32 * wc + 8 * fq; f16* H = (f16*)(ws + WS_H2H); const f16* H1 = (const f16*)(ws + WS_H1H);
#pragma unroll
        for (int ai = 0; ai < 2; ++ai)
#pragma unroll
            for (int m = 0; m < 4; ++m) { const size_t ro = (size_t)(rowb + ai * 128 + m * 16) * 1024 + colb;
#pragma unroll
                for (int bj = 0; bj < 2; ++bj) { const size_t o = ro + 128 * bj; const f16x8 hv = *(const f16x8*)(H1 + o);
                    f32x4 v0 = acc[ai][bj][m][0], v1 = acc[ai][bj][m][1];
#pragma unroll
                    for (int j = 0; j < 4; ++j) { v0[j] += (float)hv[j]; v1[j] += (float)hv[4 + j]; }
                    *(u32x4*)(H + o) = pk8(v0, v1); } }
    }
};

constexpr int MEM_ROWB = 528;
template <int RS>
__device__ __forceinline__ void mem_stage(LAS unsigned char* lds, const f16* src, int tid) {
    const unsigned voff = (unsigned)((tid >> 5) * RS + 8 * (tid & 31)) * 2u;
    const unsigned loff = (unsigned)((tid >> 5) * MEM_ROWB + (tid & 31) * 16);
#pragma unroll
    for (int bt = 0; bt < 4; ++bt) { u32x4 r[4];
#pragma unroll
        for (int i = 0; i < 4; ++i) r[i] = *(const u32x4*)((const char*)src + (size_t)(4 * bt + i) * 16 * RS * 2 + voff);
#pragma unroll
        for (int i = 0; i < 4; ++i) *(LAS u32x4*)(lds + loff + (4 * bt + i) * 16 * MEM_ROWB) = r[i]; }
}
__device__ __forceinline__ void p6_memattn(Frame& F) {
    PHASE_IDS(); unsigned char* ws = F.ws; LAS unsigned char* lds = F.lds; const int wid = wave, l16 = lane & 15, g = lane >> 4;
    const f16* MQ = (const f16*)(ws + WS_MQ); const f16* KP = (const f16*)(ws + WS_KP); const f16* MVT = (const f16*)(ws + WS_MVT); f16* MO = (f16*)(ws + WS_MO);
    const float* SSH = (const float*)(ws + WS_SSQ_H1); const float* SSM = (const float*)(ws + WS_SSQ_MQ);
    for (int un = F.vcu; un < 256; un += F.G) { const int bh = un >> 3, qc = un & 7, b = bh >> 2, h = bh & 3;
        for (int pass = 0; pass < 4; ++pass) {
            const size_t row = (size_t)b * SEQ + qc * 512 + pass * 128 + wid * 16 + l16;
            f16x8 qf[8];
#pragma unroll
            for (int ks = 0; ks < 8; ++ks) qf[ks] = *(const f16x8*)(MQ + row * 1024 + h * 256 + 32 * ks + 8 * g);
            float fac;
            { const f32x4 a0 = *(const f32x4*)(SSH + row * 16), a1 = *(const f32x4*)(SSH + row * 16 + 4), a2 = *(const f32x4*)(SSH + row * 16 + 8), a3 = *(const f32x4*)(SSH + row * 16 + 12);
              const float sh = (((a0[0] + a0[1]) + (a0[2] + a0[3])) + ((a1[0] + a1[1]) + (a1[2] + a1[3]))) + (((a2[0] + a2[1]) + (a2[2] + a2[3])) + ((a3[0] + a3[1]) + (a3[2] + a3[3])));
              const float r1 = __builtin_amdgcn_rsqf(sh * (1.f / 1024.f) + EPS);
              const f32x4 q4 = *(const f32x4*)(SSM + row * 16 + 4 * h); const float mv = ((q4[0] + q4[1]) + (q4[2] + q4[3])) * (1.f / 256.f);
              fac = r1 * __builtin_amdgcn_rsqf(r1 * r1 * mv + EPS) * (0.0625f * 1.4426950408889634f); }
            __syncthreads();
            mem_stage<256>(lds, KP + (size_t)(b * 4 + h) * 256 * 256, tid);
            __syncthreads();
            f32x4 s[16];
#pragma unroll
            for (int kb = 0; kb < 16; ++kb) { s[kb] = (f32x4){0.f, 0.f, 0.f, 0.f};
#pragma unroll
                for (int ks = 0; ks < 8; ++ks) { const f16x8 a = *(const LAS f16x8*)(lds + (16 * kb + l16) * MEM_ROWB + (32 * ks + 8 * g) * 2); s[kb] = MFMA16(a, qf[ks], s[kb]); } }
            float mx = -INFINITY;
#pragma unroll
            for (int kb = 0; kb < 16; ++kb) { s[kb] = s[kb] * fac; mx = __builtin_fmaxf(mx, __builtin_fmaxf(__builtin_fmaxf(s[kb][0], s[kb][1]), __builtin_fmaxf(s[kb][2], s[kb][3]))); }
            mx = __builtin_fmaxf(mx, __shfl_xor(mx, 16)); mx = __builtin_fmaxf(mx, __shfl_xor(mx, 32));
            float sum = 0.f; u32x4 pf[8];
#pragma unroll
            for (int s8 = 0; s8 < 8; ++s8) { f32x4 p0, p1;
#pragma unroll
                for (int j = 0; j < 4; ++j) { p0[j] = __builtin_amdgcn_exp2f(s[2 * s8][j] - mx); p1[j] = __builtin_amdgcn_exp2f(s[2 * s8 + 1][j] - mx); }
                sum += ((p0[0] + p0[1]) + (p0[2] + p0[3])) + ((p1[0] + p1[1]) + (p1[2] + p1[3]));
                pf[s8] = pk8(p0, p1); }
            sum += __shfl_xor(sum, 16); sum += __shfl_xor(sum, 32);
            const float inv = 1.f / sum;
            __syncthreads();
            mem_stage<2048>(lds, MVT + (size_t)(h * 256) * 2048 + b * 256, tid);
            __syncthreads();
#pragma unroll 4
            for (int dvb = 0; dvb < 16; ++dvb) { f32x4 o = (f32x4){0.f, 0.f, 0.f, 0.f};
#pragma unroll
                for (int s8 = 0; s8 < 8; ++s8) { const f16x8 a = *(const LAS f16x8*)(lds + (16 * dvb + l16) * MEM_ROWB + (32 * s8 + 8 * g) * 2); o = MFMA16(a, __builtin_bit_cast(f16x8, pf[s8]), o); }
                *(u32x2*)(MO + row * 1024 + h * 256 + 16 * dvb + 4 * g) = pk4(o * inv); }
        }
    }
}

__device__ __forceinline__ void p8_route(Frame& F, const Params& P) {
    PHASE_IDS(); unsigned char* ws = F.ws;
    LAS float* WR = (LAS float*)F.lds;
    LAS unsigned* hist = (LAS unsigned*)(F.lds + LDS_MISC) + 8;
    const float* w_group = P.in[24]; const float* w_router = P.in[26];
    for (int e = tid; e < 1024 * 20; e += NTHR) { const int d = e / 20, c = e % 20; WR[c * 1024 + d] = c < 4 ? w_group[d * 4 + c] : w_router[d * 16 + (c - 4)]; }
    if (tid < 24) hist[tid] = 0u;
    __syncthreads();
    const f16* H2 = (const f16*)(ws + WS_H2H); const float* gm = P.in[23];
    f32x4 g[4];
#pragma unroll
    for (int k = 0; k < 4; ++k) g[k] = *(const f32x4*)(gm + 256 * k + 4 * lane);
    float bias[20];
#pragma unroll
    for (int c = 0; c < 20; ++c) bias[c] = c < 4 ? P.in[25][c] : P.in[27][c - 4];
    int* BKT = (int*)(ws + WS_BKT); float* RR = (float*)(ws + WS_RR); float* W0 = (float*)(ws + WS_W0); float* W1 = (float*)(ws + WS_W1);
    const int gw = F.vcu * NWAVES + wave, NGW = F.G * NWAVES;
    for (int tok = gw; tok < T; tok += NGW) {
        f32x4 v[4]; float ss = 0.f;
#pragma unroll
        for (int k = 0; k < 4; ++k) { const f16x4 hx = *(const f16x4*)(H2 + (size_t)tok * 1024 + 256 * k + 4 * lane); v[k] = (f32x4){(float)hx[0], (float)hx[1], (float)hx[2], (float)hx[3]}; ss += dot4(v[k]); }
        const float r = __builtin_amdgcn_rsqf(wave_sum(ss) * (1.f / 1024.f) + EPS);
        float lg[20];
#pragma unroll
        for (int c = 0; c < 20; ++c) lg[c] = 0.f;
#pragma unroll
        for (int k = 0; k < 4; ++k) { const f32x4 tv = v[k] * r * g[k];
#pragma unroll
            for (int c = 0; c < 20; ++c) { const f32x4 w = *(const LAS f32x4*)(WR + c * 1024 + 256 * k + 4 * lane); lg[c] += (tv[0] * w[0] + tv[1] * w[1]) + (tv[2] * w[2] + tv[3] * w[3]); }
            __builtin_amdgcn_sched_barrier(0); }
#pragma unroll
        for (int c = 0; c < 20; ++c) lg[c] = wave_sum(lg[c]) + bias[c];
        int gi = 0; float gmx = lg[0];
#pragma unroll
        for (int c = 1; c < 4; ++c) if (lg[c] > gmx) { gmx = lg[c]; gi = c; }
        float gden = 0.f;
#pragma unroll
        for (int c = 0; c < 4; ++c) gden += __expf(lg[c] - gmx);
        const float gw_ = 1.f / gden;
        float el[4];
#pragma unroll
        for (int c = 0; c < 4; ++c) el[c] = gi == 0 ? lg[4 + c] : (gi == 1 ? lg[8 + c] : (gi == 2 ? lg[12 + c] : lg[16 + c]));
        int i1 = 0; float m1 = el[0];
#pragma unroll
        for (int c = 1; c < 4; ++c) if (el[c] > m1) { m1 = el[c]; i1 = c; }
        int i2 = -1; float m2 = -INFINITY;
#pragma unroll
        for (int c = 0; c < 4; ++c) if (c != i1 && el[c] > m2) { m2 = el[c]; i2 = c; }
        const float e2 = __expf(m2 - m1), wa = gw_ / (1.f + e2), wb = gw_ * e2 / (1.f + e2);
        const int lo = i1 < i2 ? i1 : i2, hi = i1 < i2 ? i2 : i1;
        const int pi = lo == 0 ? hi - 1 : (lo == 1 ? hi + 1 : 5);
        const int bk = gi * 6 + pi;
        if (lane == 0) { BKT[tok] = bk; RR[tok] = r; W0[tok] = (i1 < i2) ? wa : wb; W1[tok] = (i1 < i2) ? wb : wa; atomicAdd((unsigned*)&hist[bk], 1u); }
    }
    __syncthreads();
    if (tid < 24) { const unsigned hv = hist[tid]; if (hv) atomicAdd(F.ctl + CW_CNT + tid, hv); }
}
__device__ __forceinline__ void moe_tiles(Frame& F) {
    LAS int* tstart = (LAS int*)(F.lds + LDS_MISC) + 32;
    const int tid0 = fresh_tid();
    __syncthreads();
    if (tid0 == 0) { int acc = 0;
        for (int b = 0; b < 24; ++b) { tstart[b] = acc; acc += (int)((__hip_atomic_load(F.ctl + CW_CNT + b, __ATOMIC_RELAXED, __HIP_MEMORY_SCOPE_AGENT) + 255u) >> 8); }
        tstart[24] = acc; }
    __syncthreads();
}
__device__ __forceinline__ void p9_gather(Frame& F) {
    PHASE_IDS(); unsigned char* ws = F.ws; const int wid = wave;
    moe_tiles(F);
    LAS int* tstart = (LAS int*)(F.lds + LDS_MISC) + 32; LAS int* posarr = (LAS int*)(F.lds + LDS_MISC) + 64;
    const int* BKT = (const int*)(ws + WS_BKT); const float* RR = (const float*)(ws + WS_RR); const float* W0 = (const float*)(ws + WS_W0); const float* W1 = (const float*)(ws + WS_W1);
    int* TOK = (int*)(ws + WS_TOK); float* PR = (float*)(ws + WS_PR); float* PW0 = (float*)(ws + WS_PW0); float* PW1 = (float*)(ws + WS_PW1);
    const f16* H2H = (const f16*)(ws + WS_H2H); f16* TS = (f16*)(ws + WS_TS);
    for (int blk = F.vcu; blk < T / 128; blk += F.G) {
        if (wid < 2) { const int tok = blk * 128 + wid * 64 + lane; const int bk = BKT[tok];
            unsigned mycount = 0u, rank = 0u;
            for (int bb = 0; bb < 24; ++bb) { const unsigned long long mask = __ballot(bk == bb); const unsigned c = (unsigned)__popcll(mask);
                if (lane == bb) mycount = c;
                if (bk == bb) rank = (unsigned)__popcll(mask & ((1ull << lane) - 1ull)); }
            unsigned basev = 0u;
            if (lane < 24 && mycount) basev = atomicAdd(F.ctl + CW_CUR + lane, mycount);
            const unsigned mybase = (unsigned)__shfl((int)basev, bk);
            posarr[wid * 64 + lane] = tstart[bk] * 256 + (int)(mybase + rank); }
        __syncthreads();
#pragma unroll 1
        for (int j0 = 0; j0 < 16; j0 += 4) { u32x4 a[4], b[4]; int pos[4];
#pragma unroll
            for (int j = 0; j < 4; ++j) { const int tl = wid * 16 + j0 + j, tok = blk * 128 + tl; pos[j] = posarr[tl];
                a[j] = *(const u32x4*)(H2H + (size_t)tok * 1024 + 8 * lane); b[j] = *(const u32x4*)(H2H + (size_t)tok * 1024 + 512 + 8 * lane); }
#pragma unroll
            for (int j = 0; j < 4; ++j) { const int tl = wid * 16 + j0 + j, tok = blk * 128 + tl;
                *(u32x4*)(TS + (size_t)pos[j] * 1024 + 8 * lane) = a[j]; *(u32x4*)(TS + (size_t)pos[j] * 1024 + 512 + 8 * lane) = b[j];
                if (lane == 0) { TOK[pos[j]] = tok; PR[pos[j]] = RR[tok]; PW0[pos[j]] = W0[tok]; PW1[pos[j]] = W1[tok]; } } }
        __syncthreads();
    }
}

struct SchedMoe {
    const char* A; const char* B; LAS const int* tstart; int G, c, nct_log2, down;
    __device__ __forceinline__ bool next(int i, Unit& u) const {
        const int L = i * G + c, rt = L >> nct_log2, ct = L & ((1 << nct_log2) - 1);
        if (rt >= tstart[24]) return false;
        int bk = 0;
        for (int b = 1; b < 24; ++b) bk = (rt >= tstart[b]) ? b : bk;
        u.A = A + (size_t)rt * 256 * 1024 * 2; u.pm = rt; u.pn = ct; u.aux = bk;
        int lo, hi; moe_pair(bk % 6, lo, hi);
        if (down) { u.B = B + ((size_t)(4 * (bk / 6) + lo) * 1024 + ct * 256) * 512 * 2; u.B2 = B + ((size_t)(4 * (bk / 6) + hi) * 1024 + ct * 256) * 512 * 2; }
        else { const int e = 4 * (bk / 6) + ((ct >> 2) ? hi : lo); u.B = B + (size_t)(e * 4 + (ct & 3)) * 256 * 1024 * 2; u.B2 = nullptr; }
        return true;
    }
};
struct EpiGU {
    unsigned char* ws;
    __device__ __forceinline__ void operator()(const Acc& acc, const Unit& u, int wr, int wc, int fr_, int fq_) const {
        int fr = fr_, fq = fq_; asm volatile("" : "+v"(fr), "+v"(fq));
        const int rowb = u.pm * 256 + wr * 64 + fr, slot = u.pn >> 2, ffb = u.pn & 3; f16* HE = (f16*)(ws + WS_HE);
        const float* PR = (const float*)(ws + WS_PR); const float* PW = (const float*)(ws + (slot ? WS_PW1 : WS_PW0));
#pragma unroll
        for (int ai = 0; ai < 2; ++ai)
#pragma unroll
            for (int m = 0; m < 4; ++m) { const int row = rowb + ai * 128 + m * 16; const float r = PR[row], w = PW[row];
                f32x4 o[2];
#pragma unroll
                for (int n = 0; n < 2; ++n) { const f32x4 gt = acc[ai][0][m][n] * r, up = acc[ai][1][m][n] * r;
#pragma unroll
                    for (int j = 0; j < 4; ++j) { const float sg = gt[j] * __builtin_amdgcn_rcpf(1.f + __expf(-gt[j])); o[n][j] = sg * up[j] * w; } }
                *(u32x4*)(HE + (size_t)row * 1024 + slot * 512 + ffb * 128 + 32 * wc + 8 * fq) = pk8(o[0], o[1]); }
    }
};
struct EpiDown {
    unsigned char* ws; float* out;
    __device__ __forceinline__ void operator()(const Acc& acc, const Unit& u, int wr, int wc, int fr_, int fq_) const {
        int fr = fr_, fq = fq_; asm volatile("" : "+v"(fr), "+v"(fq));
        const int rowb = u.pm * 256 + wr * 64 + fr, colb = u.pn * 256 + 32 * wc + 8 * fq; const int* TOK = (const int*)(ws + WS_TOK); const f16* H2 = (const f16*)(ws + WS_H2H);
#pragma unroll
        for (int ai = 0; ai < 2; ++ai)
#pragma unroll
            for (int m = 0; m < 4; ++m) { const int tok = TOK[rowb + ai * 128 + m * 16];
                if (tok >= 0) { const size_t ro = (size_t)tok * 1024 + colb;
#pragma unroll
                    for (int bj = 0; bj < 2; ++bj) { const size_t o = ro + 128 * bj; const f16x8 hv = *(const f16x8*)(H2 + o);
                        f32x4 v0 = acc[ai][bj][m][0], v1 = acc[ai][bj][m][1];
#pragma unroll
                        for (int j = 0; j < 4; ++j) { v0[j] += (float)hv[j]; v1[j] += (float)hv[4 + j]; }
                        *(f32x4*)(out + o) = v0; *(f32x4*)(out + o + 4) = v1; } } }
    }
};

#ifndef MK_N_LAUNCHES
#define MK_N_LAUNCHES 1
#endif
constexpr int N_PHASES = 13;
__global__ void __launch_bounds__(NTHR, 2) fwd_kernel(Params P) {
    extern __shared__ __attribute__((aligned(16))) unsigned char lds_raw[];
    Frame F;
    F.lds = (LAS unsigned char*)lds_raw; F.MISC = (volatile LAS unsigned*)(F.lds + LDS_MISC);
    F.G = gridDim.x; F.bx = blockIdx.x; F.vcu = (F.G % 8 == 0) ? (F.bx % 8) * (F.G / 8) + F.bx / 8 : F.bx;
    F.ws = P.ws; F.out = P.out; F.ctl = (unsigned*)(P.ws + WS_CTL);
    for (int u = fresh_tid(); u < (LDS_BYTES - LDS_MISC) / 4; u += NTHR) ((LAS unsigned*)(F.lds + LDS_MISC))[u] = 0u;
    __syncthreads();
    const int lo = P.ph_lo, hi = P.ph_hi;
    const bool multi = (hi - lo) > 1;
    XcdBarrier bar; bar.bar = F.ctl + CW_BAR; bar.x = 0; bar.st = F.MISC;
    if (multi) bar = xcd_barrier_post(F.ctl + CW_BAR, F.MISC);
#define IN(k) (lo <= (k) && (k) < hi)
#define SEAM(k) do { if (IN(k) && IN((k) + 1)) xcd_barrier(bar); } while (0)
    unsigned char* ws = F.ws;
#ifndef PROBE_DUP
#define PROBE_DUP -1
#endif
#define RUN(k, ...) do { if (IN(k)) { __VA_ARGS__ if (PROBE_DUP == (k)) { xcd_barrier(bar); __VA_ARGS__ } } SEAM(k); } while (0)
    RUN(0, { p0_prologue(F, P); });
    RUN(1, {
        { SchedP1N S{ws, F.G, F.bx}; EpiP1N E{ws, P.in[12]}; pg8::gemm_phase<EpiP1N, SchedP1N, true>(F.lds, 1024, 1024, 1024, S, E); }
        { SchedP1S S{ws, F.G, (F.bx + F.G - 160) % F.G}; EpiP1S E{ws}; pg8::gemm_phase<EpiP1S, SchedP1S, true>(F.lds, 1024, 1024, 1024, S, E); }
    });
    RUN(2, {
        p2_kprime(F, P);
        { SchedGrid S{(const char*)(ws + WS_CQ), (const char*)(ws + WS_WUQ), (size_t)256 * 384 * 2, (size_t)256 * 384 * 2, 128, 3, F.G, F.bx}; EpiP2Q E{ws, P.in[9], P.in[10]};
          pg8::gemm_phase<EpiP2Q, SchedGrid, true>(F.lds, 384, 384, 384, S, E); }
        { SchedGrid S{(const char*)(ws + WS_CKV), (const char*)(ws + WS_WUKN), (size_t)256 * 256 * 2, (size_t)256 * 256 * 2, 128, 2, F.G, (F.bx + F.G - 128) % F.G}; EpiP2K E{ws, P.in[11]};
          pg8::gemm_phase<EpiP2K, SchedGrid, true>(F.lds, 256, 256, 256, S, E); }
        { SchedGrid S{(const char*)(ws + WS_WUKV), (const char*)(ws + WS_CKV), (size_t)256 * 256 * 2, (size_t)256 * 256 * 2, 2, 128, F.G, (F.bx + F.G - 128) % F.G}; EpiP2V E{ws};
          pg8::gemm_phase<EpiP2V, SchedGrid, true>(F.lds, 256, 256, 256, S, E); }
    });
    RUN(3, { p3_attention(F); });
    if (PROBE_DUP == 31 && IN(3)) { p3_attention<true, false>(F); xcd_barrier(bar); }
    if (PROBE_DUP == 32 && IN(3)) { p3_attention<false, true>(F); xcd_barrier(bar); }
    RUN(4, { p3b_norm(F, P); });
    RUN(5, { SchedGrid S{(const char*)(ws + WS_ATT), (const char*)(ws + WS_WO), (size_t)256 * 1024 * 2, (size_t)256 * 1024 * 2, 128, 4, F.G, F.bx}; EpiWo E{ws, P.in[0]};
        pg8::gemm_phase<EpiWo, SchedGrid, true>(F.lds, 1024, 1024, 1024, S, E); });
    RUN(6, { SchedGrid S{(const char*)(ws + WS_H1H), (const char*)(ws + WS_WMQ), (size_t)256 * 1024 * 2, (size_t)256 * 1024 * 2, 128, 4, F.G, F.bx}; EpiMq E{ws};
        pg8::gemm_phase<EpiMq, SchedGrid, true>(F.lds, 1024, 1024, 1024, S, E); });
    RUN(7, { p6_memattn(F); });
    RUN(8, { SchedGrid S{(const char*)(ws + WS_MO), (const char*)(ws + WS_WMO), (size_t)256 * 1024 * 2, (size_t)256 * 1024 * 2, 128, 4, F.G, F.bx}; EpiMo E{ws};
        pg8::gemm_phase<EpiMo, SchedGrid, true>(F.lds, 1024, 1024, 1024, S, E); });
    RUN(9, { p8_route(F, P); });
    RUN(10, { p9_gather(F); });
    RUN(11, { moe_tiles(F); SchedMoe S{(const char*)(ws + WS_TS), (const char*)(ws + WS_WGU), (LAS const int*)(F.lds + LDS_MISC) + 32, F.G, F.vcu, 3, 0}; EpiGU E{ws};
        pg8::gemm_phase<EpiGU, SchedMoe, true>(F.lds, 1024, 1024, 1024, S, E); });
    RUN(12, { moe_tiles(F); SchedMoe S{(const char*)(ws + WS_HE), (const char*)(ws + WS_WD2), (LAS const int*)(F.lds + LDS_MISC) + 32, F.G, F.vcu, 2, 1}; EpiDown E{ws, P.out};
        pg8::gemm_phase<EpiDown, SchedMoe, true, true>(F.lds, 1024, 1024, 512, S, E); });
#undef RUN
#undef IN
#undef SEAM
}

extern "C" void kernel_launch(void* const* d_in, const int* in_sizes, int n_in, void* d_out, int out_size, void* d_ws, size_t ws_size, hipStream_t stream) {
    static int grid = 0;
    if (grid == 0) {
        if (n_in != 31 || out_size != T * D || ws_size < WS_END) { fprintf(stderr, "kernel_launch: unexpected shapes (n_in %d, out %d, ws %zu < %zu)\n", n_in, out_size, ws_size, (size_t)WS_END); grid = -1; return; }
        int dev = 0, cus = 0, per_cu = 0;
        if (hipGetDevice(&dev) != hipSuccess || hipDeviceGetAttribute(&cus, hipDeviceAttributeMultiprocessorCount, dev) != hipSuccess) { grid = -1; return; }
        if (hipFuncSetAttribute((const void*)fwd_kernel, hipFuncAttributeMaxDynamicSharedMemorySize, LDS_BYTES) != hipSuccess) { fprintf(stderr, "kernel_launch: hipFuncSetAttribute failed\n"); grid = -1; return; }
        if (hipOccupancyMaxActiveBlocksPerMultiprocessor(&per_cu, (const void*)fwd_kernel, NTHR, LDS_BYTES) != hipSuccess || per_cu < 1) { fprintf(stderr, "kernel_launch: occupancy query says %d\n", per_cu); }
        (void)hipGetLastError();
        grid = cus;
    }
    if (grid < 0) return;
    (void)hipMemsetAsync((char*)d_ws + WS_CTL, 0, CTL_ZERO_BYTES, stream);
    Params p{};
    for (int i = 0; i < 31; ++i) p.in[i] = (const float*)d_in[i];
    p.out = (float*)d_out; p.ws = (unsigned char*)d_ws;
    if (MK_N_LAUNCHES == 1) { p.ph_lo = 0; p.ph_hi = N_PHASES; hipLaunchKernelGGL(fwd_kernel, dim3(grid), dim3(NTHR), LDS_BYTES, stream, p); }
    else { for (int k = 0; k < N_PHASES; ++k) { p.ph_lo = k; p.ph_hi = k + 1; hipLaunchKernelGGL(fwd_kernel, dim3(grid), dim3(NTHR), LDS_BYTES, stream, p); } }
}
```

```cpp
#include <hip/hip_runtime.h>
#include <cstdio>
#include <cstdint>

#define LAS __attribute__((address_space(3)))
#define GAS __attribute__((address_space(1)))
typedef _Float16 f16;
typedef _Float16 f16x8 __attribute__((ext_vector_type(8)));
typedef _Float16 f16x4 __attribute__((ext_vector_type(4)));
typedef _Float16 f16x2 __attribute__((ext_vector_type(2)));
typedef float f32x2 __attribute__((ext_vector_type(2)));
typedef float f32x4 __attribute__((ext_vector_type(4)));
typedef float f32x16 __attribute__((ext_vector_type(16)));
typedef unsigned u32x4 __attribute__((ext_vector_type(4)));
typedef unsigned u32x2 __attribute__((ext_vector_type(2)));

__device__ __forceinline__ unsigned pk2(float lo, float hi) { f16x2 v = {(f16)lo, (f16)hi}; return __builtin_bit_cast(unsigned, v); }
__device__ __forceinline__ u32x4 pk8(f32x4 a, f32x4 b) { u32x4 w; w.x = pk2(a[0], a[1]); w.y = pk2(a[2], a[3]); w.z = pk2(b[0], b[1]); w.w = pk2(b[2], b[3]); return w; }
__device__ __forceinline__ u32x2 pk4(f32x4 a) { u32x2 w; w.x = pk2(a[0], a[1]); w.y = pk2(a[2], a[3]); return w; }
__device__ __forceinline__ float dot4(f32x4 a) { return (a[0] * a[0] + a[1] * a[1]) + (a[2] * a[2] + a[3] * a[3]); }
template <int CTRL> __device__ __forceinline__ float dpp_add(float v) { const int t = __builtin_amdgcn_update_dpp(0, __builtin_bit_cast(int, v), CTRL, 0xf, 0xf, true); return v + __builtin_bit_cast(float, t); }
__device__ __forceinline__ float sum_x16(float x) { const auto rr = __builtin_amdgcn_permlane16_swap(__float_as_uint(x), __float_as_uint(x), false, false); const unsigned a = rr[0], b = rr[1]; return __uint_as_float(a) + __uint_as_float(b); }
__device__ __forceinline__ float sum_x32(float x) { const auto rr = __builtin_amdgcn_permlane32_swap(__float_as_uint(x), __float_as_uint(x), false, false); const unsigned a = rr[0], b = rr[1]; return __uint_as_float(a) + __uint_as_float(b); }
__device__ __forceinline__ float wave_sum(float v) {
    v = dpp_add<0xB1>(v);
    v = dpp_add<0x4E>(v);
    v = dpp_add<0x141>(v);
    v = dpp_add<0x140>(v);
    return sum_x32(sum_x16(v));
}
__device__ __forceinline__ int L32(int q) { return 8 * ((q >> 2) & 3) + 4 * (q >> 4) + (q & 3); }

__device__ __forceinline__ int fresh_tid() { int t = (int)threadIdx.x; asm volatile("" : "+v"(t)); return t; }
constexpr int T = 32768, D = 1024, SEQ = 4096, NB = 8;
constexpr float EPS = 1e-6f;
constexpr int NPOS = 152 * 256;

namespace pg8 {
constexpr int BM = 256, BK = 64, HALF = 128, HTB = HALF * BK * 2, STAGE_BYTES = 8 * HTB;
__host__ __device__ __forceinline__ int lds_byte(int r, int c) { const int st = (r >> 4) * 2 + (c >> 5), rr = r & 15, cc = c & 31, ob = rr * 64 + cc * 2; return st * 1024 + (ob ^ (((ob >> 9) & 1) << 5)); }
__host__ __device__ __forceinline__ void stage_rc(int b, int& R, int& C) { const int st = b / 1024, sb = b % 1024, swz = sb ^ (((sb >> 9) & 1) << 5); R = (st >> 1) * 16 + swz / 64; C = (st & 1) * 32 + (swz % 64) / 2; }
struct Unit { const char* A; const char* B; const char* B2; int pm, pn, aux; };

template <class Epi, class Sched, bool ALIGN_EPI, bool SPLITB = false>
__device__ __forceinline__ void gemm_phase(LAS unsigned char* lds, const int K, const int lda, const int ldb, const Sched& S, const Epi& E) {
    const int tid = fresh_tid(), wid = __builtin_amdgcn_readfirstlane(tid >> 6), lane = tid & 63, wr = wid >> 2, wc = wid & 3, fr = lane & 15, fq = lane >> 4;
    const int nt = K / BK;
    unsigned voffA[2], voffB[2];
#pragma unroll
    for (int i = 0; i < 2; ++i) { int R, C; stage_rc(tid * 16 + i * 8192, R, C); voffA[i] = (unsigned)(R * lda + C) * 2u; voffB[i] = (unsigned)(R * ldb + C) * 2u; }
    const size_t kstep = (size_t)(BK * 2);
    const size_t hstepA = (size_t)HALF * lda * 2, hstepB = (size_t)HALF * ldb * 2;
    const unsigned ldsw = (unsigned)wid * 1024u;
    const int aoff = lds_byte(wr * 64 + fr, fq * 8), boff = lds_byte(wc * 32 + fr, fq * 8);
#define PG8_SA(b, h) (((b) * 2 + (h)) * HTB)
#define PG8_SB(b, h) ((4 + (b) * 2 + (h)) * HTB)
#define PG8_STAGE(bufoff, gbase, voff) do { _Pragma("unroll") for (int _i = 0; _i < 2; ++_i) \
        __builtin_amdgcn_global_load_lds((const unsigned*)((const char*)(gbase) + (voff)[_i]), (LAS unsigned*)(lds + (bufoff) + ldsw + _i * 8192), 16, 0, 0); } while (0)
#define PG8_LDA(dst, b, h) do { _Pragma("unroll") for (int m = 0; m < 4; ++m) _Pragma("unroll") for (int k = 0; k < 2; ++k) dst[m][k] = *(const LAS f16x8*)(lds + PG8_SA(b, h) + aoff + m * 2048 + k * 1024); } while (0)
#define PG8_LDB(dst, b, h) do { _Pragma("unroll") for (int n = 0; n < 2; ++n) _Pragma("unroll") for (int k = 0; k < 2; ++k) dst[n][k] = *(const LAS f16x8*)(lds + PG8_SB(b, h) + boff + n * 2048 + k * 1024); } while (0)
#define PG8_MMA(ai, bj, At, Bt) do { __builtin_amdgcn_s_setprio(1); _Pragma("unroll") for (int m = 0; m < 4; ++m) _Pragma("unroll") for (int n = 0; n < 2; ++n) _Pragma("unroll") for (int k = 0; k < 2; ++k) \
        acc[ai][bj][m][n] = __builtin_amdgcn_mfma_f32_16x16x32_f16(Bt[n][k], At[m][k], acc[ai][bj][m][n], 0, 0, 0); __builtin_amdgcn_s_setprio(0); } while (0)
#define PG8_WAIT_V(n) asm volatile("s_waitcnt vmcnt(" #n ")" ::: "memory")
#define PG8_WAIT_L(n) asm volatile("s_waitcnt lgkmcnt(" #n ")" ::: "memory")
#define PG8_BAR __builtin_amdgcn_s_barrier()
#define PG8_SCHED __builtin_amdgcn_sched_barrier(0)
    Unit cur, nxt; int ui = 0;
    if (!S.next(0, cur)) return;
    f32x4 acc[2][2][4][2];
#pragma unroll
    for (int a = 0; a < 2; ++a)
#pragma unroll
        for (int b = 0; b < 2; ++b)
#pragma unroll
            for (int m = 0; m < 4; ++m)
#pragma unroll
                for (int n = 0; n < 2; ++n) acc[a][b][m][n] = (f32x4){0.f, 0.f, 0.f, 0.f};
    f16x8 At[4][2], B0[2][2], B1[2][2];
    const char* cA = cur.A; const char* cB = cur.B; const char* cB2 = SPLITB ? cur.B2 : nullptr; const int th = nt >> 1;
    PG8_STAGE(PG8_SB(0, 0), cB, voffB); PG8_STAGE(PG8_SB(0, 1), cB + hstepB, voffB); PG8_STAGE(PG8_SA(0, 0), cA, voffA); PG8_STAGE(PG8_SA(0, 1), cA + hstepA, voffA);
    if (wr == 1) PG8_BAR;
    PG8_WAIT_V(2); PG8_BAR;
    PG8_STAGE(PG8_SB(1, 0), cB + kstep, voffB); PG8_STAGE(PG8_SA(1, 0), cA + kstep, voffA); PG8_STAGE(PG8_SB(1, 1), cB + hstepB + kstep, voffB);
    PG8_WAIT_V(6); PG8_BAR;
    for (;;) {
        const bool has_next = S.next(ui + 1, nxt);
        const char* nA = has_next ? nxt.A : cA; const char* nB = has_next ? nxt.B : cB; const char* nB2 = SPLITB ? (has_next ? nxt.B2 : cB2) : nullptr;
        for (int t = 0; t < nt; t += 2) {
            if constexpr (Epi::MIDSCALE) { if (t == th) E.mid(acc, cur, wr, fr); }
            const bool last = (t == nt - 2);
            const char* a1 = cA + (size_t)(t + 1) * kstep;
            const char* a2 = last ? nA : cA + (size_t)(t + 2) * kstep;
            const char* b2 = last ? nB : ((SPLITB && t + 2 >= th) ? cB2 + (size_t)(t + 2 - th) * kstep : cB + (size_t)(t + 2) * kstep);
            const char* a3 = a2 + kstep; const char* b3 = b2 + kstep;
            PG8_LDB(B0, 0, 0); PG8_LDB(B1, 0, 1); PG8_SCHED; PG8_LDA(At, 0, 0); PG8_STAGE(PG8_SA(1, 1), a1 + hstepA, voffA);
            PG8_WAIT_V(8); PG8_WAIT_L(0); PG8_BAR; PG8_MMA(0, 0, At, B0); PG8_MMA(0, 1, At, B1); PG8_BAR; PG8_SCHED;
            PG8_LDA(At, 0, 1); PG8_STAGE(PG8_SB(0, 0), b2, voffB); PG8_STAGE(PG8_SB(0, 1), b2 + hstepB, voffB); PG8_STAGE(PG8_SA(0, 0), a2, voffA);
            PG8_WAIT_V(8); PG8_WAIT_L(0); PG8_BAR; PG8_MMA(1, 0, At, B0); PG8_MMA(1, 1, At, B1); PG8_BAR; PG8_SCHED;
            PG8_LDB(B0, 1, 0); PG8_LDB(B1, 1, 1); PG8_SCHED; PG8_LDA(At, 1, 0); PG8_STAGE(PG8_SA(0, 1), a2 + hstepA, voffA);
            PG8_WAIT_V(8); PG8_WAIT_L(0); PG8_BAR; PG8_MMA(0, 0, At, B0); PG8_MMA(0, 1, At, B1); PG8_BAR; PG8_SCHED;
            PG8_LDA(At, 1, 1); PG8_STAGE(PG8_SB(1, 0), b3, voffB); PG8_STAGE(PG8_SB(1, 1), b3 + hstepB, voffB); PG8_STAGE(PG8_SA(1, 0), a3, voffA);
            PG8_WAIT_V(8); PG8_WAIT_L(0); PG8_BAR; PG8_MMA(1, 0, At, B0); PG8_MMA(1, 1, At, B1); PG8_BAR; PG8_SCHED;
        }
        if constexpr (ALIGN_EPI) { if (wr == 0) PG8_BAR; }
        E(acc, cur, wr, wc, fr, fq);
        if (!has_next) break;
#pragma unroll
        for (int a = 0; a < 2; ++a)
#pragma unroll
            for (int b = 0; b < 2; ++b)
#pragma unroll
                for (int m = 0; m < 4; ++m)
#pragma unroll
                    for (int n = 0; n < 2; ++n) acc[a][b][m][n] = (f32x4){0.f, 0.f, 0.f, 0.f};
        cur = nxt; cA = nA; cB = nB; cB2 = nB2; ++ui;
        if constexpr (ALIGN_EPI) { if (wr == 1) PG8_BAR; }
    }
    PG8_WAIT_V(0);
    if constexpr (!ALIGN_EPI) { if (wr == 0) PG8_BAR; }
    PG8_BAR;
#undef PG8_SA
#undef PG8_SB
#undef PG8_STAGE
#undef PG8_LDA
#undef PG8_LDB
#undef PG8_MMA
#undef PG8_WAIT_V
#undef PG8_WAIT_L
#undef PG8_BAR
#undef PG8_SCHED
}
__device__ __forceinline__ void tile_map(int L, int nM, int nN, int& pm, int& pn) {
    const int nwg = nM * nN; int wgid = L;
    { const int q = nwg / 8, r = nwg % 8, xcd = wgid % 8, off = wgid / 8; wgid = (xcd < r ? xcd * (q + 1) : r * (q + 1) + (xcd - r) * q) + off; }
    const int nig = 8 * nN, gid = wgid / nig, fm = gid * 8, gsz = (nM - fm) < 8 ? (nM - fm) : 8;
    pm = fm + ((wgid % nig) % gsz); pn = (wgid % nig) / gsz;
}
}
using pg8::Unit;

#define XB_TMO      128
#define XB_XCNT(j)  (256  + 64 * (j))
#define XB_XSUB(j)  (1280 + 64 * (j))
#define XB_XGEN(j)  (2304 + 64 * (j))
#define XB_TOP      3328
#define XB_TOPGEN   3392
#define XCD_BAR_WORDS 3456
#define XB_SPIN_CAP (1u << 18)
__device__ __forceinline__ unsigned xb_ld(unsigned* p)              { return __hip_atomic_load(p, __ATOMIC_RELAXED, __HIP_MEMORY_SCOPE_AGENT); }
__device__ __forceinline__ unsigned xb_add(unsigned* p, unsigned v) { return __hip_atomic_fetch_add(p, v, __ATOMIC_RELAXED, __HIP_MEMORY_SCOPE_AGENT); }
__device__ __forceinline__ unsigned xb_xcc_id() { return (unsigned)__builtin_amdgcn_s_getreg((3 << 11) | 20) & 0xFu; }
#define XB_SPIN(cond, bar) do { unsigned _sp = 0; while (cond) { __builtin_amdgcn_s_sleep(1); \
    if ((++_sp & 255u) == 0u) { if (xb_ld(&(bar)[XB_TMO])) break; if (_sp > XB_SPIN_CAP) { atomicAdd(&(bar)[XB_TMO], 1u); break; } } } } while (0)
struct XcdBarrier { unsigned* bar; unsigned x; volatile LAS unsigned* st; };
__device__ __forceinline__ XcdBarrier xcd_barrier_post(unsigned* bar, volatile LAS unsigned* st) {
    XcdBarrier b; b.bar = bar; b.x = xb_xcc_id(); b.st = st;
    if (threadIdx.x == 0) (void)xb_add(&bar[XB_XCNT(b.x)], 1u);
    return b;
}
__device__ __forceinline__ void xcd_barrier_complete(unsigned* bar, unsigned x, unsigned& nloc, unsigned& nx) {
    const unsigned G = gridDim.x * gridDim.y * gridDim.z;
    unsigned sum, cnt, mine, sp = 0u;
    for (;;) {
        sum = 0u; cnt = 0u; mine = 0u;
#pragma unroll
        for (unsigned j = 0; j < 16; ++j) { const unsigned c = xb_ld(&bar[XB_XCNT(j)]); sum += c; cnt += (c > 0u) ? 1u : 0u; mine = (j == x) ? c : mine; }
        if (sum == G) break;
        __builtin_amdgcn_s_sleep(1);
        if ((++sp & 255u) == 0u) { if (xb_ld(&bar[XB_TMO])) break; if (sp > XB_SPIN_CAP) { atomicAdd(&bar[XB_TMO], 1u); break; } }
    }
    nloc = mine > 0u ? mine : 1u; nx = cnt > 0u ? cnt : 1u;
}
__device__ __forceinline__ void xcd_barrier(const XcdBarrier& b) {
    asm volatile("s_waitcnt vmcnt(0)" ::: "memory");
    __syncthreads();
    if (threadIdx.x == 0) {
        unsigned* bar = b.bar;
        __builtin_amdgcn_s_waitcnt(0);
        unsigned nloc = b.st[0], nx = b.st[1];
        if (nloc == 0u) { xcd_barrier_complete(bar, b.x, nloc, nx); b.st[0] = nloc; b.st[1] = nx; }
        const unsigned old = xb_add(&bar[XB_XSUB(b.x)], 1u);
        const unsigned gen = old / nloc;
        if (old + 1u == (gen + 1u) * nloc) {
            __builtin_amdgcn_fence(__ATOMIC_RELEASE, "agent");
            asm volatile("s_waitcnt vmcnt(0)" ::: "memory");
            const unsigned og = xb_add(&bar[XB_TOP], 1u);
            const unsigned tg = og / nx;
            if (og + 1u == (tg + 1u) * nx) xb_add(&bar[XB_TOPGEN], 1u);
            else XB_SPIN(xb_ld(&bar[XB_TOPGEN]) == tg, bar);
            __builtin_amdgcn_fence(__ATOMIC_ACQUIRE, "agent");
            xb_add(&bar[XB_XGEN(b.x)], 1u);
            asm volatile("s_waitcnt vmcnt(0)" ::: "memory");
        } else {
            XB_SPIN(xb_ld(&bar[XB_XGEN(b.x)]) == gen, bar);
            __builtin_amdgcn_fence(__ATOMIC_ACQUIRE, "agent");
            asm volatile("s_waitcnt vmcnt(0)" ::: "memory");
        }
    }
    __syncthreads();
}

constexpr size_t MiB = 1u << 20;
constexpr size_t WS_CTL = 0, CTL_ZERO_BYTES = 65536;
constexpr int CW_BAR = 1024;
constexpr int CW_CNT = 8192;
constexpr int CW_CUR = 8192 + 64;
constexpr size_t WS_SSQ_CQ  = 1 * MiB;
constexpr size_t WS_SSQ_CKV = 2 * MiB;
constexpr size_t WS_SSQ_MK  = 2 * MiB + 512 * 1024;
constexpr size_t WS_SSQ_ATT = 3 * MiB;
constexpr size_t WS_SSQ_H1  = 5 * MiB;
constexpr size_t WS_SSQ_MQ  = 7 * MiB;
constexpr size_t WS_COS     = 9 * MiB;
constexpr size_t WS_SIN     = 11 * MiB;
constexpr size_t WS_BKT     = 13 * MiB;
constexpr size_t WS_RR      = 13 * MiB + 128 * 1024;
constexpr size_t WS_W0      = 13 * MiB + 256 * 1024;
constexpr size_t WS_W1      = 13 * MiB + 384 * 1024;
constexpr size_t WS_TOK     = 13 * MiB + 512 * 1024;
constexpr size_t WS_PR      = 13 * MiB + 704 * 1024;
constexpr size_t WS_PW0     = 14 * MiB;
constexpr size_t WS_PW1     = 14 * MiB + 192 * 1024;
constexpr size_t WS_KRF     = 14 * MiB + 512 * 1024;
constexpr size_t WS_WIN  = 17 * MiB;
constexpr size_t WS_WSV  = WS_WIN  + 3584 * 1024;
constexpr size_t WS_WMK  = WS_WSV  + 1 * MiB;
constexpr size_t WS_WMV  = WS_WMK  + 2 * MiB;
constexpr size_t WS_WUQ  = WS_WMV  + 2 * MiB;
constexpr size_t WS_WUKN = WS_WUQ  + 1 * MiB;
constexpr size_t WS_WUKV = WS_WUKN + 256 * 1024;
constexpr size_t WS_WO   = WS_WUKV + 256 * 1024;
constexpr size_t WS_WMQ  = WS_WO   + 2 * MiB;
constexpr size_t WS_WMO  = WS_WMQ  + 2 * MiB;
constexpr size_t WS_WGU  = WS_WMO  + 2 * MiB;
constexpr size_t WS_WD2  = WS_WGU  + 32 * MiB;
constexpr size_t WS_WEND = WS_WD2  + 48 * MiB;
constexpr size_t WS_MN   = 114 * MiB;
constexpr size_t WS_MKR  = 118 * MiB;
constexpr size_t WS_MVT  = 122 * MiB;
constexpr size_t WS_KP   = 126 * MiB;
constexpr size_t WS_R1   = 130 * MiB;
constexpr size_t WS_R2   = 194 * MiB;
constexpr size_t WS_R3   = 290 * MiB;
constexpr size_t WS_R4   = 330 * MiB;
constexpr size_t WS_END  = 458 * MiB;
static_assert(WS_WEND <= WS_MN, "ws map");
constexpr size_t WS_HN = WS_R1, WS_ATT = WS_R1, WS_MQ = WS_R1, WS_H2H = WS_R1;
constexpr size_t WS_SBQ = WS_R2, WS_SBK = WS_R2 + 32 * MiB, WS_SBVT = WS_R2 + 64 * MiB, WS_H1H = WS_R2, WS_TS = WS_R2;
constexpr size_t WS_CQ = WS_R3, WS_CKV = WS_R3 + 24 * MiB;
constexpr size_t WS_MLAQ = WS_R4, WS_MLAK = WS_R4 + 48 * MiB, WS_MLAVT = WS_R4 + 96 * MiB, WS_HE = WS_R4, WS_MO = WS_R4;

constexpr int LDS_BYTES = 147456;
constexpr int LDS_MISC = 143360;
constexpr int NWAVES = 8, NTHR = 512;

struct Params { const float* in[31]; float* out; unsigned char* ws; int ph_lo, ph_hi; };

struct Frame {
    LAS unsigned char* lds; volatile LAS unsigned* MISC;
    int vcu, G, bx;
    unsigned char* ws; float* out; unsigned* ctl;
};
#define PHASE_IDS() const int tid = fresh_tid(), lane = tid & 63, wave = __builtin_amdgcn_readfirstlane(tid >> 6); (void)lane; (void)wave

__device__ __forceinline__ void conv_item(const float* src, int ld, int srccol0, int mode, int ksrc0, const float* kscale, f16* dst, int K, int row0, int k0, LAS float* scr, int lane) {
    if (mode != 2) {
        const float* base = src + (size_t)ksrc0 * ld + srccol0;
        const unsigned voff = (unsigned)((lane >> 5) * ld + (lane & 31)) * 4u;
        float v[32];
#pragma unroll
        for (int i = 0; i < 32; ++i) v[i] = *(const float*)((const char*)(base + (size_t)2 * i * ld) + voff);
#pragma unroll
        for (int i = 0; i < 32; ++i) scr[(2 * i + (lane >> 5)) * 33 + (lane & 31)] = v[i];
    }
    asm volatile("s_waitcnt lgkmcnt(0)" ::: "memory");
    const int c = lane & 7;
    f32x4 ks0 = (f32x4){1.f, 1.f, 1.f, 1.f}, ks1 = ks0;
    if (kscale) { ks0 = *(const f32x4*)(kscale + ksrc0 + 8 * c); ks1 = *(const f32x4*)(kscale + ksrc0 + 8 * c + 4); }
#pragma unroll
    for (int j = 0; j < 4; ++j) { const int q = (lane >> 3) + 8 * j; const int lc = (mode == 1) ? L32(q) : q; const LAS float* s = scr + (8 * c) * 33 + lc;
        u32x4 o;
        if (mode == 2) { o = (u32x4){0u, 0u, 0u, 0u}; }
        else { o.x = pk2(s[0 * 33] * ks0[0], s[1 * 33] * ks0[1]); o.y = pk2(s[2 * 33] * ks0[2], s[3 * 33] * ks0[3]); o.z = pk2(s[4 * 33] * ks1[0], s[5 * 33] * ks1[1]); o.w = pk2(s[6 * 33] * ks1[2], s[7 * 33] * ks1[3]); }
        *(u32x4*)(dst + (size_t)(row0 + q) * K + k0 + 8 * c) = o; }
    asm volatile("s_waitcnt lgkmcnt(0)" ::: "memory");
}
__device__ __forceinline__ void rms_rows2_to_f16(const float* x, const float* g, f16* o, int m0, int m1, bool has1, int lane) {
    const f32x4* x0 = (const f32x4*)(x + (size_t)m0 * D) + lane; const f32x4* x1 = (const f32x4*)(x + (size_t)m1 * D) + lane; const f32x4* gr = (const f32x4*)g + lane;
    f32x4 v[4], w[4]; float s0 = 0.f, s1 = 0.f;
#pragma unroll
    for (int j = 0; j < 4; ++j) v[j] = x0[64 * j];
    if (has1) {
#pragma unroll
        for (int j = 0; j < 4; ++j) w[j] = x1[64 * j];
    } else {
#pragma unroll
        for (int j = 0; j < 4; ++j) w[j] = (f32x4){0.f, 0.f, 0.f, 0.f};
    }
#pragma unroll
    for (int j = 0; j < 4; ++j) { s0 += dot4(v[j]); s1 += dot4(w[j]); }
    s0 = wave_sum(s0); s1 = wave_sum(s1);
    const float r0 = __builtin_amdgcn_rsqf(s0 * (1.f / 1024.f) + EPS), r1 = __builtin_amdgcn_rsqf(s1 * (1.f / 1024.f) + EPS);
    u32x2* o0 = (u32x2*)(o + (size_t)m0 * D) + lane; u32x2* o1 = (u32x2*)(o + (size_t)m1 * D) + lane;
#pragma unroll
    for (int j = 0; j < 4; ++j) { const f32x4 gg = gr[64 * j]; o0[64 * j] = pk4(v[j] * r0 * gg); if (has1) o1[64 * j] = pk4(w[j] * r1 * gg); }
}
__device__ __forceinline__ void moe_pair(int pi, int& lo, int& hi) { lo = pi < 3 ? 0 : (pi < 5 ? 1 : 2); hi = pi < 3 ? pi + 1 : (pi < 5 ? pi - 1 : 3); }

__device__ __forceinline__ void p0_prologue(Frame& F, const Params& P) {
    PHASE_IDS();
    LAS float* scr = (LAS float*)(F.lds + wave * 16384);
    const int gw = F.vcu * NWAVES + wave, NGW = F.G * NWAVES;
    unsigned char* ws = F.ws;
    const float* w_in = P.in[4]; const float* w_uq = P.in[6]; const float* w_ukv = P.in[8]; const float* w_o = P.in[15];
    const float* w_mq = P.in[18]; const float* w_mkv = P.in[19]; const float* w_mo = P.in[22];
    const float* w_gate = P.in[28]; const float* w_up = P.in[29]; const float* w_down = P.in[30];
    for (int it = gw; it < 56 * 16; it += NGW) { const int rb = it >> 4, kb = it & 15, tile = rb >> 3, g = rb & 7, bj = g >> 2, wc = g & 3; int col, mode = 1;
        if (tile < 2) col = (4 * tile + wc) * 64 + 32 * bj;
        else if (tile < 4) col = 512 + (4 * (tile - 2) + wc) * 64 + 32 * bj;
        else if (tile == 4) col = 1536 + 64 * wc + 32 * bj;
        else if (tile == 5) { if (bj == 0) col = 1536 + 256 + 32 * wc; else if (wc == 0) { col = 2176; mode = 0; } else { col = 0; mode = 2; } }
        else col = 1920 + 64 * wc + 32 * bj;
        conv_item(w_in, 2208, col, mode, kb * 64, nullptr, (f16*)(ws + WS_WIN), 1024, rb * 32, kb * 64, scr, lane); }
    for (int it = gw; it < 16 * 16; it += NGW) { const int rb = it >> 4, kb = it & 15; conv_item(w_in, 2208, 1024 + 32 * rb, 0, kb * 64, nullptr, (f16*)(ws + WS_WSV), 1024, rb * 32, kb * 64, scr, lane); }
    for (int it = gw; it < 32 * 16; it += NGW) { const int rb = it >> 4, kb = it & 15, tile = rb >> 3, g = rb & 7, bj = g >> 2, wc = g & 3;
        conv_item(w_mkv, 2048, 256 * tile + 64 * wc + 32 * bj, 1, kb * 64, nullptr, (f16*)(ws + WS_WMK), 1024, rb * 32, kb * 64, scr, lane); }
    for (int it = gw; it < 32 * 16; it += NGW) { const int rb = it >> 4, kb = it & 15; conv_item(w_mkv, 2048, 1024 + 32 * rb, 0, kb * 64, nullptr, (f16*)(ws + WS_WMV), 1024, rb * 32, kb * 64, scr, lane); }
    for (int it = gw; it < 24 * 6; it += NGW) { const int rb = it / 6, kb = it % 6, tile = rb >> 3, g = rb & 7, bj = g >> 2, wc = g & 3; int col, mode = 1;
        if (tile < 2) col = (4 * tile + wc) * 96 + 32 * bj; else { col = (4 * bj + wc) * 96 + 64; mode = 0; }
        conv_item(w_uq, 768, col, mode, kb * 64, P.in[5], (f16*)(ws + WS_WUQ), 384, rb * 32, kb * 64, scr, lane); }
    for (int it = gw; it < 16 * 4; it += NGW) { const int rb = it >> 2, kb = it & 3, tile = rb >> 3, g = rb & 7, bj = g >> 2, wc = g & 3;
        conv_item(w_ukv, 1024, (4 * tile + wc) * 128 + 32 * bj, 1, kb * 64, P.in[7], (f16*)(ws + WS_WUKN), 256, rb * 32, kb * 64, scr, lane); }
    for (int it = gw; it < 16 * 4; it += NGW) { const int rb = it >> 2, kb = it & 3;
        conv_item(w_ukv, 1024, (rb >> 1) * 128 + 64 + 32 * (rb & 1), 0, kb * 64, P.in[7], (f16*)(ws + WS_WUKV), 256, rb * 32, kb * 64, scr, lane); }
    for (int it = gw; it < 32 * 16; it += NGW) { const int rb = it >> 4, kb = it & 15; conv_item(w_o, 1024, 32 * rb, 1, kb * 64, kb < 8 ? P.in[13] : P.in[14] - 512, (f16*)(ws + WS_WO), 1024, rb * 32, kb * 64, scr, lane); }
    for (int it = gw; it < 32 * 16; it += NGW) { const int rb = it >> 4, kb = it & 15; conv_item(w_mq, 1024, 32 * rb, 1, kb * 64, P.in[16], (f16*)(ws + WS_WMQ), 1024, rb * 32, kb * 64, scr, lane); }
    for (int it = gw; it < 32 * 16; it += NGW) { const int rb = it >> 4, kb = it & 15; conv_item(w_mo, 1024, 32 * rb, 1, kb * 64, nullptr, (f16*)(ws + WS_WMO), 1024, rb * 32, kb * 64, scr, lane); }
    for (int it = gw; it < 64 * 8 * 16; it += NGW) { const int kb = it & 15, rb = (it >> 4) & 7, tile = it >> 7, e = tile >> 2, ffb = tile & 3, bj = rb >> 2, wc = rb & 3;
        conv_item((bj ? w_up : w_gate) + (size_t)e * 1024 * 512, 512, ffb * 128 + 32 * wc, 1, kb * 64, P.in[23], (f16*)(ws + WS_WGU) + (size_t)tile * 256 * 1024, 1024, rb * 32, kb * 64, scr, lane); }
    for (int it = gw; it < 16 * 32 * 8; it += NGW) { const int kb = it & 7, rb = (it >> 3) & 31, e = it >> 8;
        conv_item(w_down + (size_t)e * 512 * 1024, 1024, 32 * rb, 1, kb * 64, nullptr, (f16*)(ws + WS_WD2) + (size_t)e * 1024 * 512, 512, rb * 32, kb * 64, scr, lane); }
    for (int m = gw; m < T; m += 2 * NGW) rms_rows2_to_f16(P.in[0], P.in[3], (f16*)(ws + WS_HN), m, m + NGW, m + NGW < T, lane);
    for (int m = gw; m < 2048; m += 2 * NGW) rms_rows2_to_f16(P.in[1], P.in[17], (f16*)(ws + WS_MN), m, m + NGW, m + NGW < 2048, lane);
    {
        const int gt = F.vcu * NTHR + tid, NGT = F.G * NTHR; const int* pos = (const int*)P.in[2];
        float* COS = (float*)(ws + WS_COS); float* SIN = (float*)(ws + WS_SIN);
        for (int e = gt; e < T * 16; e += NGT) { const int tok = e >> 4, i = e & 15;
            const float invf = i == 0 ? 1.000000000e+00f : i == 1 ? 5.623413324e-01f : i == 2 ? 3.162277639e-01f : i == 3 ? 1.778279394e-01f : i == 4 ? 1.000000015e-01f : i == 5 ? 5.623413250e-02f : i == 6 ? 3.162277490e-02f : i == 7 ? 1.778279431e-02f :
                               i == 8 ? 9.999999776e-03f : i == 9 ? 5.623413250e-03f : i == 10 ? 3.162277630e-03f : i == 11 ? 1.778279431e-03f : i == 12 ? 1.000000047e-03f : i == 13 ? 5.623413017e-04f : i == 14 ? 3.162277571e-04f : 1.778279402e-04f;
            const float ang = (float)pos[tok] * invf;
            const double x = (double)ang; const double n = __builtin_rint(x * 0.15915494309189535); const float rev = (float)(x * 0.15915494309189535 - n);
            COS[e] = __builtin_amdgcn_cosf(rev); SIN[e] = __builtin_amdgcn_sinf(rev); }
        int* TOK = (int*)(ws + WS_TOK);
        for (int e = gt; e < NPOS; e += NGT) TOK[e] = -1;
    }
}

typedef f32x4 Acc[2][2][4][2];
template <bool SSQ>
__device__ __forceinline__ void store_w64(const Acc& acc, int rowb, f16* dst, int ld, int colb, float scale, float* ssq, int ldq, int slot, int fq) {
#pragma unroll
    for (int ai = 0; ai < 2; ++ai)
#pragma unroll
        for (int m = 0; m < 4; ++m) { const int row = rowb + ai * 128 + m * 16; float s = 0.f;
#pragma unroll
            for (int bj = 0; bj < 2; ++bj) { const f32x4 v0 = acc[ai][bj][m][0] * scale, v1 = acc[ai][bj][m][1] * scale;
                if (SSQ) s += dot4(v0) + dot4(v1);
                *(u32x4*)(dst + (size_t)row * ld + colb + bj * 32 + 8 * fq) = pk8(v0, v1); }
            if (SSQ) { s = sum_x32(sum_x16(s)); if (fq == 0) ssq[(size_t)row * ldq + slot] = s; } }
}

struct EpiP1N {
    static constexpr bool MIDSCALE = false;
    unsigned char* ws; const float* krg;
    __device__ __forceinline__ void operator()(const Acc& acc, const Unit& u, int wr, int wc, int fr_, int fq_) const {
        int fr = fr_, fq = fq_; asm volatile("" : "+v"(fr), "+v"(fq));
        const int rowb = u.pm * 256 + wr * 64 + fr;
        if (u.aux == 0) { store_w64<false>(acc, rowb, (f16*)(ws + WS_SBQ), 512, (4 * u.pn + wc) * 64, 0.125f * 1.4426950408889634f, nullptr, 0, 0, fq); }
        else if (u.aux == 1) { store_w64<false>(acc, rowb, (f16*)(ws + WS_SBK), 512, (4 * u.pn + wc) * 64, 1.f, nullptr, 0, 0, fq); }
        else if (u.aux == 2) { store_w64<true>(acc, rowb, (f16*)(ws + WS_CQ), 384, 64 * wc, 1.f, (float*)(ws + WS_SSQ_CQ), 8, wc, fq); }
        else if (u.aux == 4) { store_w64<true>(acc, rowb, (f16*)(ws + WS_CKV), 256, 64 * wc, 1.f, (float*)(ws + WS_SSQ_CKV), 4, wc, fq); }
        else if (u.aux == 5) { store_w64<true>(acc, rowb, (f16*)(ws + WS_MKR), 1024, 256 * u.pn + 64 * wc, 1.f, (float*)(ws + WS_SSQ_MK), 16, 4 * u.pn + wc, fq); }
        else {
            f16* CQ = (f16*)(ws + WS_CQ); float* SS = (float*)(ws + WS_SSQ_CQ);
#pragma unroll
            for (int ai = 0; ai < 2; ++ai)
#pragma unroll
                for (int m = 0; m < 4; ++m) { const int row = rowb + ai * 128 + m * 16;
                    const f32x4 v0 = acc[ai][0][m][0], v1 = acc[ai][0][m][1]; float s = dot4(v0) + dot4(v1);
                    *(u32x4*)(CQ + (size_t)row * 384 + 256 + 32 * wc + 8 * fq) = pk8(v0, v1);
                    s = sum_x32(sum_x16(s)); if (fq == 0) SS[(size_t)row * 8 + 4 + wc] = s; }
            if (wc == 0) {
                const float* COS = (const float*)(ws + WS_COS); const float* SIN = (const float*)(ws + WS_SIN); f16* KRF = (f16*)(ws + WS_KRF);
                const f32x4 g1 = *(const f32x4*)(krg + 4 * fq), g2 = *(const f32x4*)(krg + 16 + 4 * fq);
#pragma unroll
                for (int ai = 0; ai < 2; ++ai)
#pragma unroll
                    for (int m = 0; m < 4; ++m) { const int row = rowb + ai * 128 + m * 16;
                        f32x4 x1 = acc[ai][1][m][0], x2 = acc[ai][1][m][1]; float s = dot4(x1) + dot4(x2);
                        s = sum_x32(sum_x16(s));
                        const float rn = __builtin_amdgcn_rsqf(s * (1.f / 32.f) + EPS);
                        x1 = x1 * rn * g1; x2 = x2 * rn * g2;
                        const f32x4 c = *(const f32x4*)(COS + (size_t)row * 16 + 4 * fq), sn = *(const f32x4*)(SIN + (size_t)row * 16 + 4 * fq);
                        const f32x4 o1 = x1 * c - x2 * sn, o2 = x2 * c + x1 * sn;
                        *(u32x2*)(KRF + (size_t)row * 32 + 4 * fq) = pk4(o1); *(u32x2*)(KRF + (size_t)row * 32 + 16 + 4 * fq) = pk4(o2); }
            }
        }
    }
};
struct SchedP1N {
    unsigned char* ws; int G, c;
    __device__ __forceinline__ bool next(int i, Unit& u) const {
        int L = i * G + c;
        if (L < 896) { int pm, pn; pg8::tile_map(L, 128, 7, pm, pn);
            u.A = (const char*)(ws + WS_HN) + (size_t)pm * 256 * 1024 * 2; u.B = (const char*)(ws + WS_WIN) + (size_t)pn * 256 * 1024 * 2; u.pm = pm;
            u.aux = pn < 2 ? 0 : (pn < 4 ? 1 : pn - 2); u.pn = pn < 2 ? pn : (pn < 4 ? pn - 2 : 0); return true; }
        L -= 896; if (L >= 32) return false;
        int pm, pn; pg8::tile_map(L, 8, 4, pm, pn);
        u.A = (const char*)(ws + WS_MN) + (size_t)pm * 256 * 1024 * 2; u.B = (const char*)(ws + WS_WMK) + (size_t)pn * 256 * 1024 * 2; u.pm = pm; u.pn = pn; u.aux = 5; return true;
    }
};
struct EpiP1S {
    static constexpr bool MIDSCALE = false;
    unsigned char* ws;
    __device__ __forceinline__ void operator()(const Acc& acc, const Unit& u, int wr, int wc, int fr_, int fq_) const {
        int fr = fr_, fq = fq_; asm volatile("" : "+v"(fr), "+v"(fq));
        const int rowb = u.pm * 256 + wr * 64 + fr;
        if (u.aux == 0) { f16* dst = (f16*)(ws + WS_SBVT);
#pragma unroll
            for (int ai = 0; ai < 2; ++ai)
#pragma unroll
                for (int m = 0; m < 4; ++m) { const size_t ro = (size_t)(rowb + ai * 128 + m * 16) * T + u.pn * 256 + 32 * wc + 8 * (fq & 1) + 4 * (fq >> 1);
#pragma unroll
                    for (int bj = 0; bj < 2; ++bj)
#pragma unroll
                        for (int n = 0; n < 2; ++n) *(u32x2*)(dst + ro + 128 * bj + 16 * n) = pk4(acc[ai][bj][m][n]); }
        } else { f16* dst = (f16*)(ws + WS_MVT);
#pragma unroll
            for (int ai = 0; ai < 2; ++ai)
#pragma unroll
                for (int m = 0; m < 4; ++m) { const size_t ro = (size_t)(rowb + ai * 128 + m * 16) * 2048 + u.pn * 256 + 32 * wc + 8 * fq;
#pragma unroll
                    for (int bj = 0; bj < 2; ++bj)
#pragma unroll
                        for (int n = 0; n < 2; ++n) *(u32x2*)(dst + ro + 128 * bj + 4 * n) = pk4(acc[ai][bj][m][n]); }
        }
    }
};
struct SchedP1S {
    unsigned char* ws; int G, c;
    __device__ __forceinline__ bool next(int i, Unit& u) const {
        int L = i * G + c;
        if (L < 256) { int pm, pn; pg8::tile_map(L, 2, 128, pm, pn);
            u.A = (const char*)(ws + WS_WSV) + (size_t)pm * 256 * 1024 * 2; u.B = (const char*)(ws + WS_HN) + (size_t)pn * 256 * 1024 * 2; u.pm = pm; u.pn = pn; u.aux = 0; return true; }
        L -= 256; if (L >= 32) return false;
        int pm, pn; pg8::tile_map(L, 4, 8, pm, pn);
        u.A = (const char*)(ws + WS_WMV) + (size_t)pm * 256 * 1024 * 2; u.B = (const char*)(ws + WS_MN) + (size_t)pn * 256 * 1024 * 2; u.pm = pm; u.pn = pn; u.aux = 1; return true;
    }
};

constexpr float MLA_QSCALE = 0.10206207261596575f * 1.4426950408889634f;
__device__ __forceinline__ float rq_of(const float* SS8, int row) { const f32x4 a = *(const f32x4*)(SS8 + (size_t)row * 8), b = *(const f32x4*)(SS8 + (size_t)row * 8 + 4);
    return __builtin_amdgcn_rsqf((((a[0] + a[1]) + (a[2] + a[3])) + ((b[0] + b[1]) + (b[2] + b[3]))) * (1.f / 384.f) + EPS); }
__device__ __forceinline__ float rkv_of(const float* SS4, int row) { const f32x4 a = *(const f32x4*)(SS4 + (size_t)row * 4);
    return __builtin_amdgcn_rsqf(((a[0] + a[1]) + (a[2] + a[3])) * (1.f / 256.f) + EPS); }
struct EpiP2Q {
    static constexpr bool MIDSCALE = false;
    unsigned char* ws; const float* qng; const float* qrg;
    __device__ __forceinline__ void operator()(const Acc& acc, const Unit& u, int wr, int wc, int fr_, int fq_) const {
        int fr = fr_, fq = fq_; asm volatile("" : "+v"(fr), "+v"(fq));
        const int rowb = u.pm * 256 + wr * 64 + fr; const float* SS = (const float*)(ws + WS_SSQ_CQ); f16* Q = (f16*)(ws + WS_MLAQ);
        if (u.pn < 2) { const int h = 4 * u.pn + wc;
            f32x4 g[2][2];
#pragma unroll
            for (int bj = 0; bj < 2; ++bj)
#pragma unroll
                for (int n = 0; n < 2; ++n) g[bj][n] = *(const f32x4*)(qng + 32 * bj + 8 * fq + 4 * n) * MLA_QSCALE;
#pragma unroll
            for (int ai = 0; ai < 2; ++ai)
#pragma unroll
                for (int m = 0; m < 4; ++m) { const int row = rowb + ai * 128 + m * 16; const float rq = rq_of(SS, row);
                    f32x4 v[2][2]; float s = 0.f;
#pragma unroll
                    for (int bj = 0; bj < 2; ++bj)
#pragma unroll
                        for (int n = 0; n < 2; ++n) { v[bj][n] = acc[ai][bj][m][n] * rq; s += dot4(v[bj][n]); }
                    s = sum_x32(sum_x16(s));
                    const float rn = __builtin_amdgcn_rsqf(s * (1.f / 64.f) + EPS);
#pragma unroll
                    for (int bj = 0; bj < 2; ++bj) *(u32x4*)(Q + (size_t)row * 768 + h * 96 + 32 * bj + 8 * fq) = pk8(v[bj][0] * rn * g[bj][0], v[bj][1] * rn * g[bj][1]); }
        } else {
            const float* COS = (const float*)(ws + WS_COS); const float* SIN = (const float*)(ws + WS_SIN);
            const f32x4 g1 = *(const f32x4*)(qrg + 4 * fq) * MLA_QSCALE, g2 = *(const f32x4*)(qrg + 16 + 4 * fq) * MLA_QSCALE;
#pragma unroll
            for (int ai = 0; ai < 2; ++ai)
#pragma unroll
                for (int m = 0; m < 4; ++m) { const int row = rowb + ai * 128 + m * 16; const float rq = rq_of(SS, row);
                    const f32x4 c = *(const f32x4*)(COS + (size_t)row * 16 + 4 * fq), sn = *(const f32x4*)(SIN + (size_t)row * 16 + 4 * fq);
#pragma unroll
                    for (int bj = 0; bj < 2; ++bj) { const int h = 4 * bj + wc;
                        f32x4 x1 = acc[ai][bj][m][0] * rq, x2 = acc[ai][bj][m][1] * rq; float s = dot4(x1) + dot4(x2);
                        s = sum_x32(sum_x16(s));
                        const float rn = __builtin_amdgcn_rsqf(s * (1.f / 32.f) + EPS);
                        x1 = x1 * rn * g1; x2 = x2 * rn * g2;
                        const f32x4 o1 = x1 * c - x2 * sn, o2 = x2 * c + x1 * sn;
                        *(u32x2*)(Q + (size_t)row * 768 + h * 96 + 64 + 4 * fq) = pk4(o1); *(u32x2*)(Q + (size_t)row * 768 + h * 96 + 80 + 4 * fq) = pk4(o2); } }
        }
    }
};
struct EpiP2K {
    static constexpr bool MIDSCALE = false;
    unsigned char* ws; const float* kng;
    __device__ __forceinline__ void operator()(const Acc& acc, const Unit& u, int wr, int wc, int fr_, int fq_) const {
        int fr = fr_, fq = fq_; asm volatile("" : "+v"(fr), "+v"(fq));
        const int rowb = u.pm * 256 + wr * 64 + fr; const float* SS = (const float*)(ws + WS_SSQ_CKV); f16* Kd = (f16*)(ws + WS_MLAK); const f16* KRF = (const f16*)(ws + WS_KRF);
        const int h = 4 * u.pn + wc;
        f32x4 g[2][2];
#pragma unroll
        for (int bj = 0; bj < 2; ++bj)
#pragma unroll
            for (int n = 0; n < 2; ++n) g[bj][n] = *(const f32x4*)(kng + 32 * bj + 8 * fq + 4 * n);
#pragma unroll
        for (int ai = 0; ai < 2; ++ai)
#pragma unroll
            for (int m = 0; m < 4; ++m) { const int row = rowb + ai * 128 + m * 16; const float rk = rkv_of(SS, row);
                f32x4 v[2][2]; float s = 0.f;
#pragma unroll
                for (int bj = 0; bj < 2; ++bj)
#pragma unroll
                    for (int n = 0; n < 2; ++n) { v[bj][n] = acc[ai][bj][m][n] * rk; s += dot4(v[bj][n]); }
                s = sum_x32(sum_x16(s));
                const float rn = __builtin_amdgcn_rsqf(s * (1.f / 64.f) + EPS);
#pragma unroll
                for (int bj = 0; bj < 2; ++bj) *(u32x4*)(Kd + (size_t)row * 768 + h * 96 + 32 * bj + 8 * fq) = pk8(v[bj][0] * rn * g[bj][0], v[bj][1] * rn * g[bj][1]);
                *(u32x4*)(Kd + (size_t)row * 768 + h * 96 + 64 + 8 * fq) = *(const u32x4*)(KRF + (size_t)row * 32 + 8 * fq); }
    }
};
struct EpiP2V {
    static constexpr bool MIDSCALE = false;
    unsigned char* ws;
    __device__ __forceinline__ void operator()(const Acc& acc, const Unit& u, int wr, int wc, int fr_, int fq_) const {
        int fr = fr_, fq = fq_; asm volatile("" : "+v"(fr), "+v"(fq));
        const int rowb = u.pm * 256 + wr * 64 + fr; const float* SS = (const float*)(ws + WS_SSQ_CKV); f16* dst = (f16*)(ws + WS_MLAVT);
        f32x4 rk[2][2];
#pragma unroll
        for (int bj = 0; bj < 2; ++bj)
#pragma unroll
            for (int n = 0; n < 2; ++n) { const int tok = u.pn * 256 + 128 * bj + 32 * wc + 16 * n + 4 * fq;
#pragma unroll
                for (int j = 0; j < 4; ++j) rk[bj][n][j] = rkv_of(SS, tok + j); }
#pragma unroll
        for (int ai = 0; ai < 2; ++ai)
#pragma unroll
            for (int m = 0; m < 4; ++m) { const size_t ro = (size_t)(rowb + ai * 128 + m * 16) * T + u.pn * 256 + 32 * wc + 8 * (fq & 1) + 4 * (fq >> 1);
#pragma unroll
                for (int bj = 0; bj < 2; ++bj)
#pragma unroll
                    for (int n = 0; n < 2; ++n) *(u32x2*)(dst + ro + 128 * bj + 16 * n) = pk4(acc[ai][bj][m][n] * rk[bj][n]); }
    }
};
struct SchedGrid {
    const char* A; const char* B; size_t sA, sB; int nM, nN, G, c;
    __device__ __forceinline__ bool next(int i, Unit& u) const {
        const int L = i * G + c; if (L >= nM * nN) return false;
        int pm, pn; pg8::tile_map(L, nM, nN, pm, pn);
        u.A = A + (size_t)pm * sA; u.B = B + (size_t)pn * sB; u.pm = pm; u.pn = pn; u.aux = i; return true;
    }
};
__device__ __forceinline__ void p2_kprime(Frame& F, const Params& P) {
    PHASE_IDS();
    const int gw = F.vcu * NWAVES + wave, NGW = F.G * NWAVES;
    const f16* MKR = (const f16*)(F.ws + WS_MKR); const float* SS = (const float*)(F.ws + WS_SSQ_MK); f16* KP = (f16*)(F.ws + WS_KP);
    const f32x4 gg = *(const f32x4*)(P.in[21] + 4 * lane) * *(const f32x4*)(P.in[20] + 4 * lane);
    for (int it = gw; it < 2048 * 4; it += NGW) { const int row = it >> 2, h = it & 3, b = row >> 8, key = row & 255;
        const f32x4 a = *(const f32x4*)(SS + (size_t)row * 16 + 4 * h); const float r = __builtin_amdgcn_rsqf(((a[0] + a[1]) + (a[2] + a[3])) * (1.f / 256.f) + EPS);
        const f16x4 x = *(const f16x4*)(MKR + (size_t)row * 1024 + 256 * h + 4 * lane);
        const f32x4 v = (f32x4){(float)x[0], (float)x[1], (float)x[2], (float)x[3]} * r * gg;
        *(u32x2*)(KP + ((size_t)((b * 4 + h) * 256 + key)) * 256 + 4 * lane) = pk4(v); }
}

__device__ __forceinline__ void swap32(float x, float& a, float& b) { const auto rr = __builtin_amdgcn_permlane32_swap(__float_as_uint(x), __float_as_uint(x), false, false); a = __uint_as_float(rr[0]); b = __uint_as_float(rr[1]); }
__device__ __forceinline__ float sum32(float x) { float a, b; swap32(x, a, b); return a + b; }
#define MFMA32(a, b, c) __builtin_amdgcn_mfma_f32_32x32x16_f16((a), (b), (c), 0, 0, 0)
#define MFMA16(a, b, c) __builtin_amdgcn_mfma_f32_16x16x32_f16((a), (b), (c), 0, 0, 0)
__device__ __forceinline__ f16x8 pack8(const f32x16& s, int base) {
    u32x4 w; w.x = pk2(s[base + 0], s[base + 1]); w.y = pk2(s[base + 2], s[base + 3]); w.z = pk2(s[base + 4], s[base + 5]); w.w = pk2(s[base + 6], s[base + 7]);
    return __builtin_bit_cast(f16x8, w);
}
__device__ __forceinline__ f16x8 pack8z(const f32x16& s, int base) {
    typedef __fp16 h2 __attribute__((ext_vector_type(2)));
    const h2 a = __builtin_amdgcn_cvt_pkrtz(s[base + 0], s[base + 1]), b = __builtin_amdgcn_cvt_pkrtz(s[base + 2], s[base + 3]), c = __builtin_amdgcn_cvt_pkrtz(s[base + 4], s[base + 5]), d = __builtin_amdgcn_cvt_pkrtz(s[base + 6], s[base + 7]);
    u32x4 w; w.x = __builtin_bit_cast(unsigned, a); w.y = __builtin_bit_cast(unsigned, b); w.z = __builtin_bit_cast(unsigned, c); w.w = __builtin_bit_cast(unsigned, d);
    return __builtin_bit_cast(f16x8, w);
}
__device__ __forceinline__ float store_ot(const f32x16& o0, const f32x16& o1, float inv, f16* dst, int hf) {
    float ss = 0.f;
#pragma unroll
    for (int g4 = 0; g4 < 4; ++g4) {
        const f32x4 a = (f32x4){o0[4 * g4], o0[4 * g4 + 1], o0[4 * g4 + 2], o0[4 * g4 + 3]} * inv, b = (f32x4){o1[4 * g4], o1[4 * g4 + 1], o1[4 * g4 + 2], o1[4 * g4 + 3]} * inv;
        ss += dot4(a) + dot4(b);
        *(u32x2*)(dst + 8 * g4 + 4 * hf) = pk4(a); *(u32x2*)(dst + 32 + 8 * g4 + 4 * hf) = pk4(b); }
    return ss;
}
struct SbFrag { f16x8 k[4]; f16x8 v[2][2]; };
__device__ __forceinline__ void sb_load(SbFrag& f, const f16* kp, const f16* vp) {
#pragma unroll
    for (int ks = 0; ks < 4; ++ks) f.k[ks] = *(const f16x8*)(kp + 16 * ks);
#pragma unroll
    for (int dvb = 0; dvb < 2; ++dvb)
#pragma unroll
        for (int kk = 0; kk < 2; ++kk) f.v[dvb][kk] = *(const f16x8*)(vp + (size_t)dvb * 32 * T + 16 * kk);
}
__device__ __forceinline__ bool sb_step(const SbFrag& f, const f16x8 (&qf)[4], f32x16& o0, f32x16& o1, float& C, bool diag, int t0, int t, int hf) {
    f32x16 s = {};
#pragma unroll
    for (int ks = 0; ks < 4; ++ks) s = MFMA32(f.k[ks], qf[ks], s);
    float be[16], om[16];
#pragma unroll
    for (int r = 0; r < 16; ++r) { const float z = __builtin_amdgcn_fmed3f(s[r], -115.f, 115.f);
        const float e = __builtin_amdgcn_exp2f(-z); const float bt = __builtin_amdgcn_rcpf(1.f + e);
        be[r] = bt; om[r] = e * bt; }
    if (diag) {
#pragma unroll
        for (int r = 0; r < 16; ++r) { const int key = t0 + 8 * (r >> 2) + 4 * hf + (r & 3); const bool vis = key < t; be[r] = vis ? be[r] : 0.f; om[r] = vis ? om[r] : 1.f; }
    }
    float G[4], PG[4];
#pragma unroll
    for (int q4 = 0; q4 < 4; ++q4) { G[q4] = (om[4 * q4] * om[4 * q4 + 1]) * (om[4 * q4 + 2] * om[4 * q4 + 3]); float a_, b_; swap32(G[q4], a_, b_); PG[q4] = hf == 0 ? b_ : a_; }
    float run = C;
#pragma unroll
    for (int q4 = 3; q4 >= 0; --q4) { float a = hf == 0 ? run * PG[q4] : run;
#pragma unroll
        for (int j = 3; j >= 0; --j) { const int r = 4 * q4 + j; s[r] = be[r] * a; a *= om[r]; }
        run *= G[q4] * PG[q4]; }
    C = run;
#pragma unroll
    for (int kk = 0; kk < 2; ++kk) { const f16x8 pa = pack8(s, 8 * kk); o0 = MFMA32(f.v[0][kk], pa, o0); o1 = MFMA32(f.v[1][kk], pa, o1); }
    return __all(C == 0.f);
}
__device__ __forceinline__ void sb_item(const f16* __restrict__ Qg, const f16* __restrict__ Kg, const f16* __restrict__ Vt, f16* Og, float* SSQ, int b, int h, int qblk, int lane) {
    const int r32 = lane & 31, hf = lane >> 5;
    const int t0 = qblk * 32, t = t0 + r32; const size_t row = (size_t)b * SEQ + t;
    f16x8 qf[4];
#pragma unroll
    for (int ks = 0; ks < 4; ++ks) qf[ks] = *(const f16x8*)(Qg + row * 512 + h * 64 + 16 * ks + 8 * hf);
    f32x16 o0 = {}, o1 = {};
    float C = 1.f;
    const f16* kp = Kg + ((size_t)b * SEQ + t0 + r32) * 512 + h * 64 + 8 * hf;
    const f16* vp = Vt + ((size_t)(h * 64 + r32)) * T + (size_t)b * SEQ + t0 + 8 * hf;
    SbFrag f0, f1, f2;
    sb_load(f0, kp, vp);
    { const int d = qblk >= 1 ? 1 : 0; sb_load(f1, kp - d * 32 * 512, vp - d * 32); }
    int st = qblk;
    for (;;) {
        { const int d = st >= 2 ? 2 : 0; sb_load(f2, kp - d * 32 * 512, vp - d * 32); }
        if (sb_step(f0, qf, o0, o1, C, st == qblk, t0, t, hf)) break;
        if (--st < 0) break; kp -= 32 * 512; vp -= 32;
        { const int d = st >= 2 ? 2 : 0; sb_load(f0, kp - d * 32 * 512, vp - d * 32); }
        if (sb_step(f1, qf, o0, o1, C, false, t0, t, hf)) break;
        if (--st < 0) break; kp -= 32 * 512; vp -= 32;
        { const int d = st >= 2 ? 2 : 0; sb_load(f1, kp - d * 32 * 512, vp - d * 32); }
        if (sb_step(f2, qf, o0, o1, C, false, t0, t, hf)) break;
        if (--st < 0) break; kp -= 32 * 512; vp -= 32;
    }
    const float ss = store_ot(o0, o1, 1.f, Og + row * 1024 + h * 64, hf);
    const float tot = sum32(ss);
    if (hf == 0) SSQ[row * 16 + h] = tot;
}
constexpr int MLA_KROW = 208, MLA_VROW = 144, MLA_KBYTES = 64 * MLA_KROW, MLA_VBYTES = 64 * MLA_VROW, MLA_BUF = MLA_KBYTES + MLA_VBYTES;
__device__ __forceinline__ float max3f(float a, float b, float c) { float r; asm("v_max3_f32 %0, %1, %2, %3" : "=v"(r) : "v"(a), "v"(b), "v"(c)); return r; }
__device__ __forceinline__ float max2f(float a, float b) { float r; asm("v_max_f32_e32 %0, %1, %2" : "=v"(r) : "v"(a), "v"(b)); return r; }
__device__ __forceinline__ void mla_unit(LAS unsigned char* lds, const f16* __restrict__ Qg, const f16* __restrict__ Kg, const f16* __restrict__ Vt, f16* Og, float* SSQ, int b, int h, int qb, int tid) {
    const int lane = tid & 63, wid = __builtin_amdgcn_readfirstlane(tid >> 6), r32 = lane & 31, hf = lane >> 5;
    const size_t row = (size_t)b * SEQ + qb * 256 + wid * 32 + r32;
    const int NT = 4 * qb + 4, my_last = 4 * qb + (wid >> 1);
    const char* src[3]; unsigned dsto[3]; unsigned tstep[3];
#pragma unroll
    for (int i = 0; i < 3; ++i) { int I = wid + 8 * i; if (I >= 22) I -= 2;
        if (I < 13) { const int p = 64 * I + lane, key = p / 13, c = p % 13;
            src[i] = (const char*)(Kg + ((size_t)b * SEQ + key) * 768 + h * 96 + 8 * (c < 12 ? c : 11)); tstep[i] = 64u * 768u * 2u; }
        else { const int p = 64 * (I - 13) + lane, dv = p / 9, c = p % 9;
            src[i] = (const char*)(Vt + (size_t)(h * 64 + dv) * T + (size_t)b * SEQ + 8 * (c < 8 ? c : 7)); tstep[i] = 128u; }
        dsto[i] = (unsigned)(I < 13 ? 1024 * I : MLA_KBYTES + 1024 * (I - 13)); }
#define MLA_ISSUE(tile, bufi) do { _Pragma("unroll") for (int _i = 0; _i < 3; ++_i) \
        __builtin_amdgcn_global_load_lds((const unsigned*)(src[_i] + (size_t)(tile) * tstep[_i]), (LAS unsigned*)(lds + (bufi) * MLA_BUF + __builtin_amdgcn_readfirstlane(dsto[_i])), 16, 0, 0); } while (0)
    f16x8 qf[6];
#pragma unroll
    for (int ks = 0; ks < 6; ++ks) qf[ks] = *(const f16x8*)(Qg + row * 768 + h * 96 + 16 * ks + 8 * hf);
    asm volatile("s_waitcnt vmcnt(0)" ::: "memory");
    __builtin_amdgcn_s_barrier();
    MLA_ISSUE(0, 0); MLA_ISSUE(1, 1);
    f32x16 o0 = {}, o1 = {};
    float lrun = 0.f;
    f32x16 negm;
#pragma unroll
    for (int r = 0; r < 16; ++r) negm[r] = 64.f;
    int bi = 0;
    for (int t = 0; t < NT; ++t) {
        if (t + 1 < NT) asm volatile("s_waitcnt vmcnt(3)" ::: "memory"); else asm volatile("s_waitcnt vmcnt(0)" ::: "memory");
        __builtin_amdgcn_s_barrier();
        asm volatile("" ::: "memory");
        if (t + 2 < NT) { const int nb = bi == 0 ? 2 : bi - 1; MLA_ISSUE(t + 2, nb); }
        if (t <= my_last) {
            const LAS unsigned char* kb_ = lds + bi * MLA_BUF; const LAS unsigned char* vb_ = kb_ + MLA_KBYTES;
            f32x16 s0 = negm, s1 = negm;
#pragma unroll
            for (int ks = 0; ks < 6; ++ks) {
                const f16x8 k0 = *(const LAS f16x8*)(kb_ + r32 * MLA_KROW + (16 * ks + 8 * hf) * 2);
                const f16x8 k1 = *(const LAS f16x8*)(kb_ + (32 + r32) * MLA_KROW + (16 * ks + 8 * hf) * 2);
                s0 = MFMA32(k0, qf[ks], s0); s1 = MFMA32(k1, qf[ks], s1); }
            f16x8 vf0[4], vf1[4];
#pragma unroll
            for (int kk = 0; kk < 4; ++kk) { vf0[kk] = *(const LAS f16x8*)(vb_ + r32 * MLA_VROW + (16 * kk + 8 * hf) * 2); vf1[kk] = *(const LAS f16x8*)(vb_ + (32 + r32) * MLA_VROW + (16 * kk + 8 * hf) * 2); }
            float ta = max3f(s0[0], s1[0], s0[1]), tb = max3f(s1[1], s0[2], s1[2]);
#pragma unroll
            for (int r = 3; r < 15; r += 2) { ta = max3f(ta, s0[r], s1[r]); tb = max3f(tb, s0[r + 1], s1[r + 1]); }
            float tm = max3f(ta, tb, max2f(s0[15], s1[15]));
            { float a_, b_; swap32(tm, a_, b_); tm = max2f(a_, b_); }
            if (__any(tm > 0.f)) {
                const float delta = max2f(tm, 0.f), alpha = __builtin_amdgcn_exp2f(-delta);
                lrun *= alpha; o0 = o0 * alpha; o1 = o1 * alpha;
#pragma unroll
                for (int r = 0; r < 16; ++r) { s0[r] -= delta; s1[r] -= delta; negm[r] -= delta; }
            }
            float ps = 0.f, ps2 = 0.f;
#pragma unroll
            for (int r = 0; r < 16; ++r) { s0[r] = __builtin_amdgcn_exp2f(s0[r]); s1[r] = __builtin_amdgcn_exp2f(s1[r]); ps += s0[r]; ps2 += s1[r]; }
            lrun += ps + ps2;
#pragma unroll
            for (int kk = 0; kk < 4; ++kk) { const f16x8 pa = (kk < 2) ? pack8z(s0, 8 * (kk & 1)) : pack8z(s1, 8 * (kk & 1));
                o0 = MFMA32(vf0[kk], pa, o0); o1 = MFMA32(vf1[kk], pa, o1); }
        }
        bi = bi == 2 ? 0 : bi + 1;
    }
#undef MLA_ISSUE
    const float ltot = sum32(lrun);
    const float ss = store_ot(o0, o1, 1.f / ltot, Og + row * 1024 + 512 + h * 64, hf);
    const float tot = sum32(ss);
    if (hf == 0) SSQ[row * 16 + 8 + h] = tot;
}
template <bool DO_SB = true, bool DO_MLA = true>
__device__ __forceinline__ void p3_attention(Frame& F) {
    PHASE_IDS();
    unsigned char* ws = F.ws;
    f16* ATT = (f16*)(ws + WS_ATT); float* SSQ = (float*)(ws + WS_SSQ_ATT);
    if (DO_SB) {
        const f16* Q = (const f16*)(ws + WS_SBQ); const f16* K = (const f16*)(ws + WS_SBK); const f16* Vt = (const f16*)(ws + WS_SBVT);
        const int gw = F.vcu * NWAVES + wave, NGW = F.G * NWAVES;
        for (int it = gw; it < NB * 8 * 128; it += NGW) { const int qblk = it & 127, h = (it >> 7) & 7, b = it >> 10; sb_item(Q, K, Vt, ATT, SSQ, b, h, qblk, lane); }
    }
    if (DO_MLA) {
        const f16* Q = (const f16*)(ws + WS_MLAQ); const f16* K = (const f16*)(ws + WS_MLAK); const f16* Vt = (const f16*)(ws + WS_MLAVT);
        for (int pr = F.vcu; pr < 64 * 8; pr += F.G) { const int bh = pr >> 3, qa = pr & 7, b = bh >> 3, h = bh & 7;
            mla_unit(F.lds, Q, K, Vt, ATT, SSQ, b, h, 15 - qa, tid);
            mla_unit(F.lds, Q, K, Vt, ATT, SSQ, b, h, qa, tid); }
    }
}
__device__ __forceinline__ void p3b_norm(Frame& F, const Params& P) {
    PHASE_IDS();
    const int gw = F.vcu * NWAVES + wave, NGW = F.G * NWAVES;
    f16* ATT = (f16*)(F.ws + WS_ATT); const float* SSQ = (const float*)(F.ws + WS_SSQ_ATT);
    const f32x4 ga0 = *(const f32x4*)(P.in[13] + 8 * lane), ga1 = *(const f32x4*)(P.in[13] + 8 * lane + 4), gb0 = *(const f32x4*)(P.in[14] + 8 * lane), gb1 = *(const f32x4*)(P.in[14] + 8 * lane + 4);
    for (int row = gw; row < T; row += NGW) {
        const f32x4 a0 = *(const f32x4*)(SSQ + (size_t)row * 16), a1 = *(const f32x4*)(SSQ + (size_t)row * 16 + 4), b0 = *(const f32x4*)(SSQ + (size_t)row * 16 + 8), b1 = *(const f32x4*)(SSQ + (size_t)row * 16 + 12);
        const float ra = __builtin_amdgcn_rsqf((((a0[0] + a0[1]) + (a0[2] + a0[3])) + ((a1[0] + a1[1]) + (a1[2] + a1[3]))) * (1.f / 512.f) + EPS);
        const float rb = __builtin_amdgcn_rsqf((((b0[0] + b0[1]) + (b0[2] + b0[3])) + ((b1[0] + b1[1]) + (b1[2] + b1[3]))) * (1.f / 512.f) + EPS);
        f16* pa = ATT + (size_t)row * 1024 + 8 * lane; f16* pb = pa + 512;
        const f16x8 xa = *(const f16x8*)pa, xb = *(const f16x8*)pb;
        f32x4 va0, va1, vb0, vb1;
#pragma unroll
        for (int j = 0; j < 4; ++j) { va0[j] = (float)xa[j]; va1[j] = (float)xa[4 + j]; vb0[j] = (float)xb[j]; vb1[j] = (float)xb[4 + j]; }
        *(u32x4*)pa = pk8(va0 * ra * ga0, va1 * ra * ga1); *(u32x4*)pb = pk8(vb0 * rb * gb0, vb1 * rb * gb1);
    }
}

constexpr int WO_TAB_OFF = 131072;
struct EpiWo {
    static constexpr bool MIDSCALE = true;
    unsigned char* ws; const float* x; LAS const float* tab;
    __device__ __forceinline__ void mid(Acc& acc, const Unit& u, int wr, int fr_) const {
        int fr = fr_; asm volatile("" : "+v"(fr));
#pragma unroll
        for (int ai = 0; ai < 2; ++ai)
#pragma unroll
            for (int m = 0; m < 4; ++m) { const float ra = tab[(u.aux * 256 + ai * 128 + wr * 64 + m * 16 + fr) * 2];
#pragma unroll
                for (int bj = 0; bj < 2; ++bj)
#pragma unroll
                    for (int n = 0; n < 2; ++n) acc[ai][bj][m][n] = acc[ai][bj][m][n] * ra; }
    }
    __device__ __forceinline__ void operator()(const Acc& acc, const Unit& u, int wr, int wc, int fr_, int fq_) const {
        int fr = fr_, fq = fq_; asm volatile("" : "+v"(fr), "+v"(fq));
        const int rowb = u.pm * 256 + wr * 64 + fr, colb = u.pn * 256 + 32 * wc + 8 * fq; f16* H = (f16*)(ws + WS_H1H); float* SS = (float*)(ws + WS_SSQ_H1);
#pragma unroll
        for (int ai = 0; ai < 2; ++ai)
#pragma unroll
            for (int m = 0; m < 4; ++m) { const size_t ro = (size_t)(rowb + ai * 128 + m * 16) * 1024 + colb; float s = 0.f;
                const float rb = tab[(u.aux * 256 + ai * 128 + wr * 64 + m * 16 + fr) * 2 + 1];
#pragma unroll
                for (int bj = 0; bj < 2; ++bj) { const size_t o = ro + 128 * bj;
                    const f32x4 v0 = acc[ai][bj][m][0] * rb + *(const f32x4*)(x + o), v1 = acc[ai][bj][m][1] * rb + *(const f32x4*)(x + o + 4);
                    *(u32x4*)(H + o) = pk8(v0, v1); s += dot4(v0) + dot4(v1); }
                s = sum_x32(sum_x16(s)); if (fq == 0) SS[(size_t)(rowb + ai * 128 + m * 16) * 16 + 4 * u.pn + wc] = s; }
    }
};
template <class Sched> __device__ __forceinline__ void wo_table(Frame& F, const Sched& S) {
    const int tid = fresh_tid(); LAS float* tab = (LAS float*)(F.lds + WO_TAB_OFF); const float* SSQ = (const float*)(F.ws + WS_SSQ_ATT);
    for (int i = tid >> 8; i < 4; i += 2) { Unit u; if (!S.next(i, u)) break;
        const int row = u.pm * 256 + (tid & 255);
        const f32x4 a0 = *(const f32x4*)(SSQ + (size_t)row * 16), a1 = *(const f32x4*)(SSQ + (size_t)row * 16 + 4), b0 = *(const f32x4*)(SSQ + (size_t)row * 16 + 8), b1 = *(const f32x4*)(SSQ + (size_t)row * 16 + 12);
        const float sa = (((a0[0] + a0[1]) + (a0[2] + a0[3])) + ((a1[0] + a1[1]) + (a1[2] + a1[3]))) * (1.f / 512.f) + EPS;
        const float sb = (((b0[0] + b0[1]) + (b0[2] + b0[3])) + ((b1[0] + b1[1]) + (b1[2] + b1[3]))) * (1.f / 512.f) + EPS;
        const float ra = __builtin_amdgcn_rsqf(sa), rb = __builtin_amdgcn_rsqf(sb);
        tab[(i * 256 + (tid & 255)) * 2] = ra * __builtin_amdgcn_sqrtf(sb); tab[(i * 256 + (tid & 255)) * 2 + 1] = rb; }
    __syncthreads();
}
struct EpiMq {
    static constexpr bool MIDSCALE = false;
    unsigned char* ws;
    __device__ __forceinline__ void operator()(const Acc& acc, const Unit& u, int wr, int wc, int fr_, int fq_) const {
        int fr = fr_, fq = fq_; asm volatile("" : "+v"(fr), "+v"(fq));
        const int rowb = u.pm * 256 + wr * 64 + fr, colb = u.pn * 256 + 32 * wc + 8 * fq; f16* Q = (f16*)(ws + WS_MQ); float* SS = (float*)(ws + WS_SSQ_MQ);
#pragma unroll
        for (int ai = 0; ai < 2; ++ai)
#pragma unroll
            for (int m = 0; m < 4; ++m) { const size_t ro = (size_t)(rowb + ai * 128 + m * 16) * 1024 + colb; float s = 0.f;
#pragma unroll
                for (int bj = 0; bj < 2; ++bj) { const f32x4 v0 = acc[ai][bj][m][0], v1 = acc[ai][bj][m][1]; *(u32x4*)(Q + ro + 128 * bj) = pk8(v0, v1); s += dot4(v0) + dot4(v1); }
                s = sum_x32(sum_x16(s)); if (fq == 0) SS[(size_t)(rowb + ai * 128 + m * 16) * 16 + 4 * u.pn + wc] = s; }
    }
};
struct EpiMo {
    static constexpr bool MIDSCALE = false;
    unsigned char* ws;
    __device__ __forceinline__ void operator()(const Acc& acc, const Unit& u, int wr, int wc, int fr_, int fq_) const {
        int fr = fr_, fq = fq_; asm volatile("" : "+v"(fr), "+v"(fq));
        const int rowb = u.pm * 256 + wr * 64 + fr, colb = u.pn * 256 + 32 * wc + 8 * fq; f16* H = (f16*)(ws + WS_H2H); const f16* H1 = (const f16*)(ws + WS_H1H);
#pragma unroll
        for (int ai = 0; ai < 2; ++ai)
#pragma unroll
            for (int m = 0; m < 4; ++m) { const size_t ro = (size_t)(rowb + ai * 128 + m * 16) * 1024 + colb;
#pragma unroll
                for (int bj = 0; bj < 2; ++bj) { const size_t o = ro + 128 * bj; const f16x8 hv = *(const f16x8*)(H1 + o);
                    f32x4 v0 = acc[ai][bj][m][0], v1 = acc[ai][bj][m][1];
#pragma unroll
                    for (int j = 0; j < 4; ++j) { v0[j] += (float)hv[j]; v1[j] += (float)hv[4 + j]; }
                    *(u32x4*)(H + o) = pk8(v0, v1); } }
    }
};

constexpr int MEM_ROWB = 528;
template <int RS>
__device__ __forceinline__ void mem_stage(LAS unsigned char* lds, const f16* src, int tid) {
    const unsigned voff = (unsigned)((tid >> 5) * RS + 8 * (tid & 31)) * 2u;
    const unsigned loff = (unsigned)((tid >> 5) * MEM_ROWB + (tid & 31) * 16);
#pragma unroll
    for (int bt = 0; bt < 4; ++bt) { u32x4 r[4];
#pragma unroll
        for (int i = 0; i < 4; ++i) r[i] = *(const u32x4*)((const char*)src + (size_t)(4 * bt + i) * 16 * RS * 2 + voff);
#pragma unroll
        for (int i = 0; i < 4; ++i) *(LAS u32x4*)(lds + loff + (4 * bt + i) * 16 * MEM_ROWB) = r[i]; }
}
__device__ __forceinline__ void p6_memattn(Frame& F) {
    PHASE_IDS(); unsigned char* ws = F.ws; LAS unsigned char* lds = F.lds; const int wid = wave, l16 = lane & 15, g = lane >> 4;
    const f16* MQ = (const f16*)(ws + WS_MQ); const f16* KP = (const f16*)(ws + WS_KP); const f16* MVT = (const f16*)(ws + WS_MVT); f16* MO = (f16*)(ws + WS_MO);
    const float* SSH = (const float*)(ws + WS_SSQ_H1); const float* SSM = (const float*)(ws + WS_SSQ_MQ);
    for (int un = F.vcu; un < 256; un += F.G) { const int bh = un >> 3, qc = un & 7, b = bh >> 2, h = bh & 3;
        for (int pass = 0; pass < 4; ++pass) {
            const size_t row = (size_t)b * SEQ + qc * 512 + pass * 128 + wid * 16 + l16;
            f16x8 qf[8];
#pragma unroll
            for (int ks = 0; ks < 8; ++ks) qf[ks] = *(const f16x8*)(MQ + row * 1024 + h * 256 + 32 * ks + 8 * g);
            float fac;
            { const f32x4 a0 = *(const f32x4*)(SSH + row * 16), a1 = *(const f32x4*)(SSH + row * 16 + 4), a2 = *(const f32x4*)(SSH + row * 16 + 8), a3 = *(const f32x4*)(SSH + row * 16 + 12);
              const float sh = (((a0[0] + a0[1]) + (a0[2] + a0[3])) + ((a1[0] + a1[1]) + (a1[2] + a1[3]))) + (((a2[0] + a2[1]) + (a2[2] + a2[3])) + ((a3[0] + a3[1]) + (a3[2] + a3[3])));
              const float r1 = __builtin_amdgcn_rsqf(sh * (1.f / 1024.f) + EPS);
              const f32x4 q4 = *(const f32x4*)(SSM + row * 16 + 4 * h); const float mv = ((q4[0] + q4[1]) + (q4[2] + q4[3])) * (1.f / 256.f);
              fac = r1 * __builtin_amdgcn_rsqf(r1 * r1 * mv + EPS) * (0.0625f * 1.4426950408889634f); }
            __syncthreads();
            mem_stage<256>(lds, KP + (size_t)(b * 4 + h) * 256 * 256, tid);
            __syncthreads();
            f32x4 s[16];
#pragma unroll
            for (int kb = 0; kb < 16; ++kb) { s[kb] = (f32x4){0.f, 0.f, 0.f, 0.f};
#pragma unroll
                for (int ks = 0; ks < 8; ++ks) { const f16x8 a = *(const LAS f16x8*)(lds + (16 * kb + l16) * MEM_ROWB + (32 * ks + 8 * g) * 2); s[kb] = MFMA16(a, qf[ks], s[kb]); } }
            float mx = -INFINITY;
#pragma unroll
            for (int kb = 0; kb < 16; ++kb) { s[kb] = s[kb] * fac; mx = __builtin_fmaxf(mx, __builtin_fmaxf(__builtin_fmaxf(s[kb][0], s[kb][1]), __builtin_fmaxf(s[kb][2], s[kb][3]))); }
            mx = __builtin_fmaxf(mx, __shfl_xor(mx, 16)); mx = __builtin_fmaxf(mx, __shfl_xor(mx, 32));
            float sum = 0.f; u32x4 pf[8];
#pragma unroll
            for (int s8 = 0; s8 < 8; ++s8) { f32x4 p0, p1;
#pragma unroll
                for (int j = 0; j < 4; ++j) { p0[j] = __builtin_amdgcn_exp2f(s[2 * s8][j] - mx); p1[j] = __builtin_amdgcn_exp2f(s[2 * s8 + 1][j] - mx); }
                sum += ((p0[0] + p0[1]) + (p0[2] + p0[3])) + ((p1[0] + p1[1]) + (p1[2] + p1[3]));
                pf[s8] = pk8(p0, p1); }
            sum += __shfl_xor(sum, 16); sum += __shfl_xor(sum, 32);
            const float inv = 1.f / sum;
            __syncthreads();
            mem_stage<2048>(lds, MVT + (size_t)(h * 256) * 2048 + b * 256, tid);
            __syncthreads();
#pragma unroll 4
            for (int dvb = 0; dvb < 16; ++dvb) { f32x4 o = (f32x4){0.f, 0.f, 0.f, 0.f};
#pragma unroll
                for (int s8 = 0; s8 < 8; ++s8) { const f16x8 a = *(const LAS f16x8*)(lds + (16 * dvb + l16) * MEM_ROWB + (32 * s8 + 8 * g) * 2); o = MFMA16(a, __builtin_bit_cast(f16x8, pf[s8]), o); }
                *(u32x2*)(MO + row * 1024 + h * 256 + 16 * dvb + 4 * g) = pk4(o * inv); }
        }
    }
}

__device__ __forceinline__ void p8_route(Frame& F, const Params& P) {
    PHASE_IDS(); unsigned char* ws = F.ws;
    LAS float* WR = (LAS float*)F.lds;
    LAS unsigned* hist = (LAS unsigned*)(F.lds + LDS_MISC) + 8;
    const float* w_group = P.in[24]; const float* w_router = P.in[26];
    for (int e = tid; e < 1024 * 20; e += NTHR) { const int d = e / 20, c = e % 20; WR[c * 1024 + d] = c < 4 ? w_group[d * 4 + c] : w_router[d * 16 + (c - 4)]; }
    if (tid < 24) hist[tid] = 0u;
    __syncthreads();
    const f16* H2 = (const f16*)(ws + WS_H2H); const float* gm = P.in[23];
    f32x4 g[4];
#pragma unroll
    for (int k = 0; k < 4; ++k) g[k] = *(const f32x4*)(gm + 256 * k + 4 * lane);
    float bias[20];
#pragma unroll
    for (int c = 0; c < 20; ++c) bias[c] = c < 4 ? P.in[25][c] : P.in[27][c - 4];
    int* BKT = (int*)(ws + WS_BKT); float* RR = (float*)(ws + WS_RR); float* W0 = (float*)(ws + WS_W0); float* W1 = (float*)(ws + WS_W1);
    const int gw = F.vcu * NWAVES + wave, NGW = F.G * NWAVES;
    for (int tok = gw; tok < T; tok += NGW) {
        f32x4 v[4]; float ss = 0.f;
#pragma unroll
        for (int k = 0; k < 4; ++k) { const f16x4 hx = *(const f16x4*)(H2 + (size_t)tok * 1024 + 256 * k + 4 * lane); v[k] = (f32x4){(float)hx[0], (float)hx[1], (float)hx[2], (float)hx[3]}; ss += dot4(v[k]); }
        const float r = __builtin_amdgcn_rsqf(wave_sum(ss) * (1.f / 1024.f) + EPS);
        float lg[20];
#pragma unroll
        for (int c = 0; c < 20; ++c) lg[c] = 0.f;
#pragma unroll
        for (int k = 0; k < 4; ++k) { const f32x4 tv = v[k] * r * g[k];
#pragma unroll
            for (int c = 0; c < 20; ++c) { const f32x4 w = *(const LAS f32x4*)(WR + c * 1024 + 256 * k + 4 * lane); lg[c] += (tv[0] * w[0] + tv[1] * w[1]) + (tv[2] * w[2] + tv[3] * w[3]); }
            __builtin_amdgcn_sched_barrier(0); }
#pragma unroll
        for (int c = 0; c < 20; ++c) lg[c] = wave_sum(lg[c]) + bias[c];
        int gi = 0; float gmx = lg[0];
#pragma unroll
        for (int c = 1; c < 4; ++c) if (lg[c] > gmx) { gmx = lg[c]; gi = c; }
        float gden = 0.f;
#pragma unroll
        for (int c = 0; c < 4; ++c) gden += __expf(lg[c] - gmx);
        const float gw_ = 1.f / gden;
        float el[4];
#pragma unroll
        for (int c = 0; c < 4; ++c) el[c] = gi == 0 ? lg[4 + c] : (gi == 1 ? lg[8 + c] : (gi == 2 ? lg[12 + c] : lg[16 + c]));
        int i1 = 0; float m1 = el[0];
#pragma unroll
        for (int c = 1; c < 4; ++c) if (el[c] > m1) { m1 = el[c]; i1 = c; }
        int i2 = -1; float m2 = -INFINITY;
#pragma unroll
        for (int c = 0; c < 4; ++c) if (c != i1 && el[c] > m2) { m2 = el[c]; i2 = c; }
        const float e2 = __expf(m2 - m1), wa = gw_ / (1.f + e2), wb = gw_ * e2 / (1.f + e2);
        const int lo = i1 < i2 ? i1 : i2, hi = i1 < i2 ? i2 : i1;
        const int pi = lo == 0 ? hi - 1 : (lo == 1 ? hi + 1 : 5);
        const int bk = gi * 6 + pi;
        if (lane == 0) { BKT[tok] = bk; RR[tok] = r; W0[tok] = (i1 < i2) ? wa : wb; W1[tok] = (i1 < i2) ? wb : wa; atomicAdd((unsigned*)&hist[bk], 1u); }
    }
    __syncthreads();
    if (tid < 24) { const unsigned hv = hist[tid]; if (hv) atomicAdd(F.ctl + CW_CNT + tid, hv); }
}
__device__ __forceinline__ void moe_tiles(Frame& F) {
    LAS int* tstart = (LAS int*)(F.lds + LDS_MISC) + 32;
    const int tid0 = fresh_tid();
    __syncthreads();
    if (tid0 == 0) { int acc = 0;
        for (int b = 0; b < 24; ++b) { tstart[b] = acc; acc += (int)((__hip_atomic_load(F.ctl + CW_CNT + b, __ATOMIC_RELAXED, __HIP_MEMORY_SCOPE_AGENT) + 255u) >> 8); }
        tstart[24] = acc; }
    __syncthreads();
}
__device__ __forceinline__ void p9_gather(Frame& F) {
    PHASE_IDS(); unsigned char* ws = F.ws; const int wid = wave;
    moe_tiles(F);
    LAS int* tstart = (LAS int*)(F.lds + LDS_MISC) + 32; LAS int* posarr = (LAS int*)(F.lds + LDS_MISC) + 64;
    const int* BKT = (const int*)(ws + WS_BKT); const float* RR = (const float*)(ws + WS_RR); const float* W0 = (const float*)(ws + WS_W0); const float* W1 = (const float*)(ws + WS_W1);
    int* TOK = (int*)(ws + WS_TOK); float* PR = (float*)(ws + WS_PR); float* PW0 = (float*)(ws + WS_PW0); float* PW1 = (float*)(ws + WS_PW1);
    const f16* H2H = (const f16*)(ws + WS_H2H); f16* TS = (f16*)(ws + WS_TS);
    for (int blk = F.vcu; blk < T / 128; blk += F.G) {
        if (wid < 2) { const int tok = blk * 128 + wid * 64 + lane; const int bk = BKT[tok];
            unsigned mycount = 0u, rank = 0u;
            for (int bb = 0; bb < 24; ++bb) { const unsigned long long mask = __ballot(bk == bb); const unsigned c = (unsigned)__popcll(mask);
                if (lane == bb) mycount = c;
                if (bk == bb) rank = (unsigned)__popcll(mask & ((1ull << lane) - 1ull)); }
            unsigned basev = 0u;
            if (lane < 24 && mycount) basev = atomicAdd(F.ctl + CW_CUR + lane, mycount);
            const unsigned mybase = (unsigned)__shfl((int)basev, bk);
            posarr[wid * 64 + lane] = tstart[bk] * 256 + (int)(mybase + rank); }
        __syncthreads();
#pragma unroll 1
        for (int j0 = 0; j0 < 16; j0 += 4) { u32x4 a[4], b[4]; int pos[4];
#pragma unroll
            for (int j = 0; j < 4; ++j) { const int tl = wid * 16 + j0 + j, tok = blk * 128 + tl; pos[j] = posarr[tl];
                a[j] = *(const u32x4*)(H2H + (size_t)tok * 1024 + 8 * lane); b[j] = *(const u32x4*)(H2H + (size_t)tok * 1024 + 512 + 8 * lane); }
#pragma unroll
            for (int j = 0; j < 4; ++j) { const int tl = wid * 16 + j0 + j, tok = blk * 128 + tl;
                *(u32x4*)(TS + (size_t)pos[j] * 1024 + 8 * lane) = a[j]; *(u32x4*)(TS + (size_t)pos[j] * 1024 + 512 + 8 * lane) = b[j];
                if (lane == 0) { TOK[pos[j]] = tok; PR[pos[j]] = RR[tok]; PW0[pos[j]] = W0[tok]; PW1[pos[j]] = W1[tok]; } } }
        __syncthreads();
    }
}

struct SchedMoe {
    const char* A; const char* B; LAS const int* tstart; int G, c, nct_log2, down;
    __device__ __forceinline__ bool next(int i, Unit& u) const {
        const int L = i * G + c, rt = L >> nct_log2, ct = L & ((1 << nct_log2) - 1);
        if (rt >= tstart[24]) return false;
        int bk = 0;
        for (int b = 1; b < 24; ++b) bk = (rt >= tstart[b]) ? b : bk;
        u.A = A + (size_t)rt * 256 * 1024 * 2; u.pm = rt; u.pn = ct; u.aux = bk;
        int lo, hi; moe_pair(bk % 6, lo, hi);
        if (down) { u.B = B + ((size_t)(4 * (bk / 6) + lo) * 1024 + ct * 256) * 512 * 2; u.B2 = B + ((size_t)(4 * (bk / 6) + hi) * 1024 + ct * 256) * 512 * 2; }
        else { const int e = 4 * (bk / 6) + ((ct >> 2) ? hi : lo); u.B = B + (size_t)(e * 4 + (ct & 3)) * 256 * 1024 * 2; u.B2 = nullptr; }
        return true;
    }
};
struct EpiGU {
    static constexpr bool MIDSCALE = false;
    unsigned char* ws;
    __device__ __forceinline__ void operator()(const Acc& acc, const Unit& u, int wr, int wc, int fr_, int fq_) const {
        int fr = fr_, fq = fq_; asm volatile("" : "+v"(fr), "+v"(fq));
        const int rowb = u.pm * 256 + wr * 64 + fr, slot = u.pn >> 2, ffb = u.pn & 3; f16* HE = (f16*)(ws + WS_HE);
        const float* PR = (const float*)(ws + WS_PR); const float* PW = (const float*)(ws + (slot ? WS_PW1 : WS_PW0));
#pragma unroll
        for (int ai = 0; ai < 2; ++ai)
#pragma unroll
            for (int m = 0; m < 4; ++m) { const int row = rowb + ai * 128 + m * 16; const float r = PR[row], w = PW[row];
                f32x4 o[2];
#pragma unroll
                for (int n = 0; n < 2; ++n) { const f32x4 gt = acc[ai][0][m][n] * r, up = acc[ai][1][m][n] * r;
#pragma unroll
                    for (int j = 0; j < 4; ++j) { const float sg = gt[j] * __builtin_amdgcn_rcpf(1.f + __expf(-gt[j])); o[n][j] = sg * up[j] * w; } }
                *(u32x4*)(HE + (size_t)row * 1024 + slot * 512 + ffb * 128 + 32 * wc + 8 * fq) = pk8(o[0], o[1]); }
    }
};
struct EpiDown {
    static constexpr bool MIDSCALE = false;
    unsigned char* ws; float* out;
    __device__ __forceinline__ void operator()(const Acc& acc, const Unit& u, int wr, int wc, int fr_, int fq_) const {
        int fr = fr_, fq = fq_; asm volatile("" : "+v"(fr), "+v"(fq));
        const int rowb = u.pm * 256 + wr * 64 + fr, colb = u.pn * 256 + 32 * wc + 8 * fq; const int* TOK = (const int*)(ws + WS_TOK); const f16* H2 = (const f16*)(ws + WS_H2H);
        int tok[2][4];
#pragma unroll
        for (int ai = 0; ai < 2; ++ai)
#pragma unroll
            for (int m = 0; m < 4; ++m) tok[ai][m] = TOK[rowb + ai * 128 + m * 16];
#pragma unroll
        for (int ai = 0; ai < 2; ++ai) { f16x8 hv[4][2];
#pragma unroll
            for (int m = 0; m < 4; ++m) { const size_t ro = (size_t)(tok[ai][m] < 0 ? 0 : tok[ai][m]) * 1024 + colb;
#pragma unroll
                for (int bj = 0; bj < 2; ++bj) hv[m][bj] = *(const f16x8*)(H2 + ro + 128 * bj); }
#pragma unroll
            for (int m = 0; m < 4; ++m) { if (tok[ai][m] >= 0) { const size_t ro = (size_t)tok[ai][m] * 1024 + colb;
#pragma unroll
                for (int bj = 0; bj < 2; ++bj) { const size_t o = ro + 128 * bj;
                    f32x4 v0 = acc[ai][bj][m][0], v1 = acc[ai][bj][m][1];
#pragma unroll
                    for (int j = 0; j < 4; ++j) { v0[j] += (float)hv[m][bj][j]; v1[j] += (float)hv[m][bj][4 + j]; }
                    *(f32x4*)(out + o) = v0; *(f32x4*)(out + o + 4) = v1; } } } }
    }
};

#ifndef MK_N_LAUNCHES
#define MK_N_LAUNCHES 1
#endif
constexpr int N_PHASES = 13;
__global__ void __launch_bounds__(NTHR, 2) fwd_kernel(Params P) {
    extern __shared__ __attribute__((aligned(16))) unsigned char lds_raw[];
    Frame F;
    F.lds = (LAS unsigned char*)lds_raw; F.MISC = (volatile LAS unsigned*)(F.lds + LDS_MISC);
    F.G = gridDim.x; F.bx = blockIdx.x; F.vcu = (F.G % 8 == 0) ? (F.bx % 8) * (F.G / 8) + F.bx / 8 : F.bx;
    F.ws = P.ws; F.out = P.out; F.ctl = (unsigned*)(P.ws + WS_CTL);
    for (int u = fresh_tid(); u < (LDS_BYTES - LDS_MISC) / 4; u += NTHR) ((LAS unsigned*)(F.lds + LDS_MISC))[u] = 0u;
    __syncthreads();
    const int lo = P.ph_lo, hi = P.ph_hi;
    const bool multi = (hi - lo) > 1;
    XcdBarrier bar; bar.bar = F.ctl + CW_BAR; bar.x = 0; bar.st = F.MISC;
    if (multi) bar = xcd_barrier_post(F.ctl + CW_BAR, F.MISC);
#define IN(k) (lo <= (k) && (k) < hi)
#define SEAM(k) do { if (IN(k) && IN((k) + 1)) xcd_barrier(bar); } while (0)
    unsigned char* ws = F.ws;
#ifndef PROBE_DUP
#define PROBE_DUP -1
#endif
#define RUN(k, ...) do { if (IN(k)) { __VA_ARGS__ if (PROBE_DUP == (k)) { xcd_barrier(bar); __VA_ARGS__ } } SEAM(k); } while (0)
    RUN(0, { p0_prologue(F, P); });
    RUN(1, {
        { SchedP1N S{ws, F.G, F.bx}; EpiP1N E{ws, P.in[12]}; pg8::gemm_phase<EpiP1N, SchedP1N, true>(F.lds, 1024, 1024, 1024, S, E); }
        { SchedP1S S{ws, F.G, (F.bx + F.G - 160) % F.G}; EpiP1S E{ws}; pg8::gemm_phase<EpiP1S, SchedP1S, true>(F.lds, 1024, 1024, 1024, S, E); }
    });
    RUN(2, {
        p2_kprime(F, P);
        { SchedGrid S{(const char*)(ws + WS_CQ), (const char*)(ws + WS_WUQ), (size_t)256 * 384 * 2, (size_t)256 * 384 * 2, 128, 3, F.G, F.bx}; EpiP2Q E{ws, P.in[9], P.in[10]};
          pg8::gemm_phase<EpiP2Q, SchedGrid, true>(F.lds, 384, 384, 384, S, E); }
        { SchedGrid S{(const char*)(ws + WS_CKV), (const char*)(ws + WS_WUKN), (size_t)256 * 256 * 2, (size_t)256 * 256 * 2, 128, 2, F.G, (F.bx + F.G - 128) % F.G}; EpiP2K E{ws, P.in[11]};
          pg8::gemm_phase<EpiP2K, SchedGrid, true>(F.lds, 256, 256, 256, S, E); }
        { SchedGrid S{(const char*)(ws + WS_WUKV), (const char*)(ws + WS_CKV), (size_t)256 * 256 * 2, (size_t)256 * 256 * 2, 2, 128, F.G, (F.bx + F.G - 128) % F.G}; EpiP2V E{ws};
          pg8::gemm_phase<EpiP2V, SchedGrid, true>(F.lds, 256, 256, 256, S, E); }
    });
    RUN(3, { p3_attention(F); });
    if (PROBE_DUP == 31 && IN(3)) { p3_attention<true, false>(F); xcd_barrier(bar); }
    if (PROBE_DUP == 32 && IN(3)) { p3_attention<false, true>(F); xcd_barrier(bar); }
    RUN(5, { SchedGrid S{(const char*)(ws + WS_ATT), (const char*)(ws + WS_WO), (size_t)256 * 1024 * 2, (size_t)256 * 1024 * 2, 128, 4, F.G, F.bx}; EpiWo E{ws, P.in[0], (LAS const float*)(F.lds + WO_TAB_OFF)};
        wo_table(F, S); pg8::gemm_phase<EpiWo, SchedGrid, true>(F.lds, 1024, 1024, 1024, S, E); });
    RUN(6, { SchedGrid S{(const char*)(ws + WS_H1H), (const char*)(ws + WS_WMQ), (size_t)256 * 1024 * 2, (size_t)256 * 1024 * 2, 128, 4, F.G, F.bx}; EpiMq E{ws};
        pg8::gemm_phase<EpiMq, SchedGrid, true>(F.lds, 1024, 1024, 1024, S, E); });
    RUN(7, { p6_memattn(F); });
    RUN(8, { SchedGrid S{(const char*)(ws + WS_MO), (const char*)(ws + WS_WMO), (size_t)256 * 1024 * 2, (size_t)256 * 1024 * 2, 128, 4, F.G, F.bx}; EpiMo E{ws};
        pg8::gemm_phase<EpiMo, SchedGrid, true>(F.lds, 1024, 1024, 1024, S, E); });
    RUN(9, { p8_route(F, P); });
    RUN(10, { p9_gather(F); });
    RUN(11, { moe_tiles(F); SchedMoe S{(const char*)(ws + WS_TS), (const char*)(ws + WS_WGU), (LAS const int*)(F.lds + LDS_MISC) + 32, F.G, F.vcu, 3, 0}; EpiGU E{ws};
        pg8::gemm_phase<EpiGU, SchedMoe, true>(F.lds, 1024, 1024, 1024, S, E); });
    RUN(12, { moe_tiles(F); SchedMoe S{(const char*)(ws + WS_HE), (const char*)(ws + WS_WD2), (LAS const int*)(F.lds + LDS_MISC) + 32, F.G, F.vcu, 2, 1}; EpiDown E{ws, P.out};
        pg8::gemm_phase<EpiDown, SchedMoe, true, true>(F.lds, 1024, 1024, 512, S, E); });
#undef RUN
#undef IN
#undef SEAM
}

extern "C" void kernel_launch(void* const* d_in, const int* in_sizes, int n_in, void* d_out, int out_size, void* d_ws, size_t ws_size, hipStream_t stream) {
    static int grid = 0;
    if (grid == 0) {
        if (n_in != 31 || out_size != T * D || ws_size < WS_END) { fprintf(stderr, "kernel_launch: unexpected shapes (n_in %d, out %d, ws %zu < %zu)\n", n_in, out_size, ws_size, (size_t)WS_END); grid = -1; return; }
        int dev = 0, cus = 0, per_cu = 0;
        if (hipGetDevice(&dev) != hipSuccess || hipDeviceGetAttribute(&cus, hipDeviceAttributeMultiprocessorCount, dev) != hipSuccess) { grid = -1; return; }
        if (hipFuncSetAttribute((const void*)fwd_kernel, hipFuncAttributeMaxDynamicSharedMemorySize, LDS_BYTES) != hipSuccess) { fprintf(stderr, "kernel_launch: hipFuncSetAttribute failed\n"); grid = -1; return; }
        if (hipOccupancyMaxActiveBlocksPerMultiprocessor(&per_cu, (const void*)fwd_kernel, NTHR, LDS_BYTES) != hipSuccess || per_cu < 1) { fprintf(stderr, "kernel_launch: occupancy query says %d\n", per_cu); }
        (void)hipGetLastError();
        grid = cus;
    }
    if (grid < 0) return;
    (void)hipMemsetAsync((char*)d_ws + WS_CTL, 0, CTL_ZERO_BYTES, stream);
    Params p{};
    for (int i = 0; i < 31; ++i) p.in[i] = (const float*)d_in[i];
    p.out = (float*)d_out; p.ws = (unsigned char*)d_ws;
    if (MK_N_LAUNCHES == 1) { p.ph_lo = 0; p.ph_hi = N_PHASES; hipLaunchKernelGGL(fwd_kernel, dim3(grid), dim3(NTHR), LDS_BYTES, stream, p); }
    else { for (int k = 0; k < N_PHASES; ++k) { p.ph_lo = k; p.ph_hi = k + 1; hipLaunchKernelGGL(fwd_kernel, dim3(grid), dim3(NTHR), LDS_BYTES, stream, p); } }
}
```

```cpp
#include <hip/hip_runtime.h>
#include <cstdio>
#include <cstdint>

#define LAS __attribute__((address_space(3)))
#define GAS __attribute__((address_space(1)))
typedef _Float16 f16;
typedef _Float16 f16x8 __attribute__((ext_vector_type(8)));
typedef _Float16 f16x4 __attribute__((ext_vector_type(4)));
typedef _Float16 f16x2 __attribute__((ext_vector_type(2)));
typedef float f32x2 __attribute__((ext_vector_type(2)));
typedef float f32x4 __attribute__((ext_vector_type(4)));
typedef float f32x16 __attribute__((ext_vector_type(16)));
typedef unsigned u32x4 __attribute__((ext_vector_type(4)));
typedef unsigned u32x2 __attribute__((ext_vector_type(2)));

__device__ __forceinline__ unsigned pk2(float lo, float hi) { f16x2 v = {(f16)lo, (f16)hi}; return __builtin_bit_cast(unsigned, v); }
__device__ __forceinline__ u32x4 pk8(f32x4 a, f32x4 b) { u32x4 w; w.x = pk2(a[0], a[1]); w.y = pk2(a[2], a[3]); w.z = pk2(b[0], b[1]); w.w = pk2(b[2], b[3]); return w; }
__device__ __forceinline__ u32x2 pk4(f32x4 a) { u32x2 w; w.x = pk2(a[0], a[1]); w.y = pk2(a[2], a[3]); return w; }
__device__ __forceinline__ float dot4(f32x4 a) { return (a[0] * a[0] + a[1] * a[1]) + (a[2] * a[2] + a[3] * a[3]); }
template <int CTRL> __device__ __forceinline__ float dpp_add(float v) { const int t = __builtin_amdgcn_update_dpp(0, __builtin_bit_cast(int, v), CTRL, 0xf, 0xf, true); return v + __builtin_bit_cast(float, t); }
__device__ __forceinline__ float sum_x16(float x) { const auto rr = __builtin_amdgcn_permlane16_swap(__float_as_uint(x), __float_as_uint(x), false, false); const unsigned a = rr[0], b = rr[1]; return __uint_as_float(a) + __uint_as_float(b); }
__device__ __forceinline__ float sum_x32(float x) { const auto rr = __builtin_amdgcn_permlane32_swap(__float_as_uint(x), __float_as_uint(x), false, false); const unsigned a = rr[0], b = rr[1]; return __uint_as_float(a) + __uint_as_float(b); }
__device__ __forceinline__ float wave_sum(float v) {
    v = dpp_add<0xB1>(v);
    v = dpp_add<0x4E>(v);
    v = dpp_add<0x141>(v);
    v = dpp_add<0x140>(v);
    return sum_x32(sum_x16(v));
}
__device__ __forceinline__ int L32(int q) { return 8 * ((q >> 2) & 3) + 4 * (q >> 4) + (q & 3); }

__device__ __forceinline__ int fresh_tid() { int t = (int)threadIdx.x; asm volatile("" : "+v"(t)); return t; }
constexpr int T = 32768, D = 1024, SEQ = 4096, NB = 8;
constexpr float EPS = 1e-6f;
constexpr int NPOS = 152 * 256;

namespace pg8 {
constexpr int BM = 256, BK = 64, HALF = 128, HTB = HALF * BK * 2, STAGE_BYTES = 8 * HTB;
__host__ __device__ __forceinline__ int lds_byte(int r, int c) { const int st = (r >> 4) * 2 + (c >> 5), rr = r & 15, cc = c & 31, ob = rr * 64 + cc * 2; return st * 1024 + (ob ^ (((ob >> 9) & 1) << 5)); }
__host__ __device__ __forceinline__ void stage_rc(int b, int& R, int& C) { const int st = b / 1024, sb = b % 1024, swz = sb ^ (((sb >> 9) & 1) << 5); R = (st >> 1) * 16 + swz / 64; C = (st & 1) * 32 + (swz % 64) / 2; }
struct Unit { const char* A; const char* B; const char* B2; int pm, pn, aux; };

template <class Epi, class Sched, bool ALIGN_EPI, bool SPLITB = false>
__device__ __forceinline__ void gemm_phase(LAS unsigned char* lds, const int K, const int lda, const int ldb, const Sched& S, const Epi& E) {
    const int tid = fresh_tid(), wid = __builtin_amdgcn_readfirstlane(tid >> 6), lane = tid & 63, wr = wid >> 2, wc = wid & 3, fr = lane & 15, fq = lane >> 4;
    const int nt = K / BK;
    unsigned voffA[2], voffB[2];
#pragma unroll
    for (int i = 0; i < 2; ++i) { int R, C; stage_rc(tid * 16 + i * 8192, R, C); voffA[i] = (unsigned)(R * lda + C) * 2u; voffB[i] = (unsigned)(R * ldb + C) * 2u; }
    const size_t kstep = (size_t)(BK * 2);
    const size_t hstepA = (size_t)HALF * lda * 2, hstepB = (size_t)HALF * ldb * 2;
    const unsigned ldsw = (unsigned)wid * 1024u;
    const int aoff = lds_byte(wr * 64 + fr, fq * 8), boff = lds_byte(wc * 32 + fr, fq * 8);
#define PG8_SA(b, h) (((b) * 2 + (h)) * HTB)
#define PG8_SB(b, h) ((4 + (b) * 2 + (h)) * HTB)
#define PG8_STAGE(bufoff, gbase, voff) do { _Pragma("unroll") for (int _i = 0; _i < 2; ++_i) \
        __builtin_amdgcn_global_load_lds((const unsigned*)((const char*)(gbase) + (voff)[_i]), (LAS unsigned*)(lds + (bufoff) + ldsw + _i * 8192), 16, 0, 0); } while (0)
#define PG8_LDA(dst, b, h) do { _Pragma("unroll") for (int m = 0; m < 4; ++m) _Pragma("unroll") for (int k = 0; k < 2; ++k) dst[m][k] = *(const LAS f16x8*)(lds + PG8_SA(b, h) + aoff + m * 2048 + k * 1024); } while (0)
#define PG8_LDB(dst, b, h) do { _Pragma("unroll") for (int n = 0; n < 2; ++n) _Pragma("unroll") for (int k = 0; k < 2; ++k) dst[n][k] = *(const LAS f16x8*)(lds + PG8_SB(b, h) + boff + n * 2048 + k * 1024); } while (0)
#define PG8_MMA(ai, bj, At, Bt) do { __builtin_amdgcn_s_setprio(1); _Pragma("unroll") for (int m = 0; m < 4; ++m) _Pragma("unroll") for (int n = 0; n < 2; ++n) _Pragma("unroll") for (int k = 0; k < 2; ++k) \
        acc[ai][bj][m][n] = __builtin_amdgcn_mfma_f32_16x16x32_f16(Bt[n][k], At[m][k], acc[ai][bj][m][n], 0, 0, 0); __builtin_amdgcn_s_setprio(0); } while (0)
#define PG8_WAIT_V(n) asm volatile("s_waitcnt vmcnt(" #n ")" ::: "memory")
#define PG8_WAIT_L(n) asm volatile("s_waitcnt lgkmcnt(" #n ")" ::: "memory")
#define PG8_BAR __builtin_amdgcn_s_barrier()
#define PG8_SCHED __builtin_amdgcn_sched_barrier(0)
    Unit cur, nxt; int ui = 0;
    if (!S.next(0, cur)) return;
    f32x4 acc[2][2][4][2];
#pragma unroll
    for (int a = 0; a < 2; ++a)
#pragma unroll
        for (int b = 0; b < 2; ++b)
#pragma unroll
            for (int m = 0; m < 4; ++m)
#pragma unroll
                for (int n = 0; n < 2; ++n) acc[a][b][m][n] = (f32x4){0.f, 0.f, 0.f, 0.f};
    f16x8 At[4][2], B0[2][2], B1[2][2];
    const char* cA = cur.A; const char* cB = cur.B; const char* cB2 = SPLITB ? cur.B2 : nullptr; const int th = nt >> 1;
    PG8_STAGE(PG8_SB(0, 0), cB, voffB); PG8_STAGE(PG8_SB(0, 1), cB + hstepB, voffB); PG8_STAGE(PG8_SA(0, 0), cA, voffA); PG8_STAGE(PG8_SA(0, 1), cA + hstepA, voffA);
    if (wr == 1) PG8_BAR;
    PG8_WAIT_V(2); PG8_BAR;
    PG8_STAGE(PG8_SB(1, 0), cB + kstep, voffB); PG8_STAGE(PG8_SA(1, 0), cA + kstep, voffA); PG8_STAGE(PG8_SB(1, 1), cB + hstepB + kstep, voffB);
    PG8_WAIT_V(6); PG8_BAR;
    for (;;) {
        const bool has_next = S.next(ui + 1, nxt);
        const char* nA = has_next ? nxt.A : cA; const char* nB = has_next ? nxt.B : cB; const char* nB2 = SPLITB ? (has_next ? nxt.B2 : cB2) : nullptr;
        for (int t = 0; t < nt; t += 2) {
            if constexpr (Epi::MIDSCALE) { if (t == th) E.mid(acc, cur, wr, fr); }
            const bool last = (t == nt - 2);
            const char* a1 = cA + (size_t)(t + 1) * kstep;
            const char* a2 = last ? nA : cA + (size_t)(t + 2) * kstep;
            const char* b2 = last ? nB : ((SPLITB && t + 2 >= th) ? cB2 + (size_t)(t + 2 - th) * kstep : cB + (size_t)(t + 2) * kstep);
            const char* a3 = a2 + kstep; const char* b3 = b2 + kstep;
            PG8_LDB(B0, 0, 0); PG8_LDB(B1, 0, 1); PG8_SCHED; PG8_LDA(At, 0, 0); PG8_STAGE(PG8_SA(1, 1), a1 + hstepA, voffA);
            PG8_WAIT_V(8); PG8_WAIT_L(0); PG8_BAR; PG8_MMA(0, 0, At, B0); PG8_MMA(0, 1, At, B1); PG8_BAR; PG8_SCHED;
            PG8_LDA(At, 0, 1); PG8_STAGE(PG8_SB(0, 0), b2, voffB); PG8_STAGE(PG8_SB(0, 1), b2 + hstepB, voffB); PG8_STAGE(PG8_SA(0, 0), a2, voffA);
            PG8_WAIT_V(8); PG8_WAIT_L(0); PG8_BAR; PG8_MMA(1, 0, At, B0); PG8_MMA(1, 1, At, B1); PG8_BAR; PG8_SCHED;
            PG8_LDB(B0, 1, 0); PG8_LDB(B1, 1, 1); PG8_SCHED; PG8_LDA(At, 1, 0); PG8_STAGE(PG8_SA(0, 1), a2 + hstepA, voffA);
            PG8_WAIT_V(8); PG8_WAIT_L(0); PG8_BAR; PG8_MMA(0, 0, At, B0); PG8_MMA(0, 1, At, B1); PG8_BAR; PG8_SCHED;
            PG8_LDA(At, 1, 1); PG8_STAGE(PG8_SB(1, 0), b3, voffB); PG8_STAGE(PG8_SB(1, 1), b3 + hstepB, voffB); PG8_STAGE(PG8_SA(1, 0), a3, voffA);
            PG8_WAIT_V(8); PG8_WAIT_L(0); PG8_BAR; PG8_MMA(1, 0, At, B0); PG8_MMA(1, 1, At, B1); PG8_BAR; PG8_SCHED;
        }
        if constexpr (ALIGN_EPI) { if (wr == 0) PG8_BAR; }
        E(acc, cur, wr, wc, fr, fq);
        if (!has_next) break;
#pragma unroll
        for (int a = 0; a < 2; ++a)
#pragma unroll
            for (int b = 0; b < 2; ++b)
#pragma unroll
                for (int m = 0; m < 4; ++m)
#pragma unroll
                    for (int n = 0; n < 2; ++n) acc[a][b][m][n] = (f32x4){0.f, 0.f, 0.f, 0.f};
        cur = nxt; cA = nA; cB = nB; cB2 = nB2; ++ui;
        if constexpr (ALIGN_EPI) { if (wr == 1) PG8_BAR; }
    }
    PG8_WAIT_V(0);
    if constexpr (!ALIGN_EPI) { if (wr == 0) PG8_BAR; }
    PG8_BAR;
#undef PG8_SA
#undef PG8_SB
#undef PG8_STAGE
#undef PG8_LDA
#undef PG8_LDB
#undef PG8_MMA
#undef PG8_WAIT_V
#undef PG8_WAIT_L
#undef PG8_BAR
#undef PG8_SCHED
}
__device__ __forceinline__ void tile_map(int L, int nM, int nN, int& pm, int& pn) {
    const int nwg = nM * nN; int wgid = L;
    { const int q = nwg / 8, r = nwg % 8, xcd = wgid % 8, off = wgid / 8; wgid = (xcd < r ? xcd * (q + 1) : r * (q + 1) + (xcd - r) * q) + off; }
    const int nig = 8 * nN, gid = wgid / nig, fm = gid * 8, gsz = (nM - fm) < 8 ? (nM - fm) : 8;
    pm = fm + ((wgid % nig) % gsz); pn = (wgid % nig) / gsz;
}
}
using pg8::Unit;

#define XB_TMO      128
#define XB_XCNT(j)  (256  + 64 * (j))
#define XB_XSUB(j)  (1280 + 64 * (j))
#define XB_XGEN(j)  (2304 + 64 * (j))
#define XB_TOP      3328
#define XB_TOPGEN   3392
#define XCD_BAR_WORDS 3456
#define XB_SPIN_CAP (1u << 18)
__device__ __forceinline__ unsigned xb_ld(unsigned* p)              { return __hip_atomic_load(p, __ATOMIC_RELAXED, __HIP_MEMORY_SCOPE_AGENT); }
__device__ __forceinline__ unsigned xb_add(unsigned* p, unsigned v) { return __hip_atomic_fetch_add(p, v, __ATOMIC_RELAXED, __HIP_MEMORY_SCOPE_AGENT); }
__device__ __forceinline__ unsigned xb_xcc_id() { return (unsigned)__builtin_amdgcn_s_getreg((3 << 11) | 20) & 0xFu; }
#define XB_SPIN(cond, bar) do { unsigned _sp = 0; while (cond) { __builtin_amdgcn_s_sleep(1); \
    if ((++_sp & 255u) == 0u) { if (xb_ld(&(bar)[XB_TMO])) break; if (_sp > XB_SPIN_CAP) { atomicAdd(&(bar)[XB_TMO], 1u); break; } } } } while (0)
struct XcdBarrier { unsigned* bar; unsigned x; volatile LAS unsigned* st; };
__device__ __forceinline__ XcdBarrier xcd_barrier_post(unsigned* bar, volatile LAS unsigned* st) {
    XcdBarrier b; b.bar = bar; b.x = xb_xcc_id(); b.st = st;
    if (threadIdx.x == 0) (void)xb_add(&bar[XB_XCNT(b.x)], 1u);
    return b;
}
__device__ __forceinline__ void xcd_barrier_complete(unsigned* bar, unsigned x, unsigned& nloc, unsigned& nx) {
    const unsigned G = gridDim.x * gridDim.y * gridDim.z;
    unsigned sum, cnt, mine, sp = 0u;
    for (;;) {
        sum = 0u; cnt = 0u; mine = 0u;
#pragma unroll
        for (unsigned j = 0; j < 16; ++j) { const unsigned c = xb_ld(&bar[XB_XCNT(j)]); sum += c; cnt += (c > 0u) ? 1u : 0u; mine = (j == x) ? c : mine; }
        if (sum == G) break;
        __builtin_amdgcn_s_sleep(1);
        if ((++sp & 255u) == 0u) { if (xb_ld(&bar[XB_TMO])) break; if (sp > XB_SPIN_CAP) { atomicAdd(&bar[XB_TMO], 1u); break; } }
    }
    nloc = mine > 0u ? mine : 1u; nx = cnt > 0u ? cnt : 1u;
}
__device__ __forceinline__ void xcd_barrier(const XcdBarrier& b) {
    asm volatile("s_waitcnt vmcnt(0)" ::: "memory");
    __syncthreads();
    if (threadIdx.x == 0) {
        unsigned* bar = b.bar;
        __builtin_amdgcn_s_waitcnt(0);
        unsigned nloc = b.st[0], nx = b.st[1];
        if (nloc == 0u) { xcd_barrier_complete(bar, b.x, nloc, nx); b.st[0] = nloc; b.st[1] = nx; }
        const unsigned old = xb_add(&bar[XB_XSUB(b.x)], 1u);
        const unsigned gen = old / nloc;
        if (old + 1u == (gen + 1u) * nloc) {
            __builtin_amdgcn_fence(__ATOMIC_RELEASE, "agent");
            asm volatile("s_waitcnt vmcnt(0)" ::: "memory");
            const unsigned og = xb_add(&bar[XB_TOP], 1u);
            const unsigned tg = og / nx;
            if (og + 1u == (tg + 1u) * nx) xb_add(&bar[XB_TOPGEN], 1u);
            else XB_SPIN(xb_ld(&bar[XB_TOPGEN]) == tg, bar);
            __builtin_amdgcn_fence(__ATOMIC_ACQUIRE, "agent");
            xb_add(&bar[XB_XGEN(b.x)], 1u);
            asm volatile("s_waitcnt vmcnt(0)" ::: "memory");
        } else {
            XB_SPIN(xb_ld(&bar[XB_XGEN(b.x)]) == gen, bar);
            __builtin_amdgcn_fence(__ATOMIC_ACQUIRE, "agent");
            asm volatile("s_waitcnt vmcnt(0)" ::: "memory");
        }
    }
    __syncthreads();
}

constexpr size_t MiB = 1u << 20;
constexpr size_t WS_CTL = 0, CTL_ZERO_BYTES = 65536;
constexpr int CW_BAR = 1024;
constexpr int CW_CNT = 8192;
constexpr int CW_CUR = 8192 + 64;
constexpr size_t WS_SSQ_CQ  = 1 * MiB;
constexpr size_t WS_SSQ_CKV = 2 * MiB;
constexpr size_t WS_SSQ_MK  = 2 * MiB + 512 * 1024;
constexpr size_t WS_SSQ_ATT = 3 * MiB;
constexpr size_t WS_SSQ_H1  = 5 * MiB;
constexpr size_t WS_SSQ_MQ  = 7 * MiB;
constexpr size_t WS_COS     = 9 * MiB;
constexpr size_t WS_SIN     = 11 * MiB;
constexpr size_t WS_BKT     = 13 * MiB;
constexpr size_t WS_RR      = 13 * MiB + 128 * 1024;
constexpr size_t WS_W0      = 13 * MiB + 256 * 1024;
constexpr size_t WS_W1      = 13 * MiB + 384 * 1024;
constexpr size_t WS_TOK     = 13 * MiB + 512 * 1024;
constexpr size_t WS_PR      = 13 * MiB + 704 * 1024;
constexpr size_t WS_PW0     = 14 * MiB;
constexpr size_t WS_PW1     = 14 * MiB + 192 * 1024;
constexpr size_t WS_KRF     = 14 * MiB + 512 * 1024;
constexpr size_t WS_WIN  = 17 * MiB;
constexpr size_t WS_WSV  = WS_WIN  + 3584 * 1024;
constexpr size_t WS_WMK  = WS_WSV  + 1 * MiB;
constexpr size_t WS_WMV  = WS_WMK  + 2 * MiB;
constexpr size_t WS_WUQ  = WS_WMV  + 2 * MiB;
constexpr size_t WS_WUKN = WS_WUQ  + 1 * MiB;
constexpr size_t WS_WUKV = WS_WUKN + 256 * 1024;
constexpr size_t WS_WO   = WS_WUKV + 256 * 1024;
constexpr size_t WS_WMQ  = WS_WO   + 2 * MiB;
constexpr size_t WS_WMO  = WS_WMQ  + 2 * MiB;
constexpr size_t WS_WGU  = WS_WMO  + 2 * MiB;
constexpr size_t WS_WD2  = WS_WGU  + 32 * MiB;
constexpr size_t WS_WEND = WS_WD2  + 48 * MiB;
constexpr size_t WS_MN   = 114 * MiB;
constexpr size_t WS_MKR  = 118 * MiB;
constexpr size_t WS_MVT  = 122 * MiB;
constexpr size_t WS_KP   = 126 * MiB;
constexpr size_t WS_R1   = 130 * MiB;
constexpr size_t WS_R2   = 194 * MiB;
constexpr size_t WS_R3   = 290 * MiB;
constexpr size_t WS_R4   = 330 * MiB;
constexpr size_t WS_END  = 458 * MiB;
static_assert(WS_WEND <= WS_MN, "ws map");
constexpr size_t WS_HN = WS_R1, WS_ATT = WS_R1, WS_MQ = WS_R1, WS_H2H = WS_R1;
constexpr size_t WS_SBQ = WS_R2, WS_SBK = WS_R2 + 32 * MiB, WS_SBVT = WS_R2 + 64 * MiB, WS_H1H = WS_R2, WS_TS = WS_R2;
constexpr size_t WS_CQ = WS_R3, WS_CKV = WS_R3 + 24 * MiB;
constexpr size_t WS_MLAQ = WS_R4, WS_MLAK = WS_R4 + 48 * MiB, WS_MLAVT = WS_R4 + 96 * MiB, WS_HE = WS_R4, WS_MO = WS_R4;

constexpr int LDS_BYTES = 147456;
constexpr int LDS_MISC = 143360;
constexpr int NWAVES = 8, NTHR = 512;

struct Params { const float* in[31]; float* out; unsigned char* ws; int ph_lo, ph_hi; };

struct Frame {
    LAS unsigned char* lds; volatile LAS unsigned* MISC;
    int vcu, G, bx;
    unsigned char* ws; float* out; unsigned* ctl;
};
#define PHASE_IDS() const int tid = fresh_tid(), lane = tid & 63, wave = __builtin_amdgcn_readfirstlane(tid >> 6); (void)lane; (void)wave

__device__ __forceinline__ void conv_item(const float* src, int ld, int srccol0, int mode, int ksrc0, const float* kscale, f16* dst, int K, int row0, int k0, LAS float* scr, int lane) {
    if (mode != 2) {
        const float* base = src + (size_t)ksrc0 * ld + srccol0;
        const unsigned voff = (unsigned)((lane >> 5) * ld + (lane & 31)) * 4u;
        float v[32];
#pragma unroll
        for (int i = 0; i < 32; ++i) v[i] = *(const float*)((const char*)(base + (size_t)2 * i * ld) + voff);
#pragma unroll
        for (int i = 0; i < 32; ++i) scr[(2 * i + (lane >> 5)) * 33 + (lane & 31)] = v[i];
    }
    asm volatile("s_waitcnt lgkmcnt(0)" ::: "memory");
    const int c = lane & 7;
    f32x4 ks0 = (f32x4){1.f, 1.f, 1.f, 1.f}, ks1 = ks0;
    if (kscale) { ks0 = *(const f32x4*)(kscale + ksrc0 + 8 * c); ks1 = *(const f32x4*)(kscale + ksrc0 + 8 * c + 4); }
#pragma unroll
    for (int j = 0; j < 4; ++j) { const int q = (lane >> 3) + 8 * j; const int lc = (mode == 1) ? L32(q) : q; const LAS float* s = scr + (8 * c) * 33 + lc;
        u32x4 o;
        if (mode == 2) { o = (u32x4){0u, 0u, 0u, 0u}; }
        else { o.x = pk2(s[0 * 33] * ks0[0], s[1 * 33] * ks0[1]); o.y = pk2(s[2 * 33] * ks0[2], s[3 * 33] * ks0[3]); o.z = pk2(s[4 * 33] * ks1[0], s[5 * 33] * ks1[1]); o.w = pk2(s[6 * 33] * ks1[2], s[7 * 33] * ks1[3]); }
        *(u32x4*)(dst + (size_t)(row0 + q) * K + k0 + 8 * c) = o; }
    asm volatile("s_waitcnt lgkmcnt(0)" ::: "memory");
}
__device__ __forceinline__ void rms_rows2_to_f16(const float* x, const float* g, f16* o, int m0, int m1, bool has1, int lane) {
    const f32x4* x0 = (const f32x4*)(x + (size_t)m0 * D) + lane; const f32x4* x1 = (const f32x4*)(x + (size_t)m1 * D) + lane; const f32x4* gr = (const f32x4*)g + lane;
    f32x4 v[4], w[4]; float s0 = 0.f, s1 = 0.f;
#pragma unroll
    for (int j = 0; j < 4; ++j) v[j] = x0[64 * j];
    if (has1) {
#pragma unroll
        for (int j = 0; j < 4; ++j) w[j] = x1[64 * j];
    } else {
#pragma unroll
        for (int j = 0; j < 4; ++j) w[j] = (f32x4){0.f, 0.f, 0.f, 0.f};
    }
#pragma unroll
    for (int j = 0; j < 4; ++j) { s0 += dot4(v[j]); s1 += dot4(w[j]); }
    s0 = wave_sum(s0); s1 = wave_sum(s1);
    const float r0 = __builtin_amdgcn_rsqf(s0 * (1.f / 1024.f) + EPS), r1 = __builtin_amdgcn_rsqf(s1 * (1.f / 1024.f) + EPS);
    u32x2* o0 = (u32x2*)(o + (size_t)m0 * D) + lane; u32x2* o1 = (u32x2*)(o + (size_t)m1 * D) + lane;
#pragma unroll
    for (int j = 0; j < 4; ++j) { const f32x4 gg = gr[64 * j]; o0[64 * j] = pk4(v[j] * r0 * gg); if (has1) o1[64 * j] = pk4(w[j] * r1 * gg); }
}
__device__ __forceinline__ void moe_pair(int pi, int& lo, int& hi) { lo = pi < 3 ? 0 : (pi < 5 ? 1 : 2); hi = pi < 3 ? pi + 1 : (pi < 5 ? pi - 1 : 3); }

__device__ __forceinline__ void p0_prologue(Frame& F, const Params& P) {
    PHASE_IDS();
    LAS float* scr = (LAS float*)(F.lds + wave * 16384);
    const int gw = F.vcu * NWAVES + wave, NGW = F.G * NWAVES;
    unsigned char* ws = F.ws;
    const float* w_in = P.in[4]; const float* w_uq = P.in[6]; const float* w_ukv = P.in[8]; const float* w_o = P.in[15];
    const float* w_mq = P.in[18]; const float* w_mkv = P.in[19]; const float* w_mo = P.in[22];
    const float* w_gate = P.in[28]; const float* w_up = P.in[29]; const float* w_down = P.in[30];
    for (int it = gw; it < 56 * 16; it += NGW) { const int rb = it >> 4, kb = it & 15, tile = rb >> 3, g = rb & 7, bj = g >> 2, wc = g & 3; int col, mode = 1;
        if (tile < 2) col = (4 * tile + wc) * 64 + 32 * bj;
        else if (tile < 4) col = 512 + (4 * (tile - 2) + wc) * 64 + 32 * bj;
        else if (tile == 4) col = 1536 + 64 * wc + 32 * bj;
        else if (tile == 5) { if (bj == 0) col = 1536 + 256 + 32 * wc; else if (wc == 0) { col = 2176; mode = 0; } else { col = 0; mode = 2; } }
        else col = 1920 + 64 * wc + 32 * bj;
        conv_item(w_in, 2208, col, mode, kb * 64, nullptr, (f16*)(ws + WS_WIN), 1024, rb * 32, kb * 64, scr, lane); }
    for (int it = gw; it < 16 * 16; it += NGW) { const int rb = it >> 4, kb = it & 15; conv_item(w_in, 2208, 1024 + 32 * rb, 0, kb * 64, nullptr, (f16*)(ws + WS_WSV), 1024, rb * 32, kb * 64, scr, lane); }
    for (int it = gw; it < 32 * 16; it += NGW) { const int rb = it >> 4, kb = it & 15, tile = rb >> 3, g = rb & 7, bj = g >> 2, wc = g & 3;
        conv_item(w_mkv, 2048, 256 * tile + 64 * wc + 32 * bj, 1, kb * 64, nullptr, (f16*)(ws + WS_WMK), 1024, rb * 32, kb * 64, scr, lane); }
    for (int it = gw; it < 32 * 16; it += NGW) { const int rb = it >> 4, kb = it & 15; conv_item(w_mkv, 2048, 1024 + 32 * rb, 0, kb * 64, nullptr, (f16*)(ws + WS_WMV), 1024, rb * 32, kb * 64, scr, lane); }
    for (int it = gw; it < 24 * 6; it += NGW) { const int rb = it / 6, kb = it % 6, tile = rb >> 3, g = rb & 7, bj = g >> 2, wc = g & 3; int col, mode = 1;
        if (tile < 2) col = (4 * tile + wc) * 96 + 32 * bj; else { col = (4 * bj + wc) * 96 + 64; mode = 0; }
        conv_item(w_uq, 768, col, mode, kb * 64, P.in[5], (f16*)(ws + WS_WUQ), 384, rb * 32, kb * 64, scr, lane); }
    for (int it = gw; it < 16 * 4; it += NGW) { const int rb = it >> 2, kb = it & 3, tile = rb >> 3, g = rb & 7, bj = g >> 2, wc = g & 3;
        conv_item(w_ukv, 1024, (4 * tile + wc) * 128 + 32 * bj, 1, kb * 64, P.in[7], (f16*)(ws + WS_WUKN), 256, rb * 32, kb * 64, scr, lane); }
    for (int it = gw; it < 16 * 4; it += NGW) { const int rb = it >> 2, kb = it & 3;
        conv_item(w_ukv, 1024, (rb >> 1) * 128 + 64 + 32 * (rb & 1), 0, kb * 64, P.in[7], (f16*)(ws + WS_WUKV), 256, rb * 32, kb * 64, scr, lane); }
    for (int it = gw; it < 32 * 16; it += NGW) { const int rb = it >> 4, kb = it & 15; conv_item(w_o, 1024, 32 * rb, 1, kb * 64, kb < 8 ? P.in[13] : P.in[14] - 512, (f16*)(ws + WS_WO), 1024, rb * 32, kb * 64, scr, lane); }
    for (int it = gw; it < 32 * 16; it += NGW) { const int rb = it >> 4, kb = it & 15; conv_item(w_mq, 1024, 32 * rb, 1, kb * 64, P.in[16], (f16*)(ws + WS_WMQ), 1024, rb * 32, kb * 64, scr, lane); }
    for (int it = gw; it < 32 * 16; it += NGW) { const int rb = it >> 4, kb = it & 15; conv_item(w_mo, 1024, 32 * rb, 1, kb * 64, nullptr, (f16*)(ws + WS_WMO), 1024, rb * 32, kb * 64, scr, lane); }
    for (int it = gw; it < 64 * 8 * 16; it += NGW) { const int kb = it & 15, rb = (it >> 4) & 7, tile = it >> 7, e = tile >> 2, ffb = tile & 3, bj = rb >> 2, wc = rb & 3;
        conv_item((bj ? w_up : w_gate) + (size_t)e * 1024 * 512, 512, ffb * 128 + 32 * wc, 1, kb * 64, P.in[23], (f16*)(ws + WS_WGU) + (size_t)tile * 256 * 1024, 1024, rb * 32, kb * 64, scr, lane); }
    for (int it = gw; it < 16 * 32 * 8; it += NGW) { const int kb = it & 7, rb = (it >> 3) & 31, e = it >> 8;
        conv_item(w_down + (size_t)e * 512 * 1024, 1024, 32 * rb, 1, kb * 64, nullptr, (f16*)(ws + WS_WD2) + (size_t)e * 1024 * 512, 512, rb * 32, kb * 64, scr, lane); }
    for (int m = gw; m < T; m += 2 * NGW) rms_rows2_to_f16(P.in[0], P.in[3], (f16*)(ws + WS_HN), m, m + NGW, m + NGW < T, lane);
    for (int m = gw; m < 2048; m += 2 * NGW) rms_rows2_to_f16(P.in[1], P.in[17], (f16*)(ws + WS_MN), m, m + NGW, m + NGW < 2048, lane);
    {
        const int gt = F.vcu * NTHR + tid, NGT = F.G * NTHR; const int* pos = (const int*)P.in[2];
        float* COS = (float*)(ws + WS_COS); float* SIN = (float*)(ws + WS_SIN);
        for (int e = gt; e < T * 16; e += NGT) { const int tok = e >> 4, i = e & 15;
            const float invf = i == 0 ? 1.000000000e+00f : i == 1 ? 5.623413324e-01f : i == 2 ? 3.162277639e-01f : i == 3 ? 1.778279394e-01f : i == 4 ? 1.000000015e-01f : i == 5 ? 5.623413250e-02f : i == 6 ? 3.162277490e-02f : i == 7 ? 1.778279431e-02f :
                               i == 8 ? 9.999999776e-03f : i == 9 ? 5.623413250e-03f : i == 10 ? 3.162277630e-03f : i == 11 ? 1.778279431e-03f : i == 12 ? 1.000000047e-03f : i == 13 ? 5.623413017e-04f : i == 14 ? 3.162277571e-04f : 1.778279402e-04f;
            const float ang = (float)pos[tok] * invf;
            const double x = (double)ang; const double n = __builtin_rint(x * 0.15915494309189535); const float rev = (float)(x * 0.15915494309189535 - n);
            COS[e] = __builtin_amdgcn_cosf(rev); SIN[e] = __builtin_amdgcn_sinf(rev); }
        int* TOK = (int*)(ws + WS_TOK);
        for (int e = gt; e < NPOS; e += NGT) TOK[e] = -1;
    }
}

typedef f32x4 Acc[2][2][4][2];
template <bool SSQ>
__device__ __forceinline__ void store_w64(const Acc& acc, int rowb, f16* dst, int ld, int colb, float scale, float* ssq, int ldq, int slot, int fq) {
#pragma unroll
    for (int ai = 0; ai < 2; ++ai)
#pragma unroll
        for (int m = 0; m < 4; ++m) { const int row = rowb + ai * 128 + m * 16; float s = 0.f;
#pragma unroll
            for (int bj = 0; bj < 2; ++bj) { const f32x4 v0 = acc[ai][bj][m][0] * scale, v1 = acc[ai][bj][m][1] * scale;
                if (SSQ) s += dot4(v0) + dot4(v1);
                *(u32x4*)(dst + (size_t)row * ld + colb + bj * 32 + 8 * fq) = pk8(v0, v1); }
            if (SSQ) { s = sum_x32(sum_x16(s)); if (fq == 0) ssq[(size_t)row * ldq + slot] = s; } }
}

struct EpiP1N {
    static constexpr bool MIDSCALE = false;
    unsigned char* ws; const float* krg;
    __device__ __forceinline__ void operator()(const Acc& acc, const Unit& u, int wr, int wc, int fr_, int fq_) const {
        int fr = fr_, fq = fq_; asm volatile("" : "+v"(fr), "+v"(fq));
        const int rowb = u.pm * 256 + wr * 64 + fr;
        if (u.aux == 0) { store_w64<false>(acc, rowb, (f16*)(ws + WS_SBQ), 512, (4 * u.pn + wc) * 64, 0.125f * 1.4426950408889634f, nullptr, 0, 0, fq); }
        else if (u.aux == 1) { store_w64<false>(acc, rowb, (f16*)(ws + WS_SBK), 512, (4 * u.pn + wc) * 64, 1.f, nullptr, 0, 0, fq); }
        else if (u.aux == 2) { store_w64<true>(acc, rowb, (f16*)(ws + WS_CQ), 384, 64 * wc, 1.f, (float*)(ws + WS_SSQ_CQ), 8, wc, fq); }
        else if (u.aux == 4) { store_w64<true>(acc, rowb, (f16*)(ws + WS_CKV), 256, 64 * wc, 1.f, (float*)(ws + WS_SSQ_CKV), 4, wc, fq); }
        else if (u.aux == 5) { store_w64<true>(acc, rowb, (f16*)(ws + WS_MKR), 1024, 256 * u.pn + 64 * wc, 1.f, (float*)(ws + WS_SSQ_MK), 16, 4 * u.pn + wc, fq); }
        else {
            f16* CQ = (f16*)(ws + WS_CQ); float* SS = (float*)(ws + WS_SSQ_CQ);
#pragma unroll
            for (int ai = 0; ai < 2; ++ai)
#pragma unroll
                for (int m = 0; m < 4; ++m) { const int row = rowb + ai * 128 + m * 16;
                    const f32x4 v0 = acc[ai][0][m][0], v1 = acc[ai][0][m][1]; float s = dot4(v0) + dot4(v1);
                    *(u32x4*)(CQ + (size_t)row * 384 + 256 + 32 * wc + 8 * fq) = pk8(v0, v1);
                    s = sum_x32(sum_x16(s)); if (fq == 0) SS[(size_t)row * 8 + 4 + wc] = s; }
            if (wc == 0) {
                const float* COS = (const float*)(ws + WS_COS); const float* SIN = (const float*)(ws + WS_SIN); f16* KRF = (f16*)(ws + WS_KRF);
                const f32x4 g1 = *(const f32x4*)(krg + 4 * fq), g2 = *(const f32x4*)(krg + 16 + 4 * fq);
#pragma unroll
                for (int ai = 0; ai < 2; ++ai)
#pragma unroll
                    for (int m = 0; m < 4; ++m) { const int row = rowb + ai * 128 + m * 16;
                        f32x4 x1 = acc[ai][1][m][0], x2 = acc[ai][1][m][1]; float s = dot4(x1) + dot4(x2);
                        s = sum_x32(sum_x16(s));
                        const float rn = __builtin_amdgcn_rsqf(s * (1.f / 32.f) + EPS);
                        x1 = x1 * rn * g1; x2 = x2 * rn * g2;
                        const f32x4 c = *(const f32x4*)(COS + (size_t)row * 16 + 4 * fq), sn = *(const f32x4*)(SIN + (size_t)row * 16 + 4 * fq);
                        const f32x4 o1 = x1 * c - x2 * sn, o2 = x2 * c + x1 * sn;
                        *(u32x2*)(KRF + (size_t)row * 32 + 4 * fq) = pk4(o1); *(u32x2*)(KRF + (size_t)row * 32 + 16 + 4 * fq) = pk4(o2); }
            }
        }
    }
};
struct SchedP1N {
    unsigned char* ws; int G, c;
    __device__ __forceinline__ bool next(int i, Unit& u) const {
        int L = i * G + c;
        if (L < 896) { int pm, pn; pg8::tile_map(L, 128, 7, pm, pn);
            u.A = (const char*)(ws + WS_HN) + (size_t)pm * 256 * 1024 * 2; u.B = (const char*)(ws + WS_WIN) + (size_t)pn * 256 * 1024 * 2; u.pm = pm;
            u.aux = pn < 2 ? 0 : (pn < 4 ? 1 : pn - 2); u.pn = pn < 2 ? pn : (pn < 4 ? pn - 2 : 0); return true; }
        L -= 896; if (L >= 32) return false;
        int pm, pn; pg8::tile_map(L, 8, 4, pm, pn);
        u.A = (const char*)(ws + WS_MN) + (size_t)pm * 256 * 1024 * 2; u.B = (const char*)(ws + WS_WMK) + (size_t)pn * 256 * 1024 * 2; u.pm = pm; u.pn = pn; u.aux = 5; return true;
    }
};
struct EpiP1S {
    static constexpr bool MIDSCALE = false;
    unsigned char* ws;
    __device__ __forceinline__ void operator()(const Acc& acc, const Unit& u, int wr, int wc, int fr_, int fq_) const {
        int fr = fr_, fq = fq_; asm volatile("" : "+v"(fr), "+v"(fq));
        const int rowb = u.pm * 256 + wr * 64 + fr;
        if (u.aux == 0) { f16* dst = (f16*)(ws + WS_SBVT);
#pragma unroll
            for (int ai = 0; ai < 2; ++ai)
#pragma unroll
                for (int m = 0; m < 4; ++m) { const size_t ro = (size_t)(rowb + ai * 128 + m * 16) * T + u.pn * 256 + 32 * wc + 8 * (fq & 1) + 4 * (fq >> 1);
#pragma unroll
                    for (int bj = 0; bj < 2; ++bj)
#pragma unroll
                        for (int n = 0; n < 2; ++n) *(u32x2*)(dst + ro + 128 * bj + 16 * n) = pk4(acc[ai][bj][m][n]); }
        } else { f16* dst = (f16*)(ws + WS_MVT);
#pragma unroll
            for (int ai = 0; ai < 2; ++ai)
#pragma unroll
                for (int m = 0; m < 4; ++m) { const size_t ro = (size_t)(rowb + ai * 128 + m * 16) * 2048 + u.pn * 256 + 32 * wc + 8 * fq;
#pragma unroll
                    for (int bj = 0; bj < 2; ++bj)
#pragma unroll
                        for (int n = 0; n < 2; ++n) *(u32x2*)(dst + ro + 128 * bj + 4 * n) = pk4(acc[ai][bj][m][n]); }
        }
    }
};
struct SchedP1S {
    unsigned char* ws; int G, c;
    __device__ __forceinline__ bool next(int i, Unit& u) const {
        int L = i * G + c;
        if (L < 256) { int pm, pn; pg8::tile_map(L, 2, 128, pm, pn);
            u.A = (const char*)(ws + WS_WSV) + (size_t)pm * 256 * 1024 * 2; u.B = (const char*)(ws + WS_HN) + (size_t)pn * 256 * 1024 * 2; u.pm = pm; u.pn = pn; u.aux = 0; return true; }
        L -= 256; if (L >= 32) return false;
        int pm, pn; pg8::tile_map(L, 4, 8, pm, pn);
        u.A = (const char*)(ws + WS_WMV) + (size_t)pm * 256 * 1024 * 2; u.B = (const char*)(ws + WS_MN) + (size_t)pn * 256 * 1024 * 2; u.pm = pm; u.pn = pn; u.aux = 1; return true;
    }
};

constexpr float MLA_QSCALE = 0.10206207261596575f * 1.4426950408889634f;
__device__ __forceinline__ float rq_of(const float* SS8, int row) { const f32x4 a = *(const f32x4*)(SS8 + (size_t)row * 8), b = *(const f32x4*)(SS8 + (size_t)row * 8 + 4);
    return __builtin_amdgcn_rsqf((((a[0] + a[1]) + (a[2] + a[3])) + ((b[0] + b[1]) + (b[2] + b[3]))) * (1.f / 384.f) + EPS); }
__device__ __forceinline__ float rkv_of(const float* SS4, int row) { const f32x4 a = *(const f32x4*)(SS4 + (size_t)row * 4);
    return __builtin_amdgcn_rsqf(((a[0] + a[1]) + (a[2] + a[3])) * (1.f / 256.f) + EPS); }
struct EpiP2Q {
    static constexpr bool MIDSCALE = false;
    unsigned char* ws; const float* qng; const float* qrg;
    __device__ __forceinline__ void operator()(const Acc& acc, const Unit& u, int wr, int wc, int fr_, int fq_) const {
        int fr = fr_, fq = fq_; asm volatile("" : "+v"(fr), "+v"(fq));
        const int rowb = u.pm * 256 + wr * 64 + fr; const float* SS = (const float*)(ws + WS_SSQ_CQ); f16* Q = (f16*)(ws + WS_MLAQ);
        if (u.pn < 2) { const int h = 4 * u.pn + wc;
            f32x4 g[2][2];
#pragma unroll
            for (int bj = 0; bj < 2; ++bj)
#pragma unroll
                for (int n = 0; n < 2; ++n) g[bj][n] = *(const f32x4*)(qng + 32 * bj + 8 * fq + 4 * n) * MLA_QSCALE;
#pragma unroll
            for (int ai = 0; ai < 2; ++ai)
#pragma unroll
                for (int m = 0; m < 4; ++m) { const int row = rowb + ai * 128 + m * 16; const float rq = rq_of(SS, row);
                    f32x4 v[2][2]; float s = 0.f;
#pragma unroll
                    for (int bj = 0; bj < 2; ++bj)
#pragma unroll
                        for (int n = 0; n < 2; ++n) { v[bj][n] = acc[ai][bj][m][n] * rq; s += dot4(v[bj][n]); }
                    s = sum_x32(sum_x16(s));
                    const float rn = __builtin_amdgcn_rsqf(s * (1.f / 64.f) + EPS);
#pragma unroll
                    for (int bj = 0; bj < 2; ++bj) *(u32x4*)(Q + (size_t)row * 768 + h * 96 + 32 * bj + 8 * fq) = pk8(v[bj][0] * rn * g[bj][0], v[bj][1] * rn * g[bj][1]); }
        } else {
            const float* COS = (const float*)(ws + WS_COS); const float* SIN = (const float*)(ws + WS_SIN);
            const f32x4 g1 = *(const f32x4*)(qrg + 4 * fq) * MLA_QSCALE, g2 = *(const f32x4*)(qrg + 16 + 4 * fq) * MLA_QSCALE;
#pragma unroll
            for (int ai = 0; ai < 2; ++ai)
#pragma unroll
                for (int m = 0; m < 4; ++m) { const int row = rowb + ai * 128 + m * 16; const float rq = rq_of(SS, row);
                    const f32x4 c = *(const f32x4*)(COS + (size_t)row * 16 + 4 * fq), sn = *(const f32x4*)(SIN + (size_t)row * 16 + 4 * fq);
#pragma unroll
                    for (int bj = 0; bj < 2; ++bj) { const int h = 4 * bj + wc;
                        f32x4 x1 = acc[ai][bj][m][0] * rq, x2 = acc[ai][bj][m][1] * rq; float s = dot4(x1) + dot4(x2);
                        s = sum_x32(sum_x16(s));
                        const float rn = __builtin_amdgcn_rsqf(s * (1.f / 32.f) + EPS);
                        x1 = x1 * rn * g1; x2 = x2 * rn * g2;
                        const f32x4 o1 = x1 * c - x2 * sn, o2 = x2 * c + x1 * sn;
                        *(u32x2*)(Q + (size_t)row * 768 + h * 96 + 64 + 4 * fq) = pk4(o1); *(u32x2*)(Q + (size_t)row * 768 + h * 96 + 80 + 4 * fq) = pk4(o2); } }
        }
    }
};
struct EpiP2K {
    static constexpr bool MIDSCALE = false;
    unsigned char* ws; const float* kng;
    __device__ __forceinline__ void operator()(const Acc& acc, const Unit& u, int wr, int wc, int fr_, int fq_) const {
        int fr = fr_, fq = fq_; asm volatile("" : "+v"(fr), "+v"(fq));
        const int rowb = u.pm * 256 + wr * 64 + fr; const float* SS = (const float*)(ws + WS_SSQ_CKV); f16* Kd = (f16*)(ws + WS_MLAK); const f16* KRF = (const f16*)(ws + WS_KRF);
        const int h = 4 * u.pn + wc;
        f32x4 g[2][2];
#pragma unroll
        for (int bj = 0; bj < 2; ++bj)
#pragma unroll
            for (int n = 0; n < 2; ++n) g[bj][n] = *(const f32x4*)(kng + 32 * bj + 8 * fq + 4 * n);
#pragma unroll
        for (int ai = 0; ai < 2; ++ai)
#pragma unroll
            for (int m = 0; m < 4; ++m) { const int row = rowb + ai * 128 + m * 16; const float rk = rkv_of(SS, row);
                f32x4 v[2][2]; float s = 0.f;
#pragma unroll
                for (int bj = 0; bj < 2; ++bj)
#pragma unroll
                    for (int n = 0; n < 2; ++n) { v[bj][n] = acc[ai][bj][m][n] * rk; s += dot4(v[bj][n]); }
                s = sum_x32(sum_x16(s));
                const float rn = __builtin_amdgcn_rsqf(s * (1.f / 64.f) + EPS);
#pragma unroll
                for (int bj = 0; bj < 2; ++bj) *(u32x4*)(Kd + (size_t)row * 768 + h * 96 + 32 * bj + 8 * fq) = pk8(v[bj][0] * rn * g[bj][0], v[bj][1] * rn * g[bj][1]);
                *(u32x4*)(Kd + (size_t)row * 768 + h * 96 + 64 + 8 * fq) = *(const u32x4*)(KRF + (size_t)row * 32 + 8 * fq); }
    }
};
struct EpiP2V {
    static constexpr bool MIDSCALE = false;
    unsigned char* ws;
    __device__ __forceinline__ void operator()(const Acc& acc, const Unit& u, int wr, int wc, int fr_, int fq_) const {
        int fr = fr_, fq = fq_; asm volatile("" : "+v"(fr), "+v"(fq));
        const int rowb = u.pm * 256 + wr * 64 + fr; const float* SS = (const float*)(ws + WS_SSQ_CKV); f16* dst = (f16*)(ws + WS_MLAVT);
        f32x4 rk[2][2];
#pragma unroll
        for (int bj = 0; bj < 2; ++bj)
#pragma unroll
            for (int n = 0; n < 2; ++n) { const int tok = u.pn * 256 + 128 * bj + 32 * wc + 16 * n + 4 * fq;
#pragma unroll
                for (int j = 0; j < 4; ++j) rk[bj][n][j] = rkv_of(SS, tok + j); }
#pragma unroll
        for (int ai = 0; ai < 2; ++ai)
#pragma unroll
            for (int m = 0; m < 4; ++m) { const size_t ro = (size_t)(rowb + ai * 128 + m * 16) * T + u.pn * 256 + 32 * wc + 8 * (fq & 1) + 4 * (fq >> 1);
#pragma unroll
                for (int bj = 0; bj < 2; ++bj)
#pragma unroll
                    for (int n = 0; n < 2; ++n) *(u32x2*)(dst + ro + 128 * bj + 16 * n) = pk4(acc[ai][bj][m][n] * rk[bj][n]); }
    }
};
struct SchedGrid {
    const char* A; const char* B; size_t sA, sB; int nM, nN, G, c;
    __device__ __forceinline__ bool next(int i, Unit& u) const {
        const int L = i * G + c; if (L >= nM * nN) return false;
        int pm, pn; pg8::tile_map(L, nM, nN, pm, pn);
        u.A = A + (size_t)pm * sA; u.B = B + (size_t)pn * sB; u.pm = pm; u.pn = pn; u.aux = i; return true;
    }
};
__device__ __forceinline__ void p2_kprime(Frame& F, const Params& P) {
    PHASE_IDS();
    const int gw = F.vcu * NWAVES + wave, NGW = F.G * NWAVES;
    const f16* MKR = (const f16*)(F.ws + WS_MKR); const float* SS = (const float*)(F.ws + WS_SSQ_MK); f16* KP = (f16*)(F.ws + WS_KP);
    const f32x4 gg = *(const f32x4*)(P.in[21] + 4 * lane) * *(const f32x4*)(P.in[20] + 4 * lane);
    for (int it = gw; it < 2048 * 4; it += NGW) { const int row = it >> 2, h = it & 3, b = row >> 8, key = row & 255;
        const f32x4 a = *(const f32x4*)(SS + (size_t)row * 16 + 4 * h); const float r = __builtin_amdgcn_rsqf(((a[0] + a[1]) + (a[2] + a[3])) * (1.f / 256.f) + EPS);
        const f16x4 x = *(const f16x4*)(MKR + (size_t)row * 1024 + 256 * h + 4 * lane);
        const f32x4 v = (f32x4){(float)x[0], (float)x[1], (float)x[2], (float)x[3]} * r * gg;
        *(u32x2*)(KP + ((size_t)((b * 4 + h) * 256 + key)) * 256 + 4 * lane) = pk4(v); }
}

__device__ __forceinline__ void swap32(float x, float& a, float& b) { const auto rr = __builtin_amdgcn_permlane32_swap(__float_as_uint(x), __float_as_uint(x), false, false); a = __uint_as_float(rr[0]); b = __uint_as_float(rr[1]); }
__device__ __forceinline__ float sum32(float x) { float a, b; swap32(x, a, b); return a + b; }
#define MFMA32(a, b, c) __builtin_amdgcn_mfma_f32_32x32x16_f16((a), (b), (c), 0, 0, 0)
#define MFMA16(a, b, c) __builtin_amdgcn_mfma_f32_16x16x32_f16((a), (b), (c), 0, 0, 0)
__device__ __forceinline__ f16x8 pack8(const f32x16& s, int base) {
    u32x4 w; w.x = pk2(s[base + 0], s[base + 1]); w.y = pk2(s[base + 2], s[base + 3]); w.z = pk2(s[base + 4], s[base + 5]); w.w = pk2(s[base + 6], s[base + 7]);
    return __builtin_bit_cast(f16x8, w);
}
__device__ __forceinline__ f16x8 pack8z(const f32x16& s, int base) {
    typedef __fp16 h2 __attribute__((ext_vector_type(2)));
    const h2 a = __builtin_amdgcn_cvt_pkrtz(s[base + 0], s[base + 1]), b = __builtin_amdgcn_cvt_pkrtz(s[base + 2], s[base + 3]), c = __builtin_amdgcn_cvt_pkrtz(s[base + 4], s[base + 5]), d = __builtin_amdgcn_cvt_pkrtz(s[base + 6], s[base + 7]);
    u32x4 w; w.x = __builtin_bit_cast(unsigned, a); w.y = __builtin_bit_cast(unsigned, b); w.z = __builtin_bit_cast(unsigned, c); w.w = __builtin_bit_cast(unsigned, d);
    return __builtin_bit_cast(f16x8, w);
}
__device__ __forceinline__ float store_ot(const f32x16& o0, const f32x16& o1, float inv, f16* dst, int hf) {
    float ss = 0.f;
#pragma unroll
    for (int g4 = 0; g4 < 4; ++g4) {
        const f32x4 a = (f32x4){o0[4 * g4], o0[4 * g4 + 1], o0[4 * g4 + 2], o0[4 * g4 + 3]} * inv, b = (f32x4){o1[4 * g4], o1[4 * g4 + 1], o1[4 * g4 + 2], o1[4 * g4 + 3]} * inv;
        ss += dot4(a) + dot4(b);
        *(u32x2*)(dst + 8 * g4 + 4 * hf) = pk4(a); *(u32x2*)(dst + 32 + 8 * g4 + 4 * hf) = pk4(b); }
    return ss;
}
struct SbFrag { f16x8 k[4]; f16x8 v[2][2]; };
__device__ __forceinline__ void sb_load(SbFrag& f, const f16* kp, const f16* vp) {
#pragma unroll
    for (int ks = 0; ks < 4; ++ks) f.k[ks] = *(const f16x8*)(kp + 16 * ks);
#pragma unroll
    for (int dvb = 0; dvb < 2; ++dvb)
#pragma unroll
        for (int kk = 0; kk < 2; ++kk) f.v[dvb][kk] = *(const f16x8*)(vp + (size_t)dvb * 32 * T + 16 * kk);
}
__device__ __forceinline__ bool sb_step(const SbFrag& f, const f16x8 (&qf)[4], f32x16& o0, f32x16& o1, float& C, bool diag, int t0, int t, int hf) {
    f32x16 s = {};
#pragma unroll
    for (int ks = 0; ks < 4; ++ks) s = MFMA32(f.k[ks], qf[ks], s);
    float be[16], om[16];
#pragma unroll
    for (int r = 0; r < 16; ++r) { const float z = __builtin_amdgcn_fmed3f(s[r], -115.f, 115.f);
        const float e = __builtin_amdgcn_exp2f(-z); const float bt = __builtin_amdgcn_rcpf(1.f + e);
        be[r] = bt; om[r] = e * bt; }
    if (diag) {
#pragma unroll
        for (int r = 0; r < 16; ++r) { const int key = t0 + 8 * (r >> 2) + 4 * hf + (r & 3); const bool vis = key < t; be[r] = vis ? be[r] : 0.f; om[r] = vis ? om[r] : 1.f; }
    }
    float G[4], PG[4];
#pragma unroll
    for (int q4 = 0; q4 < 4; ++q4) { G[q4] = (om[4 * q4] * om[4 * q4 + 1]) * (om[4 * q4 + 2] * om[4 * q4 + 3]); float a_, b_; swap32(G[q4], a_, b_); PG[q4] = hf == 0 ? b_ : a_; }
    float run = C;
#pragma unroll
    for (int q4 = 3; q4 >= 0; --q4) { float a = hf == 0 ? run * PG[q4] : run;
#pragma unroll
        for (int j = 3; j >= 0; --j) { const int r = 4 * q4 + j; s[r] = be[r] * a; a *= om[r]; }
        run *= G[q4] * PG[q4]; }
    C = run;
#pragma unroll
    for (int kk = 0; kk < 2; ++kk) { const f16x8 pa = pack8(s, 8 * kk); o0 = MFMA32(f.v[0][kk], pa, o0); o1 = MFMA32(f.v[1][kk], pa, o1); }
    return __all(C == 0.f);
}
__device__ __forceinline__ void sb_item(const f16* __restrict__ Qg, const f16* __restrict__ Kg, const f16* __restrict__ Vt, f16* Og, float* SSQ, int b, int h, int qblk, int lane) {
    const int r32 = lane & 31, hf = lane >> 5;
    const int t0 = qblk * 32, t = t0 + r32; const size_t row = (size_t)b * SEQ + t;
    f16x8 qf[4];
#pragma unroll
    for (int ks = 0; ks < 4; ++ks) qf[ks] = *(const f16x8*)(Qg + row * 512 + h * 64 + 16 * ks + 8 * hf);
    f32x16 o0 = {}, o1 = {};
    float C = 1.f;
    const f16* kp = Kg + ((size_t)b * SEQ + t0 + r32) * 512 + h * 64 + 8 * hf;
    const f16* vp = Vt + ((size_t)(h * 64 + r32)) * T + (size_t)b * SEQ + t0 + 8 * hf;
    SbFrag f0, f1, f2;
    sb_load(f0, kp, vp);
    { const int d = qblk >= 1 ? 1 : 0; sb_load(f1, kp - d * 32 * 512, vp - d * 32); }
    int st = qblk;
    for (;;) {
        { const int d = st >= 2 ? 2 : 0; sb_load(f2, kp - d * 32 * 512, vp - d * 32); }
        if (sb_step(f0, qf, o0, o1, C, st == qblk, t0, t, hf)) break;
        if (--st < 0) break; kp -= 32 * 512; vp -= 32;
        { const int d = st >= 2 ? 2 : 0; sb_load(f0, kp - d * 32 * 512, vp - d * 32); }
        if (sb_step(f1, qf, o0, o1, C, false, t0, t, hf)) break;
        if (--st < 0) break; kp -= 32 * 512; vp -= 32;
        { const int d = st >= 2 ? 2 : 0; sb_load(f1, kp - d * 32 * 512, vp - d * 32); }
        if (sb_step(f2, qf, o0, o1, C, false, t0, t, hf)) break;
        if (--st < 0) break; kp -= 32 * 512; vp -= 32;
    }
    const float ss = store_ot(o0, o1, 1.f, Og + row * 1024 + h * 64, hf);
    const float tot = sum32(ss);
    if (hf == 0) SSQ[row * 16 + h] = tot;
}
constexpr int MLA_KROW = 208, MLA_VROW = 144, MLA_KBYTES = 64 * MLA_KROW, MLA_VBYTES = 64 * MLA_VROW, MLA_BUF = MLA_KBYTES + MLA_VBYTES;
__device__ __forceinline__ float max3f(float a, float b, float c) { float r; asm("v_max3_f32 %0, %1, %2, %3" : "=v"(r) : "v"(a), "v"(b), "v"(c)); return r; }
__device__ __forceinline__ float max2f(float a, float b) { float r; asm("v_max_f32_e32 %0, %1, %2" : "=v"(r) : "v"(a), "v"(b)); return r; }
__device__ __forceinline__ void mla_unit(LAS unsigned char* lds, const f16* __restrict__ Qg, const f16* __restrict__ Kg, const f16* __restrict__ Vt, f16* Og, float* SSQ, int b, int h, int qb, int tid) {
    const int lane = tid & 63, wid = __builtin_amdgcn_readfirstlane(tid >> 6), r32 = lane & 31, hf = lane >> 5;
    const size_t row = (size_t)b * SEQ + qb * 256 + wid * 32 + r32;
    const int NT = 4 * qb + 4, my_last = 4 * qb + (wid >> 1);
    const char* src[3]; unsigned dsto[3]; unsigned tstep[3];
#pragma unroll
    for (int i = 0; i < 3; ++i) { int I = wid + 8 * i; if (I >= 22) I -= 2;
        if (I < 13) { const int p = 64 * I + lane, key = p / 13, c = p % 13;
            src[i] = (const char*)(Kg + ((size_t)b * SEQ + key) * 768 + h * 96 + 8 * (c < 12 ? c : 11)); tstep[i] = 64u * 768u * 2u; }
        else { const int p = 64 * (I - 13) + lane, dv = p / 9, c = p % 9;
            src[i] = (const char*)(Vt + (size_t)(h * 64 + dv) * T + (size_t)b * SEQ + 8 * (c < 8 ? c : 7)); tstep[i] = 128u; }
        dsto[i] = (unsigned)(I < 13 ? 1024 * I : MLA_KBYTES + 1024 * (I - 13)); }
#define MLA_ISSUE(tile, bufi) do { _Pragma("unroll") for (int _i = 0; _i < 3; ++_i) \
        __builtin_amdgcn_global_load_lds((const unsigned*)(src[_i] + (size_t)(tile) * tstep[_i]), (LAS unsigned*)(lds + (bufi) * MLA_BUF + __builtin_amdgcn_readfirstlane(dsto[_i])), 16, 0, 0); } while (0)
    f16x8 qf[6];
#pragma unroll
    for (int ks = 0; ks < 6; ++ks) qf[ks] = *(const f16x8*)(Qg + row * 768 + h * 96 + 16 * ks + 8 * hf);
    asm volatile("s_waitcnt vmcnt(0)" ::: "memory");
    __builtin_amdgcn_s_barrier();
    MLA_ISSUE(0, 0); MLA_ISSUE(1, 1);
    f32x16 o0 = {}, o1 = {};
    float lrun = 0.f;
    f32x16 negm;
#pragma unroll
    for (int r = 0; r < 16; ++r) negm[r] = 64.f;
    int bi = 0;
    for (int t = 0; t < NT; ++t) {
        if (t + 1 < NT) asm volatile("s_waitcnt vmcnt(3)" ::: "memory"); else asm volatile("s_waitcnt vmcnt(0)" ::: "memory");
        __builtin_amdgcn_s_barrier();
        asm volatile("" ::: "memory");
        if (t + 2 < NT) { const int nb = bi == 0 ? 2 : bi - 1; MLA_ISSUE(t + 2, nb); }
        if (t <= my_last) {
            const LAS unsigned char* kb_ = lds + bi * MLA_BUF; const LAS unsigned char* vb_ = kb_ + MLA_KBYTES;
            f32x16 s0 = negm, s1 = negm;
#pragma unroll
            for (int ks = 0; ks < 6; ++ks) {
                const f16x8 k0 = *(const LAS f16x8*)(kb_ + r32 * MLA_KROW + (16 * ks + 8 * hf) * 2);
                const f16x8 k1 = *(const LAS f16x8*)(kb_ + (32 + r32) * MLA_KROW + (16 * ks + 8 * hf) * 2);
                s0 = MFMA32(k0, qf[ks], s0); s1 = MFMA32(k1, qf[ks], s1); }
            f16x8 vf0[4], vf1[4];
#pragma unroll
            for (int kk = 0; kk < 4; ++kk) { vf0[kk] = *(const LAS f16x8*)(vb_ + r32 * MLA_VROW + (16 * kk + 8 * hf) * 2); vf1[kk] = *(const LAS f16x8*)(vb_ + (32 + r32) * MLA_VROW + (16 * kk + 8 * hf) * 2); }
            float ta = max3f(s0[0], s1[0], s0[1]), tb = max3f(s1[1], s0[2], s1[2]);
#pragma unroll
            for (int r = 3; r < 15; r += 2) { ta = max3f(ta, s0[r], s1[r]); tb = max3f(tb, s0[r + 1], s1[r + 1]); }
            float tm = max3f(ta, tb, max2f(s0[15], s1[15]));
            { float a_, b_; swap32(tm, a_, b_); tm = max2f(a_, b_); }
            if (__any(tm > 0.f)) {
                const float delta = max2f(tm, 0.f), alpha = __builtin_amdgcn_exp2f(-delta);
                lrun *= alpha; o0 = o0 * alpha; o1 = o1 * alpha;
#pragma unroll
                for (int r = 0; r < 16; ++r) { s0[r] -= delta; s1[r] -= delta; negm[r] -= delta; }
            }
            float ps = 0.f, ps2 = 0.f;
#pragma unroll
            for (int r = 0; r < 16; ++r) { s0[r] = __builtin_amdgcn_exp2f(s0[r]); s1[r] = __builtin_amdgcn_exp2f(s1[r]); ps += s0[r]; ps2 += s1[r]; }
            lrun += ps + ps2;
#pragma unroll
            for (int kk = 0; kk < 4; ++kk) { const f16x8 pa = (kk < 2) ? pack8z(s0, 8 * (kk & 1)) : pack8z(s1, 8 * (kk & 1));
                o0 = MFMA32(vf0[kk], pa, o0); o1 = MFMA32(vf1[kk], pa, o1); }
        }
        bi = bi == 2 ? 0 : bi + 1;
    }
#undef MLA_ISSUE
    const float ltot = sum32(lrun);
    const float ss = store_ot(o0, o1, 1.f / ltot, Og + row * 1024 + 512 + h * 64, hf);
    const float tot = sum32(ss);
    if (hf == 0) SSQ[row * 16 + 8 + h] = tot;
}
template <bool DO_SB = true, bool DO_MLA = true>
__device__ __forceinline__ void p3_attention(Frame& F) {
    PHASE_IDS();
    unsigned char* ws = F.ws;
    f16* ATT = (f16*)(ws + WS_ATT); float* SSQ = (float*)(ws + WS_SSQ_ATT);
    if (DO_SB) {
        const f16* Q = (const f16*)(ws + WS_SBQ); const f16* K = (const f16*)(ws + WS_SBK); const f16* Vt = (const f16*)(ws + WS_SBVT);
        const int gw = F.vcu * NWAVES + wave, NGW = F.G * NWAVES;
        for (int it = gw; it < NB * 8 * 128; it += NGW) { const int qblk = it & 127, h = (it >> 7) & 7, b = it >> 10; sb_item(Q, K, Vt, ATT, SSQ, b, h, qblk, lane); }
    }
    if (DO_MLA) {
        const f16* Q = (const f16*)(ws + WS_MLAQ); const f16* K = (const f16*)(ws + WS_MLAK); const f16* Vt = (const f16*)(ws + WS_MLAVT);
        for (int pr = F.vcu; pr < 64 * 8; pr += F.G) { const int bh = pr >> 3, qa = pr & 7, b = bh >> 3, h = bh & 7;
            mla_unit(F.lds, Q, K, Vt, ATT, SSQ, b, h, 15 - qa, tid);
            mla_unit(F.lds, Q, K, Vt, ATT, SSQ, b, h, qa, tid); }
    }
}
__device__ __forceinline__ void p3b_norm(Frame& F, const Params& P) {
    PHASE_IDS();
    const int gw = F.vcu * NWAVES + wave, NGW = F.G * NWAVES;
    f16* ATT = (f16*)(F.ws + WS_ATT); const float* SSQ = (const float*)(F.ws + WS_SSQ_ATT);
    const f32x4 ga0 = *(const f32x4*)(P.in[13] + 8 * lane), ga1 = *(const f32x4*)(P.in[13] + 8 * lane + 4), gb0 = *(const f32x4*)(P.in[14] + 8 * lane), gb1 = *(const f32x4*)(P.in[14] + 8 * lane + 4);
    for (int row = gw; row < T; row += NGW) {
        const f32x4 a0 = *(const f32x4*)(SSQ + (size_t)row * 16), a1 = *(const f32x4*)(SSQ + (size_t)row * 16 + 4), b0 = *(const f32x4*)(SSQ + (size_t)row * 16 + 8), b1 = *(const f32x4*)(SSQ + (size_t)row * 16 + 12);
        const float ra = __builtin_amdgcn_rsqf((((a0[0] + a0[1]) + (a0[2] + a0[3])) + ((a1[0] + a1[1]) + (a1[2] + a1[3]))) * (1.f / 512.f) + EPS);
        const float rb = __builtin_amdgcn_rsqf((((b0[0] + b0[1]) + (b0[2] + b0[3])) + ((b1[0] + b1[1]) + (b1[2] + b1[3]))) * (1.f / 512.f) + EPS);
        f16* pa = ATT + (size_t)row * 1024 + 8 * lane; f16* pb = pa + 512;
        const f16x8 xa = *(const f16x8*)pa, xb = *(const f16x8*)pb;
        f32x4 va0, va1, vb0, vb1;
#pragma unroll
        for (int j = 0; j < 4; ++j) { va0[j] = (float)xa[j]; va1[j] = (float)xa[4 + j]; vb0[j] = (float)xb[j]; vb1[j] = (float)xb[4 + j]; }
        *(u32x4*)pa = pk8(va0 * ra * ga0, va1 * ra * ga1); *(u32x4*)pb = pk8(vb0 * rb * gb0, vb1 * rb * gb1);
    }
}

constexpr int WO_TAB_OFF = 131072;
struct EpiWo {
    static constexpr bool MIDSCALE = true;
    unsigned char* ws; const float* x; LAS const float* tab;
    __device__ __forceinline__ void mid(Acc& acc, const Unit& u, int wr, int fr_) const {
        int fr = fr_; asm volatile("" : "+v"(fr));
#pragma unroll
        for (int ai = 0; ai < 2; ++ai)
#pragma unroll
            for (int m = 0; m < 4; ++m) { const float ra = tab[(u.aux * 256 + ai * 128 + wr * 64 + m * 16 + fr) * 2];
#pragma unroll
                for (int bj = 0; bj < 2; ++bj)
#pragma unroll
                    for (int n = 0; n < 2; ++n) acc[ai][bj][m][n] = acc[ai][bj][m][n] * ra; }
    }
    __device__ __forceinline__ void operator()(const Acc& acc, const Unit& u, int wr, int wc, int fr_, int fq_) const {
        int fr = fr_, fq = fq_; asm volatile("" : "+v"(fr), "+v"(fq));
        const int rowb = u.pm * 256 + wr * 64 + fr, colb = u.pn * 256 + 32 * wc + 8 * fq; f16* H = (f16*)(ws + WS_H1H); float* SS = (float*)(ws + WS_SSQ_H1);
#pragma unroll
        for (int ai = 0; ai < 2; ++ai)
#pragma unroll
            for (int m = 0; m < 4; ++m) { const size_t ro = (size_t)(rowb + ai * 128 + m * 16) * 1024 + colb; float s = 0.f;
                const float rb = tab[(u.aux * 256 + ai * 128 + wr * 64 + m * 16 + fr) * 2 + 1];
#pragma unroll
                for (int bj = 0; bj < 2; ++bj) { const size_t o = ro + 128 * bj;
                    const f32x4 v0 = acc[ai][bj][m][0] * rb + *(const f32x4*)(x + o), v1 = acc[ai][bj][m][1] * rb + *(const f32x4*)(x + o + 4);
                    *(u32x4*)(H + o) = pk8(v0, v1); s += dot4(v0) + dot4(v1); }
                s = sum_x32(sum_x16(s)); if (fq == 0) SS[(size_t)(rowb + ai * 128 + m * 16) * 16 + 4 * u.pn + wc] = s; }
    }
};
template <class Sched> __device__ __forceinline__ void wo_table(Frame& F, const Sched& S) {
    const int tid = fresh_tid(); LAS float* tab = (LAS float*)(F.lds + WO_TAB_OFF); const float* SSQ = (const float*)(F.ws + WS_SSQ_ATT);
    for (int i = tid >> 8; i < 4; i += 2) { Unit u; if (!S.next(i, u)) break;
        const int row = u.pm * 256 + (tid & 255);
        const f32x4 a0 = *(const f32x4*)(SSQ + (size_t)row * 16), a1 = *(const f32x4*)(SSQ + (size_t)row * 16 + 4), b0 = *(const f32x4*)(SSQ + (size_t)row * 16 + 8), b1 = *(const f32x4*)(SSQ + (size_t)row * 16 + 12);
        const float sa = (((a0[0] + a0[1]) + (a0[2] + a0[3])) + ((a1[0] + a1[1]) + (a1[2] + a1[3]))) * (1.f / 512.f) + EPS;
        const float sb = (((b0[0] + b0[1]) + (b0[2] + b0[3])) + ((b1[0] + b1[1]) + (b1[2] + b1[3]))) * (1.f / 512.f) + EPS;
        const float ra = __builtin_amdgcn_rsqf(sa), rb = __builtin_amdgcn_rsqf(sb);
        tab[(i * 256 + (tid & 255)) * 2] = ra * __builtin_amdgcn_sqrtf(sb); tab[(i * 256 + (tid & 255)) * 2 + 1] = rb; }
    __syncthreads();
}
struct EpiMq {
    static constexpr bool MIDSCALE = false;
    unsigned char* ws;
    __device__ __forceinline__ void operator()(const Acc& acc, const Unit& u, int wr, int wc, int fr_, int fq_) const {
        int fr = fr_, fq = fq_; asm volatile("" : "+v"(fr), "+v"(fq));
        const int rowb = u.pm * 256 + wr * 64 + fr, colb = u.pn * 256 + 32 * wc + 8 * fq; f16* Q = (f16*)(ws + WS_MQ); float* SS = (float*)(ws + WS_SSQ_MQ);
#pragma unroll
        for (int ai = 0; ai < 2; ++ai)
#pragma unroll
            for (int m = 0; m < 4; ++m) { const size_t ro = (size_t)(rowb + ai * 128 + m * 16) * 1024 + colb; float s = 0.f;
#pragma unroll
                for (int bj = 0; bj < 2; ++bj) { const f32x4 v0 = acc[ai][bj][m][0], v1 = acc[ai][bj][m][1]; *(u32x4*)(Q + ro + 128 * bj) = pk8(v0, v1); s += dot4(v0) + dot4(v1); }
                s = sum_x32(sum_x16(s)); if (fq == 0) SS[(size_t)(rowb + ai * 128 + m * 16) * 16 + 4 * u.pn + wc] = s; }
    }
};
struct EpiMo {
    static constexpr bool MIDSCALE = false;
    unsigned char* ws;
    __device__ __forceinline__ void operator()(const Acc& acc, const Unit& u, int wr, int wc, int fr_, int fq_) const {
        int fr = fr_, fq = fq_; asm volatile("" : "+v"(fr), "+v"(fq));
        const int rowb = u.pm * 256 + wr * 64 + fr, colb = u.pn * 256 + 32 * wc + 8 * fq; f16* H = (f16*)(ws + WS_H2H); const f16* H1 = (const f16*)(ws + WS_H1H);
#pragma unroll
        for (int ai = 0; ai < 2; ++ai)
#pragma unroll
            for (int m = 0; m < 4; ++m) { const size_t ro = (size_t)(rowb + ai * 128 + m * 16) * 1024 + colb;
#pragma unroll
                for (int bj = 0; bj < 2; ++bj) { const size_t o = ro + 128 * bj; const f16x8 hv = *(const f16x8*)(H1 + o);
                    f32x4 v0 = acc[ai][bj][m][0], v1 = acc[ai][bj][m][1];
#pragma unroll
                    for (int j = 0; j < 4; ++j) { v0[j] += (float)hv[j]; v1[j] += (float)hv[4 + j]; }
                    *(u32x4*)(H + o) = pk8(v0, v1); } }
    }
};

constexpr int MEM_ROWB = 528;
template <int RS>
__device__ __forceinline__ void mem_stage(LAS unsigned char* lds, const f16* src, int tid) {
    const unsigned voff = (unsigned)((tid >> 5) * RS + 8 * (tid & 31)) * 2u;
    const unsigned loff = (unsigned)((tid >> 5) * MEM_ROWB + (tid & 31) * 16);
#pragma unroll
    for (int bt = 0; bt < 4; ++bt) { u32x4 r[4];
#pragma unroll
        for (int i = 0; i < 4; ++i) r[i] = *(const u32x4*)((const char*)src + (size_t)(4 * bt + i) * 16 * RS * 2 + voff);
#pragma unroll
        for (int i = 0; i < 4; ++i) *(LAS u32x4*)(lds + loff + (4 * bt + i) * 16 * MEM_ROWB) = r[i]; }
}
__device__ __forceinline__ void p6_memattn(Frame& F) {
    PHASE_IDS(); unsigned char* ws = F.ws; LAS unsigned char* lds = F.lds; const int wid = wave;
    const f16* MQ = (const f16*)(ws + WS_MQ); const f16* KP = (const f16*)(ws + WS_KP); const f16* MVT = (const f16*)(ws + WS_MVT); f16* MO = (f16*)(ws + WS_MO);
    const float* SSH = (const float*)(ws + WS_SSQ_H1); const float* SSM = (const float*)(ws + WS_SSQ_MQ);
    for (int un = F.vcu; un < 256; un += F.G) { const int bh = un >> 3, qc = un & 7, b = bh >> 2, h = bh & 3;
#pragma unroll 1
      for (int hp = 0; hp < 2; ++hp) {
        int t2 = tid; asm volatile("" : "+v"(t2));
        const int ln = t2 & 63, l16 = ln & 15, g = ln >> 4;
        const size_t row0 = (size_t)b * SEQ + qc * 512 + hp * 256 + wid * 16 + l16;
        u32x4 pf[2][8]; float inv[2];
        __syncthreads();
        mem_stage<256>(lds, KP + (size_t)(b * 4 + h) * 256 * 256, t2);
        __syncthreads();
#pragma unroll
        for (int pass = 0; pass < 2; ++pass) {
            const size_t row = row0 + pass * 128;
            f16x8 qf[8];
#pragma unroll
            for (int ks = 0; ks < 8; ++ks) qf[ks] = *(const f16x8*)(MQ + row * 1024 + h * 256 + 32 * ks + 8 * g);
            float fac;
            { const f32x4 a0 = *(const f32x4*)(SSH + row * 16), a1 = *(const f32x4*)(SSH + row * 16 + 4), a2 = *(const f32x4*)(SSH + row * 16 + 8), a3 = *(const f32x4*)(SSH + row * 16 + 12);
              const float sh = (((a0[0] + a0[1]) + (a0[2] + a0[3])) + ((a1[0] + a1[1]) + (a1[2] + a1[3]))) + (((a2[0] + a2[1]) + (a2[2] + a2[3])) + ((a3[0] + a3[1]) + (a3[2] + a3[3])));
              const float r1 = __builtin_amdgcn_rsqf(sh * (1.f / 1024.f) + EPS);
              const f32x4 q4 = *(const f32x4*)(SSM + row * 16 + 4 * h); const float mv = ((q4[0] + q4[1]) + (q4[2] + q4[3])) * (1.f / 256.f);
              fac = r1 * __builtin_amdgcn_rsqf(r1 * r1 * mv + EPS) * (0.0625f * 1.4426950408889634f); }
            f32x4 s[16];
#pragma unroll
            for (int kb = 0; kb < 16; ++kb) { s[kb] = (f32x4){0.f, 0.f, 0.f, 0.f};
#pragma unroll
                for (int ks = 0; ks < 8; ++ks) { const f16x8 a = *(const LAS f16x8*)(lds + (16 * kb + l16) * MEM_ROWB + (32 * ks + 8 * g) * 2); s[kb] = MFMA16(a, qf[ks], s[kb]); }
                __builtin_amdgcn_sched_barrier(0); }
            float mx = -INFINITY;
#pragma unroll
            for (int kb = 0; kb < 16; ++kb) { s[kb] = s[kb] * fac; mx = max3f(mx, max2f(s[kb][0], s[kb][1]), max2f(s[kb][2], s[kb][3])); }
            mx = max2f(mx, __shfl_xor(mx, 16)); mx = max2f(mx, __shfl_xor(mx, 32));
            float sum = 0.f;
#pragma unroll
            for (int s8 = 0; s8 < 8; ++s8) { f32x4 p0, p1;
#pragma unroll
                for (int j = 0; j < 4; ++j) { p0[j] = __builtin_amdgcn_exp2f(s[2 * s8][j] - mx); p1[j] = __builtin_amdgcn_exp2f(s[2 * s8 + 1][j] - mx); }
                sum += ((p0[0] + p0[1]) + (p0[2] + p0[3])) + ((p1[0] + p1[1]) + (p1[2] + p1[3]));
                pf[pass][s8] = pk8(p0, p1); }
            sum = sum_x32(sum_x16(sum));
            inv[pass] = 1.f / sum;
            __builtin_amdgcn_sched_barrier(0);
        }
        __syncthreads();
        mem_stage<2048>(lds, MVT + (size_t)(h * 256) * 2048 + b * 256, t2);
        __syncthreads();
#pragma unroll 2
        for (int dvb = 0; dvb < 16; ++dvb) { f32x4 o[2];
#pragma unroll
            for (int pass = 0; pass < 2; ++pass) o[pass] = (f32x4){0.f, 0.f, 0.f, 0.f};
#pragma unroll
            for (int s8 = 0; s8 < 8; ++s8) { const f16x8 a = *(const LAS f16x8*)(lds + (16 * dvb + l16) * MEM_ROWB + (32 * s8 + 8 * g) * 2);
#pragma unroll
                for (int pass = 0; pass < 2; ++pass) o[pass] = MFMA16(a, __builtin_bit_cast(f16x8, pf[pass][s8]), o[pass]); }
            __builtin_amdgcn_sched_barrier(0);
#pragma unroll
            for (int pass = 0; pass < 2; ++pass) *(u32x2*)(MO + (row0 + pass * 128) * 1024 + h * 256 + 16 * dvb + 4 * g) = pk4(o[pass] * inv[pass]); }
      }
    }
}

__device__ __forceinline__ void p8_route(Frame& F, const Params& P) {
    PHASE_IDS(); unsigned char* ws = F.ws;
    LAS float* WR = (LAS float*)F.lds;
    LAS unsigned* hist = (LAS unsigned*)(F.lds + LDS_MISC) + 8;
    const float* w_group = P.in[24]; const float* w_router = P.in[26];
    for (int e = tid; e < 1024 * 20; e += NTHR) { const int d = e / 20, c = e % 20; WR[c * 1024 + d] = c < 4 ? w_group[d * 4 + c] : w_router[d * 16 + (c - 4)]; }
    if (tid < 24) hist[tid] = 0u;
    __syncthreads();
    const f16* H2 = (const f16*)(ws + WS_H2H); const float* gm = P.in[23];
    f32x4 g[4];
#pragma unroll
    for (int k = 0; k < 4; ++k) g[k] = *(const f32x4*)(gm + 256 * k + 4 * lane);
    float bias[20];
#pragma unroll
    for (int c = 0; c < 20; ++c) bias[c] = c < 4 ? P.in[25][c] : P.in[27][c - 4];
    int* BKT = (int*)(ws + WS_BKT); float* RR = (float*)(ws + WS_RR); float* W0 = (float*)(ws + WS_W0); float* W1 = (float*)(ws + WS_W1);
    const int gw = F.vcu * NWAVES + wave, NGW = F.G * NWAVES;
    for (int tok = gw; tok < T; tok += NGW) {
        f32x4 v[4]; float ss = 0.f;
#pragma unroll
        for (int k = 0; k < 4; ++k) { const f16x4 hx = *(const f16x4*)(H2 + (size_t)tok * 1024 + 256 * k + 4 * lane); v[k] = (f32x4){(float)hx[0], (float)hx[1], (float)hx[2], (float)hx[3]}; ss += dot4(v[k]); }
        const float r = __builtin_amdgcn_rsqf(wave_sum(ss) * (1.f / 1024.f) + EPS);
        float lg[20];
#pragma unroll
        for (int c = 0; c < 20; ++c) lg[c] = 0.f;
#pragma unroll
        for (int k = 0; k < 4; ++k) { const f32x4 tv = v[k] * r * g[k];
#pragma unroll
            for (int c = 0; c < 20; ++c) { const f32x4 w = *(const LAS f32x4*)(WR + c * 1024 + 256 * k + 4 * lane); lg[c] += (tv[0] * w[0] + tv[1] * w[1]) + (tv[2] * w[2] + tv[3] * w[3]); }
            __builtin_amdgcn_sched_barrier(0); }
#pragma unroll
        for (int c = 0; c < 20; ++c) lg[c] = wave_sum(lg[c]) + bias[c];
        int gi = 0; float gmx = lg[0];
#pragma unroll
        for (int c = 1; c < 4; ++c) if (lg[c] > gmx) { gmx = lg[c]; gi = c; }
        float gden = 0.f;
#pragma unroll
        for (int c = 0; c < 4; ++c) gden += __expf(lg[c] - gmx);
        const float gw_ = 1.f / gden;
        float el[4];
#pragma unroll
        for (int c = 0; c < 4; ++c) el[c] = gi == 0 ? lg[4 + c] : (gi == 1 ? lg[8 + c] : (gi == 2 ? lg[12 + c] : lg[16 + c]));
        int i1 = 0; float m1 = el[0];
#pragma unroll
        for (int c = 1; c < 4; ++c) if (el[c] > m1) { m1 = el[c]; i1 = c; }
        int i2 = -1; float m2 = -INFINITY;
#pragma unroll
        for (int c = 0; c < 4; ++c) if (c != i1 && el[c] > m2) { m2 = el[c]; i2 = c; }
        const float e2 = __expf(m2 - m1), wa = gw_ / (1.f + e2), wb = gw_ * e2 / (1.f + e2);
        const int lo = i1 < i2 ? i1 : i2, hi = i1 < i2 ? i2 : i1;
        const int pi = lo == 0 ? hi - 1 : (lo == 1 ? hi + 1 : 5);
        const int bk = gi * 6 + pi;
        if (lane == 0) { BKT[tok] = bk; RR[tok] = r; W0[tok] = (i1 < i2) ? wa : wb; W1[tok] = (i1 < i2) ? wb : wa; atomicAdd((unsigned*)&hist[bk], 1u); }
    }
    __syncthreads();
    if (tid < 24) { const unsigned hv = hist[tid]; if (hv) atomicAdd(F.ctl + CW_CNT + tid, hv); }
}
__device__ __forceinline__ void moe_tiles(Frame& F) {
    LAS int* tstart = (LAS int*)(F.lds + LDS_MISC) + 32;
    const int tid0 = fresh_tid();
    __syncthreads();
    if (tid0 == 0) { int acc = 0;
        for (int b = 0; b < 24; ++b) { tstart[b] = acc; acc += (int)((__hip_atomic_load(F.ctl + CW_CNT + b, __ATOMIC_RELAXED, __HIP_MEMORY_SCOPE_AGENT) + 255u) >> 8); }
        tstart[24] = acc; }
    __syncthreads();
}
__device__ __forceinline__ void p9_gather(Frame& F) {
    PHASE_IDS(); unsigned char* ws = F.ws; const int wid = wave;
    moe_tiles(F);
    LAS int* tstart = (LAS int*)(F.lds + LDS_MISC) + 32; LAS int* posarr = (LAS int*)(F.lds + LDS_MISC) + 64;
    const int* BKT = (const int*)(ws + WS_BKT); const float* RR = (const float*)(ws + WS_RR); const float* W0 = (const float*)(ws + WS_W0); const float* W1 = (const float*)(ws + WS_W1);
    int* TOK = (int*)(ws + WS_TOK); float* PR = (float*)(ws + WS_PR); float* PW0 = (float*)(ws + WS_PW0); float* PW1 = (float*)(ws + WS_PW1);
    const f16* H2H = (const f16*)(ws + WS_H2H); f16* TS = (f16*)(ws + WS_TS);
    for (int blk = F.vcu; blk < T / 128; blk += F.G) {
        if (wid < 2) { const int tok = blk * 128 + wid * 64 + lane; const int bk = BKT[tok];
            unsigned mycount = 0u, rank = 0u;
            for (int bb = 0; bb < 24; ++bb) { const unsigned long long mask = __ballot(bk == bb); const unsigned c = (unsigned)__popcll(mask);
                if (lane == bb) mycount = c;
                if (bk == bb) rank = (unsigned)__popcll(mask & ((1ull << lane) - 1ull)); }
            unsigned basev = 0u;
            if (lane < 24 && mycount) basev = atomicAdd(F.ctl + CW_CUR + lane, mycount);
            const unsigned mybase = (unsigned)__shfl((int)basev, bk);
            posarr[wid * 64 + lane] = tstart[bk] * 256 + (int)(mybase + rank); }
        __syncthreads();
#pragma unroll 1
        for (int j0 = 0; j0 < 16; j0 += 4) { u32x4 a[4], b[4]; int pos[4];
#pragma unroll
            for (int j = 0; j < 4; ++j) { const int tl = wid * 16 + j0 + j, tok = blk * 128 + tl; pos[j] = posarr[tl];
                a[j] = *(const u32x4*)(H2H + (size_t)tok * 1024 + 8 * lane); b[j] = *(const u32x4*)(H2H + (size_t)tok * 1024 + 512 + 8 * lane); }
#pragma unroll
            for (int j = 0; j < 4; ++j) { const int tl = wid * 16 + j0 + j, tok = blk * 128 + tl;
                *(u32x4*)(TS + (size_t)pos[j] * 1024 + 8 * lane) = a[j]; *(u32x4*)(TS + (size_t)pos[j] * 1024 + 512 + 8 * lane) = b[j];
                if (lane == 0) { TOK[pos[j]] = tok; PR[pos[j]] = RR[tok]; PW0[pos[j]] = W0[tok]; PW1[pos[j]] = W1[tok]; } } }
        __syncthreads();
    }
}

struct SchedMoe {
    const char* A; const char* B; LAS const int* tstart; int G, c, nct_log2, down;
    __device__ __forceinline__ bool next(int i, Unit& u) const {
        const int L = i * G + c, rt = L >> nct_log2, ct = L & ((1 << nct_log2) - 1);
        if (rt >= tstart[24]) return false;
        int bk = 0;
        for (int b = 1; b < 24; ++b) bk = (rt >= tstart[b]) ? b : bk;
        u.A = A + (size_t)rt * 256 * 1024 * 2; u.pm = rt; u.pn = ct; u.aux = bk;
        int lo, hi; moe_pair(bk % 6, lo, hi);
        if (down) { u.B = B + ((size_t)(4 * (bk / 6) + lo) * 1024 + ct * 256) * 512 * 2; u.B2 = B + ((size_t)(4 * (bk / 6) + hi) * 1024 + ct * 256) * 512 * 2; }
        else { const int e = 4 * (bk / 6) + ((ct >> 2) ? hi : lo); u.B = B + (size_t)(e * 4 + (ct & 3)) * 256 * 1024 * 2; u.B2 = nullptr; }
        return true;
    }
};
struct EpiGU {
    static constexpr bool MIDSCALE = false;
    unsigned char* ws;
    __device__ __forceinline__ void operator()(const Acc& acc, const Unit& u, int wr, int wc, int fr_, int fq_) const {
        int fr = fr_, fq = fq_; asm volatile("" : "+v"(fr), "+v"(fq));
        const int rowb = u.pm * 256 + wr * 64 + fr, slot = u.pn >> 2, ffb = u.pn & 3; f16* HE = (f16*)(ws + WS_HE);
        const float* PR = (const float*)(ws + WS_PR); const float* PW = (const float*)(ws + (slot ? WS_PW1 : WS_PW0));
#pragma unroll
        for (int ai = 0; ai < 2; ++ai)
#pragma unroll
            for (int m = 0; m < 4; ++m) { const int row = rowb + ai * 128 + m * 16; const float r = PR[row], w = PW[row];
                f32x4 o[2];
#pragma unroll
                for (int n = 0; n < 2; ++n) { const f32x4 gt = acc[ai][0][m][n] * r, up = acc[ai][1][m][n] * r;
#pragma unroll
                    for (int j = 0; j < 4; ++j) { const float sg = gt[j] * __builtin_amdgcn_rcpf(1.f + __expf(-gt[j])); o[n][j] = sg * up[j] * w; } }
                *(u32x4*)(HE + (size_t)row * 1024 + slot * 512 + ffb * 128 + 32 * wc + 8 * fq) = pk8(o[0], o[1]); }
    }
};
struct EpiDown {
    static constexpr bool MIDSCALE = false;
    unsigned char* ws; float* out;
    __device__ __forceinline__ void operator()(const Acc& acc, const Unit& u, int wr, int wc, int fr_, int fq_) const {
        int fr = fr_, fq = fq_; asm volatile("" : "+v"(fr), "+v"(fq));
        const int rowb = u.pm * 256 + wr * 64 + fr, colb = u.pn * 256 + 32 * wc + 8 * fq; const int* TOK = (const int*)(ws + WS_TOK); const f16* H2 = (const f16*)(ws + WS_H2H);
        int tok[2][4];
#pragma unroll
        for (int ai = 0; ai < 2; ++ai)
#pragma unroll
            for (int m = 0; m < 4; ++m) tok[ai][m] = TOK[rowb + ai * 128 + m * 16];
#pragma unroll
        for (int ai = 0; ai < 2; ++ai) { f16x8 hv[4][2];
#pragma unroll
            for (int m = 0; m < 4; ++m) { const size_t ro = (size_t)(tok[ai][m] < 0 ? 0 : tok[ai][m]) * 1024 + colb;
#pragma unroll
                for (int bj = 0; bj < 2; ++bj) hv[m][bj] = *(const f16x8*)(H2 + ro + 128 * bj); }
#pragma unroll
            for (int m = 0; m < 4; ++m) { if (tok[ai][m] >= 0) { const size_t ro = (size_t)tok[ai][m] * 1024 + colb;
#pragma unroll
                for (int bj = 0; bj < 2; ++bj) { const size_t o = ro + 128 * bj;
                    f32x4 v0 = acc[ai][bj][m][0], v1 = acc[ai][bj][m][1];
#pragma unroll
                    for (int j = 0; j < 4; ++j) { v0[j] += (float)hv[m][bj][j]; v1[j] += (float)hv[m][bj][4 + j]; }
                    *(f32x4*)(out + o) = v0; *(f32x4*)(out + o + 4) = v1; } } } }
    }
};

#ifndef MK_N_LAUNCHES
#define MK_N_LAUNCHES 1
#endif
constexpr int N_PHASES = 13;
__global__ void __launch_bounds__(NTHR, 2) fwd_kernel(Params P) {
    extern __shared__ __attribute__((aligned(16))) unsigned char lds_raw[];
    Frame F;
    F.lds = (LAS unsigned char*)lds_raw; F.MISC = (volatile LAS unsigned*)(F.lds + LDS_MISC);
    F.G = gridDim.x; F.bx = blockIdx.x; F.vcu = (F.G % 8 == 0) ? (F.bx % 8) * (F.G / 8) + F.bx / 8 : F.bx;
    F.ws = P.ws; F.out = P.out; F.ctl = (unsigned*)(P.ws + WS_CTL);
    for (int u = fresh_tid(); u < (LDS_BYTES - LDS_MISC) / 4; u += NTHR) ((LAS unsigned*)(F.lds + LDS_MISC))[u] = 0u;
    __syncthreads();
    const int lo = P.ph_lo, hi = P.ph_hi;
    const bool multi = (hi - lo) > 1;
    XcdBarrier bar; bar.bar = F.ctl + CW_BAR; bar.x = 0; bar.st = F.MISC;
    if (multi) bar = xcd_barrier_post(F.ctl + CW_BAR, F.MISC);
#define IN(k) (lo <= (k) && (k) < hi)
#define SEAM(k) do { if (IN(k) && IN((k) + 1)) xcd_barrier(bar); } while (0)
    unsigned char* ws = F.ws;
#ifndef PROBE_DUP
#define PROBE_DUP -1
#endif
#define RUN(k, ...) do { if (IN(k)) { __VA_ARGS__ if (PROBE_DUP == (k)) { xcd_barrier(bar); __VA_ARGS__ } } SEAM(k); } while (0)
    RUN(0, { p0_prologue(F, P); });
    RUN(1, {
        { SchedP1N S{ws, F.G, F.bx}; EpiP1N E{ws, P.in[12]}; pg8::gemm_phase<EpiP1N, SchedP1N, true>(F.lds, 1024, 1024, 1024, S, E); }
        { SchedP1S S{ws, F.G, (F.bx + F.G - 160) % F.G}; EpiP1S E{ws}; pg8::gemm_phase<EpiP1S, SchedP1S, true>(F.lds, 1024, 1024, 1024, S, E); }
    });
    RUN(2, {
        p2_kprime(F, P);
        { SchedGrid S{(const char*)(ws + WS_CQ), (const char*)(ws + WS_WUQ), (size_t)256 * 384 * 2, (size_t)256 * 384 * 2, 128, 3, F.G, F.bx}; EpiP2Q E{ws, P.in[9], P.in[10]};
          pg8::gemm_phase<EpiP2Q, SchedGrid, true>(F.lds, 384, 384, 384, S, E); }
        { SchedGrid S{(const char*)(ws + WS_CKV), (const char*)(ws + WS_WUKN), (size_t)256 * 256 * 2, (size_t)256 * 256 * 2, 128, 2, F.G, (F.bx + F.G - 128) % F.G}; EpiP2K E{ws, P.in[11]};
          pg8::gemm_phase<EpiP2K, SchedGrid, true>(F.lds, 256, 256, 256, S, E); }
        { SchedGrid S{(const char*)(ws + WS_WUKV), (const char*)(ws + WS_CKV), (size_t)256 * 256 * 2, (size_t)256 * 256 * 2, 2, 128, F.G, (F.bx + F.G - 128) % F.G}; EpiP2V E{ws};
          pg8::gemm_phase<EpiP2V, SchedGrid, true>(F.lds, 256, 256, 256, S, E); }
    });
    RUN(3, { p3_attention(F); });
    if (PROBE_DUP == 31 && IN(3)) { p3_attention<true, false>(F); xcd_barrier(bar); }
    if (PROBE_DUP == 32 && IN(3)) { p3_attention<false, true>(F); xcd_barrier(bar); }
    RUN(5, { SchedGrid S{(const char*)(ws + WS_ATT), (const char*)(ws + WS_WO), (size_t)256 * 1024 * 2, (size_t)256 * 1024 * 2, 128, 4, F.G, F.bx}; EpiWo E{ws, P.in[0], (LAS const float*)(F.lds + WO_TAB_OFF)};
        wo_table(F, S); pg8::gemm_phase<EpiWo, SchedGrid, true>(F.lds, 1024, 1024, 1024, S, E); });
    RUN(6, { SchedGrid S{(const char*)(ws + WS_H1H), (const char*)(ws + WS_WMQ), (size_t)256 * 1024 * 2, (size_t)256 * 1024 * 2, 128, 4, F.G, F.bx}; EpiMq E{ws};
        pg8::gemm_phase<EpiMq, SchedGrid, true>(F.lds, 1024, 1024, 1024, S, E); });
    RUN(7, { p6_memattn(F); });
    RUN(8, { SchedGrid S{(const char*)(ws + WS_MO), (const char*)(ws + WS_WMO), (size_t)256 * 1024 * 2, (size_t)256 * 1024 * 2, 128, 4, F.G, F.bx}; EpiMo E{ws};
        pg8::gemm_phase<EpiMo, SchedGrid, true>(F.lds, 1024, 1024, 1024, S, E); });
    RUN(9, { p8_route(F, P); });
    RUN(10, { p9_gather(F); });
    RUN(11, { moe_tiles(F); SchedMoe S{(const char*)(ws + WS_TS), (const char*)(ws + WS_WGU), (LAS const int*)(F.lds + LDS_MISC) + 32, F.G, F.vcu, 3, 0}; EpiGU E{ws};
        pg8::gemm_phase<EpiGU, SchedMoe, true>(F.lds, 1024, 1024, 1024, S, E); });
    RUN(12, { moe_tiles(F); SchedMoe S{(const char*)(ws + WS_HE), (const char*)(ws + WS_WD2), (LAS const int*)(F.lds + LDS_MISC) + 32, F.G, F.vcu, 2, 1}; EpiDown E{ws, P.out};
        pg8::gemm_phase<EpiDown, SchedMoe, true, true>(F.lds, 1024, 1024, 512, S, E); });
#undef RUN
#undef IN
#undef SEAM
}

extern "C" void kernel_launch(void* const* d_in, const int* in_sizes, int n_in, void* d_out, int out_size, void* d_ws, size_t ws_size, hipStream_t stream) {
    static int grid = 0;
    if (grid == 0) {
        if (n_in != 31 || out_size != T * D || ws_size < WS_END) { fprintf(stderr, "kernel_launch: unexpected shapes (n_in %d, out %d, ws %zu < %zu)\n", n_in, out_size, ws_size, (size_t)WS_END); grid = -1; return; }
        int dev = 0, cus = 0, per_cu = 0;
        if (hipGetDevice(&dev) != hipSuccess || hipDeviceGetAttribute(&cus, hipDeviceAttributeMultiprocessorCount, dev) != hipSuccess) { grid = -1; return; }
        if (hipFuncSetAttribute((const void*)fwd_kernel, hipFuncAttributeMaxDynamicSharedMemorySize, LDS_BYTES) != hipSuccess) { fprintf(stderr, "kernel_launch: hipFuncSetAttribute failed\n"); grid = -1; return; }
        if (hipOccupancyMaxActiveBlocksPerMultiprocessor(&per_cu, (const void*)fwd_kernel, NTHR, LDS_BYTES) != hipSuccess || per_cu < 1) { fprintf(stderr, "kernel_launch: occupancy query says %d\n", per_cu); }
        (void)hipGetLastError();
        grid = cus;
    }
    if (grid < 0) return;
    (void)hipMemsetAsync((char*)d_ws + WS_CTL, 0, CTL_ZERO_BYTES, stream);
    Params p{};
    for (int i = 0; i < 31; ++i) p.in[i] = (const float*)d_in[i];
    p.out = (float*)d_out; p.ws = (unsigned char*)d_ws;
    if (MK_N_LAUNCHES == 1) { p.ph_lo = 0; p.ph_hi = N_PHASES; hipLaunchKernelGGL(fwd_kernel, dim3(grid), dim3(NTHR), LDS_BYTES, stream, p); }
    else { for (int k = 0; k < N_PHASES; ++k) { p.ph_lo = k; p.ph_hi = k + 1; hipLaunchKernelGGL(fwd_kernel, dim3(grid), dim3(NTHR), LDS_BYTES, stream, p); } }
}
```

```cpp
#include <hip/hip_runtime.h>
#include <cstdio>
#include <cstdint>

#define LAS __attribute__((address_space(3)))
#define GAS __attribute__((address_space(1)))
typedef _Float16 f16;
typedef _Float16 f16x8 __attribute__((ext_vector_type(8)));
typedef _Float16 f16x4 __attribute__((ext_vector_type(4)));
typedef _Float16 f16x2 __attribute__((ext_vector_type(2)));
typedef float f32x2 __attribute__((ext_vector_type(2)));
typedef float f32x4 __attribute__((ext_vector_type(4)));
typedef float f32x16 __attribute__((ext_vector_type(16)));
typedef unsigned u32x4 __attribute__((ext_vector_type(4)));
typedef unsigned u32x2 __attribute__((ext_vector_type(2)));

__device__ __forceinline__ unsigned pk2(float lo, float hi) { f16x2 v = {(f16)lo, (f16)hi}; return __builtin_bit_cast(unsigned, v); }
__device__ __forceinline__ u32x4 pk8(f32x4 a, f32x4 b) { u32x4 w; w.x = pk2(a[0], a[1]); w.y = pk2(a[2], a[3]); w.z = pk2(b[0], b[1]); w.w = pk2(b[2], b[3]); return w; }
__device__ __forceinline__ u32x2 pk4(f32x4 a) { u32x2 w; w.x = pk2(a[0], a[1]); w.y = pk2(a[2], a[3]); return w; }
__device__ __forceinline__ float dot4(f32x4 a) { return (a[0] * a[0] + a[1] * a[1]) + (a[2] * a[2] + a[3] * a[3]); }
template <int CTRL> __device__ __forceinline__ float dpp_add(float v) { const int t = __builtin_amdgcn_update_dpp(0, __builtin_bit_cast(int, v), CTRL, 0xf, 0xf, true); return v + __builtin_bit_cast(float, t); }
__device__ __forceinline__ float sum_x16(float x) { const auto rr = __builtin_amdgcn_permlane16_swap(__float_as_uint(x), __float_as_uint(x), false, false); const unsigned a = rr[0], b = rr[1]; return __uint_as_float(a) + __uint_as_float(b); }
__device__ __forceinline__ float sum_x32(float x) { const auto rr = __builtin_amdgcn_permlane32_swap(__float_as_uint(x), __float_as_uint(x), false, false); const unsigned a = rr[0], b = rr[1]; return __uint_as_float(a) + __uint_as_float(b); }
__device__ __forceinline__ float wave_sum(float v) {
    v = dpp_add<0xB1>(v);
    v = dpp_add<0x4E>(v);
    v = dpp_add<0x141>(v);
    v = dpp_add<0x140>(v);
    return sum_x32(sum_x16(v));
}
__device__ __forceinline__ int L32(int q) { return 8 * ((q >> 2) & 3) + 4 * (q >> 4) + (q & 3); }

__device__ __forceinline__ int fresh_tid() { int t = (int)threadIdx.x; asm volatile("" : "+v"(t)); return t; }
constexpr int T = 32768, D = 1024, SEQ = 4096, NB = 8;
constexpr float EPS = 1e-6f;
constexpr int NPOS = 152 * 256;

namespace pg8 {
constexpr int BM = 256, BK = 64, HALF = 128, HTB = HALF * BK * 2, STAGE_BYTES = 8 * HTB;
__host__ __device__ __forceinline__ int lds_byte(int r, int c) { const int st = (r >> 4) * 2 + (c >> 5), rr = r & 15, cc = c & 31, ob = rr * 64 + cc * 2; return st * 1024 + (ob ^ (((ob >> 9) & 1) << 5)); }
__host__ __device__ __forceinline__ void stage_rc(int b, int& R, int& C) { const int st = b / 1024, sb = b % 1024, swz = sb ^ (((sb >> 9) & 1) << 5); R = (st >> 1) * 16 + swz / 64; C = (st & 1) * 32 + (swz % 64) / 2; }
__device__ __forceinline__ bool last_iter(int t, int nt) { return t == nt - 2; }
struct Unit { const char* A; const char* B; const char* B2; int pm, pn, aux; };

template <class Epi, class Sched, bool ALIGN_EPI, bool SPLITB = false, bool GATHER = false>
__device__ __forceinline__ void gemm_phase(LAS unsigned char* lds, const int K, const int lda, const int ldb, const Sched& S, const Epi& E) {
    const int tid = fresh_tid(), wid = __builtin_amdgcn_readfirstlane(tid >> 6), lane = tid & 63, wr = wid >> 2, wc = wid & 3, fr = lane & 15, fq = lane >> 4;
    const int nt = K / BK;
    unsigned voffA[2], voffB[2];
#pragma unroll
    for (int i = 0; i < 2; ++i) { int R, C; stage_rc(tid * 16 + i * 8192, R, C); voffA[i] = (unsigned)(R * lda + C) * 2u; voffB[i] = (unsigned)(R * ldb + C) * 2u; }
    unsigned gA[2][2], ngA[2][2];
    auto gather_offs = [&](const Unit& u, unsigned (&o)[2][2]) {
        if constexpr (GATHER) {
            int tq = tid; asm volatile("" : "+v"(tq));
#pragma unroll
            for (int h = 0; h < 2; ++h)
#pragma unroll
                for (int i = 0; i < 2; ++i) { int R, C; stage_rc(tq * 16 + i * 8192, R, C); const int row = S.arow(u, h * HALF + R); o[h][i] = (unsigned)(row * lda + C) * 2u; }
        }
    };
    const size_t kstep = (size_t)(BK * 2);
    const size_t hstepA = (size_t)HALF * lda * 2, hstepB = (size_t)HALF * ldb * 2;
    const unsigned ldsw = (unsigned)wid * 1024u;
    const int aoff = lds_byte(wr * 64 + fr, fq * 8), boff = lds_byte(wc * 32 + fr, fq * 8);
#define PG8_SA(b, h) (((b) * 2 + (h)) * HTB)
#define PG8_SB(b, h) ((4 + (b) * 2 + (h)) * HTB)
#define PG8_STAGE(bufoff, gbase, voff) do { _Pragma("unroll") for (int _i = 0; _i < 2; ++_i) \
        __builtin_amdgcn_global_load_lds((const unsigned*)((const char*)(gbase) + (voff)[_i]), (LAS unsigned*)(lds + (bufoff) + ldsw + _i * 8192), 16, 0, 0); } while (0)
#define PG8_STAGEA(b, h, gbase, nextu) do { if constexpr (GATHER) { _Pragma("unroll") for (int _i = 0; _i < 2; ++_i) { const unsigned _o = (nextu) ? ngA[h][_i] : gA[h][_i]; \
        __builtin_amdgcn_global_load_lds((const unsigned*)((const char*)(gbase) + _o), (LAS unsigned*)(lds + PG8_SA(b, h) + ldsw + _i * 8192), 16, 0, 0); } } \
        else { PG8_STAGE(PG8_SA(b, h), (gbase) + ((h) ? hstepA : 0), voffA); } } while (0)
#define PG8_LDA(dst, b, h) do { _Pragma("unroll") for (int m = 0; m < 4; ++m) _Pragma("unroll") for (int k = 0; k < 2; ++k) dst[m][k] = *(const LAS f16x8*)(lds + PG8_SA(b, h) + aoff + m * 2048 + k * 1024); } while (0)
#define PG8_LDB(dst, b, h) do { _Pragma("unroll") for (int n = 0; n < 2; ++n) _Pragma("unroll") for (int k = 0; k < 2; ++k) dst[n][k] = *(const LAS f16x8*)(lds + PG8_SB(b, h) + boff + n * 2048 + k * 1024); } while (0)
#define PG8_MMA(ai, bj, At, Bt) do { __builtin_amdgcn_s_setprio(1); _Pragma("unroll") for (int m = 0; m < 4; ++m) _Pragma("unroll") for (int n = 0; n < 2; ++n) _Pragma("unroll") for (int k = 0; k < 2; ++k) \
        acc[ai][bj][m][n] = __builtin_amdgcn_mfma_f32_16x16x32_f16(Bt[n][k], At[m][k], acc[ai][bj][m][n], 0, 0, 0); __builtin_amdgcn_s_setprio(0); } while (0)
#define PG8_WAIT_V(n) asm volatile("s_waitcnt vmcnt(" #n ")" ::: "memory")
#define PG8_WAIT_L(n) asm volatile("s_waitcnt lgkmcnt(" #n ")" ::: "memory")
#define PG8_BAR __builtin_amdgcn_s_barrier()
#define PG8_SCHED __builtin_amdgcn_sched_barrier(0)
    Unit cur, nxt; int ui = 0;
    if (!S.next(0, cur)) return;
    f32x4 acc[2][2][4][2];
#pragma unroll
    for (int a = 0; a < 2; ++a)
#pragma unroll
        for (int b = 0; b < 2; ++b)
#pragma unroll
            for (int m = 0; m < 4; ++m)
#pragma unroll
                for (int n = 0; n < 2; ++n) acc[a][b][m][n] = (f32x4){0.f, 0.f, 0.f, 0.f};
    f16x8 At[4][2], B0[2][2], B1[2][2];
    const char* cA = cur.A; const char* cB = cur.B; const char* cB2 = SPLITB ? cur.B2 : nullptr; const int th = nt >> 1;
    if constexpr (GATHER) { gather_offs(cur, gA); }
    PG8_STAGE(PG8_SB(0, 0), cB, voffB); PG8_STAGE(PG8_SB(0, 1), cB + hstepB, voffB); PG8_STAGEA(0, 0, cA, false); PG8_STAGEA(0, 1, cA, false);
    if (wr == 1) PG8_BAR;
    PG8_WAIT_V(2); PG8_BAR;
    PG8_STAGE(PG8_SB(1, 0), cB + kstep, voffB); PG8_STAGEA(1, 0, cA + kstep, false); PG8_STAGE(PG8_SB(1, 1), cB + hstepB + kstep, voffB);
    PG8_WAIT_V(6); PG8_BAR;
    for (;;) {
        const bool has_next = S.next(ui + 1, nxt);
        const char* nA = has_next ? nxt.A : cA; const char* nB = has_next ? nxt.B : cB; const char* nB2 = SPLITB ? (has_next ? nxt.B2 : cB2) : nullptr;
        if constexpr (GATHER) { if (has_next) gather_offs(nxt, ngA); else {
#pragma unroll
            for (int h = 0; h < 2; ++h)
#pragma unroll
                for (int i = 0; i < 2; ++i) ngA[h][i] = gA[h][i]; } }
        for (int t = 0; t < nt; t += 2) {
            if constexpr (Sched::WAITS) { if (last_iter(t, nt) && has_next) S.a_ready(nxt); }
            if constexpr (Epi::MIDSCALE) { if (t == th) E.mid(acc, cur, wr, fr); }
            const bool last = (t == nt - 2);
            const char* a1 = cA + (size_t)(t + 1) * kstep;
            const char* a2 = last ? nA : cA + (size_t)(t + 2) * kstep;
            const char* b2 = last ? nB : ((SPLITB && t + 2 >= th) ? cB2 + (size_t)(t + 2 - th) * kstep : cB + (size_t)(t + 2) * kstep);
            const char* a3 = a2 + kstep; const char* b3 = b2 + kstep;
            PG8_LDB(B0, 0, 0); PG8_LDB(B1, 0, 1); PG8_SCHED; PG8_LDA(At, 0, 0); PG8_STAGEA(1, 1, a1, false);
            PG8_WAIT_V(8); PG8_WAIT_L(0); PG8_BAR; PG8_MMA(0, 0, At, B0); PG8_MMA(0, 1, At, B1); PG8_BAR; PG8_SCHED;
            PG8_LDA(At, 0, 1); PG8_STAGE(PG8_SB(0, 0), b2, voffB); PG8_STAGE(PG8_SB(0, 1), b2 + hstepB, voffB); PG8_STAGEA(0, 0, a2, last);
            PG8_WAIT_V(8); PG8_WAIT_L(0); PG8_BAR; PG8_MMA(1, 0, At, B0); PG8_MMA(1, 1, At, B1); PG8_BAR; PG8_SCHED;
            PG8_LDB(B0, 1, 0); PG8_LDB(B1, 1, 1); PG8_SCHED; PG8_LDA(At, 1, 0); PG8_STAGEA(0, 1, a2, last);
            PG8_WAIT_V(8); PG8_WAIT_L(0); PG8_BAR; PG8_MMA(0, 0, At, B0); PG8_MMA(0, 1, At, B1); PG8_BAR; PG8_SCHED;
            PG8_LDA(At, 1, 1); PG8_STAGE(PG8_SB(1, 0), b3, voffB); PG8_STAGE(PG8_SB(1, 1), b3 + hstepB, voffB); PG8_STAGEA(1, 0, a3, last);
            PG8_WAIT_V(8); PG8_WAIT_L(0); PG8_BAR; PG8_MMA(1, 0, At, B0); PG8_MMA(1, 1, At, B1); PG8_BAR; PG8_SCHED;
        }
        if constexpr (ALIGN_EPI) { if (wr == 0) PG8_BAR; }
        E(acc, cur, wr, wc, fr, fq);
        if (!has_next) break;
#pragma unroll
        for (int a = 0; a < 2; ++a)
#pragma unroll
            for (int b = 0; b < 2; ++b)
#pragma unroll
                for (int m = 0; m < 4; ++m)
#pragma unroll
                    for (int n = 0; n < 2; ++n) acc[a][b][m][n] = (f32x4){0.f, 0.f, 0.f, 0.f};
        cur = nxt; cA = nA; cB = nB; cB2 = nB2; ++ui;
        if constexpr (GATHER) {
#pragma unroll
            for (int h = 0; h < 2; ++h)
#pragma unroll
                for (int i = 0; i < 2; ++i) gA[h][i] = ngA[h][i]; }
        if constexpr (ALIGN_EPI) { if (wr == 1) PG8_BAR; }
    }
    PG8_WAIT_V(0);
    if constexpr (!ALIGN_EPI) { if (wr == 0) PG8_BAR; }
    PG8_BAR;
#undef PG8_SA
#undef PG8_SB
#undef PG8_STAGE
#undef PG8_STAGEA
#undef PG8_LDA
#undef PG8_LDB
#undef PG8_MMA
#undef PG8_WAIT_V
#undef PG8_WAIT_L
#undef PG8_BAR
#undef PG8_SCHED
}
__device__ __forceinline__ void tile_map(int L, int nM, int nN, int& pm, int& pn) {
    const int nwg = nM * nN; int wgid = L;
    { const int q = nwg / 8, r = nwg % 8, xcd = wgid % 8, off = wgid / 8; wgid = (xcd < r ? xcd * (q + 1) : r * (q + 1) + (xcd - r) * q) + off; }
    const int nig = 8 * nN, gid = wgid / nig, fm = gid * 8, gsz = (nM - fm) < 8 ? (nM - fm) : 8;
    pm = fm + ((wgid % nig) % gsz); pn = (wgid % nig) / gsz;
}
}
using pg8::Unit;

#define XB_TMO      128
#define XB_XCNT(j)  (256  + 64 * (j))
#define XB_XSUB(j)  (1280 + 64 * (j))
#define XB_XGEN(j)  (2304 + 64 * (j))
#define XB_TOP      3328
#define XB_TOPGEN   3392
#define XCD_BAR_WORDS 3456
#define XB_SPIN_CAP (1u << 18)
__device__ __forceinline__ unsigned xb_ld(unsigned* p)              { return __hip_atomic_load(p, __ATOMIC_RELAXED, __HIP_MEMORY_SCOPE_AGENT); }
__device__ __forceinline__ unsigned xb_add(unsigned* p, unsigned v) { return __hip_atomic_fetch_add(p, v, __ATOMIC_RELAXED, __HIP_MEMORY_SCOPE_AGENT); }
__device__ __forceinline__ unsigned xb_xcc_id() { return (unsigned)__builtin_amdgcn_s_getreg((3 << 11) | 20) & 0xFu; }
#define XB_SPIN(cond, bar) do { unsigned _sp = 0; while (cond) { __builtin_amdgcn_s_sleep(1); \
    if ((++_sp & 255u) == 0u) { if (xb_ld(&(bar)[XB_TMO])) break; if (_sp > XB_SPIN_CAP) { atomicAdd(&(bar)[XB_TMO], 1u); break; } } } } while (0)
struct XcdBarrier { unsigned* bar; unsigned x; volatile LAS unsigned* st; };
__device__ __forceinline__ XcdBarrier xcd_barrier_post(unsigned* bar, volatile LAS unsigned* st) {
    XcdBarrier b; b.bar = bar; b.x = xb_xcc_id(); b.st = st;
    if (threadIdx.x == 0) (void)xb_add(&bar[XB_XCNT(b.x)], 1u);
    return b;
}
__device__ __forceinline__ void xcd_barrier_complete(unsigned* bar, unsigned x, unsigned& nloc, unsigned& nx) {
    const unsigned G = gridDim.x * gridDim.y * gridDim.z;
    unsigned sum, cnt, mine, sp = 0u;
    for (;;) {
        sum = 0u; cnt = 0u; mine = 0u;
#pragma unroll
        for (unsigned j = 0; j < 16; ++j) { const unsigned c = xb_ld(&bar[XB_XCNT(j)]); sum += c; cnt += (c > 0u) ? 1u : 0u; mine = (j == x) ? c : mine; }
        if (sum == G) break;
        __builtin_amdgcn_s_sleep(1);
        if ((++sp & 255u) == 0u) { if (xb_ld(&bar[XB_TMO])) break; if (sp > XB_SPIN_CAP) { atomicAdd(&bar[XB_TMO], 1u); break; } }
    }
    nloc = mine > 0u ? mine : 1u; nx = cnt > 0u ? cnt : 1u;
}
__device__ __forceinline__ void xcd_barrier(const XcdBarrier& b) {
    asm volatile("s_waitcnt vmcnt(0)" ::: "memory");
    __syncthreads();
    if (threadIdx.x == 0) {
        unsigned* bar = b.bar;
        __builtin_amdgcn_s_waitcnt(0);
        unsigned nloc = b.st[0], nx = b.st[1];
        if (nloc == 0u) { xcd_barrier_complete(bar, b.x, nloc, nx); b.st[0] = nloc; b.st[1] = nx; }
        const unsigned old = xb_add(&bar[XB_XSUB(b.x)], 1u);
        const unsigned gen = old / nloc;
        if (old + 1u == (gen + 1u) * nloc) {
            __builtin_amdgcn_fence(__ATOMIC_RELEASE, "agent");
            asm volatile("s_waitcnt vmcnt(0)" ::: "memory");
            const unsigned og = xb_add(&bar[XB_TOP], 1u);
            const unsigned tg = og / nx;
            if (og + 1u == (tg + 1u) * nx) xb_add(&bar[XB_TOPGEN], 1u);
            else XB_SPIN(xb_ld(&bar[XB_TOPGEN]) == tg, bar);
            __builtin_amdgcn_fence(__ATOMIC_ACQUIRE, "agent");
            xb_add(&bar[XB_XGEN(b.x)], 1u);
            asm volatile("s_waitcnt vmcnt(0)" ::: "memory");
        } else {
            XB_SPIN(xb_ld(&bar[XB_XGEN(b.x)]) == gen, bar);
            __builtin_amdgcn_fence(__ATOMIC_ACQUIRE, "agent");
            asm volatile("s_waitcnt vmcnt(0)" ::: "memory");
        }
    }
    __syncthreads();
}

constexpr size_t MiB = 1u << 20;
constexpr size_t WS_CTL = 0, CTL_ZERO_BYTES = 131072;
constexpr int CW_BAR = 1024;
constexpr int CW_CNT = 8192;
constexpr int CW_CUR = 8192 + 64;
constexpr int CW_RT = 16384;
constexpr int CW_TMO = 8192 + 128;
constexpr size_t WS_SSQ_CQ  = 1 * MiB;
constexpr size_t WS_SSQ_CKV = 2 * MiB;
constexpr size_t WS_SSQ_MK  = 2 * MiB + 512 * 1024;
constexpr size_t WS_SSQ_ATT = 3 * MiB;
constexpr size_t WS_SSQ_H1  = 5 * MiB;
constexpr size_t WS_SSQ_MQ  = 7 * MiB;
constexpr size_t WS_COS     = 9 * MiB;
constexpr size_t WS_SIN     = 11 * MiB;
constexpr size_t WS_BKT     = 13 * MiB;
constexpr size_t WS_RR      = 13 * MiB + 128 * 1024;
constexpr size_t WS_W0      = 13 * MiB + 256 * 1024;
constexpr size_t WS_W1      = 13 * MiB + 384 * 1024;
constexpr size_t WS_TOK     = 13 * MiB + 512 * 1024;
constexpr size_t WS_PR      = 13 * MiB + 704 * 1024;
constexpr size_t WS_PW0     = 14 * MiB;
constexpr size_t WS_PW1     = 14 * MiB + 192 * 1024;
constexpr size_t WS_KRF     = 14 * MiB + 512 * 1024;
constexpr size_t WS_WIN  = 17 * MiB;
constexpr size_t WS_WSV  = WS_WIN  + 3584 * 1024;
constexpr size_t WS_WMK  = WS_WSV  + 1 * MiB;
constexpr size_t WS_WMV  = WS_WMK  + 2 * MiB;
constexpr size_t WS_WUQ  = WS_WMV  + 2 * MiB;
constexpr size_t WS_WUKN = WS_WUQ  + 1 * MiB;
constexpr size_t WS_WUKV = WS_WUKN + 256 * 1024;
constexpr size_t WS_WO   = WS_WUKV + 256 * 1024;
constexpr size_t WS_WMQ  = WS_WO   + 2 * MiB;
constexpr size_t WS_WMO  = WS_WMQ  + 2 * MiB;
constexpr size_t WS_WGU  = WS_WMO  + 2 * MiB;
constexpr size_t WS_WD2  = WS_WGU  + 32 * MiB;
constexpr size_t WS_WEND = WS_WD2  + 48 * MiB;
constexpr size_t WS_MN   = 114 * MiB;
constexpr size_t WS_MKR  = 118 * MiB;
constexpr size_t WS_MVT  = 122 * MiB;
constexpr size_t WS_KP   = 126 * MiB;
constexpr size_t WS_R1   = 130 * MiB;
constexpr size_t WS_R2   = 194 * MiB;
constexpr size_t WS_R3   = 290 * MiB;
constexpr size_t WS_R4   = 330 * MiB;
constexpr size_t WS_END  = 458 * MiB;
static_assert(WS_WEND <= WS_MN, "ws map");
constexpr size_t WS_HN = WS_R1, WS_ATT = WS_R1, WS_MQ = WS_R1, WS_H2H = WS_R1;
constexpr size_t WS_SBQ = WS_R2, WS_SBK = WS_R2 + 32 * MiB, WS_SBVT = WS_R2 + 64 * MiB, WS_H1H = WS_R2, WS_TS = WS_R2;
constexpr size_t WS_CQ = WS_R3, WS_CKV = WS_R3 + 24 * MiB;
constexpr size_t WS_MLAQ = WS_R4, WS_MLAK = WS_R4 + 48 * MiB, WS_MLAVT = WS_R4 + 96 * MiB, WS_HE = WS_R4, WS_MO = WS_R4;

constexpr int LDS_BYTES = 147456;
constexpr int LDS_MISC = 143360;
constexpr int NWAVES = 8, NTHR = 512;

struct Params { const float* in[31]; float* out; unsigned char* ws; int ph_lo, ph_hi; };

struct Frame {
    LAS unsigned char* lds; volatile LAS unsigned* MISC;
    int vcu, G, bx;
    unsigned char* ws; float* out; unsigned* ctl;
};
#define PHASE_IDS() const int tid = fresh_tid(), lane = tid & 63, wave = __builtin_amdgcn_readfirstlane(tid >> 6); (void)lane; (void)wave

__device__ __forceinline__ void conv_item(const float* src, int ld, int srccol0, int mode, int ksrc0, const float* kscale, f16* dst, int K, int row0, int k0, LAS float* scr, int lane) {
    if (mode != 2) {
        const float* base = src + (size_t)ksrc0 * ld + srccol0;
        const unsigned voff = (unsigned)((lane >> 5) * ld + (lane & 31)) * 4u;
        float v[32];
#pragma unroll
        for (int i = 0; i < 32; ++i) v[i] = *(const float*)((const char*)(base + (size_t)2 * i * ld) + voff);
#pragma unroll
        for (int i = 0; i < 32; ++i) scr[(2 * i + (lane >> 5)) * 33 + (lane & 31)] = v[i];
    }
    asm volatile("s_waitcnt lgkmcnt(0)" ::: "memory");
    const int c = lane & 7;
    f32x4 ks0 = (f32x4){1.f, 1.f, 1.f, 1.f}, ks1 = ks0;
    if (kscale) { ks0 = *(const f32x4*)(kscale + ksrc0 + 8 * c); ks1 = *(const f32x4*)(kscale + ksrc0 + 8 * c + 4); }
#pragma unroll
    for (int j = 0; j < 4; ++j) { const int q = (lane >> 3) + 8 * j; const int lc = (mode == 1) ? L32(q) : q; const LAS float* s = scr + (8 * c) * 33 + lc;
        u32x4 o;
        if (mode == 2) { o = (u32x4){0u, 0u, 0u, 0u}; }
        else { o.x = pk2(s[0 * 33] * ks0[0], s[1 * 33] * ks0[1]); o.y = pk2(s[2 * 33] * ks0[2], s[3 * 33] * ks0[3]); o.z = pk2(s[4 * 33] * ks1[0], s[5 * 33] * ks1[1]); o.w = pk2(s[6 * 33] * ks1[2], s[7 * 33] * ks1[3]); }
        *(u32x4*)(dst + (size_t)(row0 + q) * K + k0 + 8 * c) = o; }
    asm volatile("s_waitcnt lgkmcnt(0)" ::: "memory");
}
__device__ __forceinline__ void rms_rows2_to_f16(const float* x, const float* g, f16* o, int m0, int m1, bool has1, int lane) {
    const f32x4* x0 = (const f32x4*)(x + (size_t)m0 * D) + lane; const f32x4* x1 = (const f32x4*)(x + (size_t)m1 * D) + lane; const f32x4* gr = (const f32x4*)g + lane;
    f32x4 v[4], w[4]; float s0 = 0.f, s1 = 0.f;
#pragma unroll
    for (int j = 0; j < 4; ++j) v[j] = x0[64 * j];
    if (has1) {
#pragma unroll
        for (int j = 0; j < 4; ++j) w[j] = x1[64 * j];
    } else {
#pragma unroll
        for (int j = 0; j < 4; ++j) w[j] = (f32x4){0.f, 0.f, 0.f, 0.f};
    }
#pragma unroll
    for (int j = 0; j < 4; ++j) { s0 += dot4(v[j]); s1 += dot4(w[j]); }
    s0 = wave_sum(s0); s1 = wave_sum(s1);
    const float r0 = __builtin_amdgcn_rsqf(s0 * (1.f / 1024.f) + EPS), r1 = __builtin_amdgcn_rsqf(s1 * (1.f / 1024.f) + EPS);
    u32x2* o0 = (u32x2*)(o + (size_t)m0 * D) + lane; u32x2* o1 = (u32x2*)(o + (size_t)m1 * D) + lane;
#pragma unroll
    for (int j = 0; j < 4; ++j) { const f32x4 gg = gr[64 * j]; o0[64 * j] = pk4(v[j] * r0 * gg); if (has1) o1[64 * j] = pk4(w[j] * r1 * gg); }
}
__device__ __forceinline__ void moe_pair(int pi, int& lo, int& hi) { lo = pi < 3 ? 0 : (pi < 5 ? 1 : 2); hi = pi < 3 ? pi + 1 : (pi < 5 ? pi - 1 : 3); }

__device__ __forceinline__ void p0_prologue(Frame& F, const Params& P) {
    PHASE_IDS();
    LAS float* scr = (LAS float*)(F.lds + wave * 16384);
    const int gw = F.vcu * NWAVES + wave, NGW = F.G * NWAVES;
    unsigned char* ws = F.ws;
    const float* w_in = P.in[4]; const float* w_uq = P.in[6]; const float* w_ukv = P.in[8]; const float* w_o = P.in[15];
    const float* w_mq = P.in[18]; const float* w_mkv = P.in[19]; const float* w_mo = P.in[22];
    const float* w_gate = P.in[28]; const float* w_up = P.in[29]; const float* w_down = P.in[30];
    for (int it = gw; it < 56 * 16; it += NGW) { const int rb = it >> 4, kb = it & 15, tile = rb >> 3, g = rb & 7, bj = g >> 2, wc = g & 3; int col, mode = 1;
        if (tile < 2) col = (4 * tile + wc) * 64 + 32 * bj;
        else if (tile < 4) col = 512 + (4 * (tile - 2) + wc) * 64 + 32 * bj;
        else if (tile == 4) col = 1536 + 64 * wc + 32 * bj;
        else if (tile == 5) { if (bj == 0) col = 1536 + 256 + 32 * wc; else if (wc == 0) { col = 2176; mode = 0; } else { col = 0; mode = 2; } }
        else col = 1920 + 64 * wc + 32 * bj;
        conv_item(w_in, 2208, col, mode, kb * 64, nullptr, (f16*)(ws + WS_WIN), 1024, rb * 32, kb * 64, scr, lane); }
    for (int it = gw; it < 16 * 16; it += NGW) { const int rb = it >> 4, kb = it & 15; conv_item(w_in, 2208, 1024 + 32 * rb, 0, kb * 64, nullptr, (f16*)(ws + WS_WSV), 1024, rb * 32, kb * 64, scr, lane); }
    for (int it = gw; it < 32 * 16; it += NGW) { const int rb = it >> 4, kb = it & 15, tile = rb >> 3, g = rb & 7, bj = g >> 2, wc = g & 3;
        conv_item(w_mkv, 2048, 256 * tile + 64 * wc + 32 * bj, 1, kb * 64, nullptr, (f16*)(ws + WS_WMK), 1024, rb * 32, kb * 64, scr, lane); }
    for (int it = gw; it < 32 * 16; it += NGW) { const int rb = it >> 4, kb = it & 15; conv_item(w_mkv, 2048, 1024 + 32 * rb, 0, kb * 64, nullptr, (f16*)(ws + WS_WMV), 1024, rb * 32, kb * 64, scr, lane); }
    for (int it = gw; it < 24 * 6; it += NGW) { const int rb = it / 6, kb = it % 6, tile = rb >> 3, g = rb & 7, bj = g >> 2, wc = g & 3; int col, mode = 1;
        if (tile < 2) col = (4 * tile + wc) * 96 + 32 * bj; else { col = (4 * bj + wc) * 96 + 64; mode = 0; }
        conv_item(w_uq, 768, col, mode, kb * 64, P.in[5], (f16*)(ws + WS_WUQ), 384, rb * 32, kb * 64, scr, lane); }
    for (int it = gw; it < 16 * 4; it += NGW) { const int rb = it >> 2, kb = it & 3, tile = rb >> 3, g = rb & 7, bj = g >> 2, wc = g & 3;
        conv_item(w_ukv, 1024, (4 * tile + wc) * 128 + 32 * bj, 1, kb * 64, P.in[7], (f16*)(ws + WS_WUKN), 256, rb * 32, kb * 64, scr, lane); }
    for (int it = gw; it < 16 * 4; it += NGW) { const int rb = it >> 2, kb = it & 3;
        conv_item(w_ukv, 1024, (rb >> 1) * 128 + 64 + 32 * (rb & 1), 0, kb * 64, P.in[7], (f16*)(ws + WS_WUKV), 256, rb * 32, kb * 64, scr, lane); }
    for (int it = gw; it < 32 * 16; it += NGW) { const int rb = it >> 4, kb = it & 15; conv_item(w_o, 1024, 32 * rb, 1, kb * 64, kb < 8 ? P.in[13] : P.in[14] - 512, (f16*)(ws + WS_WO), 1024, rb * 32, kb * 64, scr, lane); }
    for (int it = gw; it < 32 * 16; it += NGW) { const int rb = it >> 4, kb = it & 15; conv_item(w_mq, 1024, 32 * rb, 1, kb * 64, P.in[16], (f16*)(ws + WS_WMQ), 1024, rb * 32, kb * 64, scr, lane); }
    for (int it = gw; it < 32 * 16; it += NGW) { const int rb = it >> 4, kb = it & 15; conv_item(w_mo, 1024, 32 * rb, 1, kb * 64, nullptr, (f16*)(ws + WS_WMO), 1024, rb * 32, kb * 64, scr, lane); }
    for (int it = gw; it < 64 * 8 * 16; it += NGW) { const int kb = it & 15, rb = (it >> 4) & 7, tile = it >> 7, e = tile >> 2, ffb = tile & 3, bj = rb >> 2, wc = rb & 3;
        conv_item((bj ? w_up : w_gate) + (size_t)e * 1024 * 512, 512, ffb * 128 + 32 * wc, 1, kb * 64, P.in[23], (f16*)(ws + WS_WGU) + (size_t)tile * 256 * 1024, 1024, rb * 32, kb * 64, scr, lane); }
    for (int it = gw; it < 16 * 32 * 8; it += NGW) { const int kb = it & 7, rb = (it >> 3) & 31, e = it >> 8;
        conv_item(w_down + (size_t)e * 512 * 1024, 1024, 32 * rb, 1, kb * 64, nullptr, (f16*)(ws + WS_WD2) + (size_t)e * 1024 * 1024, 1024, rb * 32, kb * 64, scr, lane); }
    for (int m = gw; m < T; m += 2 * NGW) rms_rows2_to_f16(P.in[0], P.in[3], (f16*)(ws + WS_HN), m, m + NGW, m + NGW < T, lane);
    for (int m = gw; m < 2048; m += 2 * NGW) rms_rows2_to_f16(P.in[1], P.in[17], (f16*)(ws + WS_MN), m, m + NGW, m + NGW < 2048, lane);
    {
        const int gt = F.vcu * NTHR + tid, NGT = F.G * NTHR; const int* pos = (const int*)P.in[2];
        float* COS = (float*)(ws + WS_COS); float* SIN = (float*)(ws + WS_SIN);
        for (int e = gt; e < T * 16; e += NGT) { const int tok = e >> 4, i = e & 15;
            const float invf = i == 0 ? 1.000000000e+00f : i == 1 ? 5.623413324e-01f : i == 2 ? 3.162277639e-01f : i == 3 ? 1.778279394e-01f : i == 4 ? 1.000000015e-01f : i == 5 ? 5.623413250e-02f : i == 6 ? 3.162277490e-02f : i == 7 ? 1.778279431e-02f :
                               i == 8 ? 9.999999776e-03f : i == 9 ? 5.623413250e-03f : i == 10 ? 3.162277630e-03f : i == 11 ? 1.778279431e-03f : i == 12 ? 1.000000047e-03f : i == 13 ? 5.623413017e-04f : i == 14 ? 3.162277571e-04f : 1.778279402e-04f;
            const float ang = (float)pos[tok] * invf;
            const double x = (double)ang; const double n = __builtin_rint(x * 0.15915494309189535); const float rev = (float)(x * 0.15915494309189535 - n);
            COS[e] = __builtin_amdgcn_cosf(rev); SIN[e] = __builtin_amdgcn_sinf(rev); }
        int* TOK = (int*)(ws + WS_TOK);
        for (int e = gt; e < NPOS; e += NGT) TOK[e] = -1;
    }
}

typedef f32x4 Acc[2][2][4][2];
template <bool SSQ>
__device__ __forceinline__ void store_w64(const Acc& acc, int rowb, f16* dst, int ld, int colb, float scale, float* ssq, int ldq, int slot, int fq) {
#pragma unroll
    for (int ai = 0; ai < 2; ++ai)
#pragma unroll
        for (int m = 0; m < 4; ++m) { const int row = rowb + ai * 128 + m * 16; float s = 0.f;
#pragma unroll
            for (int bj = 0; bj < 2; ++bj) { const f32x4 v0 = acc[ai][bj][m][0] * scale, v1 = acc[ai][bj][m][1] * scale;
                if (SSQ) s += dot4(v0) + dot4(v1);
                *(u32x4*)(dst + (size_t)row * ld + colb + bj * 32 + 8 * fq) = pk8(v0, v1); }
            if (SSQ) { s = sum_x32(sum_x16(s)); if (fq == 0) ssq[(size_t)row * ldq + slot] = s; } }
}

struct EpiP1N {
    static constexpr bool MIDSCALE = false;
    unsigned char* ws; const float* krg;
    __device__ __forceinline__ void operator()(const Acc& acc, const Unit& u, int wr, int wc, int fr_, int fq_) const {
        int fr = fr_, fq = fq_; asm volatile("" : "+v"(fr), "+v"(fq));
        const int rowb = u.pm * 256 + wr * 64 + fr;
        if (u.aux == 0) { store_w64<false>(acc, rowb, (f16*)(ws + WS_SBQ), 512, (4 * u.pn + wc) * 64, 0.125f * 1.4426950408889634f, nullptr, 0, 0, fq); }
        else if (u.aux == 1) { store_w64<false>(acc, rowb, (f16*)(ws + WS_SBK), 512, (4 * u.pn + wc) * 64, 1.f, nullptr, 0, 0, fq); }
        else if (u.aux == 2) { store_w64<true>(acc, rowb, (f16*)(ws + WS_CQ), 384, 64 * wc, 1.f, (float*)(ws + WS_SSQ_CQ), 8, wc, fq); }
        else if (u.aux == 4) { store_w64<true>(acc, rowb, (f16*)(ws + WS_CKV), 256, 64 * wc, 1.f, (float*)(ws + WS_SSQ_CKV), 4, wc, fq); }
        else if (u.aux == 5) { store_w64<true>(acc, rowb, (f16*)(ws + WS_MKR), 1024, 256 * u.pn + 64 * wc, 1.f, (float*)(ws + WS_SSQ_MK), 16, 4 * u.pn + wc, fq); }
        else {
            f16* CQ = (f16*)(ws + WS_CQ); float* SS = (float*)(ws + WS_SSQ_CQ);
#pragma unroll
            for (int ai = 0; ai < 2; ++ai)
#pragma unroll
                for (int m = 0; m < 4; ++m) { const int row = rowb + ai * 128 + m * 16;
                    const f32x4 v0 = acc[ai][0][m][0], v1 = acc[ai][0][m][1]; float s = dot4(v0) + dot4(v1);
                    *(u32x4*)(CQ + (size_t)row * 384 + 256 + 32 * wc + 8 * fq) = pk8(v0, v1);
                    s = sum_x32(sum_x16(s)); if (fq == 0) SS[(size_t)row * 8 + 4 + wc] = s; }
            if (wc == 0) {
                const float* COS = (const float*)(ws + WS_COS); const float* SIN = (const float*)(ws + WS_SIN); f16* KRF = (f16*)(ws + WS_KRF);
                const f32x4 g1 = *(const f32x4*)(krg + 4 * fq), g2 = *(const f32x4*)(krg + 16 + 4 * fq);
#pragma unroll
                for (int ai = 0; ai < 2; ++ai)
#pragma unroll
                    for (int m = 0; m < 4; ++m) { const int row = rowb + ai * 128 + m * 16;
                        f32x4 x1 = acc[ai][1][m][0], x2 = acc[ai][1][m][1]; float s = dot4(x1) + dot4(x2);
                        s = sum_x32(sum_x16(s));
                        const float rn = __builtin_amdgcn_rsqf(s * (1.f / 32.f) + EPS);
                        x1 = x1 * rn * g1; x2 = x2 * rn * g2;
                        const f32x4 c = *(const f32x4*)(COS + (size_t)row * 16 + 4 * fq), sn = *(const f32x4*)(SIN + (size_t)row * 16 + 4 * fq);
                        const f32x4 o1 = x1 * c - x2 * sn, o2 = x2 * c + x1 * sn;
                        *(u32x2*)(KRF + (size_t)row * 32 + 4 * fq) = pk4(o1); *(u32x2*)(KRF + (size_t)row * 32 + 16 + 4 * fq) = pk4(o2); }
            }
        }
    }
};
struct SchedP1N {
    static constexpr bool WAITS = false;
    unsigned char* ws; int G, c;
    __device__ __forceinline__ bool next(int i, Unit& u) const {
        int L = i * G + c;
        if (L < 896) { int pm, pn; pg8::tile_map(L, 128, 7, pm, pn);
            u.A = (const char*)(ws + WS_HN) + (size_t)pm * 256 * 1024 * 2; u.B = (const char*)(ws + WS_WIN) + (size_t)pn * 256 * 1024 * 2; u.pm = pm;
            u.aux = pn < 2 ? 0 : (pn < 4 ? 1 : pn - 2); u.pn = pn < 2 ? pn : (pn < 4 ? pn - 2 : 0); return true; }
        L -= 896; if (L >= 32) return false;
        int pm, pn; pg8::tile_map(L, 8, 4, pm, pn);
        u.A = (const char*)(ws + WS_MN) + (size_t)pm * 256 * 1024 * 2; u.B = (const char*)(ws + WS_WMK) + (size_t)pn * 256 * 1024 * 2; u.pm = pm; u.pn = pn; u.aux = 5; return true;
    }
};
struct EpiP1S {
    static constexpr bool MIDSCALE = false;
    unsigned char* ws;
    __device__ __forceinline__ void operator()(const Acc& acc, const Unit& u, int wr, int wc, int fr_, int fq_) const {
        int fr = fr_, fq = fq_; asm volatile("" : "+v"(fr), "+v"(fq));
        const int rowb = u.pm * 256 + wr * 64 + fr;
        if (u.aux == 0) { f16* dst = (f16*)(ws + WS_SBVT);
#pragma unroll
            for (int ai = 0; ai < 2; ++ai)
#pragma unroll
                for (int m = 0; m < 4; ++m) { const size_t ro = (size_t)(rowb + ai * 128 + m * 16) * T + u.pn * 256 + 32 * wc + 8 * (fq & 1) + 4 * (fq >> 1);
#pragma unroll
                    for (int bj = 0; bj < 2; ++bj)
#pragma unroll
                        for (int n = 0; n < 2; ++n) *(u32x2*)(dst + ro + 128 * bj + 16 * n) = pk4(acc[ai][bj][m][n]); }
        } else { f16* dst = (f16*)(ws + WS_MVT);
#pragma unroll
            for (int ai = 0; ai < 2; ++ai)
#pragma unroll
                for (int m = 0; m < 4; ++m) { const size_t ro = (size_t)(rowb + ai * 128 + m * 16) * 2048 + u.pn * 256 + 32 * wc + 8 * fq;
#pragma unroll
                    for (int bj = 0; bj < 2; ++bj)
#pragma unroll
                        for (int n = 0; n < 2; ++n) *(u32x2*)(dst + ro + 128 * bj + 4 * n) = pk4(acc[ai][bj][m][n]); }
        }
    }
};
struct SchedP1S {
    static constexpr bool WAITS = false;
    unsigned char* ws; int G, c;
    __device__ __forceinline__ bool next(int i, Unit& u) const {
        int L = i * G + c;
        if (L < 256) { int pm, pn; pg8::tile_map(L, 2, 128, pm, pn);
            u.A = (const char*)(ws + WS_WSV) + (size_t)pm * 256 * 1024 * 2; u.B = (const char*)(ws + WS_HN) + (size_t)pn * 256 * 1024 * 2; u.pm = pm; u.pn = pn; u.aux = 0; return true; }
        L -= 256; if (L >= 32) return false;
        int pm, pn; pg8::tile_map(L, 4, 8, pm, pn);
        u.A = (const char*)(ws + WS_WMV) + (size_t)pm * 256 * 1024 * 2; u.B = (const char*)(ws + WS_MN) + (size_t)pn * 256 * 1024 * 2; u.pm = pm; u.pn = pn; u.aux = 1; return true;
    }
};

constexpr float MLA_QSCALE = 0.10206207261596575f * 1.4426950408889634f;
__device__ __forceinline__ float rq_of(const float* SS8, int row) { const f32x4 a = *(const f32x4*)(SS8 + (size_t)row * 8), b = *(const f32x4*)(SS8 + (size_t)row * 8 + 4);
    return __builtin_amdgcn_rsqf((((a[0] + a[1]) + (a[2] + a[3])) + ((b[0] + b[1]) + (b[2] + b[3]))) * (1.f / 384.f) + EPS); }
__device__ __forceinline__ float rkv_of(const float* SS4, int row) { const f32x4 a = *(const f32x4*)(SS4 + (size_t)row * 4);
    return __builtin_amdgcn_rsqf(((a[0] + a[1]) + (a[2] + a[3])) * (1.f / 256.f) + EPS); }
struct EpiP2Q {
    static constexpr bool MIDSCALE = false;
    unsigned char* ws; const float* qng; const float* qrg;
    __device__ __forceinline__ void operator()(const Acc& acc, const Unit& u, int wr, int wc, int fr_, int fq_) const {
        int fr = fr_, fq = fq_; asm volatile("" : "+v"(fr), "+v"(fq));
        const int rowb = u.pm * 256 + wr * 64 + fr; const float* SS = (const float*)(ws + WS_SSQ_CQ); f16* Q = (f16*)(ws + WS_MLAQ);
        if (u.pn < 2) { const int h = 4 * u.pn + wc;
            f32x4 g[2][2];
#pragma unroll
            for (int bj = 0; bj < 2; ++bj)
#pragma unroll
                for (int n = 0; n < 2; ++n) g[bj][n] = *(const f32x4*)(qng + 32 * bj + 8 * fq + 4 * n) * MLA_QSCALE;
#pragma unroll
            for (int ai = 0; ai < 2; ++ai)
#pragma unroll
                for (int m = 0; m < 4; ++m) { const int row = rowb + ai * 128 + m * 16; const float rq = rq_of(SS, row);
                    f32x4 v[2][2]; float s = 0.f;
#pragma unroll
                    for (int bj = 0; bj < 2; ++bj)
#pragma unroll
                        for (int n = 0; n < 2; ++n) { v[bj][n] = acc[ai][bj][m][n] * rq; s += dot4(v[bj][n]); }
                    s = sum_x32(sum_x16(s));
                    const float rn = __builtin_amdgcn_rsqf(s * (1.f / 64.f) + EPS);
#pragma unroll
                    for (int bj = 0; bj < 2; ++bj) *(u32x4*)(Q + (size_t)row * 768 + h * 96 + 32 * bj + 8 * fq) = pk8(v[bj][0] * rn * g[bj][0], v[bj][1] * rn * g[bj][1]); }
        } else {
            const float* COS = (const float*)(ws + WS_COS); const float* SIN = (const float*)(ws + WS_SIN);
            const f32x4 g1 = *(const f32x4*)(qrg + 4 * fq) * MLA_QSCALE, g2 = *(const f32x4*)(qrg + 16 + 4 * fq) * MLA_QSCALE;
#pragma unroll
            for (int ai = 0; ai < 2; ++ai)
#pragma unroll
                for (int m = 0; m < 4; ++m) { const int row = rowb + ai * 128 + m * 16; const float rq = rq_of(SS, row);
                    const f32x4 c = *(const f32x4*)(COS + (size_t)row * 16 + 4 * fq), sn = *(const f32x4*)(SIN + (size_t)row * 16 + 4 * fq);
#pragma unroll
                    for (int bj = 0; bj < 2; ++bj) { const int h = 4 * bj + wc;
                        f32x4 x1 = acc[ai][bj][m][0] * rq, x2 = acc[ai][bj][m][1] * rq; float s = dot4(x1) + dot4(x2);
                        s = sum_x32(sum_x16(s));
                        const float rn = __builtin_amdgcn_rsqf(s * (1.f / 32.f) + EPS);
                        x1 = x1 * rn * g1; x2 = x2 * rn * g2;
                        const f32x4 o1 = x1 * c - x2 * sn, o2 = x2 * c + x1 * sn;
                        *(u32x2*)(Q + (size_t)row * 768 + h * 96 + 64 + 4 * fq) = pk4(o1); *(u32x2*)(Q + (size_t)row * 768 + h * 96 + 80 + 4 * fq) = pk4(o2); } }
        }
    }
};
struct EpiP2K {
    static constexpr bool MIDSCALE = false;
    unsigned char* ws; const float* kng;
    __device__ __forceinline__ void operator()(const Acc& acc, const Unit& u, int wr, int wc, int fr_, int fq_) const {
        int fr = fr_, fq = fq_; asm volatile("" : "+v"(fr), "+v"(fq));
        const int rowb = u.pm * 256 + wr * 64 + fr; const float* SS = (const float*)(ws + WS_SSQ_CKV); f16* Kd = (f16*)(ws + WS_MLAK); const f16* KRF = (const f16*)(ws + WS_KRF);
        const int h = 4 * u.pn + wc;
        f32x4 g[2][2];
#pragma unroll
        for (int bj = 0; bj < 2; ++bj)
#pragma unroll
            for (int n = 0; n < 2; ++n) g[bj][n] = *(const f32x4*)(kng + 32 * bj + 8 * fq + 4 * n);
#pragma unroll
        for (int ai = 0; ai < 2; ++ai)
#pragma unroll
            for (int m = 0; m < 4; ++m) { const int row = rowb + ai * 128 + m * 16; const float rk = rkv_of(SS, row);
                f32x4 v[2][2]; float s = 0.f;
#pragma unroll
                for (int bj = 0; bj < 2; ++bj)
#pragma unroll
                    for (int n = 0; n < 2; ++n) { v[bj][n] = acc[ai][bj][m][n] * rk; s += dot4(v[bj][n]); }
                s = sum_x32(sum_x16(s));
                const float rn = __builtin_amdgcn_rsqf(s * (1.f / 64.f) + EPS);
#pragma unroll
                for (int bj = 0; bj < 2; ++bj) *(u32x4*)(Kd + (size_t)row * 768 + h * 96 + 32 * bj + 8 * fq) = pk8(v[bj][0] * rn * g[bj][0], v[bj][1] * rn * g[bj][1]);
                *(u32x4*)(Kd + (size_t)row * 768 + h * 96 + 64 + 8 * fq) = *(const u32x4*)(KRF + (size_t)row * 32 + 8 * fq); }
    }
};
struct EpiP2V {
    static constexpr bool MIDSCALE = false;
    unsigned char* ws;
    __device__ __forceinline__ void operator()(const Acc& acc, const Unit& u, int wr, int wc, int fr_, int fq_) const {
        int fr = fr_, fq = fq_; asm volatile("" : "+v"(fr), "+v"(fq));
        const int rowb = u.pm * 256 + wr * 64 + fr; const float* SS = (const float*)(ws + WS_SSQ_CKV); f16* dst = (f16*)(ws + WS_MLAVT);
        f32x4 rk[2][2];
#pragma unroll
        for (int bj = 0; bj < 2; ++bj)
#pragma unroll
            for (int n = 0; n < 2; ++n) { const int tok = u.pn * 256 + 128 * bj + 32 * wc + 16 * n + 4 * fq;
#pragma unroll
                for (int j = 0; j < 4; ++j) rk[bj][n][j] = rkv_of(SS, tok + j); }
#pragma unroll
        for (int ai = 0; ai < 2; ++ai)
#pragma unroll
            for (int m = 0; m < 4; ++m) { const size_t ro = (size_t)(rowb + ai * 128 + m * 16) * T + u.pn * 256 + 32 * wc + 8 * (fq & 1) + 4 * (fq >> 1);
#pragma unroll
                for (int bj = 0; bj < 2; ++bj)
#pragma unroll
                    for (int n = 0; n < 2; ++n) *(u32x2*)(dst + ro + 128 * bj + 16 * n) = pk4(acc[ai][bj][m][n] * rk[bj][n]); }
    }
};
struct SchedGrid {
    static constexpr bool WAITS = false;
    const char* A; const char* B; size_t sA, sB; int nM, nN, G, c;
    __device__ __forceinline__ bool next(int i, Unit& u) const {
        const int L = i * G + c; if (L >= nM * nN) return false;
        int pm, pn; pg8::tile_map(L, nM, nN, pm, pn);
        u.A = A + (size_t)pm * sA; u.B = B + (size_t)pn * sB; u.pm = pm; u.pn = pn; u.aux = i; return true;
    }
};
__device__ __forceinline__ void p2_kprime(Frame& F, const Params& P) {
    PHASE_IDS();
    const int gw = F.vcu * NWAVES + wave, NGW = F.G * NWAVES;
    const f16* MKR = (const f16*)(F.ws + WS_MKR); const float* SS = (const float*)(F.ws + WS_SSQ_MK); f16* KP = (f16*)(F.ws + WS_KP);
    const f32x4 gg = *(const f32x4*)(P.in[21] + 4 * lane) * *(const f32x4*)(P.in[20] + 4 * lane);
    for (int it = gw; it < 2048 * 4; it += NGW) { const int row = it >> 2, h = it & 3, b = row >> 8, key = row & 255;
        const f32x4 a = *(const f32x4*)(SS + (size_t)row * 16 + 4 * h); const float r = __builtin_amdgcn_rsqf(((a[0] + a[1]) + (a[2] + a[3])) * (1.f / 256.f) + EPS);
        const f16x4 x = *(const f16x4*)(MKR + (size_t)row * 1024 + 256 * h + 4 * lane);
        const f32x4 v = (f32x4){(float)x[0], (float)x[1], (float)x[2], (float)x[3]} * r * gg;
        *(u32x2*)(KP + ((size_t)((b * 4 + h) * 256 + key)) * 256 + 4 * lane) = pk4(v); }
}

__device__ __forceinline__ void swap32(float x, float& a, float& b) { const auto rr = __builtin_amdgcn_permlane32_swap(__float_as_uint(x), __float_as_uint(x), false, false); a = __uint_as_float(rr[0]); b = __uint_as_float(rr[1]); }
__device__ __forceinline__ float sum32(float x) { float a, b; swap32(x, a, b); return a + b; }
#define MFMA32(a, b, c) __builtin_amdgcn_mfma_f32_32x32x16_f16((a), (b), (c), 0, 0, 0)
#define MFMA16(a, b, c) __builtin_amdgcn_mfma_f32_16x16x32_f16((a), (b), (c), 0, 0, 0)
__device__ __forceinline__ f16x8 pack8(const f32x16& s, int base) {
    u32x4 w; w.x = pk2(s[base + 0], s[base + 1]); w.y = pk2(s[base + 2], s[base + 3]); w.z = pk2(s[base + 4], s[base + 5]); w.w = pk2(s[base + 6], s[base + 7]);
    return __builtin_bit_cast(f16x8, w);
}
__device__ __forceinline__ f16x8 pack8z(const f32x16& s, int base) {
    typedef __fp16 h2 __attribute__((ext_vector_type(2)));
    const h2 a = __builtin_amdgcn_cvt_pkrtz(s[base + 0], s[base + 1]), b = __builtin_amdgcn_cvt_pkrtz(s[base + 2], s[base + 3]), c = __builtin_amdgcn_cvt_pkrtz(s[base + 4], s[base + 5]), d = __builtin_amdgcn_cvt_pkrtz(s[base + 6], s[base + 7]);
    u32x4 w; w.x = __builtin_bit_cast(unsigned, a); w.y = __builtin_bit_cast(unsigned, b); w.z = __builtin_bit_cast(unsigned, c); w.w = __builtin_bit_cast(unsigned, d);
    return __builtin_bit_cast(f16x8, w);
}
__device__ __forceinline__ float store_ot(const f32x16& o0, const f32x16& o1, float inv, f16* dst, int hf) {
    float ss = 0.f;
#pragma unroll
    for (int g4 = 0; g4 < 4; ++g4) {
        const f32x4 a = (f32x4){o0[4 * g4], o0[4 * g4 + 1], o0[4 * g4 + 2], o0[4 * g4 + 3]} * inv, b = (f32x4){o1[4 * g4], o1[4 * g4 + 1], o1[4 * g4 + 2], o1[4 * g4 + 3]} * inv;
        ss += dot4(a) + dot4(b);
        *(u32x2*)(dst + 8 * g4 + 4 * hf) = pk4(a); *(u32x2*)(dst + 32 + 8 * g4 + 4 * hf) = pk4(b); }
    return ss;
}
struct SbFrag { f16x8 k[4]; f16x8 v[2][2]; };
__device__ __forceinline__ void sb_load(SbFrag& f, const f16* kp, const f16* vp) {
#pragma unroll
    for (int ks = 0; ks < 4; ++ks) f.k[ks] = *(const f16x8*)(kp + 16 * ks);
#pragma unroll
    for (int dvb = 0; dvb < 2; ++dvb)
#pragma unroll
        for (int kk = 0; kk < 2; ++kk) f.v[dvb][kk] = *(const f16x8*)(vp + (size_t)dvb * 32 * T + 16 * kk);
}
__device__ __forceinline__ bool sb_step(const SbFrag& f, const f16x8 (&qf)[4], f32x16& o0, f32x16& o1, float& C, bool diag, int t0, int t, int hf) {
    f32x16 s = {};
#pragma unroll
    for (int ks = 0; ks < 4; ++ks) s = MFMA32(f.k[ks], qf[ks], s);
    float be[16], om[16];
#pragma unroll
    for (int r = 0; r < 16; ++r) { const float z = __builtin_amdgcn_fmed3f(s[r], -115.f, 115.f);
        const float e = __builtin_amdgcn_exp2f(-z); const float bt = __builtin_amdgcn_rcpf(1.f + e);
        be[r] = bt; om[r] = e * bt; }
    if (diag) {
#pragma unroll
        for (int r = 0; r < 16; ++r) { const int key = t0 + 8 * (r >> 2) + 4 * hf + (r & 3); const bool vis = key < t; be[r] = vis ? be[r] : 0.f; om[r] = vis ? om[r] : 1.f; }
    }
    float G[4], PG[4];
#pragma unroll
    for (int q4 = 0; q4 < 4; ++q4) { G[q4] = (om[4 * q4] * om[4 * q4 + 1]) * (om[4 * q4 + 2] * om[4 * q4 + 3]); float a_, b_; swap32(G[q4], a_, b_); PG[q4] = hf == 0 ? b_ : a_; }
    float run = C;
#pragma unroll
    for (int q4 = 3; q4 >= 0; --q4) { float a = hf == 0 ? run * PG[q4] : run;
#pragma unroll
        for (int j = 3; j >= 0; --j) { const int r = 4 * q4 + j; s[r] = be[r] * a; a *= om[r]; }
        run *= G[q4] * PG[q4]; }
    C = run;
#pragma unroll
    for (int kk = 0; kk < 2; ++kk) { const f16x8 pa = pack8(s, 8 * kk); o0 = MFMA32(f.v[0][kk], pa, o0); o1 = MFMA32(f.v[1][kk], pa, o1); }
    return __all(C == 0.f);
}
__device__ __forceinline__ void sb_item(const f16* __restrict__ Qg, const f16* __restrict__ Kg, const f16* __restrict__ Vt, f16* Og, float* SSQ, int b, int h, int qblk, int lane) {
    const int r32 = lane & 31, hf = lane >> 5;
    const int t0 = qblk * 32, t = t0 + r32; const size_t row = (size_t)b * SEQ + t;
    f16x8 qf[4];
#pragma unroll
    for (int ks = 0; ks < 4; ++ks) qf[ks] = *(const f16x8*)(Qg + row * 512 + h * 64 + 16 * ks + 8 * hf);
    f32x16 o0 = {}, o1 = {};
    float C = 1.f;
    const f16* kp = Kg + ((size_t)b * SEQ + t0 + r32) * 512 + h * 64 + 8 * hf;
    const f16* vp = Vt + ((size_t)(h * 64 + r32)) * T + (size_t)b * SEQ + t0 + 8 * hf;
    SbFrag f0, f1, f2;
    sb_load(f0, kp, vp);
    { const int d = qblk >= 1 ? 1 : 0; sb_load(f1, kp - d * 32 * 512, vp - d * 32); }
    int st = qblk;
    for (;;) {
        { const int d = st >= 2 ? 2 : 0; sb_load(f2, kp - d * 32 * 512, vp - d * 32); }
        if (sb_step(f0, qf, o0, o1, C, st == qblk, t0, t, hf)) break;
        if (--st < 0) break; kp -= 32 * 512; vp -= 32;
        { const int d = st >= 2 ? 2 : 0; sb_load(f0, kp - d * 32 * 512, vp - d * 32); }
        if (sb_step(f1, qf, o0, o1, C, false, t0, t, hf)) break;
        if (--st < 0) break; kp -= 32 * 512; vp -= 32;
        { const int d = st >= 2 ? 2 : 0; sb_load(f1, kp - d * 32 * 512, vp - d * 32); }
        if (sb_step(f2, qf, o0, o1, C, false, t0, t, hf)) break;
        if (--st < 0) break; kp -= 32 * 512; vp -= 32;
    }
    const float ss = store_ot(o0, o1, 1.f, Og + row * 1024 + h * 64, hf);
    const float tot = sum32(ss);
    if (hf == 0) SSQ[row * 16 + h] = tot;
}
constexpr int MLA_KROW = 208, MLA_VROW = 144, MLA_KBYTES = 64 * MLA_KROW, MLA_VBYTES = 64 * MLA_VROW, MLA_BUF = MLA_KBYTES + MLA_VBYTES;
__device__ __forceinline__ float max3f(float a, float b, float c) { float r; asm("v_max3_f32 %0, %1, %2, %3" : "=v"(r) : "v"(a), "v"(b), "v"(c)); return r; }
__device__ __forceinline__ float max2f(float a, float b) { float r; asm("v_max_f32_e32 %0, %1, %2" : "=v"(r) : "v"(a), "v"(b)); return r; }
__device__ __forceinline__ void mla_unit(LAS unsigned char* lds, const f16* __restrict__ Qg, const f16* __restrict__ Kg, const f16* __restrict__ Vt, f16* Og, float* SSQ, int b, int h, int qb, int tid) {
    const int lane = tid & 63, wid = __builtin_amdgcn_readfirstlane(tid >> 6), r32 = lane & 31, hf = lane >> 5;
    const size_t row = (size_t)b * SEQ + qb * 256 + wid * 32 + r32;
    const int NT = 4 * qb + 4, my_last = 4 * qb + (wid >> 1);
    const char* src[3]; unsigned dsto[3]; unsigned tstep[3];
#pragma unroll
    for (int i = 0; i < 3; ++i) { int I = wid + 8 * i; if (I >= 22) I -= 2;
        if (I < 13) { const int p = 64 * I + lane, key = p / 13, c = p % 13;
            src[i] = (const char*)(Kg + ((size_t)b * SEQ + key) * 768 + h * 96 + 8 * (c < 12 ? c : 11)); tstep[i] = 64u * 768u * 2u; }
        else { const int p = 64 * (I - 13) + lane, dv = p / 9, c = p % 9;
            src[i] = (const char*)(Vt + (size_t)(h * 64 + dv) * T + (size_t)b * SEQ + 8 * (c < 8 ? c : 7)); tstep[i] = 128u; }
        dsto[i] = (unsigned)(I < 13 ? 1024 * I : MLA_KBYTES + 1024 * (I - 13)); }
#define MLA_ISSUE(tile, bufi) do { _Pragma("unroll") for (int _i = 0; _i < 3; ++_i) \
        __builtin_amdgcn_global_load_lds((const unsigned*)(src[_i] + (size_t)(tile) * tstep[_i]), (LAS unsigned*)(lds + (bufi) * MLA_BUF + __builtin_amdgcn_readfirstlane(dsto[_i])), 16, 0, 0); } while (0)
    f16x8 qf[6];
#pragma unroll
    for (int ks = 0; ks < 6; ++ks) qf[ks] = *(const f16x8*)(Qg + row * 768 + h * 96 + 16 * ks + 8 * hf);
    asm volatile("s_waitcnt vmcnt(0)" ::: "memory");
    __builtin_amdgcn_s_barrier();
    MLA_ISSUE(0, 0); MLA_ISSUE(1, 1);
    f32x16 o0 = {}, o1 = {};
    float lrun = 0.f;
    f32x16 negm;
#pragma unroll
    for (int r = 0; r < 16; ++r) negm[r] = 64.f;
    int bi = 0;
    for (int t = 0; t < NT; ++t) {
        if (t + 1 < NT) asm volatile("s_waitcnt vmcnt(3)" ::: "memory"); else asm volatile("s_waitcnt vmcnt(0)" ::: "memory");
        __builtin_amdgcn_s_barrier();
        asm volatile("" ::: "memory");
        if (t + 2 < NT) { const int nb = bi == 0 ? 2 : bi - 1; MLA_ISSUE(t + 2, nb); }
        if (t <= my_last) {
            const LAS unsigned char* kb_ = lds + bi * MLA_BUF; const LAS unsigned char* vb_ = kb_ + MLA_KBYTES;
            f32x16 s0 = negm, s1 = negm;
#pragma unroll
            for (int ks = 0; ks < 6; ++ks) {
                const f16x8 k0 = *(const LAS f16x8*)(kb_ + r32 * MLA_KROW + (16 * ks + 8 * hf) * 2);
                const f16x8 k1 = *(const LAS f16x8*)(kb_ + (32 + r32) * MLA_KROW + (16 * ks + 8 * hf) * 2);
                s0 = MFMA32(k0, qf[ks], s0); s1 = MFMA32(k1, qf[ks], s1); }
            f16x8 vf0[4], vf1[4];
#pragma unroll
            for (int kk = 0; kk < 4; ++kk) { vf0[kk] = *(const LAS f16x8*)(vb_ + r32 * MLA_VROW + (16 * kk + 8 * hf) * 2); vf1[kk] = *(const LAS f16x8*)(vb_ + (32 + r32) * MLA_VROW + (16 * kk + 8 * hf) * 2); }
            float ta = max3f(s0[0], s1[0], s0[1]), tb = max3f(s1[1], s0[2], s1[2]);
#pragma unroll
            for (int r = 3; r < 15; r += 2) { ta = max3f(ta, s0[r], s1[r]); tb = max3f(tb, s0[r + 1], s1[r + 1]); }
            float tm = max3f(ta, tb, max2f(s0[15], s1[15]));
            { float a_, b_; swap32(tm, a_, b_); tm = max2f(a_, b_); }
            if (__any(tm > 0.f)) {
                const float delta = max2f(tm, 0.f), alpha = __builtin_amdgcn_exp2f(-delta);
                lrun *= alpha; o0 = o0 * alpha; o1 = o1 * alpha;
#pragma unroll
                for (int r = 0; r < 16; ++r) { s0[r] -= delta; s1[r] -= delta; negm[r] -= delta; }
            }
            float ps = 0.f, ps2 = 0.f;
#pragma unroll
            for (int r = 0; r < 16; ++r) { s0[r] = __builtin_amdgcn_exp2f(s0[r]); s1[r] = __builtin_amdgcn_exp2f(s1[r]); ps += s0[r]; ps2 += s1[r]; }
            lrun += ps + ps2;
#pragma unroll
            for (int kk = 0; kk < 4; ++kk) { const f16x8 pa = (kk < 2) ? pack8z(s0, 8 * (kk & 1)) : pack8z(s1, 8 * (kk & 1));
                o0 = MFMA32(vf0[kk], pa, o0); o1 = MFMA32(vf1[kk], pa, o1); }
        }
        bi = bi == 2 ? 0 : bi + 1;
    }
#undef MLA_ISSUE
    const float ltot = sum32(lrun);
    const float ss = store_ot(o0, o1, 1.f / ltot, Og + row * 1024 + 512 + h * 64, hf);
    const float tot = sum32(ss);
    if (hf == 0) SSQ[row * 16 + 8 + h] = tot;
}
template <bool DO_SB = true, bool DO_MLA = true>
__device__ __forceinline__ void p3_attention(Frame& F) {
    PHASE_IDS();
    unsigned char* ws = F.ws;
    f16* ATT = (f16*)(ws + WS_ATT); float* SSQ = (float*)(ws + WS_SSQ_ATT);
    if (DO_SB) {
        const f16* Q = (const f16*)(ws + WS_SBQ); const f16* K = (const f16*)(ws + WS_SBK); const f16* Vt = (const f16*)(ws + WS_SBVT);
        const int gw = F.vcu * NWAVES + wave, NGW = F.G * NWAVES;
        for (int it = gw; it < NB * 8 * 128; it += NGW) { const int qblk = it & 127, h = (it >> 7) & 7, b = it >> 10; sb_item(Q, K, Vt, ATT, SSQ, b, h, qblk, lane); }
    }
    if (DO_MLA) {
        const f16* Q = (const f16*)(ws + WS_MLAQ); const f16* K = (const f16*)(ws + WS_MLAK); const f16* Vt = (const f16*)(ws + WS_MLAVT);
        for (int pr = F.vcu; pr < 64 * 8; pr += F.G) { const int bh = pr >> 3, qa = pr & 7, b = bh >> 3, h = bh & 7;
            mla_unit(F.lds, Q, K, Vt, ATT, SSQ, b, h, 15 - qa, tid);
            mla_unit(F.lds, Q, K, Vt, ATT, SSQ, b, h, qa, tid); }
    }
}
constexpr int WO_TAB_OFF = 131072;
struct EpiWo {
    static constexpr bool MIDSCALE = true;
    unsigned char* ws; const float* x; LAS const float* tab;
    __device__ __forceinline__ void mid(Acc& acc, const Unit& u, int wr, int fr_) const {
        int fr = fr_; asm volatile("" : "+v"(fr));
#pragma unroll
        for (int ai = 0; ai < 2; ++ai)
#pragma unroll
            for (int m = 0; m < 4; ++m) { const float ra = tab[(u.aux * 256 + ai * 128 + wr * 64 + m * 16 + fr) * 2];
#pragma unroll
                for (int bj = 0; bj < 2; ++bj)
#pragma unroll
                    for (int n = 0; n < 2; ++n) acc[ai][bj][m][n] = acc[ai][bj][m][n] * ra; }
    }
    __device__ __forceinline__ void operator()(const Acc& acc, const Unit& u, int wr, int wc, int fr_, int fq_) const {
        int fr = fr_, fq = fq_; asm volatile("" : "+v"(fr), "+v"(fq));
        const int rowb = u.pm * 256 + wr * 64 + fr, colb = u.pn * 256 + 32 * wc + 8 * fq; f16* H = (f16*)(ws + WS_H1H); float* SS = (float*)(ws + WS_SSQ_H1);
#pragma unroll
        for (int ai = 0; ai < 2; ++ai)
#pragma unroll
            for (int m = 0; m < 4; ++m) { const size_t ro = (size_t)(rowb + ai * 128 + m * 16) * 1024 + colb; float s = 0.f;
                const float rb = tab[(u.aux * 256 + ai * 128 + wr * 64 + m * 16 + fr) * 2 + 1];
#pragma unroll
                for (int bj = 0; bj < 2; ++bj) { const size_t o = ro + 128 * bj;
                    const f32x4 v0 = acc[ai][bj][m][0] * rb + *(const f32x4*)(x + o), v1 = acc[ai][bj][m][1] * rb + *(const f32x4*)(x + o + 4);
                    *(u32x4*)(H + o) = pk8(v0, v1); s += dot4(v0) + dot4(v1); }
                s = sum_x32(sum_x16(s)); if (fq == 0) SS[(size_t)(rowb + ai * 128 + m * 16) * 16 + 4 * u.pn + wc] = s; }
    }
};
template <class Sched> __device__ __forceinline__ void wo_table(Frame& F, const Sched& S) {
    const int tid = fresh_tid(); LAS float* tab = (LAS float*)(F.lds + WO_TAB_OFF); const float* SSQ = (const float*)(F.ws + WS_SSQ_ATT);
    for (int i = tid >> 8; i < 4; i += 2) { Unit u; if (!S.next(i, u)) break;
        const int row = u.pm * 256 + (tid & 255);
        const f32x4 a0 = *(const f32x4*)(SSQ + (size_t)row * 16), a1 = *(const f32x4*)(SSQ + (size_t)row * 16 + 4), b0 = *(const f32x4*)(SSQ + (size_t)row * 16 + 8), b1 = *(const f32x4*)(SSQ + (size_t)row * 16 + 12);
        const float sa = (((a0[0] + a0[1]) + (a0[2] + a0[3])) + ((a1[0] + a1[1]) + (a1[2] + a1[3]))) * (1.f / 512.f) + EPS;
        const float sb = (((b0[0] + b0[1]) + (b0[2] + b0[3])) + ((b1[0] + b1[1]) + (b1[2] + b1[3]))) * (1.f / 512.f) + EPS;
        const float ra = __builtin_amdgcn_rsqf(sa), rb = __builtin_amdgcn_rsqf(sb);
        tab[(i * 256 + (tid & 255)) * 2] = ra * __builtin_amdgcn_sqrtf(sb); tab[(i * 256 + (tid & 255)) * 2 + 1] = rb; }
    __syncthreads();
}
struct EpiMq {
    static constexpr bool MIDSCALE = false;
    unsigned char* ws;
    __device__ __forceinline__ void operator()(const Acc& acc, const Unit& u, int wr, int wc, int fr_, int fq_) const {
        int fr = fr_, fq = fq_; asm volatile("" : "+v"(fr), "+v"(fq));
        const int rowb = u.pm * 256 + wr * 64 + fr, colb = u.pn * 256 + 32 * wc + 8 * fq; f16* Q = (f16*)(ws + WS_MQ); float* SS = (float*)(ws + WS_SSQ_MQ);
#pragma unroll
        for (int ai = 0; ai < 2; ++ai)
#pragma unroll
            for (int m = 0; m < 4; ++m) { const size_t ro = (size_t)(rowb + ai * 128 + m * 16) * 1024 + colb; float s = 0.f;
#pragma unroll
                for (int bj = 0; bj < 2; ++bj) { const f32x4 v0 = acc[ai][bj][m][0], v1 = acc[ai][bj][m][1]; *(u32x4*)(Q + ro + 128 * bj) = pk8(v0, v1); s += dot4(v0) + dot4(v1); }
                s = sum_x32(sum_x16(s)); if (fq == 0) SS[(size_t)(rowb + ai * 128 + m * 16) * 16 + 4 * u.pn + wc] = s; }
    }
};
struct EpiMo {
    static constexpr bool MIDSCALE = false;
    unsigned char* ws;
    __device__ __forceinline__ void operator()(const Acc& acc, const Unit& u, int wr, int wc, int fr_, int fq_) const {
        int fr = fr_, fq = fq_; asm volatile("" : "+v"(fr), "+v"(fq));
        const int rowb = u.pm * 256 + wr * 64 + fr, colb = u.pn * 256 + 32 * wc + 8 * fq; f16* H = (f16*)(ws + WS_H2H); const f16* H1 = (const f16*)(ws + WS_H1H);
#pragma unroll
        for (int ai = 0; ai < 2; ++ai)
#pragma unroll
            for (int m = 0; m < 4; ++m) { const size_t ro = (size_t)(rowb + ai * 128 + m * 16) * 1024 + colb;
#pragma unroll
                for (int bj = 0; bj < 2; ++bj) { const size_t o = ro + 128 * bj; const f16x8 hv = *(const f16x8*)(H1 + o);
                    f32x4 v0 = acc[ai][bj][m][0], v1 = acc[ai][bj][m][1];
#pragma unroll
                    for (int j = 0; j < 4; ++j) { v0[j] += (float)hv[j]; v1[j] += (float)hv[4 + j]; }
                    *(u32x4*)(H + o) = pk8(v0, v1); } }
    }
};

constexpr int MEM_ROWB = 528;
template <int RS>
__device__ __forceinline__ void mem_stage(LAS unsigned char* lds, const f16* src, int tid) {
    const unsigned voff = (unsigned)((tid >> 5) * RS + 8 * (tid & 31)) * 2u;
    const unsigned loff = (unsigned)((tid >> 5) * MEM_ROWB + (tid & 31) * 16);
#pragma unroll
    for (int bt = 0; bt < 4; ++bt) { u32x4 r[4];
#pragma unroll
        for (int i = 0; i < 4; ++i) r[i] = *(const u32x4*)((const char*)src + (size_t)(4 * bt + i) * 16 * RS * 2 + voff);
#pragma unroll
        for (int i = 0; i < 4; ++i) *(LAS u32x4*)(lds + loff + (4 * bt + i) * 16 * MEM_ROWB) = r[i]; }
}
__device__ __forceinline__ void p6_memattn(Frame& F) {
    PHASE_IDS(); unsigned char* ws = F.ws; LAS unsigned char* lds = F.lds; const int wid = wave;
    const f16* MQ = (const f16*)(ws + WS_MQ); const f16* KP = (const f16*)(ws + WS_KP); const f16* MVT = (const f16*)(ws + WS_MVT); f16* MO = (f16*)(ws + WS_MO);
    const float* SSH = (const float*)(ws + WS_SSQ_H1); const float* SSM = (const float*)(ws + WS_SSQ_MQ);
    for (int un = F.vcu; un < 256; un += F.G) { const int bh = un >> 3, qc = un & 7, b = bh >> 2, h = bh & 3;
#pragma unroll 1
      for (int hp = 0; hp < 2; ++hp) {
        int t2 = tid; asm volatile("" : "+v"(t2));
        const int ln = t2 & 63, l16 = ln & 15, g = ln >> 4;
        const size_t row0 = (size_t)b * SEQ + qc * 512 + hp * 256 + wid * 16 + l16;
        u32x4 pf[2][8]; float inv[2];
        __syncthreads();
        mem_stage<256>(lds, KP + (size_t)(b * 4 + h) * 256 * 256, t2);
        __syncthreads();
#pragma unroll
        for (int pass = 0; pass < 2; ++pass) {
            const size_t row = row0 + pass * 128;
            f16x8 qf[8];
#pragma unroll
            for (int ks = 0; ks < 8; ++ks) qf[ks] = *(const f16x8*)(MQ + row * 1024 + h * 256 + 32 * ks + 8 * g);
            float fac;
            { const f32x4 a0 = *(const f32x4*)(SSH + row * 16), a1 = *(const f32x4*)(SSH + row * 16 + 4), a2 = *(const f32x4*)(SSH + row * 16 + 8), a3 = *(const f32x4*)(SSH + row * 16 + 12);
              const float sh = (((a0[0] + a0[1]) + (a0[2] + a0[3])) + ((a1[0] + a1[1]) + (a1[2] + a1[3]))) + (((a2[0] + a2[1]) + (a2[2] + a2[3])) + ((a3[0] + a3[1]) + (a3[2] + a3[3])));
              const float r1 = __builtin_amdgcn_rsqf(sh * (1.f / 1024.f) + EPS);
              const f32x4 q4 = *(const f32x4*)(SSM + row * 16 + 4 * h); const float mv = ((q4[0] + q4[1]) + (q4[2] + q4[3])) * (1.f / 256.f);
              fac = r1 * __builtin_amdgcn_rsqf(r1 * r1 * mv + EPS) * (0.0625f * 1.4426950408889634f); }
            f32x4 s[16];
#pragma unroll
            for (int kb = 0; kb < 16; ++kb) { s[kb] = (f32x4){0.f, 0.f, 0.f, 0.f};
#pragma unroll
                for (int ks = 0; ks < 8; ++ks) { const f16x8 a = *(const LAS f16x8*)(lds + (16 * kb + l16) * MEM_ROWB + (32 * ks + 8 * g) * 2); s[kb] = MFMA16(a, qf[ks], s[kb]); }
                __builtin_amdgcn_sched_barrier(0); }
            float mx = -INFINITY;
#pragma unroll
            for (int kb = 0; kb < 16; ++kb) { s[kb] = s[kb] * fac; mx = max3f(mx, max2f(s[kb][0], s[kb][1]), max2f(s[kb][2], s[kb][3])); }
            mx = max2f(mx, __shfl_xor(mx, 16)); mx = max2f(mx, __shfl_xor(mx, 32));
            float sum = 0.f;
#pragma unroll
            for (int s8 = 0; s8 < 8; ++s8) { f32x4 p0, p1;
#pragma unroll
                for (int j = 0; j < 4; ++j) { p0[j] = __builtin_amdgcn_exp2f(s[2 * s8][j] - mx); p1[j] = __builtin_amdgcn_exp2f(s[2 * s8 + 1][j] - mx); }
                sum += ((p0[0] + p0[1]) + (p0[2] + p0[3])) + ((p1[0] + p1[1]) + (p1[2] + p1[3]));
                pf[pass][s8] = pk8(p0, p1); }
            sum = sum_x32(sum_x16(sum));
            inv[pass] = 1.f / sum;
            __builtin_amdgcn_sched_barrier(0);
        }
        __syncthreads();
        mem_stage<2048>(lds, MVT + (size_t)(h * 256) * 2048 + b * 256, t2);
        __syncthreads();
#pragma unroll 2
        for (int dvb = 0; dvb < 16; ++dvb) { f32x4 o[2];
#pragma unroll
            for (int pass = 0; pass < 2; ++pass) o[pass] = (f32x4){0.f, 0.f, 0.f, 0.f};
#pragma unroll
            for (int s8 = 0; s8 < 8; ++s8) { const f16x8 a = *(const LAS f16x8*)(lds + (16 * dvb + l16) * MEM_ROWB + (32 * s8 + 8 * g) * 2);
#pragma unroll
                for (int pass = 0; pass < 2; ++pass) o[pass] = MFMA16(a, __builtin_bit_cast(f16x8, pf[pass][s8]), o[pass]); }
            __builtin_amdgcn_sched_barrier(0);
#pragma unroll
            for (int pass = 0; pass < 2; ++pass) *(u32x2*)(MO + (row0 + pass * 128) * 1024 + h * 256 + 16 * dvb + 4 * g) = pk4(o[pass] * inv[pass]); }
      }
    }
}

constexpr int RT_ROWB = 2064;
constexpr int RT_T_OFF = 40 * RT_ROWB;
__device__ __forceinline__ void p8_route(Frame& F, const Params& P, int cnt_off = 0) {
    PHASE_IDS(); unsigned char* ws = F.ws;
    LAS unsigned char* lds = F.lds;
    LAS unsigned* hist = (LAS unsigned*)(F.lds + LDS_MISC) + 8;
    const float* w_group = P.in[24]; const float* w_router = P.in[26]; const float* gm = P.in[23];
    for (int e = tid; e < 1024 * 20; e += NTHR) { const int d = e / 20, c = e % 20; const float w = (c < 4 ? w_group[d * 4 + c] : w_router[d * 16 + (c - 4)]) * gm[d] * 256.f;
        const f16 hi = (f16)w; const f16 lo = (f16)(w - (float)hi);
        *(LAS f16*)(lds + c * RT_ROWB + d * 2) = hi; *(LAS f16*)(lds + (20 + c) * RT_ROWB + d * 2) = lo; }
    if (tid < 24) hist[tid] = 0u;
    __syncthreads();
    const f16* H2 = (const f16*)(ws + WS_H2H);
    int* BKT = (int*)(ws + WS_BKT); float* RR = (float*)(ws + WS_RR); float* W0 = (float*)(ws + WS_W0); float* W1 = (float*)(ws + WS_W1);
    const int gw = F.vcu * NWAVES + wave, NGW = F.G * NWAVES, l16 = lane & 15, g = lane >> 4;
    LAS float* Tw = (LAS float*)(lds + RT_T_OFF) + wave * 320;
    float bias[20];
#pragma unroll
    for (int c = 0; c < 20; ++c) bias[c] = c < 4 ? P.in[25][c] : P.in[27][c - 4];
    const int brow1 = (16 + l16) < 20 ? (16 + l16) : 19;
    for (int blk = gw; blk < T / 16; blk += NGW) {
        const f16* arow = H2 + (size_t)(blk * 16 + l16) * 1024 + 8 * g;
        f32x4 c0h = {0.f, 0.f, 0.f, 0.f}, c0l = c0h, c1h = c0h, c1l = c0h; float ss = 0.f;
#pragma unroll 1
        for (int kh = 0; kh < 2; ++kh) { f16x8 a[16];
#pragma unroll
            for (int ks = 0; ks < 16; ++ks) a[ks] = *(const f16x8*)(arow + 32 * (16 * kh + ks));
#pragma unroll
            for (int ks = 0; ks < 16; ++ks) { const int ko = (32 * (16 * kh + ks) + 8 * g) * 2;
                const f16x8 b0h = *(const LAS f16x8*)(lds + l16 * RT_ROWB + ko), b0l = *(const LAS f16x8*)(lds + (20 + l16) * RT_ROWB + ko);
                const f16x8 b1h = *(const LAS f16x8*)(lds + brow1 * RT_ROWB + ko), b1l = *(const LAS f16x8*)(lds + (20 + brow1) * RT_ROWB + ko);
                c0h = MFMA16(a[ks], b0h, c0h); c0l = MFMA16(a[ks], b0l, c0l); c1h = MFMA16(a[ks], b1h, c1h); c1l = MFMA16(a[ks], b1l, c1l);
#pragma unroll
                for (int j = 0; j < 8; ++j) { const float x = (float)a[ks][j]; ss += x * x; } } }
        ss = sum_x32(sum_x16(ss));
        const f32x4 c0 = c0h + c0l, c1 = c1h + c1l;
#pragma unroll
        for (int r4 = 0; r4 < 4; ++r4) { Tw[(4 * g + r4) * 20 + l16] = c0[r4]; if (l16 < 4) Tw[(4 * g + r4) * 20 + 16 + l16] = c1[r4]; }
        asm volatile("s_waitcnt lgkmcnt(0)" ::: "memory");
        if (lane < 16) {
            const int tok = blk * 16 + lane;
            const float r = __builtin_amdgcn_rsqf(ss * (1.f / 1024.f) + EPS), rs = r * (1.f / 256.f);
            float lg[20];
#pragma unroll
            for (int c4 = 0; c4 < 5; ++c4) { const f32x4 v = *(const LAS f32x4*)(Tw + lane * 20 + 4 * c4);
#pragma unroll
                for (int i = 0; i < 4; ++i) lg[4 * c4 + i] = v[i] * rs + bias[4 * c4 + i]; }
            int gi = 0; float gmx = lg[0];
#pragma unroll
            for (int c = 1; c < 4; ++c) if (lg[c] > gmx) { gmx = lg[c]; gi = c; }
            float gden = 0.f;
#pragma unroll
            for (int c = 0; c < 4; ++c) gden += __expf(lg[c] - gmx);
            const float gw_ = 1.f / gden;
            float el[4];
#pragma unroll
            for (int c = 0; c < 4; ++c) el[c] = gi == 0 ? lg[4 + c] : (gi == 1 ? lg[8 + c] : (gi == 2 ? lg[12 + c] : lg[16 + c]));
            int i1 = 0; float m1 = el[0];
#pragma unroll
            for (int c = 1; c < 4; ++c) if (el[c] > m1) { m1 = el[c]; i1 = c; }
            int i2 = -1; float m2 = -INFINITY;
#pragma unroll
            for (int c = 0; c < 4; ++c) if (c != i1 && el[c] > m2) { m2 = el[c]; i2 = c; }
            const float e2 = __expf(m2 - m1), wa = gw_ / (1.f + e2), wb = gw_ * e2 / (1.f + e2);
            const int lo = i1 < i2 ? i1 : i2, hi = i1 < i2 ? i2 : i1;
            const int pi = lo == 0 ? hi - 1 : (lo == 1 ? hi + 1 : 5);
            const int bk = gi * 6 + pi;
            BKT[tok] = bk; RR[tok] = r; W0[tok] = (i1 < i2) ? wa : wb; W1[tok] = (i1 < i2) ? wb : wa; atomicAdd((unsigned*)&hist[bk], 1u);
        }
        asm volatile("s_waitcnt lgkmcnt(0)" ::: "memory");
    }
    __syncthreads();
    if (tid < 24) { const unsigned hv = hist[tid]; if (hv) atomicAdd(F.ctl + CW_CNT + cnt_off + tid, hv); }
}
__device__ __forceinline__ void moe_tiles(Frame& F) {
    LAS int* tstart = (LAS int*)(F.lds + LDS_MISC) + 32;
    const int tid0 = fresh_tid();
    __syncthreads();
    if (tid0 == 0) { int acc = 0;
        for (int b = 0; b < 24; ++b) { tstart[b] = acc; acc += (int)((__hip_atomic_load(F.ctl + CW_CNT + b, __ATOMIC_RELAXED, __HIP_MEMORY_SCOPE_AGENT) + 255u) >> 8); }
        tstart[24] = acc; }
    __syncthreads();
}
__device__ __forceinline__ void p9_gather(Frame& F) {
    PHASE_IDS(); unsigned char* ws = F.ws; const int wid = wave;
    moe_tiles(F);
    LAS int* tstart = (LAS int*)(F.lds + LDS_MISC) + 32; LAS int* posarr = (LAS int*)(F.lds + LDS_MISC) + 64;
    const int* BKT = (const int*)(ws + WS_BKT); const float* RR = (const float*)(ws + WS_RR); const float* W0 = (const float*)(ws + WS_W0); const float* W1 = (const float*)(ws + WS_W1);
    int* TOK = (int*)(ws + WS_TOK); float* PR = (float*)(ws + WS_PR); float* PW0 = (float*)(ws + WS_PW0); float* PW1 = (float*)(ws + WS_PW1);
    const f16* H2H = (const f16*)(ws + WS_H2H); f16* TS = (f16*)(ws + WS_TS);
    for (int blk = F.vcu; blk < T / 128; blk += F.G) {
        if (wid < 2) { const int tok = blk * 128 + wid * 64 + lane; const int bk = BKT[tok];
            unsigned mycount = 0u, rank = 0u;
            for (int bb = 0; bb < 24; ++bb) { const unsigned long long mask = __ballot(bk == bb); const unsigned c = (unsigned)__popcll(mask);
                if (lane == bb) mycount = c;
                if (bk == bb) rank = (unsigned)__popcll(mask & ((1ull << lane) - 1ull)); }
            unsigned basev = 0u;
            if (lane < 24 && mycount) basev = atomicAdd(F.ctl + CW_CUR + lane, mycount);
            const unsigned mybase = (unsigned)__shfl((int)basev, bk);
            posarr[wid * 64 + lane] = tstart[bk] * 256 + (int)(mybase + rank); }
        __syncthreads();
        if (tid < 128) { const int tok = blk * 128 + tid, pos = posarr[tid]; TOK[pos] = tok; PR[pos] = RR[tok]; PW0[pos] = W0[tok]; PW1[pos] = W1[tok]; }
        __syncthreads();
    }
}

struct SchedMoeAll;
template <int MODE> struct SchedMoePart;
struct SchedMoeAll {
    static constexpr bool WAITS = true;
    const char* TSb; const char* HEb; const char* WGUb; const char* WDTb; const int* tok; LAS const int* tstart; LAS const int* itab; unsigned* ctl; int G, c;
    __device__ __forceinline__ int arow(const Unit& u, int rr) const { if (u.pn < 8) { const int t = itab[u.aux * 256 + rr]; return t < 0 ? 0 : t; } return u.pm * 256 + rr; }
    __device__ __forceinline__ bool next(int i, Unit& u) const {
        const int NRT = tstart[24]; int L = i * G + c; int rt, ct; bool down = false;
        if (L < 8 * NRT) { rt = L >> 3; ct = L & 7; } else { L -= 8 * NRT; rt = L >> 2; ct = L & 3; down = true; if (rt >= NRT) return false; }
        int bk = 0;
        for (int b = 1; b < 24; ++b) bk = (rt >= tstart[b]) ? b : bk;
        int lo, hi; moe_pair(bk % 6, lo, hi);
        u.pm = rt; u.aux = i;
        if (down) { u.A = HEb; u.pn = 8 + ct;
            u.B = WDTb + ((size_t)(4 * (bk / 6) + lo) * 1024 + ct * 256) * 1024 * 2; u.B2 = WDTb + ((size_t)(4 * (bk / 6) + hi) * 1024 + ct * 256) * 1024 * 2; }
        else { u.A = TSb; u.pn = ct; const int e = 4 * (bk / 6) + ((ct >> 2) ? hi : lo);
            u.B = WGUb + (size_t)(e * 4 + (ct & 3)) * 256 * 1024 * 2; u.B2 = u.B + 8 * 128; }
        return true;
    }
    __device__ __forceinline__ void a_ready(const Unit& u) const {
        if (u.pn >= 8) {
            if (threadIdx.x < 64) {
                unsigned* cw = ctl + CW_RT + 64 * u.pm; const unsigned long long t0 = __builtin_amdgcn_s_memrealtime(); unsigned polls = 0;
                while ((unsigned)__builtin_amdgcn_readfirstlane(__hip_atomic_load(cw, __ATOMIC_RELAXED, __HIP_MEMORY_SCOPE_AGENT)) < 64u) {
                    if ((++polls & 255u) == 0u && __builtin_amdgcn_readfirstlane(__hip_atomic_load(ctl + CW_TMO, __ATOMIC_RELAXED, __HIP_MEMORY_SCOPE_AGENT)) != 0u) break;
                    if (__builtin_amdgcn_s_memrealtime() - t0 > 2000000ull) { if (threadIdx.x == 0) __hip_atomic_store(ctl + CW_TMO, 1u, __ATOMIC_RELAXED, __HIP_MEMORY_SCOPE_AGENT); break; }
                    __builtin_amdgcn_s_sleep(2); }
                __builtin_amdgcn_fence(__ATOMIC_ACQUIRE, "agent");
                asm volatile("s_waitcnt vmcnt(0)" ::: "memory");
            }
            asm volatile("" ::: "memory"); __builtin_amdgcn_s_barrier(); asm volatile("" ::: "memory");
        }
    }
};
constexpr int MOE_ITAB_OFF = 131072;
template <class Sched> __device__ __forceinline__ void moe_itab(Frame& F, const Sched& S) {
    const int tid = fresh_tid(); LAS int* itab = (LAS int*)(F.lds + MOE_ITAB_OFF);
    for (int i = tid >> 8; i < 8; i += 2) { Unit u; if (!S.next(i, u)) break; if (u.pn < 8) itab[i * 256 + (tid & 255)] = S.tok[u.pm * 256 + (tid & 255)]; }
    __syncthreads();
}
template <int MODE> struct SchedMoePart {
    static constexpr bool WAITS = false;
    SchedMoeAll S; const int* tok;
    __device__ __forceinline__ bool next(int i, Unit& u) const {
        const int NRT = S.tstart[24]; const int L = i * S.G + S.c; int rt, ct;
        if (MODE == 0) { rt = L >> 3; ct = L & 7; } else { rt = L >> 2; ct = L & 3; }
        if (rt >= NRT) return false;
        int bk = 0;
        for (int b = 1; b < 24; ++b) bk = (rt >= S.tstart[b]) ? b : bk;
        int lo, hi; moe_pair(bk % 6, lo, hi);
        u.pm = rt; u.aux = i;
        if (MODE == 1) { u.A = S.HEb; u.pn = 8 + ct;
            u.B = S.WDTb + ((size_t)(4 * (bk / 6) + lo) * 1024 + ct * 256) * 1024 * 2; u.B2 = S.WDTb + ((size_t)(4 * (bk / 6) + hi) * 1024 + ct * 256) * 1024 * 2; }
        else { u.A = S.TSb; u.pn = ct; const int e = 4 * (bk / 6) + ((ct >> 2) ? hi : lo);
            u.B = S.WGUb + (size_t)(e * 4 + (ct & 3)) * 256 * 1024 * 2; u.B2 = u.B + 8 * 128; }
        return true;
    }
    __device__ __forceinline__ int arow(const Unit& u, int rr) const { return S.arow(u, rr); }
};
struct EpiMoe {
    static constexpr bool MIDSCALE = false;
    unsigned char* ws; float* out; unsigned* ctl;
    __device__ __forceinline__ void operator()(const Acc& acc, const Unit& u, int wr, int wc, int fr_, int fq_) const {
        int fr = fr_, fq = fq_; asm volatile("" : "+v"(fr), "+v"(fq));
        if (u.pn < 8) {
            const int rowb = u.pm * 256 + wr * 64 + fr, slot = u.pn >> 2, ffb = u.pn & 3;
            const float* PR = (const float*)(ws + WS_PR); const float* PW = (const float*)(ws + (slot ? WS_PW1 : WS_PW0));
            const __amdgpu_buffer_rsrc_t rs = __builtin_amdgcn_make_buffer_rsrc(ws + WS_HE, 0, (int)((size_t)NPOS * 1024 * 2), 0x00020000);
#pragma unroll
            for (int ai = 0; ai < 2; ++ai)
#pragma unroll
                for (int m = 0; m < 4; ++m) { const int row = rowb + ai * 128 + m * 16; const float r = PR[row], w = PW[row];
                    f32x4 o[2];
#pragma unroll
                    for (int n = 0; n < 2; ++n) { const f32x4 gt = acc[ai][0][m][n] * r, up = acc[ai][1][m][n] * r;
#pragma unroll
                        for (int j = 0; j < 4; ++j) { const float sg = gt[j] * __builtin_amdgcn_rcpf(1.f + __expf(-gt[j])); o[n][j] = sg * up[j] * w; } }
                    __builtin_amdgcn_raw_buffer_store_b128(pk8(o[0], o[1]), rs, (int)(((unsigned)row * 1024u + (unsigned)(slot * 512 + ffb * 128 + 32 * wc + 8 * fq)) * 2u), 0, 16); }
            asm volatile("s_waitcnt vmcnt(0)" ::: "memory");
            if (fr == 0 && fq == 0) __hip_atomic_fetch_add(ctl + CW_RT + 64 * u.pm, 1u, __ATOMIC_RELAXED, __HIP_MEMORY_SCOPE_AGENT);
        } else {
            const int rowb = u.pm * 256 + wr * 64 + fr, colb = (u.pn - 8) * 256 + 32 * wc + 8 * fq; const int* TOK = (const int*)(ws + WS_TOK); const f16* H2 = (const f16*)(ws + WS_H2H);
            int tok[2][4];
#pragma unroll
            for (int ai = 0; ai < 2; ++ai)
#pragma unroll
                for (int m = 0; m < 4; ++m) tok[ai][m] = TOK[rowb + ai * 128 + m * 16];
#pragma unroll
            for (int ai = 0; ai < 2; ++ai) { f16x8 hv[4][2];
#pragma unroll
                for (int m = 0; m < 4; ++m) { const size_t ro = (size_t)(tok[ai][m] < 0 ? 0 : tok[ai][m]) * 1024 + colb;
#pragma unroll
                    for (int bj = 0; bj < 2; ++bj) hv[m][bj] = *(const f16x8*)(H2 + ro + 128 * bj); }
#pragma unroll
                for (int m = 0; m < 4; ++m) { if (tok[ai][m] >= 0) { const size_t ro = (size_t)tok[ai][m] * 1024 + colb;
#pragma unroll
                    for (int bj = 0; bj < 2; ++bj) { const size_t o = ro + 128 * bj;
                        f32x4 v0 = acc[ai][bj][m][0], v1 = acc[ai][bj][m][1];
#pragma unroll
                        for (int j = 0; j < 4; ++j) { v0[j] += (float)hv[m][bj][j]; v1[j] += (float)hv[m][bj][4 + j]; }
                        *(f32x4*)(out + o) = v0; *(f32x4*)(out + o + 4) = v1; } } } }
        }
    }
};

#ifndef MK_N_LAUNCHES
#define MK_N_LAUNCHES 1
#endif
constexpr int N_PHASES = 13;
__global__ void __launch_bounds__(NTHR, 2) fwd_kernel(Params P) {
    extern __shared__ __attribute__((aligned(16))) unsigned char lds_raw[];
    Frame F;
    F.lds = (LAS unsigned char*)lds_raw; F.MISC = (volatile LAS unsigned*)(F.lds + LDS_MISC);
    F.G = gridDim.x; F.bx = blockIdx.x; F.vcu = (F.G % 8 == 0) ? (F.bx % 8) * (F.G / 8) + F.bx / 8 : F.bx;
    F.ws = P.ws; F.out = P.out; F.ctl = (unsigned*)(P.ws + WS_CTL);
    for (int u = fresh_tid(); u < (LDS_BYTES - LDS_MISC) / 4; u += NTHR) ((LAS unsigned*)(F.lds + LDS_MISC))[u] = 0u;
    __syncthreads();
    const int lo = P.ph_lo, hi = P.ph_hi;
    const bool multi = (hi - lo) > 1;
    XcdBarrier bar; bar.bar = F.ctl + CW_BAR; bar.x = 0; bar.st = F.MISC;
    if (multi) bar = xcd_barrier_post(F.ctl + CW_BAR, F.MISC);
#define IN(k) (lo <= (k) && (k) < hi)
#define SEAM(k) do { if (IN(k) && IN((k) + 1)) xcd_barrier(bar); } while (0)
    unsigned char* ws = F.ws;
#ifndef PROBE_DUP
#define PROBE_DUP -1
#endif
#define RUN(k, ...) do { if (IN(k)) { __VA_ARGS__ if (PROBE_DUP == (k)) { xcd_barrier(bar); __VA_ARGS__ } } SEAM(k); } while (0)
    RUN(0, { p0_prologue(F, P); });
    RUN(1, {
        { SchedP1N S{ws, F.G, F.bx}; EpiP1N E{ws, P.in[12]}; pg8::gemm_phase<EpiP1N, SchedP1N, true>(F.lds, 1024, 1024, 1024, S, E); }
        { SchedP1S S{ws, F.G, (F.bx + F.G - 160) % F.G}; EpiP1S E{ws}; pg8::gemm_phase<EpiP1S, SchedP1S, true>(F.lds, 1024, 1024, 1024, S, E); }
    });
    RUN(2, {
        p2_kprime(F, P);
        { SchedGrid S{(const char*)(ws + WS_CQ), (const char*)(ws + WS_WUQ), (size_t)256 * 384 * 2, (size_t)256 * 384 * 2, 128, 3, F.G, F.bx}; EpiP2Q E{ws, P.in[9], P.in[10]};
          pg8::gemm_phase<EpiP2Q, SchedGrid, true>(F.lds, 384, 384, 384, S, E); }
        { SchedGrid S{(const char*)(ws + WS_CKV), (const char*)(ws + WS_WUKN), (size_t)256 * 256 * 2, (size_t)256 * 256 * 2, 128, 2, F.G, (F.bx + F.G - 128) % F.G}; EpiP2K E{ws, P.in[11]};
          pg8::gemm_phase<EpiP2K, SchedGrid, true>(F.lds, 256, 256, 256, S, E); }
        { SchedGrid S{(const char*)(ws + WS_WUKV), (const char*)(ws + WS_CKV), (size_t)256 * 256 * 2, (size_t)256 * 256 * 2, 2, 128, F.G, (F.bx + F.G - 128) % F.G}; EpiP2V E{ws};
          pg8::gemm_phase<EpiP2V, SchedGrid, true>(F.lds, 256, 256, 256, S, E); }
    });
    RUN(3, { p3_attention(F); });
    if (PROBE_DUP == 31 && IN(3)) { p3_attention<true, false>(F); xcd_barrier(bar); }
    if (PROBE_DUP == 32 && IN(3)) { p3_attention<false, true>(F); xcd_barrier(bar); }
    RUN(5, { SchedGrid S{(const char*)(ws + WS_ATT), (const char*)(ws + WS_WO), (size_t)256 * 1024 * 2, (size_t)256 * 1024 * 2, 128, 4, F.G, F.bx}; EpiWo E{ws, P.in[0], (LAS const float*)(F.lds + WO_TAB_OFF)};
        wo_table(F, S); pg8::gemm_phase<EpiWo, SchedGrid, true>(F.lds, 1024, 1024, 1024, S, E); });
    RUN(6, { SchedGrid S{(const char*)(ws + WS_H1H), (const char*)(ws + WS_WMQ), (size_t)256 * 1024 * 2, (size_t)256 * 1024 * 2, 128, 4, F.G, F.bx}; EpiMq E{ws};
        pg8::gemm_phase<EpiMq, SchedGrid, true>(F.lds, 1024, 1024, 1024, S, E); });
    RUN(7, { p6_memattn(F); });
    RUN(8, { SchedGrid S{(const char*)(ws + WS_MO), (const char*)(ws + WS_WMO), (size_t)256 * 1024 * 2, (size_t)256 * 1024 * 2, 128, 4, F.G, F.bx}; EpiMo E{ws};
        pg8::gemm_phase<EpiMo, SchedGrid, true>(F.lds, 1024, 1024, 1024, S, E); });
    if (PROBE_DUP == 90 && IN(9)) { p8_route(F, P, 2048); xcd_barrier(bar); }
    RUN(9, { p8_route(F, P); });
    RUN(10, { p9_gather(F); });
#ifndef MOE_SPLIT
#define MOE_SPLIT 1
#endif
#if MOE_SPLIT
    RUN(11, { moe_tiles(F); SchedMoeAll S0{(const char*)(ws + WS_H2H), (const char*)(ws + WS_HE), (const char*)(ws + WS_WGU), (const char*)(ws + WS_WD2), (const int*)(ws + WS_TOK), (LAS const int*)(F.lds + LDS_MISC) + 32, (LAS const int*)(F.lds + MOE_ITAB_OFF), F.ctl, F.G, F.vcu};
        SchedMoePart<0> S{S0, S0.tok}; moe_itab(F, S);
        EpiMoe E{ws, P.out, F.ctl}; pg8::gemm_phase<EpiMoe, SchedMoePart<0>, true, true, true>(F.lds, 1024, 1024, 1024, S, E); });
    RUN(12, { moe_tiles(F); SchedMoeAll S0{(const char*)(ws + WS_H2H), (const char*)(ws + WS_HE), (const char*)(ws + WS_WGU), (const char*)(ws + WS_WD2), (const int*)(ws + WS_TOK), (LAS const int*)(F.lds + LDS_MISC) + 32, (LAS const int*)(F.lds + MOE_ITAB_OFF), F.ctl, F.G, F.vcu};
        SchedMoePart<1> S{S0, S0.tok};
        EpiMoe E{ws, P.out, F.ctl}; pg8::gemm_phase<EpiMoe, SchedMoePart<1>, true, true, true>(F.lds, 1024, 1024, 1024, S, E); });
#else
    RUN(11, { moe_tiles(F); SchedMoeAll S{(const char*)(ws + WS_H2H), (const char*)(ws + WS_HE), (const char*)(ws + WS_WGU), (const char*)(ws + WS_WD2), (const int*)(ws + WS_TOK), (LAS const int*)(F.lds + LDS_MISC) + 32, (LAS const int*)(F.lds + MOE_ITAB_OFF), F.ctl, F.G, F.vcu};
        moe_itab(F, S);
        EpiMoe E{ws, P.out, F.ctl}; pg8::gemm_phase<EpiMoe, SchedMoeAll, true, true, true>(F.lds, 1024, 1024, 1024, S, E); });
#endif
#undef RUN
#undef IN
#undef SEAM
}

extern "C" void kernel_launch(void* const* d_in, const int* in_sizes, int n_in, void* d_out, int out_size, void* d_ws, size_t ws_size, hipStream_t stream) {
    static int grid = 0;
    if (grid == 0) {
        if (n_in != 31 || out_size != T * D || ws_size < WS_END) { fprintf(stderr, "kernel_launch: unexpected shapes (n_in %d, out %d, ws %zu < %zu)\n", n_in, out_size, ws_size, (size_t)WS_END); grid = -1; return; }
        int dev = 0, cus = 0, per_cu = 0;
        if (hipGetDevice(&dev) != hipSuccess || hipDeviceGetAttribute(&cus, hipDeviceAttributeMultiprocessorCount, dev) != hipSuccess) { grid = -1; return; }
        if (hipFuncSetAttribute((const void*)fwd_kernel, hipFuncAttributeMaxDynamicSharedMemorySize, LDS_BYTES) != hipSuccess) { fprintf(stderr, "kernel_launch: hipFuncSetAttribute failed\n"); grid = -1; return; }
        if (hipOccupancyMaxActiveBlocksPerMultiprocessor(&per_cu, (const void*)fwd_kernel, NTHR, LDS_BYTES) != hipSuccess || per_cu < 1) { fprintf(stderr, "kernel_launch: occupancy query says %d\n", per_cu); }
        (void)hipGetLastError();
        grid = cus;
    }
    if (grid < 0) return;
    (void)hipMemsetAsync((char*)d_ws + WS_CTL, 0, CTL_ZERO_BYTES, stream);
    Params p{};
    for (int i = 0; i < 31; ++i) p.in[i] = (const float*)d_in[i];
    p.out = (float*)d_out; p.ws = (unsigned char*)d_ws;
    if (MK_N_LAUNCHES == 1) { p.ph_lo = 0; p.ph_hi = N_PHASES; hipLaunchKernelGGL(fwd_kernel, dim3(grid), dim3(NTHR), LDS_BYTES, stream, p); }
    else { for (int k = 0; k < N_PHASES; ++k) { p.ph_lo = k; p.ph_hi = k + 1; hipLaunchKernelGGL(fwd_kernel, dim3(grid), dim3(NTHR), LDS_BYTES, stream, p); } }
}
```
